# Optimizing an MI355X kernel written in HIP

```python
import jax, jax.numpy as jnp
from jax import lax
import numpy as np

D_MODEL = 1024
BATCH = 16
SEQ = 2048
DEPTH = 2
DEC_BATCH = 8
DEC_SEQ = 16
PAST_LEN = 1024

CHUNK = 64
CONV_W = 4
EPS = 1e-6
SSD_HEADS = 16
SSD_HEAD_DIM = 64
SSD_INNER = SSD_HEADS * SSD_HEAD_DIM
SSD_GROUPS = 2
SSD_STATE = 64
SSD_CONV_DIM = SSD_INNER + 2 * SSD_GROUPS * SSD_STATE
LRU_WIDTH = 1024
LRU_BLOCKS = 16
LRU_BLOCK_DIM = LRU_WIDTH // LRU_BLOCKS
LRU_C = 8.0
PEER_HEADS = 8
PEER_KEYS = 128
PEER_EXPERTS = PEER_KEYS * PEER_KEYS
PEER_KEY_DIM = 256
PEER_TOPK = 16
PEER_BLOCK = 128
Z_END = SSD_INNER
XBC_END = Z_END + SSD_CONV_DIM
DT_END = XBC_END + SSD_HEADS
LX_END = DT_END + LRU_WIDTH
LY_END = LX_END + LRU_WIDTH
GS_END = LY_END + D_MODEL
IN_COLS = GS_END + D_MODEL

kernel_name = 'hybrid_ssd_rglru_peer_stream_step'


def rmsnorm(x, w):
    xf = x.astype(jnp.float32)
    y = xf * lax.rsqrt(jnp.mean(xf * xf, axis=-1, keepdims=True) + EPS)
    return (y * w.astype(jnp.float32)).astype(x.dtype)


def causal_conv(x, buf, w, b):
    L = x.shape[1]
    xp = jnp.concatenate([buf.astype(x.dtype), x], axis=1)
    y = b + w[0] * xp[:, 0:L]
    for k in range(1, CONV_W):
        y = y + w[k] * xp[:, k:k + L]
    return y, xp[:, -(CONV_W - 1):]


def ssd_scan(x, dt, a, bm, cm, h0):
    f32 = jnp.float32
    bsz, L = x.shape[0], x.shape[1]
    nc = -(-L // CHUNK)
    pad = nc * CHUNK - L
    hg = SSD_HEADS // SSD_GROUPS
    def padl(t):
        return jnp.pad(t.astype(f32), [(0, 0), (0, pad)] + [(0, 0)] * (t.ndim - 2))
    xc = padl(x).reshape(bsz, nc, CHUNK, SSD_GROUPS, hg, SSD_HEAD_DIM)
    dtc = padl(dt).reshape(bsz, nc, CHUNK, SSD_GROUPS, hg)
    bc = padl(bm).reshape(bsz, nc, CHUNK, SSD_GROUPS, SSD_STATE)
    cc = padl(cm).reshape(bsz, nc, CHUNK, SSD_GROUPS, SSD_STATE)
    acum = jnp.cumsum(dtc * a.astype(f32).reshape(SSD_GROUPS, hg), axis=2)
    causal = jnp.tril(jnp.ones((CHUNK, CHUNK), dtype=bool))[None, None, :, :, None, None]
    seg = acum[:, :, :, None] - acum[:, :, None, :]
    decay = jnp.exp(jnp.where(causal, seg, -jnp.inf))
    cb = jnp.einsum('bcqgn,bcsgn->bcqsg', cc, bc)
    wts = cb[..., None] * decay * dtc[:, :, None]
    y_diag = jnp.einsum('bcqsgh,bcsghp->bcqghp', wts, xc)
    decay_end = jnp.exp(acum[:, :, -1:] - acum)
    chunk_states = jnp.einsum('bcsgn,bcsghp->bcghpn', bc, (decay_end * dtc)[..., None] * xc)
    chunk_decay = jnp.exp(acum[:, :, -1])
    h0g = h0.astype(f32).reshape(bsz, SSD_GROUPS, hg, SSD_HEAD_DIM, SSD_STATE)
    def step(h, inp):
        dec, st = inp
        return dec[..., None, None] * h + st, h
    h_fin, h_in = lax.scan(step, h0g, (jnp.moveaxis(chunk_decay, 1, 0), jnp.moveaxis(chunk_states, 1, 0)))
    h_in = jnp.moveaxis(h_in, 0, 1)
    y_off = jnp.einsum('bcqgn,bcghpn->bcqghp', cc, h_in) * jnp.exp(acum)[..., None]
    y = (y_diag + y_off).reshape(bsz, nc * CHUNK, SSD_HEADS, SSD_HEAD_DIM)[:, :L]
    return y, h_fin.reshape(bsz, SSD_HEADS, SSD_HEAD_DIM, SSD_STATE)


def rglru(xb, h0, wa, ba, wx, bx, lam):
    f32 = jnp.float32
    bsz, L = xb.shape[0], xb.shape[1]
    xf = xb.astype(f32)
    xblk = xf.reshape(bsz, L, LRU_BLOCKS, LRU_BLOCK_DIM)
    r = jax.nn.sigmoid(jnp.einsum('blnd,nde->blne', xblk, wa.astype(f32)).reshape(bsz, L, LRU_WIDTH) + ba.astype(f32))
    i = jax.nn.sigmoid(jnp.einsum('blnd,nde->blne', xblk, wx.astype(f32)).reshape(bsz, L, LRU_WIDTH) + bx.astype(f32))
    log_a = -LRU_C * r * jax.nn.softplus(-lam.astype(f32))
    a = jnp.exp(log_a)
    u = jnp.sqrt(-jnp.expm1(2.0 * log_a)) * (i * xf)
    def step(h, inp):
        a_t, u_t = inp
        h = a_t * h + u_t
        return h, h
    h_last, hs = lax.scan(step, h0.astype(f32), (jnp.swapaxes(a, 0, 1), jnp.swapaxes(u, 0, 1)))
    return jnp.swapaxes(hs, 0, 1), h_last


def token_mixer(h, ssd_h0, ssd_buf, lru_h0, lru_buf, w_in, ssd_conv_w, ssd_conv_b, ssd_dt_bias, ssd_a_log,
                ssd_d, ssd_norm_w, lru_conv_w, lru_conv_b, lru_wa, lru_ba, lru_wx, lru_bx, lru_lambda,
                w_br_ssd, w_br_lru, w_out):
    bsz, L = h.shape[0], h.shape[1]
    proj = h @ w_in
    z, xbc, dt, lx, ly, g_ssd, g_lru = jnp.split(proj, [Z_END, XBC_END, DT_END, LX_END, LY_END, GS_END], axis=-1)
    xbc, ssd_buf_new = causal_conv(xbc, ssd_buf, ssd_conv_w, ssd_conv_b)
    xbc = jax.nn.silu(xbc)
    xs, bm, cm = jnp.split(xbc, [SSD_INNER, SSD_INNER + SSD_GROUPS * SSD_STATE], axis=-1)
    xs = xs.reshape(bsz, L, SSD_HEADS, SSD_HEAD_DIM)
    bm = bm.reshape(bsz, L, SSD_GROUPS, SSD_STATE)
    cm = cm.reshape(bsz, L, SSD_GROUPS, SSD_STATE)
    dtf = jax.nn.softplus(dt.astype(jnp.float32) + ssd_dt_bias.astype(jnp.float32))
    a = -jnp.exp(ssd_a_log.astype(jnp.float32))
    y, ssd_h_new = ssd_scan(xs, dtf, a, bm, cm, ssd_h0)
    y = y + ssd_d.astype(jnp.float32)[:, None] * xs.astype(jnp.float32)
    y = y.reshape(bsz, L, SSD_INNER).astype(h.dtype) * jax.nn.silu(z)
    y_ssd = rmsnorm(y, ssd_norm_w)
    lx, lru_buf_new = causal_conv(lx, lru_buf, lru_conv_w, lru_conv_b)
    hs, lru_h_new = rglru(lx, lru_h0, lru_wa, lru_ba, lru_wx, lru_bx, lru_lambda)
    y_lru = hs.astype(h.dtype) * jax.nn.gelu(ly)
    merged = jax.nn.sigmoid(g_ssd) * (y_ssd @ w_br_ssd) + jax.nn.sigmoid(g_lru) * (y_lru @ w_br_lru)
    return merged @ w_out, ssd_h_new, ssd_buf_new, lru_h_new, lru_buf_new


def peer(h, wq, k1, k2, u, v):
    f32 = jnp.float32
    bsz, L, D = h.shape
    T = bsz * L
    hf = h.reshape(T, D)
    q = (hf @ wq).astype(f32).reshape(T, PEER_HEADS, PEER_KEY_DIM)
    half = PEER_KEY_DIM // 2
    s1 = jnp.einsum('thd,kd->thk', q[..., :half], k1.astype(f32))
    s2 = jnp.einsum('thd,kd->thk', q[..., half:], k2.astype(f32))
    v1, i1 = lax.top_k(s1, PEER_TOPK)
    v2, i2 = lax.top_k(s2, PEER_TOPK)
    cand = (v1[..., :, None] + v2[..., None, :]).reshape(T, PEER_HEADS, PEER_TOPK * PEER_TOPK)
    sv, si = lax.top_k(cand, PEER_TOPK)
    e = (jnp.take_along_axis(i1, si // PEER_TOPK, axis=-1) * PEER_KEYS
         + jnp.take_along_axis(i2, si % PEER_TOPK, axis=-1))
    g = jax.nn.softmax(sv, axis=-1)
    e = e.reshape(T, PEER_HEADS * PEER_TOPK)
    g = g.reshape(T, PEER_HEADS * PEER_TOPK).astype(h.dtype)
    nb = -(-T // PEER_BLOCK)
    pad = nb * PEER_BLOCK - T
    hb = jnp.pad(hf, ((0, pad), (0, 0))).reshape(nb, PEER_BLOCK, D)
    eb = jnp.pad(e, ((0, pad), (0, 0))).reshape(nb, PEER_BLOCK, PEER_HEADS * PEER_TOPK)
    gb = jnp.pad(g, ((0, pad), (0, 0))).reshape(nb, PEER_BLOCK, PEER_HEADS * PEER_TOPK)
    def blk(args):
        hx, ex, gx = args
        act = jax.nn.gelu(jnp.einsum('td,tkd->tk', hx, u[ex])) * gx
        return jnp.einsum('tk,tkd->td', act, v[ex])
    out = lax.map(blk, (hb, eb, gb)).reshape(nb * PEER_BLOCK, D)[:T]
    return out.reshape(bsz, L, D)


def layer(x, c, ssd_h0, ssd_buf, lru_h0, lru_buf, ln1_w, ln2_w, w_mod, b_mod, w_in, ssd_conv_w, ssd_conv_b,
          ssd_dt_bias, ssd_a_log, ssd_d, ssd_norm_w, lru_conv_w, lru_conv_b, lru_wa, lru_ba, lru_wx, lru_bx,
          lru_lambda, w_br_ssd, w_br_lru, w_out, peer_wq, peer_k1, peer_k2, peer_u, peer_v):
    mod = (jax.nn.silu(c) @ w_mod + b_mod)[:, None, :]
    sh1, sc1, g1, sh2, sc2, g2 = jnp.split(mod, 6, axis=-1)
    h = rmsnorm(x, ln1_w) * (1.0 + sc1) + sh1
    tm, ssd_h, ssd_b, lru_h, lru_b = token_mixer(
        h, ssd_h0, ssd_buf, lru_h0, lru_buf, w_in, ssd_conv_w, ssd_conv_b, ssd_dt_bias, ssd_a_log, ssd_d,
        ssd_norm_w, lru_conv_w, lru_conv_b, lru_wa, lru_ba, lru_wx, lru_bx, lru_lambda, w_br_ssd, w_br_lru, w_out)
    x = x + g1 * tm
    h = rmsnorm(x, ln2_w) * (1.0 + sc2) + sh2
    x = x + g2 * peer(h, peer_wq, peer_k1, peer_k2, peer_u, peer_v)
    return x, ssd_h, ssd_b, lru_h, lru_b


def trunk(x, c, ssd_h, ssd_buf, lru_h, lru_buf, layer_w, final_norm_w):
    n_ssd, n_sbuf, n_lru, n_lbuf = [], [], [], []
    for l in range(DEPTH):
        wl = [w[l] for w in layer_w]
        x, sh, sb, lh, lb = layer(x, c, ssd_h[l], ssd_buf[l], lru_h[l], lru_buf[l], *wl)
        n_ssd.append(sh)
        n_sbuf.append(sb)
        n_lru.append(lh)
        n_lbuf.append(lb)
    y = rmsnorm(x, final_norm_w)
    return y, jnp.stack(n_ssd), jnp.stack(n_sbuf), jnp.stack(n_lru), jnp.stack(n_lbuf)


def setup_inputs(seed: int = 0) -> dict:
    key = jax.random.key(seed)
    ks = jax.random.split(key, 40)
    f32 = jnp.float32
    D = D_MODEL
    nrm = lambda k, shape, s: jax.random.normal(k, shape, f32) * s
    dt0 = jnp.exp(jax.random.uniform(ks[15], (DEPTH, SSD_HEADS), f32, np.log(1e-3), np.log(1e-1)))
    a0 = jax.random.uniform(ks[22], (DEPTH, LRU_WIDTH), f32, 0.9, 0.999)
    s0 = a0 ** (1.0 / LRU_C)
    return {
        'x_prompt': nrm(ks[0], (BATCH, SEQ, D), 1.0),
        'x_sample': nrm(ks[1], (DEC_BATCH, DEC_SEQ, D), 1.0),
        'c_prompt': nrm(ks[2], (BATCH, D), 1.0),
        'c_sample': nrm(ks[3], (DEC_BATCH, D), 1.0),
        'state_ssd': nrm(ks[4], (DEPTH, DEC_BATCH, SSD_HEADS, SSD_HEAD_DIM, SSD_STATE), 0.3),
        'state_ssd_conv': nrm(ks[5], (DEPTH, DEC_BATCH, CONV_W - 1, SSD_CONV_DIM), 1.0),
        'state_lru': nrm(ks[6], (DEPTH, DEC_BATCH, LRU_WIDTH), 0.5),
        'state_lru_conv': nrm(ks[7], (DEPTH, DEC_BATCH, CONV_W - 1, LRU_WIDTH), 1.0),
        'ln1_w': 1.0 + nrm(ks[8], (DEPTH, D), 0.02),
        'ln2_w': 1.0 + nrm(ks[9], (DEPTH, D), 0.02),
        'w_mod': nrm(ks[10], (DEPTH, D, 6 * D), 0.5 * D ** -0.5),
        'b_mod': nrm(ks[11], (DEPTH, 6 * D), 0.02),
        'w_in': nrm(ks[12], (DEPTH, D, IN_COLS), D ** -0.5),
        'ssd_conv_w': nrm(ks[13], (DEPTH, CONV_W, SSD_CONV_DIM), 0.5),
        'ssd_conv_b': nrm(ks[14], (DEPTH, SSD_CONV_DIM), 0.02),
        'ssd_dt_bias': dt0 + jnp.log(-jnp.expm1(-dt0)),
        'ssd_a_log': jnp.log(jax.random.uniform(ks[16], (DEPTH, SSD_HEADS), f32, 1.0, 16.0)),
        'ssd_d': 1.0 + nrm(ks[17], (DEPTH, SSD_HEADS), 0.02),
        'ssd_norm_w': 1.0 + nrm(ks[18], (DEPTH, SSD_INNER), 0.02),
        'lru_conv_w': nrm(ks[19], (DEPTH, CONV_W, LRU_WIDTH), 0.5),
        'lru_conv_b': nrm(ks[20], (DEPTH, LRU_WIDTH), 0.02),
        'lru_wa': nrm(ks[21], (DEPTH, LRU_BLOCKS, LRU_BLOCK_DIM, LRU_BLOCK_DIM), LRU_BLOCK_DIM ** -0.5),
        'lru_ba': nrm(ks[23], (DEPTH, LRU_WIDTH), 0.02),
        'lru_wx': nrm(ks[24], (DEPTH, LRU_BLOCKS, LRU_BLOCK_DIM, LRU_BLOCK_DIM), LRU_BLOCK_DIM ** -0.5),
        'lru_bx': nrm(ks[25], (DEPTH, LRU_WIDTH), 0.02),
        'lru_lambda': jnp.log(s0) - jnp.log1p(-s0),
        'w_br_ssd': nrm(ks[26], (DEPTH, SSD_INNER, D), SSD_INNER ** -0.5),
        'w_br_lru': nrm(ks[27], (DEPTH, LRU_WIDTH, D), LRU_WIDTH ** -0.5),
        'w_out': nrm(ks[28], (DEPTH, D, D), D ** -0.5),
        'peer_wq': nrm(ks[29], (DEPTH, D, PEER_HEADS * PEER_KEY_DIM), D ** -0.5),
        'peer_k1': nrm(ks[30], (DEPTH, PEER_KEYS, PEER_KEY_DIM // 2), (PEER_KEY_DIM // 2) ** -0.5),
        'peer_k2': nrm(ks[31], (DEPTH, PEER_KEYS, PEER_KEY_DIM // 2), (PEER_KEY_DIM // 2) ** -0.5),
        'peer_u': nrm(ks[32], (DEPTH, PEER_EXPERTS, D), D ** -0.5),
        'peer_v': nrm(ks[33], (DEPTH, PEER_EXPERTS, D), 0.2),
        'final_norm_w': 1.0 + nrm(ks[34], (D,), 0.02),
    }


def reference(x_prompt, x_sample, c_prompt, c_sample, state_ssd, state_ssd_conv, state_lru, state_lru_conv,
              ln1_w, ln2_w, w_mod, b_mod, w_in, ssd_conv_w, ssd_conv_b, ssd_dt_bias, ssd_a_log, ssd_d,
              ssd_norm_w, lru_conv_w, lru_conv_b, lru_wa, lru_ba, lru_wx, lru_bx, lru_lambda, w_br_ssd,
              w_br_lru, w_out, peer_wq, peer_k1, peer_k2, peer_u, peer_v, final_norm_w):
    layer_w = (ln1_w, ln2_w, w_mod, b_mod, w_in, ssd_conv_w, ssd_conv_b, ssd_dt_bias, ssd_a_log, ssd_d,
               ssd_norm_w, lru_conv_w, lru_conv_b, lru_wa, lru_ba, lru_wx, lru_bx, lru_lambda, w_br_ssd,
               w_br_lru, w_out, peer_wq, peer_k1, peer_k2, peer_u, peer_v)
    bp = x_prompt.shape[0]
    z_ssd = jnp.zeros((DEPTH, bp, SSD_HEADS, SSD_HEAD_DIM, SSD_STATE), jnp.float32)
    z_sconv = jnp.zeros((DEPTH, bp, CONV_W - 1, SSD_CONV_DIM), x_prompt.dtype)
    z_lru = jnp.zeros((DEPTH, bp, LRU_WIDTH), jnp.float32)
    z_lconv = jnp.zeros((DEPTH, bp, CONV_W - 1, LRU_WIDTH), x_prompt.dtype)
    y_prompt, p_ssd, p_sconv, p_lru, p_lconv = trunk(
        x_prompt, c_prompt, z_ssd, z_sconv, z_lru, z_lconv, layer_w, final_norm_w)
    y_sample, s_ssd, s_sconv, s_lru, s_lconv = trunk(
        x_sample, c_sample, state_ssd, state_ssd_conv, state_lru, state_lru_conv, layer_w, final_norm_w)
    return (y_prompt, y_sample, p_ssd, p_sconv, p_lru, p_lconv, s_ssd, s_sconv, s_lru, s_lconv)
```

```cpp
#include <hip/hip_runtime.h>
#include <hip/hip_cooperative_groups.h>
#include <cstdio>
#include <cstdint>
namespace cg = cooperative_groups;

#ifndef MEGA
#define MEGA 0
#endif

#define LAS __attribute__((address_space(3)))
typedef unsigned short bf16_t;
typedef __bf16 bf16x2_t __attribute__((ext_vector_type(2)));
typedef short bf16x8 __attribute__((ext_vector_type(8)));
typedef float f32x4 __attribute__((ext_vector_type(4)));
typedef float f32x16 __attribute__((ext_vector_type(16)));
typedef unsigned u32x4 __attribute__((ext_vector_type(4)));
typedef unsigned u32x2 __attribute__((ext_vector_type(2)));

constexpr int DM = 1024;
constexpr int TP = 32768, TS = 128, TT = TP + TS, MT = 33024;
constexpr int NBT = 24;
constexpr int N1 = 4608;
constexpr int NG = 2048;
constexpr int NE = 16384;
constexpr int INC = 6416;
constexpr float EPS = 1e-6f;
constexpr int NWAVES = 8, NTHREADS = 512;
constexpr int LDS_BYTES = 147456;

enum { IN_XP = 0, IN_XS, IN_CP, IN_CS, IN_SSD, IN_SSDCONV, IN_LRU, IN_LRUCONV, IN_LN1, IN_LN2, IN_WMOD, IN_BMOD, IN_WIN, IN_SCW, IN_SCB, IN_DTB,
       IN_ALOG, IN_SSDD, IN_SNW, IN_LCW, IN_LCB, IN_WA, IN_BA, IN_WX, IN_BX, IN_LAM, IN_WBS, IN_WBL, IN_WO, IN_WQ, IN_K1, IN_K2, IN_U, IN_V, IN_FNW, N_IN };

constexpr size_t O_Y = 0, O_PSSD = 33685504, O_PSCONV = 35782656, O_PLRU = 35905536, O_PLCONV = 35938304,
                 O_SSSD = 36036608, O_SSCONV = 37085184, O_SLRU = 37146624, O_SLCONV = 37163008, O_END = 37212160;

constexpr size_t al256(size_t x) { return (x + 255) & ~(size_t)255; }
constexpr size_t WS_CTL = 0;
constexpr size_t WS_MOD = 1u << 20;
constexpr size_t WS_DT = al256(WS_MOD + (size_t)2 * NBT * 6144 * 4);
constexpr size_t WS_SSQ = al256(WS_DT + (size_t)MT * 16 * 4);
constexpr size_t WS_W1T = al256(WS_SSQ + (size_t)MT * 16 * 4);
constexpr size_t WS_WGT = al256(WS_W1T + (size_t)2 * N1 * DM * 2);
constexpr size_t WS_WBS = al256(WS_WGT + (size_t)2 * NG * DM * 2);
constexpr size_t WS_WBL = al256(WS_WBS + (size_t)2 * DM * DM * 2);
constexpr size_t WS_WO = al256(WS_WBL + (size_t)2 * DM * DM * 2);
constexpr size_t WS_WC = al256(WS_WO + (size_t)2 * DM * DM * 2);
constexpr size_t WS_U16 = al256(WS_WC + (size_t)2 * 2048 * DM * 2);
constexpr size_t WS_V16 = al256(WS_U16 + (size_t)NE * DM * 2);
constexpr size_t WS_EI = al256(WS_V16 + (size_t)NE * DM * 2);
constexpr size_t WS_GW = al256(WS_EI + (size_t)MT * 128 * 4);
constexpr size_t WS_B0 = al256(WS_GW + (size_t)MT * 128 * 4);
constexpr size_t WS_B1 = al256(WS_B0 + (size_t)MT * DM * 2);
constexpr size_t WS_B2 = al256(WS_B1 + (size_t)MT * DM * 2);
constexpr size_t WS_B3 = al256(WS_B2 + (size_t)MT * 1280 * 2);
constexpr size_t WS_B4 = al256(WS_B3 + (size_t)MT * DM * 2);
constexpr size_t WS_END = al256(WS_B4 + (size_t)MT * DM * 2);
constexpr size_t WS_GS = WS_B2, WS_GL = WS_B2 + (size_t)MT * DM * 2;
constexpr size_t WS_SC = WS_B1;
static_assert(WS_GL + (size_t)MT * DM * 2 <= WS_B4, "gate overlay");
static_assert(WS_SC + (size_t)MT * 2048 * 4 <= WS_END, "score overlay");
static_assert(WS_END <= (size_t)512 << 20, "d_ws budget");

struct Params {
    const float* in[N_IN];
    float* out;
    unsigned char* ws;
    int ph_lo, ph_hi;
};

__device__ __forceinline__ unsigned f2bf(float f) { unsigned u = __float_as_uint(f); return (u + 0x7fffu + ((u >> 16) & 1u)) >> 16; }
__device__ __forceinline__ float bf2f(unsigned b) { return __uint_as_float(b << 16); }
__device__ __forceinline__ unsigned pk2(float lo, float hi) { return f2bf(lo) | (f2bf(hi) << 16); }
__device__ __forceinline__ float bflo(unsigned w) { return __uint_as_float(w << 16); }
__device__ __forceinline__ float bfhi(unsigned w) { return __uint_as_float(w & 0xffff0000u); }
__device__ __forceinline__ float wave_sum(float v) {
#pragma unroll
    for (int o = 1; o < 64; o <<= 1) v += __shfl_xor(v, o);
    return v;
}
__device__ __forceinline__ float sigmoidf_(float x) { return 1.0f / (1.0f + __expf(-x)); }
__device__ __forceinline__ float siluf_(float x) { return x / (1.0f + __expf(-x)); }
__device__ __forceinline__ float geluf_(float x) { const float u = 1.5957691216057308f * (x + 0.044715f * x * x * x); return x / (1.0f + __expf(-u)); }
__device__ __forceinline__ float softplusf_(float x) { return fmaxf(x, 0.f) + log1pf(__expf(-fabsf(x))); }
__device__ __forceinline__ int row_batch(int row) { return row < TP ? (row >> 11) : (row < TT ? 16 + ((row - TP) >> 4) : 23); }
__device__ __forceinline__ float dot2bf(unsigned a, unsigned b, float acc) { return __builtin_amdgcn_fdot2_f32_bf16(__builtin_bit_cast(bf16x2_t, a), __builtin_bit_cast(bf16x2_t, b), acc, false); }
__device__ __forceinline__ float rl(float v, int lane) { return __int_as_float(__builtin_amdgcn_readlane(__float_as_int(v), lane)); }
#define LDS_WAIT() asm volatile("s_waitcnt lgkmcnt(0)" ::: "memory")

struct Ctx {
    const Params* P; LAS unsigned char* lds; unsigned char* ws; float* out;
    int tid, lane, wave, bid, G;
};
#define WSP(T, off) ((T*)(C.ws + (off)))

__device__ __forceinline__ void tr_item(const float* W, int ldw, int src_col0, int valid, const float* kscale, int k0, bf16_t* dst, LAS float* scr, int lane) {
#pragma unroll 8
    for (int i = 0; i < 32; ++i) { const int kk = 2 * i + (lane >> 5), c = lane & 31;
        float v = (c < valid) ? W[(size_t)(k0 + kk) * ldw + src_col0 + c] : 0.f; if (kscale) v *= kscale[k0 + kk]; scr[kk * 33 + c] = v; }
    LDS_WAIT();
    const int c8 = lane & 7;
#pragma unroll
    for (int j = 0; j < 4; ++j) { const int n = (lane >> 3) + 8 * j; const LAS float* s = scr + (8 * c8) * 33 + n;
        u32x4 o; o.x = pk2(s[0 * 33], s[1 * 33]); o.y = pk2(s[2 * 33], s[3 * 33]); o.z = pk2(s[4 * 33], s[5 * 33]); o.w = pk2(s[6 * 33], s[7 * 33]);
        *(u32x4*)(dst + (size_t)n * DM + k0 + 8 * c8) = o; }
    LDS_WAIT();
}
__device__ __forceinline__ void convert_tables(const Ctx& C, int l) {
    const float* u = C.P->in[IN_U] + (size_t)l * NE * DM; const float* v = C.P->in[IN_V] + (size_t)l * NE * DM;
    bf16_t* U16 = WSP(bf16_t, WS_U16); bf16_t* V16 = WSP(bf16_t, WS_V16);
    const size_t n8 = (size_t)NE * DM / 8, stride = (size_t)C.G * NTHREADS;
    for (size_t i = (size_t)C.bid * NTHREADS + C.tid; i < 2 * n8; i += stride) {
        const bool isv = i >= n8; const size_t j = isv ? i - n8 : i;
        const f32x4 a = *(const f32x4*)((isv ? v : u) + j * 8), b = *(const f32x4*)((isv ? v : u) + j * 8 + 4);
        u32x4 o; o.x = pk2(a[0], a[1]); o.y = pk2(a[2], a[3]); o.z = pk2(b[0], b[1]); o.w = pk2(b[2], b[3]);
        *(u32x4*)((isv ? V16 : U16) + j * 8) = o;
    }
}
__device__ __forceinline__ void phase_prep(const Ctx& C) {
    const Params& P = *C.P;
    {
        LAS float* Kh = (LAS float*)C.lds;
        LAS float* Wq = (LAS float*)(C.lds + 128 * 132 * 4);
        bf16_t* WcT = WSP(bf16_t, WS_WC);
        for (int it = C.bid; it < 512; it += C.G) {
            const int l = it >> 8, h = (it >> 5) & 7, half = (it >> 4) & 1, jb = it & 15;
            const float* ksrc = P.in[half ? IN_K2 : IN_K1] + (size_t)l * 128 * 128;
            const float* wsrc = P.in[IN_WQ] + (size_t)l * DM * 2048 + (size_t)(jb * 64) * 2048 + h * 256 + half * 128;
            __syncthreads();
            for (int i = C.tid; i < 128 * 32; i += NTHREADS) { const int r = i >> 5, c4 = i & 31; *(LAS f32x4*)(Kh + r * 132 + c4 * 4) = *(const f32x4*)(ksrc + r * 128 + c4 * 4); }
            for (int i = C.tid; i < 64 * 32; i += NTHREADS) { const int r = i >> 5, c4 = i & 31; *(LAS f32x4*)(Wq + r * 132 + c4 * 4) = *(const f32x4*)(wsrc + (size_t)r * 2048 + c4 * 4); }
            __syncthreads();
            const int tk = C.tid & 31, tj = C.tid >> 5;
            float acc[4][4];
#pragma unroll
            for (int a = 0; a < 4; ++a)
#pragma unroll
                for (int b = 0; b < 4; ++b) acc[a][b] = 0.f;
            for (int d4 = 0; d4 < 32; ++d4) {
                f32x4 kv[4], wv[4];
#pragma unroll
                for (int a = 0; a < 4; ++a) { kv[a] = *(LAS f32x4*)(Kh + (tk + 32 * a) * 132 + d4 * 4); wv[a] = *(LAS f32x4*)(Wq + (4 * tj + a) * 132 + d4 * 4); }
#pragma unroll
                for (int a = 0; a < 4; ++a)
#pragma unroll
                    for (int b = 0; b < 4; ++b) acc[a][b] += kv[a][0] * wv[b][0] + kv[a][1] * wv[b][1] + kv[a][2] * wv[b][2] + kv[a][3] * wv[b][3];
            }
#pragma unroll
            for (int a = 0; a < 4; ++a) { const int n = h * 256 + half * 128 + tk + 32 * a;
                u32x2 o; o.x = pk2(acc[a][0], acc[a][1]); o.y = pk2(acc[a][2], acc[a][3]);
                *(u32x2*)(WcT + ((size_t)l * 2048 + n) * DM + jb * 64 + 4 * tj) = o; }
        }
        __syncthreads();
    }
    {
        LAS float* sc = (LAS float*)C.lds;
        for (int i = C.tid; i < NBT * DM; i += NTHREADS) { const int bb = i >> 10, k = i & 1023;
            const float cv = bb < 16 ? P.in[IN_CP][bb * DM + k] : P.in[IN_CS][(bb - 16) * DM + k]; sc[i] = siluf_(cv); }
        __syncthreads();
        float* MOD = WSP(float, WS_MOD);
        for (int it = C.bid; it < 192; it += C.G) {
            const int l = it / 96, cg_ = it % 96, j = cg_ * 64 + C.lane;
            const float* wm = P.in[IN_WMOD] + (size_t)l * DM * 6144 + j;
            float a0 = 0.f, a1 = 0.f, a2 = 0.f; const int b0 = 3 * C.wave;
#pragma unroll 8
            for (int k = 0; k < DM; ++k) { const float w = wm[(size_t)k * 6144]; a0 += sc[b0 * DM + k] * w; a1 += sc[(b0 + 1) * DM + k] * w; a2 += sc[(b0 + 2) * DM + k] * w; }
            const float bm = P.in[IN_BMOD][l * 6144 + j];
            MOD[((size_t)l * NBT + b0) * 6144 + j] = a0 + bm; MOD[((size_t)l * NBT + b0 + 1) * 6144 + j] = a1 + bm; MOD[((size_t)l * NBT + b0 + 2) * 6144 + j] = a2 + bm;
        }
        __syncthreads();
    }
    {
        LAS float* scr = (LAS float*)(C.lds + C.wave * 16384);
        const int gw = C.bid * NWAVES + C.wave, NGW = C.G * NWAVES;
        constexpr int I_W1 = 144 * 16, I_WG = 64 * 16, I_SQ = 32 * 16, PER_L = I_W1 + I_WG + 3 * I_SQ;
        for (int it = gw; it < 2 * PER_L; it += NGW) {
            const int l = it / PER_L; int r = it % PER_L;
            if (r < I_W1) { const int nb = r >> 4, kb = r & 15, n0 = nb * 32; int src, valid;
                if (n0 < 2304) { src = n0; valid = 32; } else if (n0 < 4352) { src = n0 + 16; valid = 32; } else if (n0 == 4352) { src = 2304; valid = 16; } else { src = 0; valid = 0; }
                tr_item(P.in[IN_WIN] + (size_t)l * DM * INC, INC, src, valid, nullptr, kb * 64, WSP(bf16_t, WS_W1T) + ((size_t)l * N1 + n0) * DM, scr, C.lane); continue; }
            r -= I_W1;
            if (r < I_WG) { const int nb = r >> 4, kb = r & 15, n0 = nb * 32;
                tr_item(P.in[IN_WIN] + (size_t)l * DM * INC, INC, 4368 + n0, 32, nullptr, kb * 64, WSP(bf16_t, WS_WGT) + ((size_t)l * NG + n0) * DM, scr, C.lane); continue; }
            r -= I_WG;
            const int which = r / I_SQ; r %= I_SQ; const int nb = r >> 4, kb = r & 15, n0 = nb * 32;
            const float* src = P.in[which == 0 ? IN_WBS : (which == 1 ? IN_WBL : IN_WO)] + (size_t)l * DM * DM;
            bf16_t* dst = WSP(bf16_t, which == 0 ? WS_WBS : (which == 1 ? WS_WBL : WS_WO)) + ((size_t)l * DM + n0) * DM;
            tr_item(src, DM, n0, 32, which == 0 ? P.in[IN_SNW] + l * DM : nullptr, kb * 64, dst, scr, C.lane);
        }
    }
    convert_tables(C, 0);
}

__device__ __forceinline__ void phase_norm(const Ctx& C, int l, int which) {
    const Params& P = *C.P;
    const int gw = C.bid * NWAVES + C.wave, NGW = C.G * NWAVES;
    bf16_t* H = WSP(bf16_t, WS_B0);
    const float* lw = P.in[which ? IN_LN2 : IN_LN1] + l * DM;
    const float* MOD = WSP(float, WS_MOD);
    for (int row = gw; row < MT; row += NGW) {
        u32x2* o8 = (u32x2*)(H + (size_t)row * DM) + C.lane;
        if (row >= TT) {
#pragma unroll
            for (int j = 0; j < 4; ++j) o8[64 * j] = (u32x2){0u, 0u};
            continue; }
        const float* src = (which == 0 && l == 0) ? (row < TP ? P.in[IN_XP] + (size_t)row * DM : P.in[IN_XS] + (size_t)(row - TP) * DM) : C.out + (size_t)row * DM;
        const f32x4* xr = (const f32x4*)src + C.lane;
        f32x4 v[4]; float s = 0.f;
#pragma unroll
        for (int j = 0; j < 4; ++j) { v[j] = xr[64 * j]; s += (v[j][0] * v[j][0] + v[j][1] * v[j][1]) + (v[j][2] * v[j][2] + v[j][3] * v[j][3]); }
        const float rstd = rsqrtf(wave_sum(s) * (1.f / DM) + EPS);
        const float* md = MOD + ((size_t)l * NBT + row_batch(row)) * 6144 + (which ? 3072 : 0);
#pragma unroll
        for (int j = 0; j < 4; ++j) { const int col = C.lane * 4 + 256 * j;
            const f32x4 w = *(const f32x4*)(lw + col), sh = *(const f32x4*)(md + col), scv = *(const f32x4*)(md + 1024 + col);
            const f32x4 y = (v[j] * rstd * w) * (scv + 1.0f) + sh;
            o8[64 * j] = (u32x2){pk2(y[0], y[1]), pk2(y[2], y[3])}; }
    }
    if (which == 0 && l == 1) convert_tables(C, 1);
}

struct Epi1 {
    bf16_t *Z, *XBC, *LX, *LY; float* DT; const float* dtb;
    __device__ __forceinline__ void apply(int, int row, int col, f32x4 v) const {
        if (col < 1024) { *(u32x2*)(Z + (size_t)row * DM + col) = (u32x2){pk2(siluf_(v[0]), siluf_(v[1])), pk2(siluf_(v[2]), siluf_(v[3]))}; }
        else if (col < 2304) { *(u32x2*)(XBC + (size_t)row * 1280 + (col - 1024)) = (u32x2){pk2(v[0], v[1]), pk2(v[2], v[3])}; }
        else if (col < 3328) { *(u32x2*)(LX + (size_t)row * DM + (col - 2304)) = (u32x2){pk2(v[0], v[1]), pk2(v[2], v[3])}; }
        else if (col < 4352) { *(u32x2*)(LY + (size_t)row * DM + (col - 3328)) = (u32x2){pk2(geluf_(v[0]), geluf_(v[1])), pk2(geluf_(v[2]), geluf_(v[3]))}; }
        else if (col < 4368) { const int c = col - 4352; const f32x4 b = *(const f32x4*)(dtb + c);
            *(f32x4*)(DT + (size_t)row * 16 + c) = (f32x4){softplusf_(v[0] + b[0]), softplusf_(v[1] + b[1]), softplusf_(v[2] + b[2]), softplusf_(v[3] + b[3])}; }
    }
};
struct Epi2 {
    bf16_t *GS, *GL;
    __device__ __forceinline__ void apply(int, int row, int col, f32x4 v) const {
        bf16_t* d = (col < 1024 ? GS + (size_t)row * DM + col : GL + (size_t)row * DM + (col - 1024));
        *(u32x2*)d = (u32x2){pk2(sigmoidf_(v[0]), sigmoidf_(v[1])), pk2(sigmoidf_(v[2]), sigmoidf_(v[3]))};
    }
};
struct Epi3 {
    const bf16_t *GS, *GL; const float* SSQ; bf16_t* MG;
    __device__ __forceinline__ void apply(int w, int row, int col, f32x4 v) const {
        u32x2* m = (u32x2*)(MG + (size_t)row * DM + col);
        if (w == 0) {
            const f32x4* q = (const f32x4*)(SSQ + (size_t)row * 16); const f32x4 a = q[0] + q[1] + q[2] + q[3];
            const float rstd = rsqrtf(((a[0] + a[1]) + (a[2] + a[3])) * (1.f / DM) + EPS);
            const u32x2 g = *(const u32x2*)(GS + (size_t)row * DM + col);
            *m = (u32x2){pk2(bflo(g.x) * rstd * v[0], bfhi(g.x) * rstd * v[1]), pk2(bflo(g.y) * rstd * v[2], bfhi(g.y) * rstd * v[3])};
        } else {
            const u32x2 g = *(const u32x2*)(GL + (size_t)row * DM + col); const u32x2 p = *m;
            *m = (u32x2){pk2(bflo(p.x) + bflo(g.x) * v[0], bfhi(p.x) + bfhi(g.x) * v[1]), pk2(bflo(p.y) + bflo(g.y) * v[2], bfhi(p.y) + bfhi(g.y) * v[3])};
        }
    }
};
struct Epi4 {
    const float *xp, *xs; float* XR; const float* MODl; int layer;
    __device__ __forceinline__ void apply(int, int row, int col, f32x4 v) const {
        if (row >= TT) return;
        const float* src = layer == 0 ? (row < TP ? xp + (size_t)row * DM : xs + (size_t)(row - TP) * DM) : XR + (size_t)row * DM;
        const f32x4 x = *(const f32x4*)(src + col), g = *(const f32x4*)(MODl + (size_t)row_batch(row) * 6144 + 2048 + col);
        *(f32x4*)(XR + (size_t)row * DM + col) = x + g * v;
    }
};
struct Epi5 {
    float* SC;
    __device__ __forceinline__ void apply(int, int row, int col, f32x4 v) const { *(f32x4*)(SC + (size_t)row * 2048 + col) = v; }
};

template <class Epi>
__device__ __forceinline__ void gemm_naive(const Ctx& C, const bf16_t* A0, const bf16_t* B0, const bf16_t* A1, const bf16_t* B1, int N, const Epi& E) {
    const int n4 = N / 4; const size_t items = (size_t)MT * n4, stride = (size_t)C.G * NTHREADS;
    for (size_t it = (size_t)C.bid * NTHREADS + C.tid; it < items; it += stride) {
        const int row = (int)(it / n4), col = (int)(it % n4) * 4;
        for (int w = 0; w < (A1 ? 2 : 1); ++w) {
            const u32x4* a = (const u32x4*)((w ? A1 : A0) + (size_t)row * DM); const u32x4* b = (const u32x4*)((w ? B1 : B0) + (size_t)col * DM);
            float acc[4] = {0.f, 0.f, 0.f, 0.f};
#pragma unroll 4
            for (int k = 0; k < DM / 8; ++k) { const u32x4 av = a[k];
#pragma unroll
                for (int j = 0; j < 4; ++j) { const u32x4 bv = b[j * (DM / 8) + k];
                    acc[j] = dot2bf(av.x, bv.x, acc[j]); acc[j] = dot2bf(av.y, bv.y, acc[j]); acc[j] = dot2bf(av.z, bv.z, acc[j]); acc[j] = dot2bf(av.w, bv.w, acc[j]); } }
            E.apply(w, row, col, (f32x4){acc[0], acc[1], acc[2], acc[3]});
        }
    }
}

__device__ __forceinline__ void ssd_item_naive(const Ctx& C, int l, int idx) {
    const Params& P = *C.P; const int lane = C.lane;
    const bool smp = idx >= 256; const int ii = smp ? idx - 256 : idx; const int b = ii >> 4, head = ii & 15, g = head >> 3;
    const int tok0 = smp ? TP + b * 16 : b * 2048, L = smp ? 16 : 2048, NB = smp ? 8 : 16;
    bf16_t* XBC = WSP(bf16_t, WS_B2); bf16_t* Z = WSP(bf16_t, WS_B1); const float* DT = WSP(float, WS_DT); float* SSQ = WSP(float, WS_SSQ);
    const float a = -__expf(P.in[IN_ALOG][l * 16 + head]), Dh = P.in[IN_SSDD][l * 16 + head];
    const int cx = head * 64 + lane, cB = 1024 + g * 64 + lane, cC = 1152 + g * 64 + lane;
    const float* cw = P.in[IN_SCW] + (size_t)l * 4 * 1280; const float* cbp = P.in[IN_SCB] + (size_t)l * 1280;
    float wx[4], wb[4], wc[4];
#pragma unroll
    for (int k = 0; k < 4; ++k) { wx[k] = cw[k * 1280 + cx]; wb[k] = cw[k * 1280 + cB]; wc[k] = cw[k * 1280 + cC]; }
    const float bx = cbp[cx], bb = cbp[cB], bc = cbp[cC];
    float rx[3] = {0.f, 0.f, 0.f}, rb[3] = {0.f, 0.f, 0.f}, rc[3] = {0.f, 0.f, 0.f};
    float h[64];
#pragma unroll
    for (int n = 0; n < 64; ++n) h[n] = 0.f;
    if (smp) {
        const float* cs = P.in[IN_SSDCONV] + (size_t)(l * 8 + b) * 3 * 1280;
#pragma unroll
        for (int i = 0; i < 3; ++i) { rx[i] = cs[i * 1280 + cx]; rb[i] = cs[i * 1280 + cB]; rc[i] = cs[i * 1280 + cC]; }
        const f32x4* hs = (const f32x4*)(P.in[IN_SSD] + ((size_t)((l * 8 + b) * 16 + head) * 64 + lane) * 64);
#pragma unroll
        for (int n4 = 0; n4 < 16; ++n4) { const f32x4 t = hs[n4]; h[4 * n4] = t[0]; h[4 * n4 + 1] = t[1]; h[4 * n4 + 2] = t[2]; h[4 * n4 + 3] = t[3]; }
    }
    for (int t = 0; t < L; ++t) {
        const size_t tok = (size_t)(tok0 + t);
        const float x0 = bf2f(XBC[tok * 1280 + cx]), b0 = bf2f(XBC[tok * 1280 + cB]), c0 = bf2f(XBC[tok * 1280 + cC]);
        const float xs = siluf_(bx + wx[0] * rx[0] + wx[1] * rx[1] + wx[2] * rx[2] + wx[3] * x0);
        const float bv = siluf_(bb + wb[0] * rb[0] + wb[1] * rb[1] + wb[2] * rb[2] + wb[3] * b0);
        const float cv = siluf_(bc + wc[0] * rc[0] + wc[1] * rc[1] + wc[2] * rc[2] + wc[3] * c0);
        rx[0] = rx[1]; rx[1] = rx[2]; rx[2] = x0; rb[0] = rb[1]; rb[1] = rb[2]; rb[2] = b0; rc[0] = rc[1]; rc[1] = rc[2]; rc[2] = c0;
        const float dt = DT[tok * 16 + head], dA = __expf(dt * a), dtx = dt * xs;
        float y = 0.f;
#pragma unroll
        for (int n = 0; n < 64; ++n) { h[n] = dA * h[n] + dtx * rl(bv, n); y += rl(cv, n) * h[n]; }
        y += Dh * xs;
        const float ys = y * bf2f(Z[tok * DM + cx]);
        Z[tok * DM + cx] = (bf16_t)f2bf(ys);
        const float ss = wave_sum(ys * ys);
        if (lane == 0) SSQ[tok * 16 + head] = ss;
    }
    float* so = C.out + (smp ? O_SSSD : O_PSSD) + ((size_t)((l * NB + b) * 16 + head) * 64 + lane) * 64;
#pragma unroll
    for (int n4 = 0; n4 < 16; ++n4) *(f32x4*)(so + 4 * n4) = (f32x4){h[4 * n4], h[4 * n4 + 1], h[4 * n4 + 2], h[4 * n4 + 3]};
    float* co = C.out + (smp ? O_SSCONV : O_PSCONV) + (size_t)(l * NB + b) * 3 * 1280;
#pragma unroll
    for (int i = 0; i < 3; ++i) { co[i * 1280 + cx] = rx[i]; if ((head & 7) == 0) { co[i * 1280 + cB] = rb[i]; co[i * 1280 + cC] = rc[i]; } }
}
__device__ __forceinline__ void lru_item_naive(const Ctx& C, int l, int idx) {
    const Params& P = *C.P; const int lane = C.lane;
    const bool smp = idx >= 256; const int ii = smp ? idx - 256 : idx; const int b = ii >> 4, j = ii & 15;
    const int tok0 = smp ? TP + b * 16 : b * 2048, L = smp ? 16 : 2048, NB = smp ? 8 : 16, ch = j * 64 + lane;
    bf16_t* LX = WSP(bf16_t, WS_B3); bf16_t* LY = WSP(bf16_t, WS_B4);
    float wa[64], wx[64];
    const float* wap = P.in[IN_WA] + (size_t)(l * 16 + j) * 4096 + lane; const float* wxp = P.in[IN_WX] + (size_t)(l * 16 + j) * 4096 + lane;
#pragma unroll
    for (int d = 0; d < 64; ++d) { wa[d] = wap[d * 64]; wx[d] = wxp[d * 64]; }
    const float ba = P.in[IN_BA][l * DM + ch], bxx = P.in[IN_BX][l * DM + ch], sp = softplusf_(-P.in[IN_LAM][l * DM + ch]);
    float cw[4];
#pragma unroll
    for (int k = 0; k < 4; ++k) cw[k] = P.in[IN_LCW][(size_t)(l * 4 + k) * DM + ch];
    const float cb = P.in[IN_LCB][l * DM + ch];
    float r[3] = {0.f, 0.f, 0.f}, h = 0.f;
    if (smp) { const float* cs = P.in[IN_LRUCONV] + (size_t)(l * 8 + b) * 3 * DM;
#pragma unroll
        for (int i = 0; i < 3; ++i) r[i] = cs[i * DM + ch];
        h = P.in[IN_LRU][(size_t)(l * 8 + b) * DM + ch]; }
    for (int t = 0; t < L; ++t) {
        const size_t tok = (size_t)(tok0 + t);
        const float x0 = bf2f(LX[tok * DM + ch]);
        const float xc = cb + cw[0] * r[0] + cw[1] * r[1] + cw[2] * r[2] + cw[3] * x0;
        r[0] = r[1]; r[1] = r[2]; r[2] = x0;
        float rp = ba, ip = bxx;
#pragma unroll
        for (int d = 0; d < 64; ++d) { const float xd = rl(xc, d); rp += xd * wa[d]; ip += xd * wx[d]; }
        const float rg = sigmoidf_(rp), ig = sigmoidf_(ip), log_a = -8.0f * rg * sp, av = __expf(log_a);
        const float u = sqrtf(-expm1f(2.0f * log_a)) * (ig * xc);
        h = av * h + u;
        LY[tok * DM + ch] = (bf16_t)f2bf(h * bf2f(LY[tok * DM + ch]));
    }
    C.out[(smp ? O_SLRU : O_PLRU) + (size_t)(l * NB + b) * DM + ch] = h;
    float* co = C.out + (smp ? O_SLCONV : O_PLCONV) + (size_t)(l * NB + b) * 3 * DM;
#pragma unroll
    for (int i = 0; i < 3; ++i) co[i * DM + ch] = r[i];
}
__device__ __forceinline__ void phase_scan(const Ctx& C, int l) {
    for (int it = C.wave * C.G + C.bid; it < 768; it += NWAVES * C.G) { if (it < 384) ssd_item_naive(C, l, it); else lru_item_naive(C, l, it - 384); }
}

__device__ __forceinline__ unsigned mono(float f) { const unsigned u = __float_as_uint(f); return (u & 0x80000000u) ? ~u : (u | 0x80000000u); }
__device__ __forceinline__ float unmono(unsigned k) { const unsigned u = (k & 0x80000000u) ? (k & 0x7fffffffu) : ~k; return __uint_as_float(u); }
__device__ __forceinline__ void phase_topk(const Ctx& C) {
    const float* SC = WSP(float, WS_SC); int* EI = WSP(int, WS_EI); float* GW = WSP(float, WS_GW);
    const int lane = C.lane, half = lane >> 5, li = lane & 31;
    int ic = 0, jc = 0; { int c = lane, i = 0; for (; i < 16; ++i) { const int cnt = 16 / (i + 1); if (c < cnt) break; c -= cnt; } ic = i; jc = c; }
    const bool cvalid = lane < 50;
    const int gw = C.bid * NWAVES + C.wave, NGW = C.G * NWAVES;
    for (int it = gw; it < TT * 8; it += NGW) {
        const int row = it >> 3, hd = it & 7;
        const f32x4 s = *(const f32x4*)(SC + (size_t)row * 2048 + hd * 256 + half * 128 + li * 4);
        unsigned k[4];
#pragma unroll
        for (int j = 0; j < 4; ++j) k[j] = (mono(s[j]) & ~127u) | (unsigned)(127 - (li * 4 + j));
        unsigned res = 0u;
        for (int r = 0; r < 16; ++r) {
            unsigned m = max(max(k[0], k[1]), max(k[2], k[3]));
#pragma unroll
            for (int o = 1; o < 32; o <<= 1) m = max(m, (unsigned)__shfl_xor((int)m, o));
#pragma unroll
            for (int j = 0; j < 4; ++j) k[j] = (k[j] == m) ? 0u : k[j];
            if (li == r) res = m;
        }
        const float val = unmono(res & ~127u); const int idx = 127 - (int)(res & 127u);
        const float v1 = __shfl(val, ic), v2 = __shfl(val, 32 + jc);
        const float sum = v1 + v2;
        unsigned ck = cvalid ? ((mono(sum) & ~63u) | (unsigned)(63 - lane)) : 0u, res2 = 0u;
        for (int r = 0; r < 16; ++r) {
            unsigned m = ck;
#pragma unroll
            for (int o = 1; o < 64; o <<= 1) m = max(m, (unsigned)__shfl_xor((int)m, o));
            ck = (ck == m) ? 0u : ck;
            if (lane == r) res2 = m;
        }
        const int csel = 63 - (int)(res2 & 63u);
        const float sv = __shfl(sum, csel); const int ics = __shfl(ic, csel), jcs = __shfl(jc, csel);
        const int e1 = __shfl(idx, ics), e2 = __shfl(idx, 32 + jcs);
        const float mx = __shfl(sv, 0);
        const float ex = __expf(sv - mx);
        float den = ex;
#pragma unroll
        for (int o = 1; o < 16; o <<= 1) den += __shfl_xor(den, o);
        if (lane < 16) { EI[(size_t)row * 128 + hd * 16 + lane] = e1 * 128 + e2; GW[(size_t)row * 128 + hd * 16 + lane] = ex / den; }
    }
}

__device__ __forceinline__ void phase_peer(const Ctx& C, int l) {
    const Params& P = *C.P; const int lane = C.lane;
    const bf16_t* H2 = WSP(bf16_t, WS_B0); const bf16_t* U16 = WSP(bf16_t, WS_U16); const bf16_t* V16 = WSP(bf16_t, WS_V16);
    const int* EI = WSP(int, WS_EI); const float* GW = WSP(float, WS_GW); const float* MOD = WSP(float, WS_MOD);
    const int gw = C.bid * NWAVES + C.wave, NGW = C.G * NWAVES;
    const int jl = ((lane >> 5) & 1) * 8 + ((lane >> 4) & 1) * 4 + ((lane >> 3) & 1) * 2 + ((lane >> 2) & 1);
    LAS float* act_s = (LAS float*)(C.lds + C.wave * 1024);
    for (int tok = gw; tok < TT; tok += NGW) {
        const u32x4 h0 = ((const u32x4*)(H2 + (size_t)tok * DM))[lane], h1 = ((const u32x4*)(H2 + (size_t)tok * DM))[64 + lane];
#pragma unroll 1
        for (int kb = 0; kb < 8; ++kb) {
            const int ev = EI[(size_t)tok * 128 + kb * 16 + (lane & 15)];
            float p[16];
#pragma unroll
            for (int j = 0; j < 16; ++j) {
                const int e = __builtin_amdgcn_readlane(ev, j);
                const u32x4* ur = (const u32x4*)(U16 + (size_t)e * DM);
                const u32x4 u0 = ur[lane], u1 = ur[64 + lane];
                float a = dot2bf(u0.x, h0.x, 0.f); a = dot2bf(u0.y, h0.y, a); a = dot2bf(u0.z, h0.z, a); a = dot2bf(u0.w, h0.w, a);
                a = dot2bf(u1.x, h1.x, a); a = dot2bf(u1.y, h1.y, a); a = dot2bf(u1.z, h1.z, a); a = dot2bf(u1.w, h1.w, a);
                p[j] = a;
            }
#pragma unroll
            for (int cnt = 8, m = 32; cnt >= 1; cnt >>= 1, m >>= 1) {
                const bool up = (lane & m) != 0;
#pragma unroll
                for (int j = 0; j < cnt; ++j) { const float mine = up ? p[j + cnt] : p[j], send = up ? p[j] : p[j + cnt]; p[j] = mine + __shfl_xor(send, m); }
            }
            float a = p[0]; a += __shfl_xor(a, 2); a += __shfl_xor(a, 1);
            const float av = geluf_(a) * GW[(size_t)tok * 128 + kb * 16 + jl];
            if ((lane & 3) == 0) act_s[kb * 16 + jl] = av;
        }
        LDS_WAIT();
        float o[16];
#pragma unroll
        for (int i = 0; i < 16; ++i) o[i] = 0.f;
#pragma unroll 1
        for (int kb = 0; kb < 8; ++kb) {
            const int ev = EI[(size_t)tok * 128 + kb * 16 + (lane & 15)];
#pragma unroll
            for (int j = 0; j < 16; ++j) {
                const int e = __builtin_amdgcn_readlane(ev, j);
                const float a = act_s[kb * 16 + j];
                const u32x4* vr = (const u32x4*)(V16 + (size_t)e * DM);
                const u32x4 v0 = vr[lane], v1 = vr[64 + lane];
                o[0] += a * bflo(v0.x); o[1] += a * bfhi(v0.x); o[2] += a * bflo(v0.y); o[3] += a * bfhi(v0.y);
                o[4] += a * bflo(v0.z); o[5] += a * bfhi(v0.z); o[6] += a * bflo(v0.w); o[7] += a * bfhi(v0.w);
                o[8] += a * bflo(v1.x); o[9] += a * bfhi(v1.x); o[10] += a * bflo(v1.y); o[11] += a * bfhi(v1.y);
                o[12] += a * bflo(v1.z); o[13] += a * bfhi(v1.z); o[14] += a * bflo(v1.w); o[15] += a * bfhi(v1.w);
            }
        }
        LDS_WAIT();
        float* xr = C.out + (size_t)tok * DM; const float* g2 = MOD + ((size_t)l * NBT + row_batch(tok)) * 6144 + 5120;
        float x[16]; float ss = 0.f;
#pragma unroll
        for (int q = 0; q < 4; ++q) { const int col = (q >> 1) * 512 + 8 * lane + (q & 1) * 4; const f32x4 xv = *(const f32x4*)(xr + col), gv = *(const f32x4*)(g2 + col);
#pragma unroll
            for (int i = 0; i < 4; ++i) { x[q * 4 + i] = xv[i] + gv[i] * o[q * 4 + i]; ss += x[q * 4 + i] * x[q * 4 + i]; } }
        if (l == 1) { const float rstd = rsqrtf(wave_sum(ss) * (1.f / DM) + EPS); const float* fw = P.in[IN_FNW];
#pragma unroll
            for (int q = 0; q < 4; ++q) { const int col = (q >> 1) * 512 + 8 * lane + (q & 1) * 4; const f32x4 wv = *(const f32x4*)(fw + col);
#pragma unroll
                for (int i = 0; i < 4; ++i) x[q * 4 + i] = x[q * 4 + i] * rstd * wv[i]; } }
#pragma unroll
        for (int q = 0; q < 4; ++q) { const int col = (q >> 1) * 512 + 8 * lane + (q & 1) * 4; *(f32x4*)(xr + col) = (f32x4){x[q * 4], x[q * 4 + 1], x[q * 4 + 2], x[q * 4 + 3]}; }
    }
}

constexpr int NPH = 21;
__device__ __forceinline__ void run_phase(const Ctx& C, int ph) {
    const Params& P = *C.P;
    if (ph == 0) { phase_prep(C); return; }
    const int l = (ph - 1) / 10, k = (ph - 1) % 10;
    switch (k) {
    case 0: phase_norm(C, l, 0); break;
    case 1: { Epi1 E{WSP(bf16_t, WS_B1), WSP(bf16_t, WS_B2), WSP(bf16_t, WS_B3), WSP(bf16_t, WS_B4), WSP(float, WS_DT), P.in[IN_DTB] + l * 16};
              gemm_naive(C, WSP(bf16_t, WS_B0), WSP(bf16_t, WS_W1T) + (size_t)l * N1 * DM, nullptr, nullptr, N1, E); } break;
    case 2: phase_scan(C, l); break;
    case 3: { Epi2 E{WSP(bf16_t, WS_GS), WSP(bf16_t, WS_GL)};
              gemm_naive(C, WSP(bf16_t, WS_B0), WSP(bf16_t, WS_WGT) + (size_t)l * NG * DM, nullptr, nullptr, NG, E); } break;
    case 4: { Epi3 E{WSP(bf16_t, WS_GS), WSP(bf16_t, WS_GL), WSP(float, WS_SSQ), WSP(bf16_t, WS_B0)};
              gemm_naive(C, WSP(bf16_t, WS_B1), WSP(bf16_t, WS_WBS) + (size_t)l * DM * DM, WSP(bf16_t, WS_B4), WSP(bf16_t, WS_WBL) + (size_t)l * DM * DM, DM, E); } break;
    case 5: { Epi4 E{P.in[IN_XP], P.in[IN_XS], C.out, WSP(float, WS_MOD) + (size_t)l * NBT * 6144, l};
              gemm_naive(C, WSP(bf16_t, WS_B0), WSP(bf16_t, WS_WO) + (size_t)l * DM * DM, nullptr, nullptr, DM, E); } break;
    case 6: phase_norm(C, l, 1); break;
    case 7: { Epi5 E{WSP(float, WS_SC)};
              gemm_naive(C, WSP(bf16_t, WS_B0), WSP(bf16_t, WS_WC) + (size_t)l * 2048 * DM, nullptr, nullptr, 2048, E); } break;
    case 8: phase_topk(C); break;
    case 9: phase_peer(C, l); break;
    }
}

__global__ void __launch_bounds__(NTHREADS, 2) fwd(Params P) {
    extern __shared__ __attribute__((aligned(16))) unsigned char lds_raw[];
    for (int ph = P.ph_lo; ph < P.ph_hi; ++ph) {
        Ctx C; C.P = &P; C.lds = (LAS unsigned char*)lds_raw;
        int tid = threadIdx.x; asm volatile("" : "+v"(tid));
        unsigned char* ws = P.ws; float* out = P.out; asm volatile("" : "+s"(ws), "+s"(out));
        C.ws = ws; C.out = out;
        C.tid = tid; C.lane = tid & 63; C.wave = __builtin_amdgcn_readfirstlane(tid >> 6); C.bid = blockIdx.x; C.G = gridDim.x;
        run_phase(C, ph);
        if (ph + 1 < P.ph_hi) cg::this_grid().sync();
    }
}

extern "C" void kernel_launch(void* const* d_in, const int* in_sizes, int n_in, void* d_out, int out_size, void* d_ws, size_t ws_size, hipStream_t stream) {
    static int grid = 0;
    if (grid == 0) {
        if (n_in != N_IN || (size_t)out_size != O_END || ws_size < WS_END) { fprintf(stderr, "kernel_launch: unexpected shapes n_in %d out %d ws %zu (need %zu)\n", n_in, out_size, ws_size, (size_t)WS_END); grid = -1; return; }
        int dev = 0, cus = 0, per_cu = 0;
        hipGetDevice(&dev); hipDeviceGetAttribute(&cus, hipDeviceAttributeMultiprocessorCount, dev);
        hipFuncSetAttribute((const void*)fwd, hipFuncAttributeMaxDynamicSharedMemorySize, LDS_BYTES);
        hipOccupancyMaxActiveBlocksPerMultiprocessor(&per_cu, (const void*)fwd, NTHREADS, LDS_BYTES);
        if (per_cu < 1) { fprintf(stderr, "kernel_launch: occupancy query says %d blocks/CU\n", per_cu); per_cu = 1; }
        grid = cus;
        fprintf(stderr, "kernel_launch: cus %d per_cu %d grid %d ws %zu\n", cus, per_cu, grid, ws_size);
    }
    if (grid < 0) return;
    Params p{};
    for (int i = 0; i < N_IN; ++i) p.in[i] = (const float*)d_in[i];
    p.out = (float*)d_out; p.ws = (unsigned char*)d_ws;
#if MEGA
    p.ph_lo = 0; p.ph_hi = NPH;
    void* args[] = {&p};
    hipError_t e = hipLaunchCooperativeKernel((const void*)fwd, dim3(grid), dim3(NTHREADS), args, LDS_BYTES, stream);
    if (e != hipSuccess) fprintf(stderr, "cooperative launch failed: %s\n", hipGetErrorString(e));
#else
    for (int ph = 0; ph < NPH; ++ph) { p.ph_lo = ph; p.ph_hi = ph + 1; hipLaunchKernelGGL(fwd, dim3(grid), dim3(NTHREADS), LDS_BYTES, stream, p); }
#endif
}
```

```cpp
#include <hip/hip_runtime.h>
#include <hip/hip_cooperative_groups.h>
#include <cstdio>
#include <cstdint>
namespace cg = cooperative_groups;

#ifndef MEGA
#define MEGA 1
#endif

#define LAS __attribute__((address_space(3)))
typedef unsigned short bf16_t;
typedef __bf16 bf16x2_t __attribute__((ext_vector_type(2)));
typedef short bf16x8 __attribute__((ext_vector_type(8)));
typedef float f32x4 __attribute__((ext_vector_type(4)));
typedef float f32x16 __attribute__((ext_vector_type(16)));
typedef unsigned u32x4 __attribute__((ext_vector_type(4)));
typedef unsigned u32x2 __attribute__((ext_vector_type(2)));

constexpr int DM = 1024;
constexpr int TP = 32768, TS = 128, TT = TP + TS, MT = 33024;
constexpr int NBT = 24;
constexpr int N1 = 4608;
constexpr int NG = 2048;
constexpr int NE = 16384;
constexpr int INC = 6416;
constexpr float EPS = 1e-6f;
constexpr int NWAVES = 8, NTHREADS = 512;
constexpr int LDS_BYTES = 150528;

enum { IN_XP = 0, IN_XS, IN_CP, IN_CS, IN_SSD, IN_SSDCONV, IN_LRU, IN_LRUCONV, IN_LN1, IN_LN2, IN_WMOD, IN_BMOD, IN_WIN, IN_SCW, IN_SCB, IN_DTB,
       IN_ALOG, IN_SSDD, IN_SNW, IN_LCW, IN_LCB, IN_WA, IN_BA, IN_WX, IN_BX, IN_LAM, IN_WBS, IN_WBL, IN_WO, IN_WQ, IN_K1, IN_K2, IN_U, IN_V, IN_FNW, N_IN };

constexpr size_t O_Y = 0, O_PSSD = 33685504, O_PSCONV = 35782656, O_PLRU = 35905536, O_PLCONV = 35938304,
                 O_SSSD = 36036608, O_SSCONV = 37085184, O_SLRU = 37146624, O_SLCONV = 37163008, O_END = 37212160;

constexpr size_t al256(size_t x) { return (x + 255) & ~(size_t)255; }
constexpr size_t WS_CTL = 0;
constexpr size_t WS_MOD = 1u << 20;
constexpr size_t WS_DT = al256(WS_MOD + (size_t)2 * NBT * 6144 * 4);
constexpr size_t WS_SSQ = al256(WS_DT + (size_t)MT * 16 * 4);
constexpr size_t WS_W1T = al256(WS_SSQ + (size_t)MT * 16 * 4);
constexpr size_t WS_WGT = al256(WS_W1T + (size_t)2 * N1 * DM * 2);
constexpr size_t WS_WBS = al256(WS_WGT + (size_t)2 * NG * DM * 2);
constexpr size_t WS_WBL = al256(WS_WBS + (size_t)2 * DM * DM * 2);
constexpr size_t WS_WO = al256(WS_WBL + (size_t)2 * DM * DM * 2);
constexpr size_t WS_WC = al256(WS_WO + (size_t)2 * DM * DM * 2);
constexpr size_t WS_U16 = al256(WS_WC + (size_t)2 * 2048 * DM * 2);
constexpr size_t WS_V16 = al256(WS_U16 + (size_t)NE * DM * 2);
constexpr size_t WS_EI = al256(WS_V16 + (size_t)NE * DM * 2);
constexpr size_t WS_GW = al256(WS_EI + (size_t)MT * 128 * 4);
constexpr size_t WS_B0 = al256(WS_GW + (size_t)MT * 128 * 4);
constexpr size_t WS_B1 = al256(WS_B0 + (size_t)MT * DM * 2);
constexpr size_t WS_B2 = al256(WS_B1 + (size_t)MT * DM * 2);
constexpr size_t WS_B3 = al256(WS_B2 + (size_t)MT * 1280 * 2);
constexpr size_t WS_B4 = al256(WS_B3 + (size_t)MT * DM * 2);
constexpr size_t WS_END = al256(WS_B4 + (size_t)MT * DM * 2);
constexpr size_t WS_GS = WS_B2, WS_GL = WS_B2 + (size_t)MT * DM * 2;
constexpr size_t WS_SC = WS_B1;
static_assert(WS_GL + (size_t)MT * DM * 2 <= WS_B4, "gate overlay");
static_assert(WS_SC + (size_t)MT * 2048 * 4 <= WS_END, "score overlay");
static_assert(WS_END <= (size_t)512 << 20, "d_ws budget");

struct Params {
    const float* in[N_IN];
    float* out;
    unsigned char* ws;
    int ph_lo, ph_hi;
};

__device__ __forceinline__ unsigned f2bf(float f) { return (unsigned)__builtin_bit_cast(unsigned short, (__bf16)f); }
__device__ __forceinline__ float bf2f(unsigned b) { return __uint_as_float(b << 16); }
__device__ __forceinline__ unsigned pk2(float lo, float hi) { typedef float f32x2_ __attribute__((ext_vector_type(2))); return __builtin_bit_cast(unsigned, __builtin_convertvector((f32x2_){lo, hi}, bf16x2_t)); }
__device__ __forceinline__ float bflo(unsigned w) { return __uint_as_float(w << 16); }
__device__ __forceinline__ float bfhi(unsigned w) { return __uint_as_float(w & 0xffff0000u); }
template <int M> __device__ __forceinline__ int shfx_i(int v, int lane) {
    if constexpr (M == 32) { auto r = __builtin_amdgcn_permlane32_swap((unsigned)v, (unsigned)v, false, false); return (int)((lane & 32) ? r[0] : r[1]); }
    else return __builtin_amdgcn_ds_swizzle(v, 0x1f | (M << 10));
}
template <int M> __device__ __forceinline__ float shfx(float v, int lane) { return __int_as_float(shfx_i<M>(__float_as_int(v), lane)); }
__device__ __forceinline__ float shfl_f(float v, int src) { return __int_as_float(__builtin_amdgcn_ds_bpermute(src << 2, __float_as_int(v))); }
__device__ __forceinline__ int shfl_i(int v, int src) { return __builtin_amdgcn_ds_bpermute(src << 2, v); }
template <int CTRL> __device__ __forceinline__ float dppf_(float v) { return __int_as_float(__builtin_amdgcn_update_dpp(0, __float_as_int(v), CTRL, 0xf, 0xf, true)); }
__device__ __forceinline__ float row8_sum(float v) { v += dppf_<0xB1>(v); v += dppf_<0x4E>(v); v += dppf_<0x141>(v); return v; }
__device__ __forceinline__ float wave_sum(float v) {
    v += dppf_<0xB1>(v); v += dppf_<0x4E>(v); v += dppf_<0x141>(v); v += dppf_<0x140>(v);
    { auto r = __builtin_amdgcn_permlane16_swap(__float_as_uint(v), __float_as_uint(v), false, false); v = __uint_as_float(r[0]) + __uint_as_float(r[1]); }
    { auto r = __builtin_amdgcn_permlane32_swap(__float_as_uint(v), __float_as_uint(v), false, false); v = __uint_as_float(r[0]) + __uint_as_float(r[1]); }
    return v;
}
__device__ __forceinline__ float exp_fast(float x) { return __builtin_amdgcn_exp2f(x * 1.4426950408889634f); }
__device__ __forceinline__ float sigmoidf_(float x) { return __builtin_amdgcn_rcpf(1.0f + exp_fast(-x)); }
__device__ __forceinline__ float siluf_(float x) { return x * __builtin_amdgcn_rcpf(1.0f + exp_fast(-x)); }
__device__ __forceinline__ float geluf_(float x) { const float u = 1.5957691216057308f * (x + 0.044715f * x * x * x); return x * __builtin_amdgcn_rcpf(1.0f + exp_fast(-u)); }
__device__ __forceinline__ float softplusf_(float x) { return fmaxf(x, 0.f) + log1pf(__expf(-fabsf(x))); }
__device__ __forceinline__ int row_batch(int row) { return row < TP ? (row >> 11) : (row < TT ? 16 + ((row - TP) >> 4) : 23); }
__device__ __forceinline__ float dot2bf(unsigned a, unsigned b, float acc) { return __builtin_amdgcn_fdot2_f32_bf16(__builtin_bit_cast(bf16x2_t, a), __builtin_bit_cast(bf16x2_t, b), acc, false); }
__device__ __forceinline__ float rl(float v, int lane) { return __int_as_float(__builtin_amdgcn_readlane(__float_as_int(v), lane)); }
#define LDS_WAIT() asm volatile("s_waitcnt lgkmcnt(0)" ::: "memory")
#define MFMA32(a, b, c) __builtin_amdgcn_mfma_f32_32x32x16_bf16((a), (b), (c), 0, 0, 0)

typedef const __attribute__((address_space(4))) Params CParams;
template <class T> __device__ __forceinline__ T* as_global(T* p) { __attribute__((address_space(1))) T* g = (__attribute__((address_space(1))) T*)p; asm volatile("" : "+s"(g)); return (T*)g; }
struct Ctx {
    CParams* P; LAS unsigned char* lds; unsigned char* ws; float* out;
    int tid, lane, wave, bid, G;
};
#define WSP(T, off) (as_global((T*)(C.ws + (off))))

__device__ __forceinline__ void tr_item(const float* W, int ldw, int src_col0, int valid, const float* kscale, int k0, bf16_t* dst, LAS float* scr, int lane) {
#pragma unroll 8
    for (int i = 0; i < 32; ++i) { const int kk = 2 * i + (lane >> 5), c = lane & 31;
        float v = (c < valid) ? W[(size_t)(k0 + kk) * ldw + src_col0 + c] : 0.f; if (kscale) v *= kscale[k0 + kk]; scr[kk * 33 + c] = v; }
    LDS_WAIT();
    const int c8 = lane & 7;
#pragma unroll
    for (int j = 0; j < 4; ++j) { const int n = (lane >> 3) + 8 * j; const LAS float* s = scr + (8 * c8) * 33 + n;
        u32x4 o; o.x = pk2(s[0 * 33], s[1 * 33]); o.y = pk2(s[2 * 33], s[3 * 33]); o.z = pk2(s[4 * 33], s[5 * 33]); o.w = pk2(s[6 * 33], s[7 * 33]);
        *(u32x4*)(dst + (size_t)n * DM + k0 + 8 * c8) = o; }
    LDS_WAIT();
}
typedef float f32x2 __attribute__((ext_vector_type(2)));
constexpr size_t WS_U8 = WS_U16, WS_SU = WS_U16 + ((size_t)16 << 20), WS_V8 = WS_V16, WS_SV = WS_V16 + ((size_t)16 << 20);
__device__ __forceinline__ float wave_max(float v) {
    v = fmaxf(v, shfx<1>(v, 0)); v = fmaxf(v, shfx<2>(v, 0)); v = fmaxf(v, shfx<4>(v, 0)); v = fmaxf(v, shfx<8>(v, 0)); v = fmaxf(v, shfx<16>(v, 0));
    auto r = __builtin_amdgcn_permlane32_swap(__float_as_uint(v), __float_as_uint(v), false, false);
    return fmaxf(__uint_as_float(r[0]), __uint_as_float(r[1]));
}
__device__ __forceinline__ void convert_tables(const Ctx& C, int l) {
    const int gw = C.bid * NWAVES + C.wave, NGW = C.G * NWAVES, lane = C.lane;
    const float* up = as_global(C.P->in[IN_U]) + (size_t)l * NE * DM; const float* vp = as_global(C.P->in[IN_V]) + (size_t)l * NE * DM;
#define TROW(it_) (((it_) >= NE ? vp + (size_t)((it_) - NE) * DM : up + (size_t)(it_) * DM) + lane * 4)
    f32x4 nv[4];
    { const float* s0 = TROW(min(gw, 2 * NE - 1));
#pragma unroll
      for (int j = 0; j < 4; ++j) nv[j] = *(const f32x4*)(s0 + 256 * j); }
    for (int it = gw; it < 2 * NE; it += NGW) {
        const bool isv = it >= NE; const int e = isv ? it - NE : it;
        unsigned char* dst = C.ws + (isv ? WS_V8 : WS_U8); float* sc = (float*)(C.ws + (isv ? WS_SV : WS_SU));
        f32x4 v[4]; float m = 0.f;
#pragma unroll
        for (int j = 0; j < 4; ++j) { v[j] = nv[j]; m = fmaxf(m, fmaxf(fmaxf(fabsf(v[j][0]), fabsf(v[j][1])), fmaxf(fabsf(v[j][2]), fabsf(v[j][3])))); }
        { const float* s0 = TROW(min(it + NGW, 2 * NE - 1));
#pragma unroll
          for (int j = 0; j < 4; ++j) nv[j] = *(const f32x4*)(s0 + 256 * j); }
        m = wave_max(m);
        const float scale = m > 0.f ? m * (1.0f / 440.0f) : 1.0f, inv = 1.0f / scale;
        if (lane == 0) sc[e] = scale;
#pragma unroll
        for (int j = 0; j < 4; ++j) { int w = __builtin_amdgcn_cvt_pk_fp8_f32(v[j][0] * inv, v[j][1] * inv, 0, false); w = __builtin_amdgcn_cvt_pk_fp8_f32(v[j][2] * inv, v[j][3] * inv, w, true);
            const int slice = 2 * j + (lane >> 5);
            *(int*)(dst + ((size_t)slice * NE + e) * 128 + (lane & 31) * 4) = w; }
    }
#undef TROW
}
__device__ __forceinline__ void phase_prep(const Ctx& C) {
    CParams& P = *C.P;
    {
        LAS float* Kh = (LAS float*)C.lds;
        LAS float* Wq = (LAS float*)(C.lds + 128 * 132 * 4);
        bf16_t* WcT = WSP(bf16_t, WS_WC);
        for (int it = C.bid; it < 512; it += C.G) {
            const int l = it >> 8, h = (it >> 5) & 7, half = (it >> 4) & 1, jb = it & 15;
            const float* ksrc = as_global(P.in[half ? IN_K2 : IN_K1]) + (size_t)l * 128 * 128;
            const float* wsrc = as_global(P.in[IN_WQ]) + (size_t)l * DM * 2048 + (size_t)(jb * 64) * 2048 + h * 256 + half * 128;
            __syncthreads();
            for (int i = C.tid; i < 128 * 32; i += NTHREADS) { const int r = i >> 5, c4 = i & 31; *(LAS f32x4*)(Kh + r * 132 + c4 * 4) = *(const f32x4*)(ksrc + r * 128 + c4 * 4); }
            for (int i = C.tid; i < 64 * 32; i += NTHREADS) { const int r = i >> 5, c4 = i & 31; *(LAS f32x4*)(Wq + r * 132 + c4 * 4) = *(const f32x4*)(wsrc + (size_t)r * 2048 + c4 * 4); }
            __syncthreads();
            const int tk = C.tid & 31, tj = C.tid >> 5;
            float acc[4][4];
#pragma unroll
            for (int a = 0; a < 4; ++a)
#pragma unroll
                for (int b = 0; b < 4; ++b) acc[a][b] = 0.f;
            for (int d4 = 0; d4 < 32; ++d4) {
                f32x4 kv[4], wv[4];
#pragma unroll
                for (int a = 0; a < 4; ++a) { kv[a] = *(LAS f32x4*)(Kh + (tk + 32 * a) * 132 + d4 * 4); wv[a] = *(LAS f32x4*)(Wq + (4 * tj + a) * 132 + d4 * 4); }
#pragma unroll
                for (int a = 0; a < 4; ++a)
#pragma unroll
                    for (int b = 0; b < 4; ++b) acc[a][b] += kv[a][0] * wv[b][0] + kv[a][1] * wv[b][1] + kv[a][2] * wv[b][2] + kv[a][3] * wv[b][3];
            }
#pragma unroll
            for (int a = 0; a < 4; ++a) { const int n = h * 256 + half * 128 + tk + 32 * a;
                u32x2 o; o.x = pk2(acc[a][0], acc[a][1]); o.y = pk2(acc[a][2], acc[a][3]);
                *(u32x2*)(WcT + ((size_t)l * 2048 + n) * DM + jb * 64 + 4 * tj) = o; }
        }
        __syncthreads();
    }
    {
        LAS float* sc = (LAS float*)C.lds;
        LAS float* red = (LAS float*)(C.lds + 98304);
        for (int i = C.tid; i < NBT * DM; i += NTHREADS) { const int bb = i >> 10, k = i & 1023;
            const float cv = bb < 16 ? as_global(P.in[IN_CP])[bb * DM + k] : as_global(P.in[IN_CS])[(bb - 16) * DM + k]; sc[i] = siluf_(cv); }
        __syncthreads();
        float* MOD = WSP(float, WS_MOD);
        for (int it = C.bid; it < 192; it += C.G) {
            const int l = it / 96, cg_ = it % 96, j = cg_ * 64 + C.lane;
            const float* wm = as_global(P.in[IN_WMOD]) + (size_t)l * DM * 6144 + j;
            float acc[NBT];
#pragma unroll
            for (int bb = 0; bb < NBT; ++bb) acc[bb] = 0.f;
            const int k0 = C.wave * 128;
#pragma unroll 16
            for (int k = 0; k < 128; ++k) { const float w = wm[(size_t)(k0 + k) * 6144];
#pragma unroll
                for (int bb = 0; bb < NBT; ++bb) acc[bb] += sc[bb * DM + k0 + k] * w; }
#pragma unroll
            for (int bb = 0; bb < NBT; ++bb) red[(C.wave * NBT + bb) * 64 + C.lane] = acc[bb];
            __syncthreads();
            const float bm = as_global(P.in[IN_BMOD])[l * 6144 + j];
#pragma unroll
            for (int q = 0; q < 3; ++q) { const int bb = 3 * C.wave + q; float a = bm;
#pragma unroll
                for (int w8 = 0; w8 < 8; ++w8) a += red[(w8 * NBT + bb) * 64 + C.lane];
                MOD[((size_t)l * NBT + bb) * 6144 + j] = a; }
            __syncthreads();
        }
        __syncthreads();
    }
    {
        LAS float* scr = (LAS float*)(C.lds + C.wave * 16384);
        const int gw = C.bid * NWAVES + C.wave, NGW = C.G * NWAVES;
        constexpr int I_W1 = 144 * 16, I_WG = 64 * 16, I_SQ = 32 * 16, PER_L = I_W1 + I_WG + 3 * I_SQ;
        for (int it = gw; it < 2 * PER_L; it += NGW) {
            const int l = it / PER_L; int r = it % PER_L;
            if (r < I_W1) { const int nb = r >> 4, kb = r & 15, n0 = nb * 32; int src, valid;
                if (n0 < 2304) { src = n0; valid = 32; } else if (n0 < 4352) { src = n0 + 16; valid = 32; } else if (n0 == 4352) { src = 2304; valid = 16; } else { src = 0; valid = 0; }
                tr_item(as_global(P.in[IN_WIN]) + (size_t)l * DM * INC, INC, src, valid, nullptr, kb * 64, WSP(bf16_t, WS_W1T) + ((size_t)l * N1 + n0) * DM, scr, C.lane); continue; }
            r -= I_W1;
            if (r < I_WG) { const int nb = r >> 4, kb = r & 15, n0 = nb * 32;
                tr_item(as_global(P.in[IN_WIN]) + (size_t)l * DM * INC, INC, 4368 + n0, 32, nullptr, kb * 64, WSP(bf16_t, WS_WGT) + ((size_t)l * NG + n0) * DM, scr, C.lane); continue; }
            r -= I_WG;
            const int which = r / I_SQ; r %= I_SQ; const int nb = r >> 4, kb = r & 15, n0 = nb * 32;
            const float* src = as_global(P.in[which == 0 ? IN_WBS : (which == 1 ? IN_WBL : IN_WO)]) + (size_t)l * DM * DM;
            bf16_t* dst = WSP(bf16_t, which == 0 ? WS_WBS : (which == 1 ? WS_WBL : WS_WO)) + ((size_t)l * DM + n0) * DM;
            tr_item(src, DM, n0, 32, which == 0 ? as_global(P.in[IN_SNW]) + l * DM : nullptr, kb * 64, dst, scr, C.lane);
        }
    }
    convert_tables(C, 0);
}

__device__ __forceinline__ void phase_norm(const Ctx& C, int l, int which) {
    CParams& P = *C.P;
    const int gw = C.bid * NWAVES + C.wave, NGW = C.G * NWAVES;
    bf16_t* H = WSP(bf16_t, WS_B0);
    const float* lw = as_global(P.in[which ? IN_LN2 : IN_LN1]) + l * DM;
    const float* MOD = WSP(float, WS_MOD);
    const float* xpp = as_global(P.in[IN_XP]); const float* xsp = as_global(P.in[IN_XS]);
#define NORM_SRC(row_) ((which == 0 && l == 0) ? ((row_) < TP ? xpp + (size_t)(row_) * DM : xsp + (size_t)((row_) - TP) * DM) : C.out + (size_t)(row_) * DM)
    f32x4 nv[4];
    { const f32x4* xr = (const f32x4*)NORM_SRC(min(gw, TT - 1)) + C.lane;
#pragma unroll
      for (int j = 0; j < 4; ++j) nv[j] = xr[64 * j]; }
    for (int row = gw; row < TT; row += NGW) {
        u32x2* o8 = (u32x2*)(H + (size_t)row * DM) + C.lane;
        f32x4 v[4]; float s = 0.f;
#pragma unroll
        for (int j = 0; j < 4; ++j) { v[j] = nv[j]; s += (v[j][0] * v[j][0] + v[j][1] * v[j][1]) + (v[j][2] * v[j][2] + v[j][3] * v[j][3]); }
        { const f32x4* xr = (const f32x4*)NORM_SRC(min(row + NGW, TT - 1)) + C.lane;
#pragma unroll
          for (int j = 0; j < 4; ++j) nv[j] = xr[64 * j]; }
        const float rstd = rsqrtf(wave_sum(s) * (1.f / DM) + EPS);
        const float* md = MOD + ((size_t)l * NBT + row_batch(row)) * 6144 + (which ? 3072 : 0);
#pragma unroll
        for (int j = 0; j < 4; ++j) { const int col = C.lane * 4 + 256 * j;
            const f32x4 w = *(const f32x4*)(lw + col), sh = *(const f32x4*)(md + col), scv = *(const f32x4*)(md + 1024 + col);
            const f32x4 y = (v[j] * rstd * w) * (scv + 1.0f) + sh;
            o8[64 * j] = (u32x2){pk2(y[0], y[1]), pk2(y[2], y[3])}; }
    }
#undef NORM_SRC
    if (which == 0 && l == 1) convert_tables(C, 1);
}

struct Epi1 {
    __device__ __forceinline__ bool idem() const { return true; }
    static constexpr int NK = 5; static constexpr bool PERM = true;
    bf16_t *Z, *XBC, *LX, *LY; float* DT; const float* dtb;
    __device__ __forceinline__ int kind(int pn) const { return pn < 4 ? 0 : (pn < 9 ? 1 : (pn < 13 ? 2 : (pn < 17 ? 3 : 4))); }
    template <int KD> __device__ __forceinline__ void apply(int, int row, int col, f32x4 v) const {
        if constexpr (KD == 0) { *(u32x2*)(Z + (size_t)row * DM + col) = (u32x2){pk2(siluf_(v[0]), siluf_(v[1])), pk2(siluf_(v[2]), siluf_(v[3]))}; }
        else if constexpr (KD == 1) { *(u32x2*)(XBC + (size_t)row * 1280 + (col - 1024)) = (u32x2){pk2(v[0], v[1]), pk2(v[2], v[3])}; }
        else if constexpr (KD == 2) { *(u32x2*)(LX + (size_t)row * DM + (col - 2304)) = (u32x2){pk2(v[0], v[1]), pk2(v[2], v[3])}; }
        else if constexpr (KD == 3) { *(u32x2*)(LY + (size_t)row * DM + (col - 3328)) = (u32x2){pk2(geluf_(v[0]), geluf_(v[1])), pk2(geluf_(v[2]), geluf_(v[3]))}; }
        else { if (col < 4368) { const int c = col - 4352; const f32x4 b = *(const f32x4*)(dtb + c);
            *(f32x4*)(DT + (size_t)row * 16 + c) = (f32x4){softplusf_(v[0] + b[0]), softplusf_(v[1] + b[1]), softplusf_(v[2] + b[2]), softplusf_(v[3] + b[3])}; } }
    }
    template <int KD> __device__ __forceinline__ void apply8(int w, int row, int col, f32x4 a, f32x4 b) const {
        if constexpr (KD == 0) { *(u32x4*)(Z + (size_t)row * DM + col) = (u32x4){pk2(siluf_(a[0]), siluf_(a[1])), pk2(siluf_(a[2]), siluf_(a[3])), pk2(siluf_(b[0]), siluf_(b[1])), pk2(siluf_(b[2]), siluf_(b[3]))}; }
        else if constexpr (KD == 1) { *(u32x4*)(XBC + (size_t)row * 1280 + (col - 1024)) = (u32x4){pk2(a[0], a[1]), pk2(a[2], a[3]), pk2(b[0], b[1]), pk2(b[2], b[3])}; }
        else if constexpr (KD == 2) { *(u32x4*)(LX + (size_t)row * DM + (col - 2304)) = (u32x4){pk2(a[0], a[1]), pk2(a[2], a[3]), pk2(b[0], b[1]), pk2(b[2], b[3])}; }
        else if constexpr (KD == 3) { *(u32x4*)(LY + (size_t)row * DM + (col - 3328)) = (u32x4){pk2(geluf_(a[0]), geluf_(a[1])), pk2(geluf_(a[2]), geluf_(a[3])), pk2(geluf_(b[0]), geluf_(b[1])), pk2(geluf_(b[2]), geluf_(b[3]))}; }
        else { apply<KD>(w, row, col, a); apply<KD>(w, row, col + 4, b); }
    }
};
struct Epi2 {
    __device__ __forceinline__ bool idem() const { return true; }
    static constexpr int NK = 2; static constexpr bool PERM = true;
    bf16_t *GS, *GL;
    __device__ __forceinline__ int kind(int pn) const { return pn < 4 ? 0 : 1; }
    template <int KD> __device__ __forceinline__ void apply(int, int row, int col, f32x4 v) const {
        bf16_t* d = (KD == 0 ? GS + (size_t)row * DM + col : GL + (size_t)row * DM + (col - 1024));
        *(u32x2*)d = (u32x2){pk2(sigmoidf_(v[0]), sigmoidf_(v[1])), pk2(sigmoidf_(v[2]), sigmoidf_(v[3]))};
    }
    template <int KD> __device__ __forceinline__ void apply8(int, int row, int col, f32x4 a, f32x4 b) const {
        bf16_t* d = (KD == 0 ? GS + (size_t)row * DM + col : GL + (size_t)row * DM + (col - 1024));
        *(u32x4*)d = (u32x4){pk2(sigmoidf_(a[0]), sigmoidf_(a[1])), pk2(sigmoidf_(a[2]), sigmoidf_(a[3])), pk2(sigmoidf_(b[0]), sigmoidf_(b[1])), pk2(sigmoidf_(b[2]), sigmoidf_(b[3]))};
    }
};
struct Epi3 {
    __device__ __forceinline__ bool idem() const { return true; }
    static constexpr int NK = 1; static constexpr bool PERM = true;
    const bf16_t *GS, *GL; const float* SSQ; bf16_t* MG;
    __device__ __forceinline__ int kind(int) const { return 0; }
    __device__ __forceinline__ float rstd_of(int row) const { const f32x4* q = (const f32x4*)(SSQ + (size_t)row * 16); const f32x4 a = q[0] + q[1] + q[2] + q[3];
        return rsqrtf(((a[0] + a[1]) + (a[2] + a[3])) * (1.f / DM) + EPS); }
    template <int KD> __device__ __forceinline__ void apply(int w, int row, int col, f32x4 v) const {
        u32x2* m = (u32x2*)(MG + (size_t)row * DM + col);
        if (w == 0) { const float rstd = rstd_of(row);
            const u32x2 g = *(const u32x2*)(GS + (size_t)row * DM + col);
            *m = (u32x2){pk2(bflo(g.x) * rstd * v[0], bfhi(g.x) * rstd * v[1]), pk2(bflo(g.y) * rstd * v[2], bfhi(g.y) * rstd * v[3])};
        } else {
            const u32x2 g = *(const u32x2*)(GL + (size_t)row * DM + col); const u32x2 p = *m;
            *m = (u32x2){pk2(bflo(p.x) + bflo(g.x) * v[0], bfhi(p.x) + bfhi(g.x) * v[1]), pk2(bflo(p.y) + bflo(g.y) * v[2], bfhi(p.y) + bfhi(g.y) * v[3])};
        }
    }
    template <int KD> __device__ __forceinline__ void apply8(int w, int row, int col, f32x4 a, f32x4 b) const {
        u32x4* m = (u32x4*)(MG + (size_t)row * DM + col);
        if (w == 0) { const float rstd = rstd_of(row);
            const u32x4 g = *(const u32x4*)(GS + (size_t)row * DM + col);
            *m = (u32x4){pk2(bflo(g.x) * rstd * a[0], bfhi(g.x) * rstd * a[1]), pk2(bflo(g.y) * rstd * a[2], bfhi(g.y) * rstd * a[3]), pk2(bflo(g.z) * rstd * b[0], bfhi(g.z) * rstd * b[1]), pk2(bflo(g.w) * rstd * b[2], bfhi(g.w) * rstd * b[3])};
        } else {
            const u32x4 g = *(const u32x4*)(GL + (size_t)row * DM + col); const u32x4 p = *m;
            *m = (u32x4){pk2(bflo(p.x) + bflo(g.x) * a[0], bfhi(p.x) + bfhi(g.x) * a[1]), pk2(bflo(p.y) + bflo(g.y) * a[2], bfhi(p.y) + bfhi(g.y) * a[3]),
                         pk2(bflo(p.z) + bflo(g.z) * b[0], bfhi(p.z) + bfhi(g.z) * b[1]), pk2(bflo(p.w) + bflo(g.w) * b[2], bfhi(p.w) + bfhi(g.w) * b[3])};
        }
    }
};
struct Epi4 {
    static constexpr bool PERM = true;
    __device__ __forceinline__ bool idem() const { return layer == 0; }
    static constexpr int NK = 1;
    const float *xp, *xs; float* XR; const float* MODl; int layer;
    __device__ __forceinline__ int kind(int) const { return 0; }
    template <int KD> __device__ __forceinline__ void apply(int, int row, int col, f32x4 v) const {
        if (row >= TT) return;
        const float* src = layer == 0 ? (row < TP ? xp + (size_t)row * DM : xs + (size_t)(row - TP) * DM) : XR + (size_t)row * DM;
        const f32x4 x = *(const f32x4*)(src + col), g = *(const f32x4*)(MODl + (size_t)row_batch(row) * 6144 + 2048 + col);
        *(f32x4*)(XR + (size_t)row * DM + col) = x + g * v;
    }
    template <int KD> __device__ __forceinline__ void apply8(int, int row, int col, f32x4 a, f32x4 b) const {
        const float* src = (layer == 0 ? xp : XR) + (size_t)row * DM + col; const float* gp = MODl + (size_t)(row >> 11) * 6144 + 2048 + col;
        const f32x4 x0 = *(const f32x4*)src, x1 = *(const f32x4*)(src + 4), g0 = *(const f32x4*)gp, g1 = *(const f32x4*)(gp + 4);
        float* d = XR + (size_t)row * DM + col; *(f32x4*)d = x0 + g0 * a; *(f32x4*)(d + 4) = x1 + g1 * b;
    }
};
struct Epi5 {
    static constexpr bool PERM = true;
    __device__ __forceinline__ bool idem() const { return true; }
    static constexpr int NK = 1;
    float* SC;
    __device__ __forceinline__ int kind(int) const { return 0; }
    template <int KD> __device__ __forceinline__ void apply(int, int row, int col, f32x4 v) const { *(f32x4*)(SC + (size_t)row * 2048 + col) = v; }
    template <int KD> __device__ __forceinline__ void apply8(int, int row, int col, f32x4 a, f32x4 b) const { float* d = SC + (size_t)row * 2048 + col; *(f32x4*)d = a; *(f32x4*)(d + 4) = b; }
};

namespace pg8 {
constexpr int BM = 256, BK = 64, HALF = 128, HTB = HALF * BK * 2, STAGE_BYTES = 8 * HTB, NXCD = 8, WGM = 8;
__host__ __device__ __forceinline__ int lds_byte(int r, int c) { const int st = (r >> 4) * 2 + (c >> 5), rr = r & 15, cc = c & 31, ob = rr * 64 + cc * 2; return st * 1024 + (ob ^ (((ob >> 9) & 1) << 5)); }
__host__ __device__ __forceinline__ void stage_rc(int b, int& R, int& C) { const int st = b / 1024, sb = b % 1024, swz = sb ^ (((sb >> 9) & 1) << 5); R = (st >> 1) * 16 + swz / 64; C = (st & 1) * 32 + (swz % 64) / 2; }
struct Unit { int pm, pn, w; };
struct Sched {
    int nM, nN, nW, nwg, G, c; const char *A0, *B0, *A1, *B1;
    __device__ __forceinline__ bool next(int i, Unit& u) const {
        const int ti = i / nW; u.w = i - ti * nW;
        const long L = (long)ti * G + c; if (L >= nwg) return false;
        int wgid = (int)L; { const int q = nwg / NXCD, r = nwg % NXCD, xcd = wgid % NXCD, off = wgid / NXCD; wgid = (xcd < r ? xcd * (q + 1) : r * (q + 1) + (xcd - r) * q) + off; }
        const int nig = WGM * nN, gid = wgid / nig, fm = gid * WGM, gsz = (nM - fm) < WGM ? (nM - fm) : WGM;
        u.pm = fm + ((wgid % nig) % gsz); u.pn = (wgid % nig) / gsz; return true;
    }
};
__host__ __device__ __forceinline__ int perm32(int rho) { const int n = rho >> 4, i = rho & 15; return 8 * (i >> 2) + 4 * n + (i & 3); }
template <int KD, class Epi>
__device__ __forceinline__ void epi_tile(const Epi& E, const f32x4 (&acc)[2][2][4][2], const Unit& u, int wr, int wc, int fr, int fq) {
#pragma unroll
    for (int ai = 0; ai < 2; ++ai)
#pragma unroll
        for (int m = 0; m < 4; ++m) { const int row = u.pm * BM + ai * HALF + wr * 64 + m * 16 + fr;
#pragma unroll
            for (int bj = 0; bj < 2; ++bj) {
                if constexpr (Epi::PERM) E.template apply8<KD>(u.w, row, u.pn * BM + bj * HALF + wc * 32 + 8 * fq, acc[ai][bj][m][0], acc[ai][bj][m][1]);
                else {
#pragma unroll
                    for (int n = 0; n < 2; ++n) E.template apply<KD>(u.w, row, u.pn * BM + bj * HALF + wc * 32 + n * 16 + 4 * fq, acc[ai][bj][m][n]); } } }
}
template <class Epi>
__device__ __forceinline__ void epi_apply(const Epi& E, const f32x4 (&acc)[2][2][4][2], const Unit& u, int wr, int wc, int fr, int fq) {
    if constexpr (Epi::NK == 1) epi_tile<0>(E, acc, u, wr, wc, fr, fq);
    else { const int kd = E.kind(u.pn);
        if (kd == 0) epi_tile<0>(E, acc, u, wr, wc, fr, fq);
        else if (kd == 1) epi_tile<1>(E, acc, u, wr, wc, fr, fq);
        else if constexpr (Epi::NK > 2) { if (kd == 2) epi_tile<2>(E, acc, u, wr, wc, fr, fq); else if (kd == 3) epi_tile<3>(E, acc, u, wr, wc, fr, fq); else epi_tile<4>(E, acc, u, wr, wc, fr, fq); } }
}
template <class Epi, bool ALIGN_EPI = true, bool SP2 = true>
__device__ __forceinline__ void gemm_phase(LAS unsigned char* lds, int tid, int K, const Sched& S, const Epi& E) {
    const int wid = __builtin_amdgcn_readfirstlane(tid >> 6), lane = tid & 63, wr = wid >> 2, wc = wid & 3, fr = lane & 15, fq = lane >> 4;
    const int nt = K / BK;
    unsigned voffA[2], voffB[2];
#pragma unroll
    for (int i = 0; i < 2; ++i) { int R, Cc; stage_rc(tid * 16 + i * 8192, R, Cc); const int Rb = Epi::PERM ? ((R & ~31) + perm32(R & 31)) : R;
        voffA[i] = (unsigned)(R * K + Cc) * 2u; voffB[i] = (unsigned)(Rb * K + Cc) * 2u; }
    const size_t kstep = (size_t)(BK * 2);
    const size_t hstep = (size_t)HALF * K * 2;
    const size_t tstep = 2 * hstep;
    const unsigned ldsw = (unsigned)wid * 1024u;
    const int aoff = lds_byte(wr * 64 + fr, fq * 8), boff = lds_byte(wc * 32 + fr, fq * 8);
#define PG8_SA(b, h) (((b) * 2 + (h)) * HTB)
#define PG8_SB(b, h) ((4 + (b) * 2 + (h)) * HTB)
#define PG8_STAGE(bufoff, gbase, voff) do { _Pragma("unroll") for (int _i = 0; _i < 2; ++_i) \
        __builtin_amdgcn_global_load_lds((const unsigned*)((const char*)(gbase) + (voff)[_i]), (LAS unsigned*)(lds + (bufoff) + ldsw + _i * 8192), 16, 0, 0); } while (0)
#define PG8_LDA(dst, b, h) do { _Pragma("unroll") for (int m = 0; m < 4; ++m) _Pragma("unroll") for (int k = 0; k < 2; ++k) dst[m][k] = *(const LAS bf16x8*)(lds + PG8_SA(b, h) + aoff + m * 2048 + k * 1024); } while (0)
#define PG8_LDB(dst, b, h) do { _Pragma("unroll") for (int n = 0; n < 2; ++n) _Pragma("unroll") for (int k = 0; k < 2; ++k) dst[n][k] = *(const LAS bf16x8*)(lds + PG8_SB(b, h) + boff + n * 2048 + k * 1024); } while (0)
#define PG8_MMA(ai, bj, At, Bt) do { __builtin_amdgcn_s_setprio(1); _Pragma("unroll") for (int m = 0; m < 4; ++m) _Pragma("unroll") for (int n = 0; n < 2; ++n) _Pragma("unroll") for (int k = 0; k < 2; ++k) \
        acc[ai][bj][m][n] = __builtin_amdgcn_mfma_f32_16x16x32_bf16(Bt[n][k], At[m][k], acc[ai][bj][m][n], 0, 0, 0); __builtin_amdgcn_s_setprio(0); } while (0)
#define PG8_WAIT_V(n) asm volatile("s_waitcnt vmcnt(" #n ")" ::: "memory")
#define PG8_WAIT_L(n) asm volatile("s_waitcnt lgkmcnt(" #n ")" ::: "memory")
#define PG8_BAR __builtin_amdgcn_s_barrier()
#define PG8_SCHED __builtin_amdgcn_sched_barrier(0)
    Unit cur, nxt; int ui = 0;
    if (!S.next(0, cur)) return;
    f32x4 acc[2][2][4][2];
#pragma unroll
    for (int a = 0; a < 2; ++a)
#pragma unroll
        for (int b = 0; b < 2; ++b)
#pragma unroll
            for (int m = 0; m < 4; ++m)
#pragma unroll
                for (int n = 0; n < 2; ++n) acc[a][b][m][n] = (f32x4){0.f, 0.f, 0.f, 0.f};
    bf16x8 At[4][2], B0[2][2], B1[2][2];
    const char* cA = (cur.w ? S.A1 : S.A0) + (size_t)cur.pm * tstep; const char* cB = (cur.w ? S.B1 : S.B0) + (size_t)cur.pn * tstep;
    if constexpr (SP2) {
        PG8_STAGE(PG8_SB(0, 0), cB, voffB); PG8_STAGE(PG8_SB(0, 1), cB + hstep, voffB); PG8_STAGE(PG8_SA(0, 0), cA, voffA); PG8_STAGE(PG8_SA(0, 1), cA + hstep, voffA);
        if (wr == 1) PG8_BAR;
        PG8_WAIT_V(2); PG8_BAR;
        PG8_STAGE(PG8_SB(1, 0), cB + kstep, voffB); PG8_STAGE(PG8_SA(1, 0), cA + kstep, voffA); PG8_STAGE(PG8_SB(1, 1), cB + hstep + kstep, voffB);
        PG8_WAIT_V(6); PG8_BAR;
    } else {
        PG8_STAGE(PG8_SB(0, 0), cB, voffB); PG8_STAGE(PG8_SA(0, 0), cA, voffA); PG8_STAGE(PG8_SB(0, 1), cB + hstep, voffB); PG8_STAGE(PG8_SA(0, 1), cA + hstep, voffA);
        if (wr == 1) PG8_BAR;
        PG8_WAIT_V(4); PG8_BAR;
        PG8_STAGE(PG8_SB(1, 0), cB + kstep, voffB); PG8_STAGE(PG8_SA(1, 0), cA + kstep, voffA); PG8_STAGE(PG8_SB(1, 1), cB + hstep + kstep, voffB);
        PG8_WAIT_V(6); PG8_BAR;
    }
    for (;;) {
        const bool has_next = S.next(ui + 1, nxt);
        const char* nA = has_next ? (nxt.w ? S.A1 : S.A0) + (size_t)nxt.pm * tstep : cA; const char* nB = has_next ? (nxt.w ? S.B1 : S.B0) + (size_t)nxt.pn * tstep : cB;
        for (int t = 0; t < nt; t += 2) {
            const bool last = (t == nt - 2);
            const char* a1 = cA + (size_t)(t + 1) * kstep;
            const char* a2 = last ? nA : cA + (size_t)(t + 2) * kstep; const char* b2 = last ? nB : cB + (size_t)(t + 2) * kstep;
            const char* a3 = a2 + kstep; const char* b3 = b2 + kstep;
            if constexpr (SP2) {
            PG8_LDB(B0, 0, 0); PG8_LDB(B1, 0, 1); PG8_SCHED; PG8_LDA(At, 0, 0); PG8_STAGE(PG8_SA(1, 1), a1 + hstep, voffA);
            PG8_WAIT_V(8); PG8_WAIT_L(0); PG8_BAR; PG8_MMA(0, 0, At, B0); PG8_MMA(0, 1, At, B1); PG8_BAR; PG8_SCHED;
            PG8_LDA(At, 0, 1); PG8_STAGE(PG8_SB(0, 0), b2, voffB); PG8_STAGE(PG8_SB(0, 1), b2 + hstep, voffB); PG8_STAGE(PG8_SA(0, 0), a2, voffA);
            PG8_WAIT_V(8); PG8_WAIT_L(0); PG8_BAR; PG8_MMA(1, 0, At, B0); PG8_MMA(1, 1, At, B1); PG8_BAR; PG8_SCHED;
            PG8_LDB(B0, 1, 0); PG8_LDB(B1, 1, 1); PG8_SCHED; PG8_LDA(At, 1, 0); PG8_STAGE(PG8_SA(0, 1), a2 + hstep, voffA);
            PG8_WAIT_V(8); PG8_WAIT_L(0); PG8_BAR; PG8_MMA(0, 0, At, B0); PG8_MMA(0, 1, At, B1); PG8_BAR; PG8_SCHED;
            PG8_LDA(At, 1, 1); PG8_STAGE(PG8_SB(1, 0), b3, voffB); PG8_STAGE(PG8_SB(1, 1), b3 + hstep, voffB); PG8_STAGE(PG8_SA(1, 0), a3, voffA);
            PG8_WAIT_V(8); PG8_WAIT_L(0); PG8_BAR; PG8_MMA(1, 0, At, B0); PG8_MMA(1, 1, At, B1); PG8_BAR; PG8_SCHED;
            } else {
            PG8_LDB(B0, 0, 0); PG8_SCHED; PG8_LDA(At, 0, 0); PG8_STAGE(PG8_SA(1, 1), a1 + hstep, voffA);
            PG8_WAIT_L(8); PG8_BAR; PG8_WAIT_L(0); PG8_MMA(0, 0, At, B0); PG8_BAR; PG8_SCHED;
            PG8_LDB(B1, 0, 1); PG8_STAGE(PG8_SB(0, 0), b2, voffB);
            PG8_BAR; PG8_WAIT_L(0); PG8_MMA(0, 1, At, B1); PG8_BAR;
            PG8_LDA(At, 0, 1); PG8_STAGE(PG8_SA(0, 0), a2, voffA);
            PG8_BAR; PG8_WAIT_L(0); PG8_MMA(1, 0, At, B0); PG8_BAR; PG8_SCHED;
            PG8_STAGE(PG8_SB(0, 1), b2 + hstep, voffB);
            PG8_WAIT_V(6); PG8_BAR; PG8_MMA(1, 1, At, B1); PG8_BAR;
            PG8_LDB(B0, 1, 0); PG8_SCHED; PG8_LDA(At, 1, 0); PG8_STAGE(PG8_SA(0, 1), a2 + hstep, voffA);
            PG8_WAIT_L(8); PG8_BAR; PG8_WAIT_L(0); PG8_MMA(0, 0, At, B0); PG8_BAR; PG8_SCHED;
            PG8_LDB(B1, 1, 1); PG8_STAGE(PG8_SB(1, 0), b3, voffB);
            PG8_BAR; PG8_WAIT_L(0); PG8_MMA(0, 1, At, B1); PG8_BAR;
            PG8_LDA(At, 1, 1); PG8_STAGE(PG8_SA(1, 0), a3, voffA);
            PG8_BAR; PG8_WAIT_L(0); PG8_MMA(1, 0, At, B0); PG8_BAR; PG8_SCHED;
            PG8_STAGE(PG8_SB(1, 1), b3 + hstep, voffB);
            PG8_WAIT_V(6); PG8_BAR; PG8_MMA(1, 1, At, B1); PG8_BAR;
            }
        }
        if constexpr (ALIGN_EPI) { if (wr == 0) PG8_BAR; }
        epi_apply(E, acc, cur, wr, wc, fr, fq);
        if (!has_next) break;
#pragma unroll
        for (int a = 0; a < 2; ++a)
#pragma unroll
            for (int b = 0; b < 2; ++b)
#pragma unroll
                for (int m = 0; m < 4; ++m)
#pragma unroll
                    for (int n = 0; n < 2; ++n) acc[a][b][m][n] = (f32x4){0.f, 0.f, 0.f, 0.f};
        cur = nxt; cA = nA; cB = nB; ++ui;
        if constexpr (ALIGN_EPI) { if (wr == 1) PG8_BAR; }
    }
    PG8_WAIT_V(0);
    if constexpr (!ALIGN_EPI) { if (wr == 0) PG8_BAR; }
    PG8_BAR;
#undef PG8_SA
#undef PG8_SB
#undef PG8_STAGE
#undef PG8_LDA
#undef PG8_LDB
#undef PG8_MMA
#undef PG8_WAIT_V
#undef PG8_WAIT_L
#undef PG8_BAR
#undef PG8_SCHED
}
}
template <int KD, class Epi>
__device__ __forceinline__ void sample_tile(const Ctx& C, const bf16_t* A0, const bf16_t* B0, const bf16_t* A1, const bf16_t* B1, int rb, int cb, const Epi& E) {
    const int fr = C.lane & 15, fq = C.lane >> 4;
    for (int w = 0; w < (A1 ? 2 : 1); ++w) {
        const bf16_t* ap = (w ? A1 : A0) + (size_t)(TP + 16 * rb + fr) * DM + 8 * fq; const bf16_t* bp = (w ? B1 : B0) + (size_t)(16 * cb + fr) * DM + 8 * fq;
        f32x4 acc = (f32x4){0.f, 0.f, 0.f, 0.f};
#pragma unroll 16
        for (int ks = 0; ks < DM / 32; ++ks) { const bf16x8 a = *(const bf16x8*)(ap + 32 * ks), b = *(const bf16x8*)(bp + 32 * ks); acc = __builtin_amdgcn_mfma_f32_16x16x32_bf16(b, a, acc, 0, 0, 0); }
        E.template apply<KD>(w, TP + 16 * rb + fr, 16 * cb + 4 * fq, acc);
    }
}
template <class Epi>
__device__ __forceinline__ void gemm_sample(const Ctx& C, const bf16_t* A0, const bf16_t* B0, const bf16_t* A1, const bf16_t* B1, int N, const Epi& E) {
    const int gw = C.bid * NWAVES + C.wave, NGW = C.G * NWAVES, ncb = N / 16;
    for (int it = gw; it < 8 * ncb; it += NGW) {
        const int cb = it >> 3, rb = it & 7; const int kd = E.kind(cb >> 4);
        if constexpr (Epi::NK == 1) sample_tile<0>(C, A0, B0, A1, B1, rb, cb, E);
        else { if (kd == 0) sample_tile<0>(C, A0, B0, A1, B1, rb, cb, E); else if (kd == 1) sample_tile<1>(C, A0, B0, A1, B1, rb, cb, E);
            else if constexpr (Epi::NK > 2) { if (kd == 2) sample_tile<2>(C, A0, B0, A1, B1, rb, cb, E); else if (kd == 3) sample_tile<3>(C, A0, B0, A1, B1, rb, cb, E); else sample_tile<4>(C, A0, B0, A1, B1, rb, cb, E); } }
    }
}
template <class Epi>
__device__ __forceinline__ void gemm_run(const Ctx& C, const bf16_t* A0, const bf16_t* B0, const bf16_t* A1, const bf16_t* B1, int N, const Epi& E) {
    gemm_sample(C, A0, B0, A1, B1, N, E);
    pg8::Sched S; S.nM = TP / 256; S.nN = N / 256; S.nW = A1 ? 2 : 1; S.nwg = S.nM * S.nN; S.G = C.G; S.c = C.bid;
    S.A0 = (const char*)A0; S.B0 = (const char*)B0; S.A1 = (const char*)A1; S.B1 = (const char*)B1;
    pg8::gemm_phase<Epi>(C.lds, C.tid, DM, S, E);
    __syncthreads();
}

__device__ __forceinline__ unsigned cvt_pk_bf16(float lo, float hi) { unsigned r; asm volatile("v_cvt_pk_bf16_f32 %0, %1, %2" : "=v"(r) : "v"(lo), "v"(hi)); return r; }
__device__ __forceinline__ bf16x8 pack_acc(const f32x16& a, int t) {
    u32x4 w;
    if (t == 0) { w.x = cvt_pk_bf16(a[0], a[1]); w.y = cvt_pk_bf16(a[2], a[3]); w.z = cvt_pk_bf16(a[4], a[5]); w.w = cvt_pk_bf16(a[6], a[7]); }
    else { w.x = cvt_pk_bf16(a[8], a[9]); w.y = cvt_pk_bf16(a[10], a[11]); w.z = cvt_pk_bf16(a[12], a[13]); w.w = cvt_pk_bf16(a[14], a[15]); }
    return __builtin_bit_cast(bf16x8, w);
}
__device__ __forceinline__ int sig_pos(int s) { return (s & ~15) | (((s >> 2) & 1) << 3) | (((s >> 3) & 1) << 2) | (s & 3); }
constexpr int SROW = 144;

template <int WSTR>
__device__ __forceinline__ void conv8(const u32x4 (&rw)[4], const LAS float* wl, float (&v)[8]) {
    f32x4 w[5][2];
#pragma unroll
    for (int k = 0; k < 5; ++k) { w[k][0] = *(const LAS f32x4*)(wl + k * WSTR); w[k][1] = *(const LAS f32x4*)(wl + k * WSTR + 4); }
#pragma unroll
    for (int e = 0; e < 8; ++e) { const int dw = e >> 1; const bool hi = e & 1;
        float x[4];
#pragma unroll
        for (int k = 0; k < 4; ++k) { const unsigned q = dw == 0 ? rw[k].x : (dw == 1 ? rw[k].y : (dw == 2 ? rw[k].z : rw[k].w)); x[k] = hi ? bfhi(q) : bflo(q); }
        v[e] = w[4][e >> 2][e & 3] + w[0][e >> 2][e & 3] * x[0] + w[1][e >> 2][e & 3] * x[1] + w[2][e >> 2][e & 3] * x[2] + w[3][e >> 2][e & 3] * x[3]; }
}
constexpr size_t WS_CBC = WS_EI;
__device__ __forceinline__ void phase_convbc(const Ctx& C, int l) {
    CParams& P = *C.P;
    const bf16_t* XBC = WSP(bf16_t, WS_B2); bf16_t* CBC = WSP(bf16_t, WS_CBC);
    const float* cw = as_global(P.in[IN_SCW]) + (size_t)l * 4 * 1280 + 1024; const float* cbp = as_global(P.in[IN_SCB]) + (size_t)l * 1280 + 1024;
    const float* cst = as_global(P.in[IN_SSDCONV]) + (size_t)l * 8 * 3 * 1280;
    const size_t items = (size_t)TT * 32, stride = (size_t)C.G * NTHREADS;
    for (size_t it = (size_t)C.bid * NTHREADS + C.tid; it < items; it += stride) {
        const int tok = (int)(it >> 5), cg = (int)(it & 31), ch = cg * 8;
        const bool smp = tok >= TP; const int b = smp ? (tok - TP) >> 4 : tok >> 11, t = smp ? (tok - TP) & 15 : tok & 2047, L = smp ? 16 : 2048, NB = smp ? 8 : 16;
        u32x4 rw[4];
#pragma unroll
        for (int k = 0; k < 4; ++k) { const int tr = t - 3 + k;
            if (tr >= 0) rw[k] = *(const u32x4*)(XBC + (size_t)(tok - t + tr) * 1280 + 1024 + ch);
            else if (smp) { const float* s0 = cst + ((size_t)b * 3 + (tr + 3)) * 1280 + 1024 + ch; const f32x4 a0 = *(const f32x4*)s0, a1 = *(const f32x4*)(s0 + 4);
                rw[k] = (u32x4){pk2(a0[0], a0[1]), pk2(a0[2], a0[3]), pk2(a1[0], a1[1]), pk2(a1[2], a1[3])}; }
            else rw[k] = (u32x4){0u, 0u, 0u, 0u}; }
        f32x4 w[5][2];
#pragma unroll
        for (int k = 0; k < 4; ++k) { w[k][0] = *(const f32x4*)(cw + k * 1280 + ch); w[k][1] = *(const f32x4*)(cw + k * 1280 + ch + 4); }
        w[4][0] = *(const f32x4*)(cbp + ch); w[4][1] = *(const f32x4*)(cbp + ch + 4);
        float v[8];
#pragma unroll
        for (int e = 0; e < 8; ++e) { const int dw = e >> 1; const bool hi = e & 1; float x[4];
#pragma unroll
            for (int k = 0; k < 4; ++k) { const unsigned q = dw == 0 ? rw[k].x : (dw == 1 ? rw[k].y : (dw == 2 ? rw[k].z : rw[k].w)); x[k] = hi ? bfhi(q) : bflo(q); }
            v[e] = siluf_(w[4][e >> 2][e & 3] + w[0][e >> 2][e & 3] * x[0] + w[1][e >> 2][e & 3] * x[1] + w[2][e >> 2][e & 3] * x[2] + w[3][e >> 2][e & 3] * x[3]); }
        *(u32x4*)(CBC + (size_t)tok * 256 + ch) = (u32x4){pk2(v[0], v[1]), pk2(v[2], v[3]), pk2(v[4], v[5]), pk2(v[6], v[7])};
        if (t >= L - 3) { float* co = C.out + (smp ? O_SSCONV : O_PSCONV) + ((size_t)(l * NB + b) * 3 + (t - (L - 3))) * 1280 + 1024 + ch; const u32x4 q = rw[3];
            *(f32x4*)co = (f32x4){bflo(q.x), bfhi(q.x), bflo(q.y), bfhi(q.y)}; *(f32x4*)(co + 4) = (f32x4){bflo(q.z), bfhi(q.z), bflo(q.w), bfhi(q.w)}; }
    }
}

#ifndef SCAN_SKIP
#define SCAN_SKIP 0
#endif
__device__ __forceinline__ void scan_item_fused(const Ctx& C, int l, int idx, bool dry) {
    const int skip = dry ? SCAN_SKIP : 0;
    CParams& P = *C.P; const int tid = C.tid, lane = C.lane, wave = C.wave;
    const bool smp = idx >= 256; const int ii = smp ? idx - 256 : idx; const int b = ii >> 4, head = ii & 15, g = head >> 3, j = head;
    const int tok0 = smp ? TP + b * 16 : b * 2048, L = smp ? 16 : 2048, NB = smp ? 8 : 16, nchunk = smp ? 1 : 32;
    const bf16_t* XBC = WSP(bf16_t, WS_B2); const bf16_t* CBC = WSP(bf16_t, WS_CBC); bf16_t* Z = WSP(bf16_t, WS_B1); const float* DT = WSP(float, WS_DT); float* SSQ = WSP(float, WS_SSQ);
    const float a_h = -__expf(as_global(P.in[IN_ALOG])[l * 16 + head]), Dh = as_global(P.in[IN_SSDD])[l * 16 + head];
    LAS unsigned char* bmS = C.lds; LAS unsigned char* cmS = C.lds + 9216; LAS unsigned char* xsT = C.lds + 18432; LAS unsigned char* bmT = C.lds + 27648;
    LAS float* ybuf = (LAS float*)(C.lds + 36864);
    LAS float* acum = (LAS float*)(C.lds + 53248); LAS float* dtv = acum + 64; LAS float* eac = acum + 128; LAS float* wsc = acum + 192; LAS float* misc = acum + 256; LAS float* cwl = acum + 320;
    const int t = tid >> 3, cg = tid & 7;
    const int chx = head * 64 + cg * 8, chb = 1024 + g * 64 + cg * 8, chc = 1152 + g * 64 + cg * 8;
    const float* scw = as_global(P.in[IN_SCW]) + (size_t)l * 4 * 1280; const float* scb = as_global(P.in[IN_SCB]) + (size_t)l * 1280;
    const float* scst = smp ? as_global(P.in[IN_SSDCONV]) + (size_t)(l * 8 + b) * 3 * 1280 : nullptr;
    const int qb = (wave >> 1) & 1, pb = wave & 1, r = lane & 31, hh = lane >> 5;
    f32x16 hacc[2];
#pragma unroll
    for (int nb = 0; nb < 2; ++nb)
#pragma unroll
        for (int i = 0; i < 16; ++i) hacc[nb][i] = 0.f;
    if (smp && wave < 4) {
        const float* hs = as_global(P.in[IN_SSD]) + ((size_t)((l * 8 + b) * 16 + head) * 64 + 32 * pb + r) * 64;
#pragma unroll
        for (int nb = 0; nb < 2; ++nb)
#pragma unroll
            for (int i4 = 0; i4 < 4; ++i4) { const f32x4 v = *(const f32x4*)(hs + 32 * nb + 8 * i4 + 4 * hh); hacc[nb][4 * i4] = v[0]; hacc[nb][4 * i4 + 1] = v[1]; hacc[nb][4 * i4 + 2] = v[2]; hacc[nb][4 * i4 + 3] = v[3]; }
    }
    const bf16_t* LX = WSP(bf16_t, WS_B3); bf16_t* LY = WSP(bf16_t, WS_B4);
    LAS unsigned char* LB = C.lds + 65536;
    LAS unsigned char* xcB = LB; LAS unsigned char* waT = LB + 9216; LAS unsigned char* wxT = LB + 18432;
    LAS float* xcF = (LAS float*)(LB + 27648); LAS float* aF = (LAS float*)(LB + 44032); LAS float* uF = (LAS float*)(LB + 60416); LAS float* lcwl = (LAS float*)(LB + 76800);
    const int ch0 = j * 64 + cg * 8;
    const float* lcw = as_global(P.in[IN_LCW]) + (size_t)l * 4 * DM; const float* lcb = as_global(P.in[IN_LCB]) + (size_t)l * DM;
    const float* lcst = smp ? as_global(P.in[IN_LRUCONV]) + (size_t)(l * 8 + b) * 3 * DM : nullptr;
    const int tb = qb, eb = pb, ech = j * 64 + 32 * eb + r;
    const float ba = as_global(P.in[IN_BA])[l * DM + ech], bxx = as_global(P.in[IN_BX])[l * DM + ech], sp8 = -8.0f * softplusf_(-as_global(P.in[IN_LAM])[l * DM + ech]);
    float hstate = (smp && wave == 4) ? as_global(P.in[IN_LRU])[(size_t)(l * 8 + b) * DM + j * 64 + lane] : 0.f;
    __syncthreads();
    for (int i = tid; i < 5 * 192; i += NTHREADS) { const int k = i / 192, cc = i % 192; const int ch = cc < 64 ? head * 64 + cc : (cc < 128 ? 1024 + g * 64 + (cc - 64) : 1152 + g * 64 + (cc - 128));
        cwl[i] = k < 4 ? scw[k * 1280 + ch] : scb[ch]; }
    { const float* wap = as_global(P.in[IN_WA]) + (size_t)(l * 16 + j) * 4096; const float* wxp = as_global(P.in[IN_WX]) + (size_t)(l * 16 + j) * 4096;
      for (int i = tid; i < 4096; i += NTHREADS) { const int d = i >> 6, e = i & 63; *(LAS bf16_t*)(waT + e * SROW + d * 2) = (bf16_t)f2bf(wap[i]); *(LAS bf16_t*)(wxT + e * SROW + d * 2) = (bf16_t)f2bf(wxp[i]); } }
    for (int i = tid; i < 5 * 64; i += NTHREADS) { const int k = i >> 6, cc = i & 63; lcwl[i] = k < 4 ? lcw[k * DM + j * 64 + cc] : lcb[j * 64 + cc]; }
    u32x4 rw[4], bcv, ccv, lrw[4], zs, lyv; float dtl = 0.f;
#define RAWROW(dst, base, ld, ch, cstp, tr) { if ((tr) >= 0) dst = ((tr) < L) ? *(const u32x4*)((base) + (size_t)(tok0 + (tr)) * (ld) + (ch)) : (u32x4){0u, 0u, 0u, 0u}; \
        else if (smp) { const float* s0_ = (cstp) + (size_t)((tr) + 3) * (ld) + (ch); const f32x4 a0_ = *(const f32x4*)s0_, a1_ = *(const f32x4*)(s0_ + 4); \
            dst = (u32x4){pk2(a0_[0], a0_[1]), pk2(a0_[2], a0_[3]), pk2(a1_[0], a1_[1]), pk2(a1_[2], a1_[3])}; } else dst = (u32x4){0u, 0u, 0u, 0u}; }
#define SSD_LOAD(c_) { const int tg_ = (c_) * 64 + t; _Pragma("unroll") for (int k = 0; k < 4; ++k) { RAWROW(rw[k], XBC, 1280, chx, scst, tg_ - 3 + k) } \
        const bool v_ = tg_ < L; bcv = v_ ? *(const u32x4*)(CBC + (size_t)(tok0 + tg_) * 256 + g * 64 + cg * 8) : (u32x4){0u, 0u, 0u, 0u}; ccv = v_ ? *(const u32x4*)(CBC + (size_t)(tok0 + tg_) * 256 + 128 + g * 64 + cg * 8) : (u32x4){0u, 0u, 0u, 0u}; \
        }
#define LRU_LOAD(c_) { const int tg_ = (c_) * 64 + t; _Pragma("unroll") for (int k = 0; k < 4; ++k) { RAWROW(lrw[k], LX, DM, ch0, lcst, tg_ - 3 + k) } }
#define TAIL_LOAD(c_) { const int tg_ = (c_) * 64 + t; const bool v_ = tg_ < L; zs = v_ ? *(const u32x4*)(Z + (size_t)(tok0 + tg_) * DM + chx) : (u32x4){0u, 0u, 0u, 0u}; lyv = v_ ? *(const u32x4*)(LY + (size_t)(tok0 + tg_) * DM + ch0) : (u32x4){0u, 0u, 0u, 0u}; }
    SSD_LOAD(0) LRU_LOAD(0) TAIL_LOAD(0)
    if (wave == 0) dtl = (lane < L) ? DT[(size_t)(tok0 + lane) * 16 + head] : 0.f;
    __syncthreads();
    for (int c = 0; c < nchunk; ++c) {
        int lt_ = tid; asm volatile("" : "+v"(lt_));
        const int t = lt_ >> 3, cg = lt_ & 7, lane = lt_ & 63, r = lane & 31, hh = lane >> 5;
        const int chx = head * 64 + cg * 8, chb = 1024 + g * 64 + cg * 8, chc = 1152 + g * 64 + cg * 8, ch0 = j * 64 + cg * 8;
        const int tg = c * 64 + t; const bool valid = tg < L;
        if (wave == 0 && !(skip & 128)) {
            float cs = dtl * a_h;
            { float o = shfl_f(cs, lane - 1); if (lane >= 1) cs += o; o = shfl_f(cs, lane - 2); if (lane >= 2) cs += o; o = shfl_f(cs, lane - 4); if (lane >= 4) cs += o;
              o = shfl_f(cs, lane - 8); if (lane >= 8) cs += o; o = shfl_f(cs, lane - 16); if (lane >= 16) cs += o; o = shfl_f(cs, lane - 32); if (lane >= 32) cs += o; }
            const float tot = shfl_f(cs, 63);
            acum[lane] = cs; dtv[lane] = dtl; eac[lane] = __expf(cs); wsc[lane] = __expf(tot - cs) * dtl; if (lane == 0) misc[0] = __expf(tot);
        }
        if (!(skip & 32)) {
            float v[8]; conv8<64>(lrw, lcwl + cg * 8, v);
            *(LAS u32x4*)(xcB + t * SROW + cg * 16) = (u32x4){pk2(v[0], v[1]), pk2(v[2], v[3]), pk2(v[4], v[5]), pk2(v[6], v[7])};
            *(LAS f32x4*)(xcF + t * 64 + cg * 8) = (f32x4){v[0], v[1], v[2], v[3]}; *(LAS f32x4*)(xcF + t * 64 + cg * 8 + 4) = (f32x4){v[4], v[5], v[6], v[7]};
            if (!dry && valid && tg >= L - 3) { float* co = C.out + (smp ? O_SLCONV : O_PLCONV) + ((size_t)(l * NB + b) * 3 + (tg - (L - 3))) * DM + ch0; const u32x4 q = lrw[3];
                *(f32x4*)co = (f32x4){bflo(q.x), bfhi(q.x), bflo(q.y), bfhi(q.y)}; *(f32x4*)(co + 4) = (f32x4){bflo(q.z), bfhi(q.z), bflo(q.w), bfhi(q.w)}; }
        }
        LRU_LOAD(c + 1)
        if (!(skip & 256)) __syncthreads();
        if (!(skip & 16)) {
            const float wsl = wsc[t]; const int ps = sig_pos(t);
            { float v[8]; conv8<192>(rw, cwl + cg * 8, v);
#pragma unroll
              for (int e = 0; e < 8; ++e) { const float sv_ = valid ? siluf_(v[e]) : 0.f; asm volatile("" :: "v"(sv_)); if (!(skip & 1)) *(LAS bf16_t*)(xsT + (cg * 8 + e) * SROW + ps * 2) = (bf16_t)f2bf(sv_); } }
            const int gq = cg >> 1, aq = cg & 1;
            { LAS unsigned char* rowp = bmS + t * SROW;
              *(LAS u32x2*)(rowp + (16 * gq + 4 * aq) * 2) = (u32x2){bcv.x, bcv.y}; *(LAS u32x2*)(rowp + (16 * gq + 8 + 4 * aq) * 2) = (u32x2){bcv.z, bcv.w};
              const float v[8] = {bflo(bcv.x), bfhi(bcv.x), bflo(bcv.y), bfhi(bcv.y), bflo(bcv.z), bfhi(bcv.z), bflo(bcv.w), bfhi(bcv.w)};
#pragma unroll
              for (int e = 0; e < 8; ++e) if (!(skip & 1)) *(LAS bf16_t*)(bmT + (cg * 8 + e) * SROW + ps * 2) = (bf16_t)f2bf(v[e] * wsl); }
            { LAS unsigned char* rowp = cmS + t * SROW;
              *(LAS u32x2*)(rowp + (16 * gq + 4 * aq) * 2) = (u32x2){ccv.x, ccv.y}; *(LAS u32x2*)(rowp + (16 * gq + 8 + 4 * aq) * 2) = (u32x2){ccv.z, ccv.w}; }
            if (!dry && valid && tg >= L - 3) { float* co = C.out + (smp ? O_SSCONV : O_PSCONV) + ((size_t)(l * NB + b) * 3 + (tg - (L - 3))) * 1280 + chx; const u32x4 q = rw[3];
                *(f32x4*)co = (f32x4){bflo(q.x), bfhi(q.x), bflo(q.y), bfhi(q.y)}; *(f32x4*)(co + 4) = (f32x4){bflo(q.z), bfhi(q.z), bflo(q.w), bfhi(q.w)}; }
        }
        asm volatile("" ::: "memory");
        SSD_LOAD(c + 1)
        if (wave == 0) { const int tq_ = (c + 1) * 64 + lane; dtl = (tq_ < L) ? DT[(size_t)(tok0 + tq_) * 16 + head] : 0.f; }
        if (wave >= 4 && !(skip & 2)) {
            f32x16 ra, ia;
#pragma unroll
            for (int i = 0; i < 16; ++i) { ra[i] = 0.f; ia[i] = 0.f; }
#pragma unroll
            for (int ks = 0; ks < 4; ++ks) { const bf16x8 A = *(const LAS bf16x8*)(xcB + (32 * tb + r) * SROW + (16 * ks + 8 * hh) * 2);
                const bf16x8 Ba = *(const LAS bf16x8*)(waT + (32 * eb + r) * SROW + (16 * ks + 8 * hh) * 2), Bx = *(const LAS bf16x8*)(wxT + (32 * eb + r) * SROW + (16 * ks + 8 * hh) * 2);
                ra = MFMA32(A, Ba, ra); ia = MFMA32(A, Bx, ia); }
#pragma unroll
            for (int i = 0; i < 16; ++i) { const int tt = 32 * tb + (i & 3) + 8 * (i >> 2) + 4 * hh, e = 32 * eb + r;
                const float rg = sigmoidf_(ra[i] + ba), ig = sigmoidf_(ia[i] + bxx), log_a = rg * sp8, av = exp_fast(log_a);
                const float u = __builtin_amdgcn_sqrtf(fmaxf(1.0f - av * av, 0.f)) * (ig * xcF[tt * 64 + e]);
                aF[tt * 64 + e] = av; uF[tt * 64 + e] = u; }
        }
        if (!(skip & 256)) __syncthreads();
        if (wave < 4 && !(skip & 4)) {
            f32x16 y;
#pragma unroll
            for (int i = 0; i < 16; ++i) y[i] = 0.f;
#pragma unroll
            for (int nb = 0; nb < 2; ++nb)
#pragma unroll
                for (int tt = 0; tt < 2; ++tt) { const bf16x8 A = *(const LAS bf16x8*)(cmS + (32 * qb + r) * SROW + (32 * nb + 16 * tt + 8 * hh) * 2); y = MFMA32(A, pack_acc(hacc[nb], tt), y); }
#pragma unroll
            for (int i = 0; i < 16; ++i) y[i] *= eac[32 * qb + (i & 3) + 8 * (i >> 2) + 4 * hh];
            const float aq = acum[32 * qb + r]; const int qg = 32 * qb + r;
            for (int sb = 0; sb <= qb; ++sb) {
                f32x16 cbt;
#pragma unroll
                for (int i = 0; i < 16; ++i) cbt[i] = 0.f;
#pragma unroll
                for (int ks = 0; ks < 4; ++ks) { const bf16x8 A = *(const LAS bf16x8*)(bmS + (32 * sb + r) * SROW + (16 * ks + 8 * hh) * 2), B = *(const LAS bf16x8*)(cmS + (32 * qb + r) * SROW + (16 * ks + 8 * hh) * 2); cbt = MFMA32(A, B, cbt); }
#pragma unroll
                for (int i = 0; i < 16; ++i) { const int sg = 32 * sb + (i & 3) + 8 * (i >> 2) + 4 * hh;
                    float wv = cbt[i] * exp_fast(fminf(aq - acum[sg], 0.f)) * dtv[sg]; wv = sg > qg ? 0.f : wv; wv = sg == qg ? wv + Dh : wv; cbt[i] = wv; }
#pragma unroll
                for (int tt = 0; tt < 2; ++tt) { const bf16x8 B = *(const LAS bf16x8*)(xsT + (32 * pb + r) * SROW + (32 * sb + 16 * tt + 8 * hh) * 2); y = MFMA32(pack_acc(cbt, tt), B, y); }
            }
#pragma unroll
            for (int i = 0; i < 16; ++i) ybuf[(32 * qb + (i & 3) + 8 * (i >> 2) + 4 * hh) * 64 + 32 * pb + r] = y[i];
            const float dec = misc[0];
#pragma unroll
            for (int nb = 0; nb < 2; ++nb) {
#pragma unroll
                for (int i = 0; i < 16; ++i) hacc[nb][i] *= dec;
#pragma unroll
                for (int ks = 0; ks < 4; ++ks) { const bf16x8 A = *(const LAS bf16x8*)(bmT + (32 * nb + r) * SROW + (16 * ks + 8 * hh) * 2), B = *(const LAS bf16x8*)(xsT + (32 * pb + r) * SROW + (16 * ks + 8 * hh) * 2); hacc[nb] = MFMA32(A, B, hacc[nb]); }
            }
        } else if (wave == 4 && !(skip & 8)) {
            const int nsteps = (L - c * 64) < 64 ? (L - c * 64) : 64;
            for (int s0 = 0; s0 < nsteps; s0 += 8) {
                float av[8], uv[8];
#pragma unroll
                for (int q = 0; q < 8; ++q) { av[q] = aF[(s0 + q) * 64 + lane]; uv[q] = uF[(s0 + q) * 64 + lane]; }
#pragma unroll
                for (int q = 0; q < 8; ++q) { hstate = (s0 + q < nsteps) ? av[q] * hstate + uv[q] : hstate; uF[(s0 + q) * 64 + lane] = hstate; }
            }
        }
        if (!(skip & 256)) __syncthreads();
        if (!(skip & 64)) {
            const f32x4 y0 = *(const LAS f32x4*)(ybuf + t * 64 + cg * 8), y1 = *(const LAS f32x4*)(ybuf + t * 64 + cg * 8 + 4);
            const float o0 = y0[0] * bflo(zs.x), o1 = y0[1] * bfhi(zs.x), o2 = y0[2] * bflo(zs.y), o3 = y0[3] * bfhi(zs.y);
            const float o4 = y1[0] * bflo(zs.z), o5 = y1[1] * bfhi(zs.z), o6 = y1[2] * bflo(zs.w), o7 = y1[3] * bfhi(zs.w);
            float ss = (o0 * o0 + o1 * o1) + (o2 * o2 + o3 * o3) + (o4 * o4 + o5 * o5) + (o6 * o6 + o7 * o7);
            ss = row8_sum(ss);
            const f32x4 h0 = *(const LAS f32x4*)(uF + t * 64 + cg * 8), h1 = *(const LAS f32x4*)(uF + t * 64 + cg * 8 + 4);
            asm volatile("" :: "v"(o0), "v"(o7), "v"(ss), "v"(h0[0]), "v"(h1[3]));
            if (valid && !dry) { *(u32x4*)(Z + (size_t)(tok0 + tg) * DM + chx) = (u32x4){pk2(o0, o1), pk2(o2, o3), pk2(o4, o5), pk2(o6, o7)};
                if (cg == 0) SSQ[(size_t)(tok0 + tg) * 16 + head] = ss;
                *(u32x4*)(LY + (size_t)(tok0 + tg) * DM + ch0) = (u32x4){pk2(h0[0] * bflo(lyv.x), h0[1] * bfhi(lyv.x)), pk2(h0[2] * bflo(lyv.y), h0[3] * bfhi(lyv.y)),
                                                                          pk2(h1[0] * bflo(lyv.z), h1[1] * bfhi(lyv.z)), pk2(h1[2] * bflo(lyv.w), h1[3] * bfhi(lyv.w))}; }
        }
        if (skip & 512) {
#pragma unroll
            for (int k = 0; k < 4; ++k) asm volatile("" :: "v"(rw[k].x), "v"(rw[k].w), "v"(lrw[k].x), "v"(lrw[k].w));
            asm volatile("" :: "v"(bcv.x), "v"(ccv.x), "v"(zs.x), "v"(lyv.x), "v"(dtl)); }
        TAIL_LOAD(c + 1)
    }
#undef RAWROW
#undef SSD_LOAD
#undef LRU_LOAD
#undef TAIL_LOAD
    if (!dry && wave < 4 && qb == 0) {
        float* so = C.out + (smp ? O_SSSD : O_PSSD) + ((size_t)((l * NB + b) * 16 + head) * 64 + 32 * pb + r) * 64;
#pragma unroll
        for (int nb = 0; nb < 2; ++nb)
#pragma unroll
            for (int i4 = 0; i4 < 4; ++i4) *(f32x4*)(so + 32 * nb + 8 * i4 + 4 * hh) = (f32x4){hacc[nb][4 * i4], hacc[nb][4 * i4 + 1], hacc[nb][4 * i4 + 2], hacc[nb][4 * i4 + 3]};
    }
    if (wave == 4 && !dry) C.out[(smp ? O_SLRU : O_PLRU) + (size_t)(l * NB + b) * DM + j * 64 + lane] = hstate;
    __syncthreads();
}

__device__ __forceinline__ void phase_scan(const Ctx& C, int l, bool dry = false) {
    for (int it = C.bid; it < 384; it += C.G) scan_item_fused(C, l, it, dry);
}

__device__ __forceinline__ unsigned mono(float f) { const unsigned u = __float_as_uint(f); return (u & 0x80000000u) ? ~u : (u | 0x80000000u); }
__device__ __forceinline__ float unmono(unsigned k) { const unsigned u = (k & 0x80000000u) ? (k & 0x7fffffffu) : ~k; return __uint_as_float(u); }
template <int CTRL> __device__ __forceinline__ unsigned dpp_u(unsigned v) { return (unsigned)__builtin_amdgcn_update_dpp(0, (int)v, CTRL, 0xf, 0xf, true); }
__device__ __forceinline__ unsigned row_max_u(unsigned m) {
    m = max(m, dpp_u<0xB1>(m)); m = max(m, dpp_u<0x4E>(m)); m = max(m, dpp_u<0x141>(m)); m = max(m, dpp_u<0x140>(m)); return m;
}
__device__ __forceinline__ float row_max_f(float m) {
    m = fmaxf(m, __uint_as_float(dpp_u<0xB1>(__float_as_uint(m)))); m = fmaxf(m, __uint_as_float(dpp_u<0x4E>(__float_as_uint(m))));
    m = fmaxf(m, __uint_as_float(dpp_u<0x141>(__float_as_uint(m)))); m = fmaxf(m, __uint_as_float(dpp_u<0x140>(__float_as_uint(m)))); return m;
}
__device__ __forceinline__ float row_sum_f(float m) {
    m += __uint_as_float(dpp_u<0xB1>(__float_as_uint(m))); m += __uint_as_float(dpp_u<0x4E>(__float_as_uint(m)));
    m += __uint_as_float(dpp_u<0x141>(__float_as_uint(m))); m += __uint_as_float(dpp_u<0x140>(__float_as_uint(m))); return m;
}
#define CE_(a, b) { const unsigned hi_ = max(a, b), lo_ = min(a, b); a = hi_; b = lo_; }
#define KEY8(k, a, b) unsigned k##0 = (mono(a[0]) & ~127u) | (unsigned)(127 - (li * 8 + 0)), k##1 = (mono(a[1]) & ~127u) | (unsigned)(127 - (li * 8 + 1)), k##2 = (mono(a[2]) & ~127u) | (unsigned)(127 - (li * 8 + 2)), \
        k##3 = (mono(a[3]) & ~127u) | (unsigned)(127 - (li * 8 + 3)), k##4 = (mono(b[0]) & ~127u) | (unsigned)(127 - (li * 8 + 4)), k##5 = (mono(b[1]) & ~127u) | (unsigned)(127 - (li * 8 + 5)), \
        k##6 = (mono(b[2]) & ~127u) | (unsigned)(127 - (li * 8 + 6)), k##7 = (mono(b[3]) & ~127u) | (unsigned)(127 - (li * 8 + 7));
#define SORT8(k) CE_(k##0, k##1) CE_(k##2, k##3) CE_(k##4, k##5) CE_(k##6, k##7)  CE_(k##0, k##2) CE_(k##1, k##3) CE_(k##4, k##6) CE_(k##5, k##7)  CE_(k##1, k##2) CE_(k##5, k##6) \
        CE_(k##0, k##4) CE_(k##1, k##5) CE_(k##2, k##6) CE_(k##3, k##7)  CE_(k##2, k##4) CE_(k##3, k##5)  CE_(k##1, k##2) CE_(k##3, k##4) CE_(k##5, k##6)
#define POP8(k, m, c) k##0 = c ? k##1 : k##0; k##1 = c ? k##2 : k##1; k##2 = c ? k##3 : k##2; k##3 = c ? k##4 : k##3; k##4 = c ? k##5 : k##4; k##5 = c ? k##6 : k##5; k##6 = c ? k##7 : k##6; k##7 = c ? 0u : k##7;
__device__ __forceinline__ void top16_row2(const f32x4 a0, const f32x4 b0, const f32x4 a1, const f32x4 b1, int li, unsigned& r0, unsigned& r1) {
    KEY8(x, a0, b0) KEY8(y, a1, b1)
    SORT8(x) SORT8(y)
    unsigned rx = 0u, ry = 0u;
#pragma unroll
    for (int r = 0; r < 16; ++r) {
        const unsigned mx = row_max_u(x0), my = row_max_u(y0); const bool cx = (x0 == mx), cy = (y0 == my);
        POP8(x, mx, cx) POP8(y, my, cy)
        rx = (li == r) ? mx : rx; ry = (li == r) ? my : ry;
    }
    r0 = rx; r1 = ry;
}
#undef KEY8
#undef SORT8
#undef POP8
__device__ __forceinline__ void phase_topk(const Ctx& C) {
    const float* SC = WSP(float, WS_SC); int* EI = WSP(int, WS_EI); float* GW = WSP(float, WS_GW);
    const int lane = C.lane, li = lane & 15, rowi = lane >> 4;
    LAS float* sv = (LAS float*)(C.lds + 4096 + C.wave * 1024);
    LAS int* si = (LAS int*)(sv + 128);
    LAS unsigned char* tab = (LAS unsigned char*)C.lds;
    if (C.tid < 64) { int c = C.tid, i = 0; for (; i < 16; ++i) { const int cnt = 16 / (i + 1); if (c < cnt) break; c -= cnt; } tab[C.tid] = (unsigned char)(C.tid < 50 ? (i | (c << 4)) : 0); }
    __syncthreads();
    int ica[4], jca[4];
#pragma unroll
    for (int q = 0; q < 4; ++q) { const int tb = tab[4 * li + q]; ica[q] = tb & 15; jca[q] = tb >> 4; }
    const int gw = C.bid * NWAVES + C.wave, NGW = C.G * NWAVES;
    f32x4 na0, nb0, na1, nb1;
    { const float* base = SC + (size_t)min(gw, TT * 2 - 1) * 1024;
      na0 = *(const f32x4*)(base + lane * 8); nb0 = *(const f32x4*)(base + lane * 8 + 4); na1 = *(const f32x4*)(base + 512 + lane * 8); nb1 = *(const f32x4*)(base + 512 + lane * 8 + 4); }
    for (int g4 = gw; g4 < TT * 2; g4 += NGW) {
        const int row = g4 >> 1, hd0 = (g4 & 1) * 4;
        const f32x4 a0 = na0, b0 = nb0, a1 = na1, b1 = nb1;
        { const float* base = SC + (size_t)min(g4 + NGW, TT * 2 - 1) * 1024;
          na0 = *(const f32x4*)(base + lane * 8); nb0 = *(const f32x4*)(base + lane * 8 + 4); na1 = *(const f32x4*)(base + 512 + lane * 8); nb1 = *(const f32x4*)(base + 512 + lane * 8 + 4); }
        unsigned r0, r1; top16_row2(a0, b0, a1, b1, li, r0, r1);
        sv[lane] = unmono(r0 & ~127u); si[lane] = 127 - (int)(r0 & 127u); sv[64 + lane] = unmono(r1 & ~127u); si[64 + lane] = 127 - (int)(r1 & 127u);
        LDS_WAIT();
        const LAS float* v1 = sv + rowi * 32; const LAS float* v2 = v1 + 16;
        unsigned k[4];
#pragma unroll
        for (int q = 0; q < 4; ++q) { const int c = 4 * li + q; const float sum = v1[ica[q]] + v2[jca[q]]; k[q] = (c < 50) ? ((mono(sum) & ~63u) | (unsigned)(63 - c)) : 0u; }
        CE_(k[0], k[1]) CE_(k[2], k[3]) CE_(k[0], k[2]) CE_(k[1], k[3]) CE_(k[1], k[2])
        unsigned res = 0u;
#pragma unroll
        for (int r = 0; r < 16; ++r) {
            const unsigned m = row_max_u(k[0]); const bool c = (k[0] == m);
            k[0] = c ? k[1] : k[0]; k[1] = c ? k[2] : k[1]; k[2] = c ? k[3] : k[2]; k[3] = c ? 0u : k[3];
            res = (li == r) ? m : res;
        }
        const int csel = 63 - (int)(res & 63u); const int tb = tab[csel];
        const int e1 = (si + rowi * 32)[tb & 15], e2 = (si + rowi * 32 + 16)[tb >> 4];
        const float svv = unmono(res & ~63u);
        const float mx = row_max_f(svv), ex = __expf(svv - mx), den = row_sum_f(ex);
        const size_t o = (size_t)row * 128 + (hd0 + rowi) * 16 + li;
        EI[o] = e1 * 128 + e2; GW[o] = ex / den;
        LDS_WAIT();
    }
    __syncthreads();
}

template <int CTRL> __device__ __forceinline__ float dpp_f(float v) { return __int_as_float(__builtin_amdgcn_update_dpp(0, __float_as_int(v), CTRL, 0xf, 0xf, true)); }
__device__ __forceinline__ float swap16_f(float v, int lane) { auto r = __builtin_amdgcn_permlane16_swap(__float_as_uint(v), __float_as_uint(v), false, false); return __uint_as_float((lane & 16) ? r[0] : r[1]); }
constexpr int PEER_SLICES = 8;
#define PEER_LOAD_E(E, t_) { const u32x4* ep_ = (const u32x4*)(EI + (size_t)(t_) * 128 + r8 * 16); E[0] = ep_[0]; E[1] = ep_[1]; E[2] = ep_[2]; E[3] = ep_[3]; }
#define PEER_GATHER(U, E, base_, coff_) { _Pragma("unroll") for (int q_ = 0; q_ < 4; ++q_) { U[4 * q_] = *(const u32x4*)((base_) + (E[q_].x * 128u + (coff_))); U[4 * q_ + 1] = *(const u32x4*)((base_) + (E[q_].y * 128u + (coff_))); \
        U[4 * q_ + 2] = *(const u32x4*)((base_) + (E[q_].z * 128u + (coff_))); U[4 * q_ + 3] = *(const u32x4*)((base_) + (E[q_].w * 128u + (coff_))); } }
#define FP8LO(d) __builtin_amdgcn_cvt_pk_f32_fp8((int)(d), false)
#define FP8HI(d) __builtin_amdgcn_cvt_pk_f32_fp8((int)(d), true)
__device__ __forceinline__ void peer_u_reduce(const u32x4 (&U)[16], const u32x4 hq0, const u32x4 hq1, float* po, int c, bool store) {
    f32x2 h[8];
    h[0] = (f32x2){bflo(hq0.x), bfhi(hq0.x)}; h[1] = (f32x2){bflo(hq0.y), bfhi(hq0.y)}; h[2] = (f32x2){bflo(hq0.z), bfhi(hq0.z)}; h[3] = (f32x2){bflo(hq0.w), bfhi(hq0.w)};
    h[4] = (f32x2){bflo(hq1.x), bfhi(hq1.x)}; h[5] = (f32x2){bflo(hq1.y), bfhi(hq1.y)}; h[6] = (f32x2){bflo(hq1.z), bfhi(hq1.z)}; h[7] = (f32x2){bflo(hq1.w), bfhi(hq1.w)};
    float p[16];
#pragma unroll
    for (int i = 0; i < 16; ++i) {
        f32x2 s0 = FP8LO(U[i].x) * h[0], s1 = FP8HI(U[i].x) * h[1];
        s0 = __builtin_elementwise_fma(FP8LO(U[i].y), h[2], s0); s1 = __builtin_elementwise_fma(FP8HI(U[i].y), h[3], s1);
        s0 = __builtin_elementwise_fma(FP8LO(U[i].z), h[4], s0); s1 = __builtin_elementwise_fma(FP8HI(U[i].z), h[5], s1);
        s0 = __builtin_elementwise_fma(FP8LO(U[i].w), h[6], s0); s1 = __builtin_elementwise_fma(FP8HI(U[i].w), h[7], s1);
        s0 = s0 + s1; p[i] = s0.x + s0.y;
    }
#pragma unroll
    for (int bq = 0; bq < 2; ++bq) { float* q = p + 8 * bq;
        { const bool up = (c & 4) != 0;
#pragma unroll
          for (int j = 0; j < 4; ++j) { const float mine = up ? q[j + 4] : q[j], send = up ? q[j] : q[j + 4]; q[j] = mine + dpp_f<0x141>(send); } }
        { const bool up = (c & 2) != 0;
#pragma unroll
          for (int j = 0; j < 2; ++j) { const float mine = up ? q[j + 2] : q[j], send = up ? q[j] : q[j + 2]; q[j] = mine + dpp_f<0x4E>(send); } }
        { const bool up = (c & 1) != 0; const float mine = up ? q[1] : q[0], send = up ? q[0] : q[1]; q[0] = mine + dpp_f<0xB1>(send); } }
    if (store) { po[0] = p[0]; po[8] = p[8]; }
}
__device__ __forceinline__ void phase_peer_u(const Ctx& C) {
    const int lane = C.lane, r8 = lane >> 3, c = lane & 7;
    const bf16_t* H2 = WSP(bf16_t, WS_B0); const unsigned char* U8 = C.ws + WS_U8; const int* EI = WSP(int, WS_EI); float* PA = WSP(float, WS_SC);
    const int s = C.bid & 7, wg = (C.bid >> 3) * NWAVES + C.wave, nwg = (C.G >> 3) * NWAVES;
    const int n = (TT - wg + nwg - 1) / nwg;
    const unsigned char* ub = U8 + (size_t)s * NE * 128; const unsigned coff = (unsigned)c * 16u; const bf16_t* hb = H2 + s * 128 + c * 16;
    float* pab = PA + (size_t)s * 128 + r8 * 16 + c;
#define TOK(i_) (min(wg + (i_) * nwg, TT - 1))
#define LOAD_H(H0, H1, t_) { const u32x4* hp_ = (const u32x4*)(hb + (size_t)(t_) * DM); H0 = hp_[0]; H1 = hp_[1]; }
    u32x4 uA[16], uB[16], en[4], enn[4], hc0, hc1, hn0, hn1, hnn0, hnn1;
    PEER_LOAD_E(en, TOK(0)); LOAD_H(hc0, hc1, TOK(0));
    PEER_GATHER(uA, en, ub, coff);
    PEER_LOAD_E(en, TOK(1)); LOAD_H(hn0, hn1, TOK(1));
    for (int i = 0; i < n; i += 2) {
        PEER_GATHER(uB, en, ub, coff);
        PEER_LOAD_E(enn, TOK(i + 2)); LOAD_H(hnn0, hnn1, TOK(i + 2));
        peer_u_reduce(uA, hc0, hc1, pab + (size_t)TOK(i) * (PEER_SLICES * 128), c, true);
        hc0 = hn0; hc1 = hn1; hn0 = hnn0; hn1 = hnn1;
        PEER_GATHER(uA, enn, ub, coff);
        PEER_LOAD_E(en, TOK(i + 3)); LOAD_H(hnn0, hnn1, TOK(i + 3));
        peer_u_reduce(uB, hc0, hc1, pab + (size_t)TOK(i + 1) * (PEER_SLICES * 128), c, i + 1 < n);
        hc0 = hn0; hc1 = hn1; hn0 = hnn0; hn1 = hnn1;
    }
#undef LOAD_H
#undef TOK
}
__device__ __forceinline__ void phase_peer_act(const Ctx& C) {
    const float* PA = WSP(float, WS_SC); float* GW = WSP(float, WS_GW); const int* EI = WSP(int, WS_EI); const float* SU = WSP(float, WS_SU); const float* SV = WSP(float, WS_SV);
    const size_t n = (size_t)TT * 128, stride = (size_t)C.G * NTHREADS;
    for (size_t i = (size_t)C.bid * NTHREADS + C.tid; i < n; i += stride) {
        const size_t t = i >> 7; const int k = (int)(i & 127); const float* pp = PA + t * (PEER_SLICES * 128) + k;
        float a = 0.f;
#pragma unroll
        for (int s = 0; s < PEER_SLICES; ++s) a += pp[s * 128];
        const int e = EI[i];
        GW[i] = geluf_(a * SU[e]) * GW[i] * SV[e];
    }
}
#define PEER_LOAD_A(A, t_) { const f32x4* ap_ = (const f32x4*)(ACT + (size_t)(t_) * 128 + r8 * 16); A[0] = ap_[0]; A[1] = ap_[1]; A[2] = ap_[2]; A[3] = ap_[3]; }
#define PEER_GATHER8(U, E0, E1, base_, coff_) { U[0] = *(const u32x4*)((base_) + (E0.x * 128u + (coff_))); U[1] = *(const u32x4*)((base_) + (E0.y * 128u + (coff_))); U[2] = *(const u32x4*)((base_) + (E0.z * 128u + (coff_))); U[3] = *(const u32x4*)((base_) + (E0.w * 128u + (coff_))); \
        U[4] = *(const u32x4*)((base_) + (E1.x * 128u + (coff_))); U[5] = *(const u32x4*)((base_) + (E1.y * 128u + (coff_))); U[6] = *(const u32x4*)((base_) + (E1.z * 128u + (coff_))); U[7] = *(const u32x4*)((base_) + (E1.w * 128u + (coff_))); }
__device__ __forceinline__ void peer_v_acc8(f32x2 (&o)[8], const u32x4 (&V)[8], const f32x4 A0, const f32x4 A1) {
#pragma unroll
    for (int i = 0; i < 8; ++i) { const float a = i < 4 ? A0[i & 3] : A1[i & 3]; const f32x2 a2 = (f32x2){a, a};
        o[0] = __builtin_elementwise_fma(FP8LO(V[i].x), a2, o[0]); o[1] = __builtin_elementwise_fma(FP8HI(V[i].x), a2, o[1]);
        o[2] = __builtin_elementwise_fma(FP8LO(V[i].y), a2, o[2]); o[3] = __builtin_elementwise_fma(FP8HI(V[i].y), a2, o[3]);
        o[4] = __builtin_elementwise_fma(FP8LO(V[i].z), a2, o[4]); o[5] = __builtin_elementwise_fma(FP8HI(V[i].z), a2, o[5]);
        o[6] = __builtin_elementwise_fma(FP8LO(V[i].w), a2, o[6]); o[7] = __builtin_elementwise_fma(FP8HI(V[i].w), a2, o[7]); }
}
__device__ __forceinline__ f32x2 peer_v_scatter(const f32x2 (&o2)[8], int lane) {
    float o[16];
#pragma unroll
    for (int j = 0; j < 8; ++j) { o[2 * j] = o2[j].x; o[2 * j + 1] = o2[j].y; }
    { const bool up = (lane & 32) != 0;
#pragma unroll
      for (int j = 0; j < 8; ++j) { const float mine = up ? o[j + 8] : o[j], send = up ? o[j] : o[j + 8]; o[j] = mine + shfx<32>(send, lane); } }
    { const bool up = (lane & 16) != 0;
#pragma unroll
      for (int j = 0; j < 4; ++j) { const float mine = up ? o[j + 4] : o[j], send = up ? o[j] : o[j + 4]; o[j] = mine + swap16_f(send, lane); } }
    { const bool up = (lane & 8) != 0;
#pragma unroll
      for (int j = 0; j < 2; ++j) { const float mine = up ? o[j + 2] : o[j], send = up ? o[j] : o[j + 2]; o[j] = mine + dpp_f<0x128>(send); } }
    return (f32x2){o[0], o[1]};
}
__device__ __forceinline__ void phase_peer_v(const Ctx& C, int l, bool dry = false) {
    const int lane = C.lane, r8 = lane >> 3, c = lane & 7;
    const unsigned char* V8 = C.ws + WS_V8; const int* EI = WSP(int, WS_EI); const float* ACT = WSP(float, WS_GW); const float* MOD = WSP(float, WS_MOD);
    const int s = C.bid & 7, wg = (C.bid >> 3) * NWAVES + C.wave, nwg = (C.G >> 3) * NWAVES;
    const int n = (TT - wg + nwg - 1) / nwg;
    const int jcol = ((lane >> 5) & 1) * 8 + ((lane >> 4) & 1) * 4 + ((lane >> 3) & 1) * 2;
    const int col = s * 128 + c * 16 + jcol;
    const unsigned char* vb = V8 + (size_t)s * NE * 128; const unsigned coff = (unsigned)c * 16u;
    float* xb = C.out + col; const float* g2 = MOD + (size_t)l * NBT * 6144 + 5120 + col;
#define TOK(i_) (min(wg + (i_) * nwg, TT - 1))
    u32x4 vA[8], vB[8], ec[4], en[4]; f32x4 ac[4], an[4];
    PEER_LOAD_E(ec, TOK(0)); PEER_LOAD_A(ac, TOK(0));
    PEER_GATHER8(vA, ec[0], ec[1], vb, coff);
    PEER_LOAD_E(en, TOK(1)); PEER_LOAD_A(an, TOK(1));
    for (int i = 0; i < n; ++i) {
        const int t = TOK(i);
        PEER_GATHER8(vB, ec[2], ec[3], vb, coff);
        const f32x2 xv = *(const f32x2*)(xb + (size_t)t * DM), gv = *(const f32x2*)(g2 + (size_t)row_batch(t) * 6144);
        f32x2 o[8];
#pragma unroll
        for (int j = 0; j < 8; ++j) o[j] = (f32x2){0.f, 0.f};
        peer_v_acc8(o, vA, ac[0], ac[1]);
        PEER_GATHER8(vA, en[0], en[1], vb, coff);
        peer_v_acc8(o, vB, ac[2], ac[3]);
#pragma unroll
        for (int q = 0; q < 4; ++q) { ec[q] = en[q]; ac[q] = an[q]; }
        PEER_LOAD_E(en, TOK(i + 2)); PEER_LOAD_A(an, TOK(i + 2));
        const f32x2 ov = peer_v_scatter(o, lane);
        asm volatile("" :: "v"(ov.x), "v"(ov.y));
        if (!dry) *(f32x2*)(xb + (size_t)t * DM) = xv + gv * ov;
    }
#undef TOK
}
#undef PEER_GATHER8
#undef PEER_LOAD_E
#undef PEER_LOAD_A
#undef PEER_GATHER
__device__ __forceinline__ void phase_final_norm(const Ctx& C) {
    const int gw = C.bid * NWAVES + C.wave, NGW = C.G * NWAVES; const float* fw = as_global(C.P->in[IN_FNW]);
    for (int row = gw; row < TT; row += NGW) {
        f32x4* xr = (f32x4*)(C.out + (size_t)row * DM) + C.lane;
        f32x4 v[4]; float s = 0.f;
#pragma unroll
        for (int j = 0; j < 4; ++j) { v[j] = xr[64 * j]; s += (v[j][0] * v[j][0] + v[j][1] * v[j][1]) + (v[j][2] * v[j][2] + v[j][3] * v[j][3]); }
        const float rstd = rsqrtf(wave_sum(s) * (1.f / DM) + EPS);
#pragma unroll
        for (int j = 0; j < 4; ++j) xr[64 * j] = v[j] * rstd * *(const f32x4*)(fw + C.lane * 4 + 256 * j);
    }
}


#define XB_TMO      128
#define XB_XCNT(j)  (256  + 64 * (j))
#define XB_XSUB(j)  (1280 + 64 * (j))
#define XB_XGEN(j)  (2304 + 64 * (j))
#define XB_TOP      3328
#define XB_TOPGEN   3392
#define XCD_BAR_WORDS 3456
#define XB_SPIN_CAP (1u << 22)
__device__ __forceinline__ unsigned xb_ld(unsigned* p)              { return __hip_atomic_load(p, __ATOMIC_RELAXED, __HIP_MEMORY_SCOPE_AGENT); }
__device__ __forceinline__ unsigned xb_add(unsigned* p, unsigned v) { return __hip_atomic_fetch_add(p, v, __ATOMIC_RELAXED, __HIP_MEMORY_SCOPE_AGENT); }
__device__ __forceinline__ unsigned xb_xcc_id() { return (unsigned)__builtin_amdgcn_s_getreg((3 << 11) | 20) & 0xFu; }
#define XB_SPIN(cond, bar) do { unsigned _sp = 0; while (cond) { __builtin_amdgcn_s_sleep(1); \
    if ((++_sp & 255u) == 0u) { if (xb_ld(&(bar)[XB_TMO])) break; if (_sp > XB_SPIN_CAP) { atomicAdd(&(bar)[XB_TMO], 1u); break; } } } } while (0)
struct XcdBarrier { unsigned* bar; unsigned x; volatile LAS unsigned* st; };
__device__ __forceinline__ XcdBarrier xcd_barrier_post(unsigned* bar, volatile LAS unsigned* st) {
    XcdBarrier b; b.bar = bar; b.x = xb_xcc_id(); b.st = st;
    if (threadIdx.x == 0) (void)xb_add(&bar[XB_XCNT(b.x)], 1u);
    return b;
}
__device__ __forceinline__ void xcd_barrier_complete(unsigned* bar, unsigned x, unsigned& nloc, unsigned& nx) {
    const unsigned G = gridDim.x * gridDim.y * gridDim.z;
    unsigned sum, cnt, mine, sp = 0u;
    for (;;) {
        sum = 0u; cnt = 0u; mine = 0u;
#pragma unroll
        for (unsigned j = 0; j < 16; ++j) { const unsigned c = xb_ld(&bar[XB_XCNT(j)]); sum += c; cnt += (c > 0u) ? 1u : 0u; mine = (j == x) ? c : mine; }
        if (sum == G) break;
        __builtin_amdgcn_s_sleep(1);
        if ((++sp & 255u) == 0u) { if (xb_ld(&bar[XB_TMO])) break; if (sp > XB_SPIN_CAP) { atomicAdd(&bar[XB_TMO], 1u); break; } }
    }
    nloc = mine > 0u ? mine : 1u; nx = cnt > 0u ? cnt : 1u;
}
__device__ __forceinline__ void xcd_barrier(const XcdBarrier& b) {
    asm volatile("s_waitcnt vmcnt(0)" ::: "memory");
    __syncthreads();
    if (threadIdx.x == 0) {
        unsigned* bar = b.bar;
        __builtin_amdgcn_s_waitcnt(0);
        unsigned nloc = b.st[0], nx = b.st[1];
        if (nloc == 0u) { xcd_barrier_complete(bar, b.x, nloc, nx); b.st[0] = nloc; b.st[1] = nx; }
        const unsigned old = xb_add(&bar[XB_XSUB(b.x)], 1u);
        const unsigned gen = old / nloc;
        if (old + 1u == (gen + 1u) * nloc) {
            __builtin_amdgcn_fence(__ATOMIC_RELEASE, "agent");
            asm volatile("s_waitcnt vmcnt(0)" ::: "memory");
            const unsigned og = xb_add(&bar[XB_TOP], 1u);
            const unsigned tg = og / nx;
            if (og + 1u == (tg + 1u) * nx) xb_add(&bar[XB_TOPGEN], 1u);
            else XB_SPIN(xb_ld(&bar[XB_TOPGEN]) == tg, bar);
            __builtin_amdgcn_fence(__ATOMIC_ACQUIRE, "agent");
            xb_add(&bar[XB_XGEN(b.x)], 1u);
            asm volatile("s_waitcnt vmcnt(0)" ::: "memory");
        } else {
            XB_SPIN(xb_ld(&bar[XB_XGEN(b.x)]) == gen, bar);
            __builtin_amdgcn_fence(__ATOMIC_ACQUIRE, "agent");
            asm volatile("s_waitcnt vmcnt(0)" ::: "memory");
        }
    }
    __syncthreads();
}

__device__ __forceinline__ Ctx relaunder(const Ctx& C) {
    Ctx D = C; int t = C.tid; asm volatile("" : "+v"(t)); D.tid = t; D.lane = t & 63;
    unsigned char* w = C.ws; float* o = C.out; asm volatile("" : "+s"(w), "+s"(o)); D.ws = as_global(w); D.out = as_global(o); return D;
}
constexpr int NPL = 13, NPH = 2 + 2 * NPL;
__device__ __forceinline__ void run_phase(const Ctx& C0, int ph, bool dry) {
    if (ph == 0) { const Ctx C = relaunder(C0); phase_prep(C); return; }
    if (ph == NPH - 1) { const Ctx C = relaunder(C0); phase_final_norm(C); return; }
    const int l = (ph - 1) / NPL, k = (ph - 1) % NPL;
    switch (k) {
    case 0: { const Ctx C = relaunder(C0); phase_norm(C, l, 0); } break;
    case 1: { const Ctx C = relaunder(C0); CParams& P = *C.P; Epi1 E{WSP(bf16_t, WS_B1), WSP(bf16_t, WS_B2), WSP(bf16_t, WS_B3), WSP(bf16_t, WS_B4), WSP(float, WS_DT), as_global(P.in[IN_DTB]) + l * 16};
              gemm_run(C, WSP(bf16_t, WS_B0), WSP(bf16_t, WS_W1T) + (size_t)l * N1 * DM, nullptr, nullptr, N1, E); } break;
    case 2: { const Ctx C = relaunder(C0); phase_convbc(C, l); } break;
    case 3: { const Ctx C = relaunder(C0); phase_scan(C, l, dry); } break;
    case 4: { const Ctx C = relaunder(C0); Epi2 E{WSP(bf16_t, WS_GS), WSP(bf16_t, WS_GL)};
              gemm_run(C, WSP(bf16_t, WS_B0), WSP(bf16_t, WS_WGT) + (size_t)l * NG * DM, nullptr, nullptr, NG, E); } break;
    case 5: { const Ctx C = relaunder(C0); Epi3 E{WSP(bf16_t, WS_GS), WSP(bf16_t, WS_GL), WSP(float, WS_SSQ), WSP(bf16_t, WS_B0)};
              gemm_run(C, WSP(bf16_t, WS_B1), WSP(bf16_t, WS_WBS) + (size_t)l * DM * DM, WSP(bf16_t, WS_B4), WSP(bf16_t, WS_WBL) + (size_t)l * DM * DM, DM, E); } break;
    case 6: { const Ctx C = relaunder(C0); CParams& P = *C.P; Epi4 E{as_global(P.in[IN_XP]), as_global(P.in[IN_XS]), C.out, WSP(float, WS_MOD) + (size_t)l * NBT * 6144, l};
              gemm_run(C, WSP(bf16_t, WS_B0), WSP(bf16_t, WS_WO) + (size_t)l * DM * DM, nullptr, nullptr, DM, E); } break;
    case 7: { const Ctx C = relaunder(C0); phase_norm(C, l, 1); } break;
    case 8: { const Ctx C = relaunder(C0); Epi5 E{WSP(float, WS_SC)};
              gemm_run(C, WSP(bf16_t, WS_B0), WSP(bf16_t, WS_WC) + (size_t)l * 2048 * DM, nullptr, nullptr, 2048, E); } break;
    case 9: { const Ctx C = relaunder(C0); phase_topk(C); } break;
    case 10: { const Ctx C = relaunder(C0); phase_peer_u(C); } break;
    case 11: { const Ctx C = relaunder(C0); phase_peer_act(C); } break;
    case 12: { const Ctx C = relaunder(C0); phase_peer_v(C, l, dry); } break;
    }
}

__global__ void __launch_bounds__(NTHREADS, 2) fwd(Params P) {
    extern __shared__ __attribute__((aligned(16))) unsigned char lds_raw[];
    const int ph_lo = P.ph_lo, ph_hi = P.ph_hi;
    volatile LAS unsigned* bst = (volatile LAS unsigned*)((LAS unsigned char*)lds_raw + LDS_BYTES - 64);
    if (threadIdx.x == 0) { bst[0] = 0u; bst[1] = 0u; }
    __syncthreads();
    (void)xcd_barrier_post((unsigned*)(P.ws + WS_CTL), bst);
    for (int ph = ph_lo; ph < ph_hi; ++ph) {
        CParams* Pp = (CParams*)__builtin_amdgcn_kernarg_segment_ptr(); asm volatile("" : "+s"(Pp));
        Ctx C; C.P = Pp; C.lds = (LAS unsigned char*)lds_raw;
        int tid = threadIdx.x; asm volatile("" : "+v"(tid));
        unsigned char* ws = Pp->ws; float* out = Pp->out; asm volatile("" : "+s"(ws), "+s"(out));
        C.ws = ws; C.out = out;
        C.tid = tid; C.lane = tid & 63; C.wave = __builtin_amdgcn_readfirstlane(tid >> 6); C.bid = blockIdx.x; C.G = gridDim.x;
#ifdef PROBE_K
        { const bool hit = (PROBE_K == 100) ? ph == 0 : ((PROBE_K == 101) ? ph == NPH - 1 : (ph > 0 && ph < NPH - 1 && (ph - 1) % NPL == PROBE_K));
          if (hit) for (int rep = 0; rep < PROBE_N; ++rep) { run_phase(C, ph, true); __syncthreads(); } }
#endif
        run_phase(C, ph, false);
        if (ph + 1 < ph_hi) { if (ph == 0) cg::this_grid().sync();
            else { XcdBarrier xb; xb.bar = (unsigned*)(ws + WS_CTL); xb.x = xb_xcc_id(); xb.st = (volatile LAS unsigned*)((LAS unsigned char*)lds_raw + LDS_BYTES - 64); xcd_barrier(xb); } }
    }
}

extern "C" void kernel_launch(void* const* d_in, const int* in_sizes, int n_in, void* d_out, int out_size, void* d_ws, size_t ws_size, hipStream_t stream) {
    static int grid = 0;
    if (grid == 0) {
        if (n_in != N_IN || (size_t)out_size != O_END || ws_size < WS_END) { fprintf(stderr, "kernel_launch: unexpected shapes n_in %d out %d ws %zu (need %zu)\n", n_in, out_size, ws_size, (size_t)WS_END); grid = -1; return; }
        int dev = 0, cus = 0, per_cu = 0;
        hipGetDevice(&dev); hipDeviceGetAttribute(&cus, hipDeviceAttributeMultiprocessorCount, dev);
        hipFuncSetAttribute((const void*)fwd, hipFuncAttributeMaxDynamicSharedMemorySize, LDS_BYTES);
        hipOccupancyMaxActiveBlocksPerMultiprocessor(&per_cu, (const void*)fwd, NTHREADS, LDS_BYTES);
        if (per_cu < 1) { fprintf(stderr, "kernel_launch: occupancy query says %d blocks/CU\n", per_cu); per_cu = 1; }
        grid = cus;
        fprintf(stderr, "kernel_launch: cus %d per_cu %d grid %d ws %zu\n", cus, per_cu, grid, ws_size);
    }
    if (grid < 0) return;
    Params p{};
    for (int i = 0; i < N_IN; ++i) p.in[i] = (const float*)d_in[i];
    p.out = (float*)d_out; p.ws = (unsigned char*)d_ws;
    hipMemsetAsync((char*)d_ws + WS_CTL, 0, 65536, stream);
#if MEGA
    p.ph_lo = 0; p.ph_hi = NPH;
    void* args[] = {&p};
    hipError_t e = hipLaunchCooperativeKernel((const void*)fwd, dim3(grid), dim3(NTHREADS), args, LDS_BYTES, stream);
    if (e != hipSuccess) fprintf(stderr, "cooperative launch failed: %s\n", hipGetErrorString(e));
#else
    for (int ph = 0; ph < NPH; ++ph) { p.ph_lo = ph; p.ph_hi = ph + 1; hipLaunchKernelGGL(fwd, dim3(grid), dim3(NTHREADS), LDS_BYTES, stream, p); }
#endif
}
```

```cpp
#include <hip/hip_runtime.h>
#include <hip/hip_cooperative_groups.h>
#include <cstdio>
#include <cstdint>
namespace cg = cooperative_groups;

#ifndef MEGA
#define MEGA 1
#endif

#define LAS __attribute__((address_space(3)))
typedef unsigned short bf16_t;
typedef __bf16 bf16x2_t __attribute__((ext_vector_type(2)));
typedef short bf16x8 __attribute__((ext_vector_type(8)));
typedef float f32x4 __attribute__((ext_vector_type(4)));
typedef float f32x16 __attribute__((ext_vector_type(16)));
typedef unsigned u32x4 __attribute__((ext_vector_type(4)));
typedef unsigned u32x2 __attribute__((ext_vector_type(2)));

constexpr int DM = 1024;
constexpr int TP = 32768, TS = 128, TT = TP + TS, MT = 33024;
constexpr int NBT = 24;
constexpr int N1 = 4608;
constexpr int NG = 2048;
constexpr int NE = 16384;
constexpr int INC = 6416;
constexpr float EPS = 1e-6f;
constexpr int NWAVES = 8, NTHREADS = 512;
constexpr int LDS_BYTES = 150528;

enum { IN_XP = 0, IN_XS, IN_CP, IN_CS, IN_SSD, IN_SSDCONV, IN_LRU, IN_LRUCONV, IN_LN1, IN_LN2, IN_WMOD, IN_BMOD, IN_WIN, IN_SCW, IN_SCB, IN_DTB,
       IN_ALOG, IN_SSDD, IN_SNW, IN_LCW, IN_LCB, IN_WA, IN_BA, IN_WX, IN_BX, IN_LAM, IN_WBS, IN_WBL, IN_WO, IN_WQ, IN_K1, IN_K2, IN_U, IN_V, IN_FNW, N_IN };

constexpr size_t O_Y = 0, O_PSSD = 33685504, O_PSCONV = 35782656, O_PLRU = 35905536, O_PLCONV = 35938304,
                 O_SSSD = 36036608, O_SSCONV = 37085184, O_SLRU = 37146624, O_SLCONV = 37163008, O_END = 37212160;

constexpr size_t al256(size_t x) { return (x + 255) & ~(size_t)255; }
constexpr size_t WS_CTL = 0;
constexpr size_t WS_MOD = 1u << 20;
constexpr size_t WS_DT = al256(WS_MOD + (size_t)2 * NBT * 6144 * 4);
constexpr size_t WS_SSQ = al256(WS_DT + (size_t)MT * 16 * 4);
constexpr size_t WS_W1T = al256(WS_SSQ + (size_t)MT * 16 * 4);
constexpr size_t WS_WGT = al256(WS_W1T + (size_t)2 * N1 * DM * 2);
constexpr size_t WS_WBS = al256(WS_WGT + (size_t)2 * NG * DM * 2);
constexpr size_t WS_WBL = al256(WS_WBS + (size_t)2 * DM * DM * 2);
constexpr size_t WS_WO = al256(WS_WBL + (size_t)2 * DM * DM * 2);
constexpr size_t WS_WC = al256(WS_WO + (size_t)2 * DM * DM * 2);
constexpr size_t WS_U16 = al256(WS_WC + (size_t)2 * 2048 * DM * 2);
constexpr size_t WS_V16 = al256(WS_U16 + (size_t)NE * DM * 2);
constexpr size_t WS_EI = al256(WS_V16 + (size_t)NE * DM * 2);
constexpr size_t WS_GW = al256(WS_EI + (size_t)MT * 128 * 4);
constexpr size_t WS_B0 = al256(WS_GW + (size_t)MT * 128 * 4);
constexpr size_t WS_B1 = al256(WS_B0 + (size_t)MT * DM * 2);
constexpr size_t WS_B2 = al256(WS_B1 + (size_t)MT * DM * 2);
constexpr size_t WS_B3 = al256(WS_B2 + (size_t)MT * 1280 * 2);
constexpr size_t WS_B4 = al256(WS_B3 + (size_t)MT * DM * 2);
constexpr size_t WS_END = al256(WS_B4 + (size_t)MT * DM * 2);
constexpr size_t WS_GS = WS_B2, WS_GL = WS_B2 + (size_t)MT * DM * 2;
constexpr size_t WS_SC = WS_B1;
static_assert(WS_GL + (size_t)MT * DM * 2 <= WS_B4, "gate overlay");
static_assert(WS_SC + (size_t)MT * 2048 * 4 <= WS_END, "score overlay");
static_assert(WS_END <= (size_t)512 << 20, "d_ws budget");

struct Params {
    const float* in[N_IN];
    float* out;
    unsigned char* ws;
    int ph_lo, ph_hi;
};

__device__ __forceinline__ unsigned f2bf(float f) { return (unsigned)__builtin_bit_cast(unsigned short, (__bf16)f); }
__device__ __forceinline__ float bf2f(unsigned b) { return __uint_as_float(b << 16); }
__device__ __forceinline__ unsigned pk2(float lo, float hi) { typedef float f32x2_ __attribute__((ext_vector_type(2))); return __builtin_bit_cast(unsigned, __builtin_convertvector((f32x2_){lo, hi}, bf16x2_t)); }
__device__ __forceinline__ float bflo(unsigned w) { return __uint_as_float(w << 16); }
__device__ __forceinline__ float bfhi(unsigned w) { return __uint_as_float(w & 0xffff0000u); }
template <int M> __device__ __forceinline__ int shfx_i(int v, int lane) {
    if constexpr (M == 32) { auto r = __builtin_amdgcn_permlane32_swap((unsigned)v, (unsigned)v, false, false); return (int)((lane & 32) ? r[0] : r[1]); }
    else return __builtin_amdgcn_ds_swizzle(v, 0x1f | (M << 10));
}
template <int M> __device__ __forceinline__ float shfx(float v, int lane) { return __int_as_float(shfx_i<M>(__float_as_int(v), lane)); }
__device__ __forceinline__ float shfl_f(float v, int src) { return __int_as_float(__builtin_amdgcn_ds_bpermute(src << 2, __float_as_int(v))); }
__device__ __forceinline__ int shfl_i(int v, int src) { return __builtin_amdgcn_ds_bpermute(src << 2, v); }
template <int CTRL> __device__ __forceinline__ float dppf_(float v) { return __int_as_float(__builtin_amdgcn_update_dpp(0, __float_as_int(v), CTRL, 0xf, 0xf, true)); }
__device__ __forceinline__ float row8_sum(float v) { v += dppf_<0xB1>(v); v += dppf_<0x4E>(v); v += dppf_<0x141>(v); return v; }
__device__ __forceinline__ float wave_sum(float v) {
    v += dppf_<0xB1>(v); v += dppf_<0x4E>(v); v += dppf_<0x141>(v); v += dppf_<0x140>(v);
    { auto r = __builtin_amdgcn_permlane16_swap(__float_as_uint(v), __float_as_uint(v), false, false); v = __uint_as_float(r[0]) + __uint_as_float(r[1]); }
    { auto r = __builtin_amdgcn_permlane32_swap(__float_as_uint(v), __float_as_uint(v), false, false); v = __uint_as_float(r[0]) + __uint_as_float(r[1]); }
    return v;
}
__device__ __forceinline__ float exp_fast(float x) { return __builtin_amdgcn_exp2f(x * 1.4426950408889634f); }
__device__ __forceinline__ float sigmoidf_(float x) { return __builtin_amdgcn_rcpf(1.0f + exp_fast(-x)); }
__device__ __forceinline__ float siluf_(float x) { return x * __builtin_amdgcn_rcpf(1.0f + exp_fast(-x)); }
__device__ __forceinline__ float geluf_(float x) { const float u = 1.5957691216057308f * (x + 0.044715f * x * x * x); return x * __builtin_amdgcn_rcpf(1.0f + exp_fast(-u)); }
__device__ __forceinline__ float softplusf_(float x) { return fmaxf(x, 0.f) + log1pf(__expf(-fabsf(x))); }
__device__ __forceinline__ int row_batch(int row) { return row < TP ? (row >> 11) : (row < TT ? 16 + ((row - TP) >> 4) : 23); }
__device__ __forceinline__ float dot2bf(unsigned a, unsigned b, float acc) { return __builtin_amdgcn_fdot2_f32_bf16(__builtin_bit_cast(bf16x2_t, a), __builtin_bit_cast(bf16x2_t, b), acc, false); }
__device__ __forceinline__ float rl(float v, int lane) { return __int_as_float(__builtin_amdgcn_readlane(__float_as_int(v), lane)); }
#define LDS_WAIT() asm volatile("s_waitcnt lgkmcnt(0)" ::: "memory")
#define MFMA32(a, b, c) __builtin_amdgcn_mfma_f32_32x32x16_bf16((a), (b), (c), 0, 0, 0)

typedef const __attribute__((address_space(4))) Params CParams;
template <class T> __device__ __forceinline__ T* as_global(T* p) { __attribute__((address_space(1))) T* g = (__attribute__((address_space(1))) T*)p; asm volatile("" : "+s"(g)); return (T*)g; }
struct Ctx {
    CParams* P; LAS unsigned char* lds; unsigned char* ws; float* out;
    int tid, lane, wave, bid, G;
};
#define WSP(T, off) (as_global((T*)(C.ws + (off))))

__device__ __forceinline__ void tr_item(const float* W, int ldw, int src_col0, int valid, const float* kscale, int k0, bf16_t* dst, LAS float* scr, int lane) {
#pragma unroll 8
    for (int i = 0; i < 32; ++i) { const int kk = 2 * i + (lane >> 5), c = lane & 31;
        float v = (c < valid) ? W[(size_t)(k0 + kk) * ldw + src_col0 + c] : 0.f; if (kscale) v *= kscale[k0 + kk]; scr[kk * 33 + c] = v; }
    LDS_WAIT();
    const int c8 = lane & 7;
#pragma unroll
    for (int j = 0; j < 4; ++j) { const int n = (lane >> 3) + 8 * j; const LAS float* s = scr + (8 * c8) * 33 + n;
        u32x4 o; o.x = pk2(s[0 * 33], s[1 * 33]); o.y = pk2(s[2 * 33], s[3 * 33]); o.z = pk2(s[4 * 33], s[5 * 33]); o.w = pk2(s[6 * 33], s[7 * 33]);
        *(u32x4*)(dst + (size_t)n * DM + k0 + 8 * c8) = o; }
    LDS_WAIT();
}
typedef float f32x2 __attribute__((ext_vector_type(2)));
typedef short s16x4_ __attribute__((ext_vector_type(4)));
constexpr size_t WS_U8 = WS_U16, WS_SU = WS_U16 + ((size_t)16 << 20), WS_V8 = WS_V16, WS_SV = WS_V16 + ((size_t)16 << 20);
__device__ __forceinline__ float wave_max(float v) {
    v = fmaxf(v, shfx<1>(v, 0)); v = fmaxf(v, shfx<2>(v, 0)); v = fmaxf(v, shfx<4>(v, 0)); v = fmaxf(v, shfx<8>(v, 0)); v = fmaxf(v, shfx<16>(v, 0));
    auto r = __builtin_amdgcn_permlane32_swap(__float_as_uint(v), __float_as_uint(v), false, false);
    return fmaxf(__uint_as_float(r[0]), __uint_as_float(r[1]));
}
__device__ __forceinline__ void convert_tables(const Ctx& C, int l) {
    const int gw = C.bid * NWAVES + C.wave, NGW = C.G * NWAVES, lane = C.lane;
    const float* up = as_global(C.P->in[IN_U]) + (size_t)l * NE * DM; const float* vp = as_global(C.P->in[IN_V]) + (size_t)l * NE * DM;
#define TROW(it_) (((it_) >= NE ? vp + (size_t)((it_) - NE) * DM : up + (size_t)(it_) * DM) + lane * 4)
    f32x4 nv[4];
    { const float* s0 = TROW(min(gw, 2 * NE - 1));
#pragma unroll
      for (int j = 0; j < 4; ++j) nv[j] = *(const f32x4*)(s0 + 256 * j); }
    for (int it = gw; it < 2 * NE; it += NGW) {
        const bool isv = it >= NE; const int e = isv ? it - NE : it;
        unsigned char* dst = C.ws + (isv ? WS_V8 : WS_U8); float* sc = (float*)(C.ws + (isv ? WS_SV : WS_SU));
        f32x4 v[4]; float m = 0.f;
#pragma unroll
        for (int j = 0; j < 4; ++j) { v[j] = nv[j]; m = fmaxf(m, fmaxf(fmaxf(fabsf(v[j][0]), fabsf(v[j][1])), fmaxf(fabsf(v[j][2]), fabsf(v[j][3])))); }
        { const float* s0 = TROW(min(it + NGW, 2 * NE - 1));
#pragma unroll
          for (int j = 0; j < 4; ++j) nv[j] = *(const f32x4*)(s0 + 256 * j); }
        m = wave_max(m);
        const float scale = m > 0.f ? m * (1.0f / 440.0f) : 1.0f, inv = 1.0f / scale;
        if (lane == 0) sc[e] = scale;
#pragma unroll
        for (int j = 0; j < 4; ++j) { int w = __builtin_amdgcn_cvt_pk_fp8_f32(v[j][0] * inv, v[j][1] * inv, 0, false); w = __builtin_amdgcn_cvt_pk_fp8_f32(v[j][2] * inv, v[j][3] * inv, w, true);
            const int slice = 2 * j + (lane >> 5);
            *(int*)(dst + ((size_t)slice * NE + e) * 128 + (lane & 31) * 4) = w; }
    }
#undef TROW
}
__device__ __forceinline__ void phase_prep(const Ctx& C) {
    CParams& P = *C.P;
    {
        LAS float* Kh = (LAS float*)C.lds;
        LAS float* Wq = (LAS float*)(C.lds + 128 * 132 * 4);
        bf16_t* WcT = WSP(bf16_t, WS_WC);
        for (int it = C.bid; it < 512; it += C.G) {
            const int l = it >> 8, h = (it >> 5) & 7, half = (it >> 4) & 1, jb = it & 15;
            const float* ksrc = as_global(P.in[half ? IN_K2 : IN_K1]) + (size_t)l * 128 * 128;
            const float* wsrc = as_global(P.in[IN_WQ]) + (size_t)l * DM * 2048 + (size_t)(jb * 64) * 2048 + h * 256 + half * 128;
            __syncthreads();
            for (int i = C.tid; i < 128 * 32; i += NTHREADS) { const int r = i >> 5, c4 = i & 31; *(LAS f32x4*)(Kh + r * 132 + c4 * 4) = *(const f32x4*)(ksrc + r * 128 + c4 * 4); }
            for (int i = C.tid; i < 64 * 32; i += NTHREADS) { const int r = i >> 5, c4 = i & 31; *(LAS f32x4*)(Wq + r * 132 + c4 * 4) = *(const f32x4*)(wsrc + (size_t)r * 2048 + c4 * 4); }
            __syncthreads();
            const int tk = C.tid & 31, tj = C.tid >> 5;
            float acc[4][4];
#pragma unroll
            for (int a = 0; a < 4; ++a)
#pragma unroll
                for (int b = 0; b < 4; ++b) acc[a][b] = 0.f;
            for (int d4 = 0; d4 < 32; ++d4) {
                f32x4 kv[4], wv[4];
#pragma unroll
                for (int a = 0; a < 4; ++a) { kv[a] = *(LAS f32x4*)(Kh + (tk + 32 * a) * 132 + d4 * 4); wv[a] = *(LAS f32x4*)(Wq + (4 * tj + a) * 132 + d4 * 4); }
#pragma unroll
                for (int a = 0; a < 4; ++a)
#pragma unroll
                    for (int b = 0; b < 4; ++b) acc[a][b] += kv[a][0] * wv[b][0] + kv[a][1] * wv[b][1] + kv[a][2] * wv[b][2] + kv[a][3] * wv[b][3];
            }
#pragma unroll
            for (int a = 0; a < 4; ++a) { const int n = h * 256 + half * 128 + tk + 32 * a;
                u32x2 o; o.x = pk2(acc[a][0], acc[a][1]); o.y = pk2(acc[a][2], acc[a][3]);
                *(u32x2*)(WcT + ((size_t)l * 2048 + n) * DM + jb * 64 + 4 * tj) = o; }
        }
        __syncthreads();
    }
    {
        LAS float* sc = (LAS float*)C.lds;
        LAS float* red = (LAS float*)(C.lds + 98304);
        for (int i = C.tid; i < NBT * DM; i += NTHREADS) { const int bb = i >> 10, k = i & 1023;
            const float cv = bb < 16 ? as_global(P.in[IN_CP])[bb * DM + k] : as_global(P.in[IN_CS])[(bb - 16) * DM + k]; sc[i] = siluf_(cv); }
        __syncthreads();
        float* MOD = WSP(float, WS_MOD);
        for (int it = C.bid; it < 192; it += C.G) {
            const int l = it / 96, cg_ = it % 96, j = cg_ * 64 + C.lane;
            const float* wm = as_global(P.in[IN_WMOD]) + (size_t)l * DM * 6144 + j;
            float acc[NBT];
#pragma unroll
            for (int bb = 0; bb < NBT; ++bb) acc[bb] = 0.f;
            const int k0 = C.wave * 128;
#pragma unroll 16
            for (int k = 0; k < 128; ++k) { const float w = wm[(size_t)(k0 + k) * 6144];
#pragma unroll
                for (int bb = 0; bb < NBT; ++bb) acc[bb] += sc[bb * DM + k0 + k] * w; }
#pragma unroll
            for (int bb = 0; bb < NBT; ++bb) red[(C.wave * NBT + bb) * 64 + C.lane] = acc[bb];
            __syncthreads();
            const float bm = as_global(P.in[IN_BMOD])[l * 6144 + j];
#pragma unroll
            for (int q = 0; q < 3; ++q) { const int bb = 3 * C.wave + q; float a = bm;
#pragma unroll
                for (int w8 = 0; w8 < 8; ++w8) a += red[(w8 * NBT + bb) * 64 + C.lane];
                MOD[((size_t)l * NBT + bb) * 6144 + j] = a; }
            __syncthreads();
        }
        __syncthreads();
    }
    {
        LAS float* scr = (LAS float*)(C.lds + C.wave * 16384);
        const int gw = C.bid * NWAVES + C.wave, NGW = C.G * NWAVES;
        constexpr int I_W1 = 144 * 16, I_WG = 64 * 16, I_SQ = 32 * 16, PER_L = I_W1 + I_WG + 3 * I_SQ;
        for (int it = gw; it < 2 * PER_L; it += NGW) {
            const int l = it / PER_L; int r = it % PER_L;
            if (r < I_W1) { const int nb = r >> 4, kb = r & 15, n0 = nb * 32; int src, valid;
                if (n0 < 2304) { src = n0; valid = 32; } else if (n0 < 4352) { src = n0 + 16; valid = 32; } else if (n0 == 4352) { src = 2304; valid = 16; } else { src = 0; valid = 0; }
                tr_item(as_global(P.in[IN_WIN]) + (size_t)l * DM * INC, INC, src, valid, nullptr, kb * 64, WSP(bf16_t, WS_W1T) + ((size_t)l * N1 + n0) * DM, scr, C.lane); continue; }
            r -= I_W1;
            if (r < I_WG) { const int nb = r >> 4, kb = r & 15, n0 = nb * 32;
                tr_item(as_global(P.in[IN_WIN]) + (size_t)l * DM * INC, INC, 4368 + n0, 32, nullptr, kb * 64, WSP(bf16_t, WS_WGT) + ((size_t)l * NG + n0) * DM, scr, C.lane); continue; }
            r -= I_WG;
            const int which = r / I_SQ; r %= I_SQ; const int nb = r >> 4, kb = r & 15, n0 = nb * 32;
            const float* src = as_global(P.in[which == 0 ? IN_WBS : (which == 1 ? IN_WBL : IN_WO)]) + (size_t)l * DM * DM;
            bf16_t* dst = WSP(bf16_t, which == 0 ? WS_WBS : (which == 1 ? WS_WBL : WS_WO)) + ((size_t)l * DM + n0) * DM;
            tr_item(src, DM, n0, 32, which == 0 ? as_global(P.in[IN_SNW]) + l * DM : nullptr, kb * 64, dst, scr, C.lane);
        }
    }
    convert_tables(C, 0);
}

__device__ __forceinline__ void phase_norm(const Ctx& C, int l, int which) {
    CParams& P = *C.P;
    const int gw = C.bid * NWAVES + C.wave, NGW = C.G * NWAVES;
    bf16_t* H = WSP(bf16_t, WS_B0);
    const float* lw = as_global(P.in[which ? IN_LN2 : IN_LN1]) + l * DM;
    const float* MOD = WSP(float, WS_MOD);
    const float* xpp = as_global(P.in[IN_XP]); const float* xsp = as_global(P.in[IN_XS]);
#define NORM_SRC(row_) ((which == 0 && l == 0) ? ((row_) < TP ? xpp + (size_t)(row_) * DM : xsp + (size_t)((row_) - TP) * DM) : C.out + (size_t)(row_) * DM)
    f32x4 nv[4];
    { const f32x4* xr = (const f32x4*)NORM_SRC(min(gw, TT - 1)) + C.lane;
#pragma unroll
      for (int j = 0; j < 4; ++j) nv[j] = xr[64 * j]; }
    for (int row = gw; row < TT; row += NGW) {
        u32x2* o8 = (u32x2*)(H + (size_t)row * DM) + C.lane;
        f32x4 v[4]; float s = 0.f;
#pragma unroll
        for (int j = 0; j < 4; ++j) { v[j] = nv[j]; s += (v[j][0] * v[j][0] + v[j][1] * v[j][1]) + (v[j][2] * v[j][2] + v[j][3] * v[j][3]); }
        { const f32x4* xr = (const f32x4*)NORM_SRC(min(row + NGW, TT - 1)) + C.lane;
#pragma unroll
          for (int j = 0; j < 4; ++j) nv[j] = xr[64 * j]; }
        const float rstd = rsqrtf(wave_sum(s) * (1.f / DM) + EPS);
        const float* md = MOD + ((size_t)l * NBT + row_batch(row)) * 6144 + (which ? 3072 : 0);
#pragma unroll
        for (int j = 0; j < 4; ++j) { const int col = C.lane * 4 + 256 * j;
            const f32x4 w = *(const f32x4*)(lw + col), sh = *(const f32x4*)(md + col), scv = *(const f32x4*)(md + 1024 + col);
            const f32x4 y = (v[j] * rstd * w) * (scv + 1.0f) + sh;
            o8[64 * j] = (u32x2){pk2(y[0], y[1]), pk2(y[2], y[3])}; }
    }
#undef NORM_SRC
    if (which == 0 && l == 1) convert_tables(C, 1);
}

struct Epi1 {
    __device__ __forceinline__ bool idem() const { return true; }
    static constexpr int NK = 5; static constexpr bool PERM = true;
    bf16_t *Z, *XBC, *LX, *LY; float* DT; const float* dtb;
    __device__ __forceinline__ int kind(int pn) const { return pn < 4 ? 0 : (pn < 9 ? 1 : (pn < 13 ? 2 : (pn < 17 ? 3 : 4))); }
    template <int KD> __device__ __forceinline__ void apply(int, int row, int col, f32x4 v) const {
        if constexpr (KD == 0) { *(u32x2*)(Z + (size_t)row * DM + col) = (u32x2){pk2(siluf_(v[0]), siluf_(v[1])), pk2(siluf_(v[2]), siluf_(v[3]))}; }
        else if constexpr (KD == 1) { *(u32x2*)(XBC + (size_t)row * 1280 + (col - 1024)) = (u32x2){pk2(v[0], v[1]), pk2(v[2], v[3])}; }
        else if constexpr (KD == 2) { *(u32x2*)(LX + (size_t)row * DM + (col - 2304)) = (u32x2){pk2(v[0], v[1]), pk2(v[2], v[3])}; }
        else if constexpr (KD == 3) { *(u32x2*)(LY + (size_t)row * DM + (col - 3328)) = (u32x2){pk2(geluf_(v[0]), geluf_(v[1])), pk2(geluf_(v[2]), geluf_(v[3]))}; }
        else { if (col < 4368) { const int c = col - 4352; const f32x4 b = *(const f32x4*)(dtb + c);
            *(f32x4*)(DT + (size_t)row * 16 + c) = (f32x4){softplusf_(v[0] + b[0]), softplusf_(v[1] + b[1]), softplusf_(v[2] + b[2]), softplusf_(v[3] + b[3])}; } }
    }
    template <int KD> __device__ __forceinline__ void apply8(int w, int row, int col, f32x4 a, f32x4 b) const {
        if constexpr (KD == 0) { *(u32x4*)(Z + (size_t)row * DM + col) = (u32x4){pk2(siluf_(a[0]), siluf_(a[1])), pk2(siluf_(a[2]), siluf_(a[3])), pk2(siluf_(b[0]), siluf_(b[1])), pk2(siluf_(b[2]), siluf_(b[3]))}; }
        else if constexpr (KD == 1) { *(u32x4*)(XBC + (size_t)row * 1280 + (col - 1024)) = (u32x4){pk2(a[0], a[1]), pk2(a[2], a[3]), pk2(b[0], b[1]), pk2(b[2], b[3])}; }
        else if constexpr (KD == 2) { *(u32x4*)(LX + (size_t)row * DM + (col - 2304)) = (u32x4){pk2(a[0], a[1]), pk2(a[2], a[3]), pk2(b[0], b[1]), pk2(b[2], b[3])}; }
        else if constexpr (KD == 3) { *(u32x4*)(LY + (size_t)row * DM + (col - 3328)) = (u32x4){pk2(geluf_(a[0]), geluf_(a[1])), pk2(geluf_(a[2]), geluf_(a[3])), pk2(geluf_(b[0]), geluf_(b[1])), pk2(geluf_(b[2]), geluf_(b[3]))}; }
        else { apply<KD>(w, row, col, a); apply<KD>(w, row, col + 4, b); }
    }
};
struct Epi2 {
    __device__ __forceinline__ bool idem() const { return true; }
    static constexpr int NK = 2; static constexpr bool PERM = true;
    bf16_t *GS, *GL;
    __device__ __forceinline__ int kind(int pn) const { return pn < 4 ? 0 : 1; }
    template <int KD> __device__ __forceinline__ void apply(int, int row, int col, f32x4 v) const {
        bf16_t* d = (KD == 0 ? GS + (size_t)row * DM + col : GL + (size_t)row * DM + (col - 1024));
        *(u32x2*)d = (u32x2){pk2(sigmoidf_(v[0]), sigmoidf_(v[1])), pk2(sigmoidf_(v[2]), sigmoidf_(v[3]))};
    }
    template <int KD> __device__ __forceinline__ void apply8(int, int row, int col, f32x4 a, f32x4 b) const {
        bf16_t* d = (KD == 0 ? GS + (size_t)row * DM + col : GL + (size_t)row * DM + (col - 1024));
        *(u32x4*)d = (u32x4){pk2(sigmoidf_(a[0]), sigmoidf_(a[1])), pk2(sigmoidf_(a[2]), sigmoidf_(a[3])), pk2(sigmoidf_(b[0]), sigmoidf_(b[1])), pk2(sigmoidf_(b[2]), sigmoidf_(b[3]))};
    }
};
struct Epi3 {
    __device__ __forceinline__ bool idem() const { return true; }
    static constexpr int NK = 1; static constexpr bool PERM = true;
    const bf16_t *GS, *GL; const float* SSQ; bf16_t* MG;
    __device__ __forceinline__ int kind(int) const { return 0; }
    __device__ __forceinline__ float rstd_of(int row) const { const f32x4* q = (const f32x4*)(SSQ + (size_t)row * 16); const f32x4 a = q[0] + q[1] + q[2] + q[3];
        return rsqrtf(((a[0] + a[1]) + (a[2] + a[3])) * (1.f / DM) + EPS); }
    template <int KD> __device__ __forceinline__ void apply(int w, int row, int col, f32x4 v) const {
        u32x2* m = (u32x2*)(MG + (size_t)row * DM + col);
        if (w == 0) { const float rstd = rstd_of(row);
            const u32x2 g = *(const u32x2*)(GS + (size_t)row * DM + col);
            *m = (u32x2){pk2(bflo(g.x) * rstd * v[0], bfhi(g.x) * rstd * v[1]), pk2(bflo(g.y) * rstd * v[2], bfhi(g.y) * rstd * v[3])};
        } else {
            const u32x2 g = *(const u32x2*)(GL + (size_t)row * DM + col); const u32x2 p = *m;
            *m = (u32x2){pk2(bflo(p.x) + bflo(g.x) * v[0], bfhi(p.x) + bfhi(g.x) * v[1]), pk2(bflo(p.y) + bflo(g.y) * v[2], bfhi(p.y) + bfhi(g.y) * v[3])};
        }
    }
    template <int KD> __device__ __forceinline__ void apply8(int w, int row, int col, f32x4 a, f32x4 b) const {
        u32x4* m = (u32x4*)(MG + (size_t)row * DM + col);
        if (w == 0) { const float rstd = rstd_of(row);
            const u32x4 g = *(const u32x4*)(GS + (size_t)row * DM + col);
            *m = (u32x4){pk2(bflo(g.x) * rstd * a[0], bfhi(g.x) * rstd * a[1]), pk2(bflo(g.y) * rstd * a[2], bfhi(g.y) * rstd * a[3]), pk2(bflo(g.z) * rstd * b[0], bfhi(g.z) * rstd * b[1]), pk2(bflo(g.w) * rstd * b[2], bfhi(g.w) * rstd * b[3])};
        } else {
            const u32x4 g = *(const u32x4*)(GL + (size_t)row * DM + col); const u32x4 p = *m;
            *m = (u32x4){pk2(bflo(p.x) + bflo(g.x) * a[0], bfhi(p.x) + bfhi(g.x) * a[1]), pk2(bflo(p.y) + bflo(g.y) * a[2], bfhi(p.y) + bfhi(g.y) * a[3]),
                         pk2(bflo(p.z) + bflo(g.z) * b[0], bfhi(p.z) + bfhi(g.z) * b[1]), pk2(bflo(p.w) + bflo(g.w) * b[2], bfhi(p.w) + bfhi(g.w) * b[3])};
        }
    }
};
struct Epi4 {
    static constexpr bool PERM = true;
    __device__ __forceinline__ bool idem() const { return layer == 0; }
    static constexpr int NK = 1;
    const float *xp, *xs; float* XR; const float* MODl; int layer;
    __device__ __forceinline__ int kind(int) const { return 0; }
    template <int KD> __device__ __forceinline__ void apply(int, int row, int col, f32x4 v) const {
        if (row >= TT) return;
        const float* src = layer == 0 ? (row < TP ? xp + (size_t)row * DM : xs + (size_t)(row - TP) * DM) : XR + (size_t)row * DM;
        const f32x4 x = *(const f32x4*)(src + col), g = *(const f32x4*)(MODl + (size_t)row_batch(row) * 6144 + 2048 + col);
        *(f32x4*)(XR + (size_t)row * DM + col) = x + g * v;
    }
    template <int KD> __device__ __forceinline__ void apply8(int, int row, int col, f32x4 a, f32x4 b) const {
        const float* src = (layer == 0 ? xp : XR) + (size_t)row * DM + col; const float* gp = MODl + (size_t)(row >> 11) * 6144 + 2048 + col;
        const f32x4 x0 = *(const f32x4*)src, x1 = *(const f32x4*)(src + 4), g0 = *(const f32x4*)gp, g1 = *(const f32x4*)(gp + 4);
        float* d = XR + (size_t)row * DM + col; *(f32x4*)d = x0 + g0 * a; *(f32x4*)(d + 4) = x1 + g1 * b;
    }
};
struct Epi5 {
    static constexpr bool PERM = true;
    __device__ __forceinline__ bool idem() const { return true; }
    static constexpr int NK = 1;
    float* SC;
    __device__ __forceinline__ int kind(int) const { return 0; }
    template <int KD> __device__ __forceinline__ void apply(int, int row, int col, f32x4 v) const { *(f32x4*)(SC + (size_t)row * 2048 + col) = v; }
    template <int KD> __device__ __forceinline__ void apply8(int, int row, int col, f32x4 a, f32x4 b) const { float* d = SC + (size_t)row * 2048 + col; *(f32x4*)d = a; *(f32x4*)(d + 4) = b; }
};

namespace pg8 {
constexpr int BM = 256, BK = 64, HALF = 128, HTB = HALF * BK * 2, STAGE_BYTES = 8 * HTB, NXCD = 8, WGM = 8;
__host__ __device__ __forceinline__ int lds_byte(int r, int c) { const int st = (r >> 4) * 2 + (c >> 5), rr = r & 15, cc = c & 31, ob = rr * 64 + cc * 2; return st * 1024 + (ob ^ (((ob >> 9) & 1) << 5)); }
__host__ __device__ __forceinline__ void stage_rc(int b, int& R, int& C) { const int st = b / 1024, sb = b % 1024, swz = sb ^ (((sb >> 9) & 1) << 5); R = (st >> 1) * 16 + swz / 64; C = (st & 1) * 32 + (swz % 64) / 2; }
struct Unit { int pm, pn, w; };
struct Sched {
    int nM, nN, nW, nwg, G, c; const char *A0, *B0, *A1, *B1;
    __device__ __forceinline__ bool next(int i, Unit& u) const {
        const int ti = i / nW; u.w = i - ti * nW;
        const long L = (long)ti * G + c; if (L >= nwg) return false;
        int wgid = (int)L; { const int q = nwg / NXCD, r = nwg % NXCD, xcd = wgid % NXCD, off = wgid / NXCD; wgid = (xcd < r ? xcd * (q + 1) : r * (q + 1) + (xcd - r) * q) + off; }
        const int nig = WGM * nN, gid = wgid / nig, fm = gid * WGM, gsz = (nM - fm) < WGM ? (nM - fm) : WGM;
        u.pm = fm + ((wgid % nig) % gsz); u.pn = (wgid % nig) / gsz; return true;
    }
};
__host__ __device__ __forceinline__ int perm32(int rho) { const int n = rho >> 4, i = rho & 15; return 8 * (i >> 2) + 4 * n + (i & 3); }
template <int KD, class Epi>
__device__ __forceinline__ void epi_tile(const Epi& E, const f32x4 (&acc)[2][2][4][2], const Unit& u, int wr, int wc, int fr, int fq) {
#pragma unroll
    for (int ai = 0; ai < 2; ++ai)
#pragma unroll
        for (int m = 0; m < 4; ++m) { const int row = u.pm * BM + ai * HALF + wr * 64 + m * 16 + fr;
#pragma unroll
            for (int bj = 0; bj < 2; ++bj) {
                if constexpr (Epi::PERM) E.template apply8<KD>(u.w, row, u.pn * BM + bj * HALF + wc * 32 + 8 * fq, acc[ai][bj][m][0], acc[ai][bj][m][1]);
                else {
#pragma unroll
                    for (int n = 0; n < 2; ++n) E.template apply<KD>(u.w, row, u.pn * BM + bj * HALF + wc * 32 + n * 16 + 4 * fq, acc[ai][bj][m][n]); } } }
}
template <class Epi>
__device__ __forceinline__ void epi_apply(const Epi& E, const f32x4 (&acc)[2][2][4][2], const Unit& u, int wr, int wc, int fr, int fq) {
    if constexpr (Epi::NK == 1) epi_tile<0>(E, acc, u, wr, wc, fr, fq);
    else { const int kd = E.kind(u.pn);
        if (kd == 0) epi_tile<0>(E, acc, u, wr, wc, fr, fq);
        else if (kd == 1) epi_tile<1>(E, acc, u, wr, wc, fr, fq);
        else if constexpr (Epi::NK > 2) { if (kd == 2) epi_tile<2>(E, acc, u, wr, wc, fr, fq); else if (kd == 3) epi_tile<3>(E, acc, u, wr, wc, fr, fq); else epi_tile<4>(E, acc, u, wr, wc, fr, fq); } }
}
template <class Epi, bool ALIGN_EPI = true, bool SP2 = true>
__device__ __forceinline__ void gemm_phase(LAS unsigned char* lds, int tid, int K, const Sched& S, const Epi& E) {
    const int wid = __builtin_amdgcn_readfirstlane(tid >> 6), lane = tid & 63, wr = wid >> 2, wc = wid & 3, fr = lane & 15, fq = lane >> 4;
    const int nt = K / BK;
    unsigned voffA[2], voffB[2];
#pragma unroll
    for (int i = 0; i < 2; ++i) { int R, Cc; stage_rc(tid * 16 + i * 8192, R, Cc); const int Rb = Epi::PERM ? ((R & ~31) + perm32(R & 31)) : R;
        voffA[i] = (unsigned)(R * K + Cc) * 2u; voffB[i] = (unsigned)(Rb * K + Cc) * 2u; }
    const size_t kstep = (size_t)(BK * 2);
    const size_t hstep = (size_t)HALF * K * 2;
    const size_t tstep = 2 * hstep;
    const unsigned ldsw = (unsigned)wid * 1024u;
    const int aoff = lds_byte(wr * 64 + fr, fq * 8), boff = lds_byte(wc * 32 + fr, fq * 8);
#define PG8_SA(b, h) (((b) * 2 + (h)) * HTB)
#define PG8_SB(b, h) ((4 + (b) * 2 + (h)) * HTB)
#define PG8_STAGE(bufoff, gbase, voff) do { _Pragma("unroll") for (int _i = 0; _i < 2; ++_i) \
        __builtin_amdgcn_global_load_lds((const unsigned*)((const char*)(gbase) + (voff)[_i]), (LAS unsigned*)(lds + (bufoff) + ldsw + _i * 8192), 16, 0, 0); } while (0)
#define PG8_LDA(dst, b, h) do { _Pragma("unroll") for (int m = 0; m < 4; ++m) _Pragma("unroll") for (int k = 0; k < 2; ++k) dst[m][k] = *(const LAS bf16x8*)(lds + PG8_SA(b, h) + aoff + m * 2048 + k * 1024); } while (0)
#define PG8_LDB(dst, b, h) do { _Pragma("unroll") for (int n = 0; n < 2; ++n) _Pragma("unroll") for (int k = 0; k < 2; ++k) dst[n][k] = *(const LAS bf16x8*)(lds + PG8_SB(b, h) + boff + n * 2048 + k * 1024); } while (0)
#define PG8_MMA(ai, bj, At, Bt) do { __builtin_amdgcn_s_setprio(1); _Pragma("unroll") for (int m = 0; m < 4; ++m) _Pragma("unroll") for (int n = 0; n < 2; ++n) _Pragma("unroll") for (int k = 0; k < 2; ++k) \
        acc[ai][bj][m][n] = __builtin_amdgcn_mfma_f32_16x16x32_bf16(Bt[n][k], At[m][k], acc[ai][bj][m][n], 0, 0, 0); __builtin_amdgcn_s_setprio(0); } while (0)
#define PG8_WAIT_V(n) asm volatile("s_waitcnt vmcnt(" #n ")" ::: "memory")
#define PG8_WAIT_L(n) asm volatile("s_waitcnt lgkmcnt(" #n ")" ::: "memory")
#define PG8_BAR __builtin_amdgcn_s_barrier()
#define PG8_SCHED __builtin_amdgcn_sched_barrier(0)
    Unit cur, nxt; int ui = 0;
    if (!S.next(0, cur)) return;
    f32x4 acc[2][2][4][2];
#pragma unroll
    for (int a = 0; a < 2; ++a)
#pragma unroll
        for (int b = 0; b < 2; ++b)
#pragma unroll
            for (int m = 0; m < 4; ++m)
#pragma unroll
                for (int n = 0; n < 2; ++n) acc[a][b][m][n] = (f32x4){0.f, 0.f, 0.f, 0.f};
    bf16x8 At[4][2], B0[2][2], B1[2][2];
    const char* cA = (cur.w ? S.A1 : S.A0) + (size_t)cur.pm * tstep; const char* cB = (cur.w ? S.B1 : S.B0) + (size_t)cur.pn * tstep;
    if constexpr (SP2) {
        PG8_STAGE(PG8_SB(0, 0), cB, voffB); PG8_STAGE(PG8_SB(0, 1), cB + hstep, voffB); PG8_STAGE(PG8_SA(0, 0), cA, voffA); PG8_STAGE(PG8_SA(0, 1), cA + hstep, voffA);
        if (wr == 1) PG8_BAR;
        PG8_WAIT_V(2); PG8_BAR;
        PG8_STAGE(PG8_SB(1, 0), cB + kstep, voffB); PG8_STAGE(PG8_SA(1, 0), cA + kstep, voffA); PG8_STAGE(PG8_SB(1, 1), cB + hstep + kstep, voffB);
        PG8_WAIT_V(6); PG8_BAR;
    } else {
        PG8_STAGE(PG8_SB(0, 0), cB, voffB); PG8_STAGE(PG8_SA(0, 0), cA, voffA); PG8_STAGE(PG8_SB(0, 1), cB + hstep, voffB); PG8_STAGE(PG8_SA(0, 1), cA + hstep, voffA);
        if (wr == 1) PG8_BAR;
        PG8_WAIT_V(4); PG8_BAR;
        PG8_STAGE(PG8_SB(1, 0), cB + kstep, voffB); PG8_STAGE(PG8_SA(1, 0), cA + kstep, voffA); PG8_STAGE(PG8_SB(1, 1), cB + hstep + kstep, voffB);
        PG8_WAIT_V(6); PG8_BAR;
    }
    for (;;) {
        const bool has_next = S.next(ui + 1, nxt);
        const char* nA = has_next ? (nxt.w ? S.A1 : S.A0) + (size_t)nxt.pm * tstep : cA; const char* nB = has_next ? (nxt.w ? S.B1 : S.B0) + (size_t)nxt.pn * tstep : cB;
        for (int t = 0; t < nt; t += 2) {
            const bool last = (t == nt - 2);
            const char* a1 = cA + (size_t)(t + 1) * kstep;
            const char* a2 = last ? nA : cA + (size_t)(t + 2) * kstep; const char* b2 = last ? nB : cB + (size_t)(t + 2) * kstep;
            const char* a3 = a2 + kstep; const char* b3 = b2 + kstep;
            if constexpr (SP2) {
            PG8_LDB(B0, 0, 0); PG8_LDB(B1, 0, 1); PG8_SCHED; PG8_LDA(At, 0, 0); PG8_STAGE(PG8_SA(1, 1), a1 + hstep, voffA);
            PG8_WAIT_V(8); PG8_WAIT_L(0); PG8_BAR; PG8_MMA(0, 0, At, B0); PG8_MMA(0, 1, At, B1); PG8_BAR; PG8_SCHED;
            PG8_LDA(At, 0, 1); PG8_STAGE(PG8_SB(0, 0), b2, voffB); PG8_STAGE(PG8_SB(0, 1), b2 + hstep, voffB); PG8_STAGE(PG8_SA(0, 0), a2, voffA);
            PG8_WAIT_V(8); PG8_WAIT_L(0); PG8_BAR; PG8_MMA(1, 0, At, B0); PG8_MMA(1, 1, At, B1); PG8_BAR; PG8_SCHED;
            PG8_LDB(B0, 1, 0); PG8_LDB(B1, 1, 1); PG8_SCHED; PG8_LDA(At, 1, 0); PG8_STAGE(PG8_SA(0, 1), a2 + hstep, voffA);
            PG8_WAIT_V(8); PG8_WAIT_L(0); PG8_BAR; PG8_MMA(0, 0, At, B0); PG8_MMA(0, 1, At, B1); PG8_BAR; PG8_SCHED;
            PG8_LDA(At, 1, 1); PG8_STAGE(PG8_SB(1, 0), b3, voffB); PG8_STAGE(PG8_SB(1, 1), b3 + hstep, voffB); PG8_STAGE(PG8_SA(1, 0), a3, voffA);
            PG8_WAIT_V(8); PG8_WAIT_L(0); PG8_BAR; PG8_MMA(1, 0, At, B0); PG8_MMA(1, 1, At, B1); PG8_BAR; PG8_SCHED;
            } else {
            PG8_LDB(B0, 0, 0); PG8_SCHED; PG8_LDA(At, 0, 0); PG8_STAGE(PG8_SA(1, 1), a1 + hstep, voffA);
            PG8_WAIT_L(8); PG8_BAR; PG8_WAIT_L(0); PG8_MMA(0, 0, At, B0); PG8_BAR; PG8_SCHED;
            PG8_LDB(B1, 0, 1); PG8_STAGE(PG8_SB(0, 0), b2, voffB);
            PG8_BAR; PG8_WAIT_L(0); PG8_MMA(0, 1, At, B1); PG8_BAR;
            PG8_LDA(At, 0, 1); PG8_STAGE(PG8_SA(0, 0), a2, voffA);
            PG8_BAR; PG8_WAIT_L(0); PG8_MMA(1, 0, At, B0); PG8_BAR; PG8_SCHED;
            PG8_STAGE(PG8_SB(0, 1), b2 + hstep, voffB);
            PG8_WAIT_V(6); PG8_BAR; PG8_MMA(1, 1, At, B1); PG8_BAR;
            PG8_LDB(B0, 1, 0); PG8_SCHED; PG8_LDA(At, 1, 0); PG8_STAGE(PG8_SA(0, 1), a2 + hstep, voffA);
            PG8_WAIT_L(8); PG8_BAR; PG8_WAIT_L(0); PG8_MMA(0, 0, At, B0); PG8_BAR; PG8_SCHED;
            PG8_LDB(B1, 1, 1); PG8_STAGE(PG8_SB(1, 0), b3, voffB);
            PG8_BAR; PG8_WAIT_L(0); PG8_MMA(0, 1, At, B1); PG8_BAR;
            PG8_LDA(At, 1, 1); PG8_STAGE(PG8_SA(1, 0), a3, voffA);
            PG8_BAR; PG8_WAIT_L(0); PG8_MMA(1, 0, At, B0); PG8_BAR; PG8_SCHED;
            PG8_STAGE(PG8_SB(1, 1), b3 + hstep, voffB);
            PG8_WAIT_V(6); PG8_BAR; PG8_MMA(1, 1, At, B1); PG8_BAR;
            }
        }
        if constexpr (ALIGN_EPI) { if (wr == 0) PG8_BAR; }
        epi_apply(E, acc, cur, wr, wc, fr, fq);
        if (!has_next) break;
#pragma unroll
        for (int a = 0; a < 2; ++a)
#pragma unroll
            for (int b = 0; b < 2; ++b)
#pragma unroll
                for (int m = 0; m < 4; ++m)
#pragma unroll
                    for (int n = 0; n < 2; ++n) acc[a][b][m][n] = (f32x4){0.f, 0.f, 0.f, 0.f};
        cur = nxt; cA = nA; cB = nB; ++ui;
        if constexpr (ALIGN_EPI) { if (wr == 1) PG8_BAR; }
    }
    PG8_WAIT_V(0);
    if constexpr (!ALIGN_EPI) { if (wr == 0) PG8_BAR; }
    PG8_BAR;
#undef PG8_SA
#undef PG8_SB
#undef PG8_STAGE
#undef PG8_LDA
#undef PG8_LDB
#undef PG8_MMA
#undef PG8_WAIT_V
#undef PG8_WAIT_L
#undef PG8_BAR
#undef PG8_SCHED
}
}
template <int KD, class Epi>
__device__ __forceinline__ void sample_tile(const Ctx& C, const bf16_t* A0, const bf16_t* B0, const bf16_t* A1, const bf16_t* B1, int rb, int cb, const Epi& E) {
    const int fr = C.lane & 15, fq = C.lane >> 4;
    for (int w = 0; w < (A1 ? 2 : 1); ++w) {
        const bf16_t* ap = (w ? A1 : A0) + (size_t)(TP + 16 * rb + fr) * DM + 8 * fq; const bf16_t* bp = (w ? B1 : B0) + (size_t)(16 * cb + fr) * DM + 8 * fq;
        f32x4 acc = (f32x4){0.f, 0.f, 0.f, 0.f};
#pragma unroll 16
        for (int ks = 0; ks < DM / 32; ++ks) { const bf16x8 a = *(const bf16x8*)(ap + 32 * ks), b = *(const bf16x8*)(bp + 32 * ks); acc = __builtin_amdgcn_mfma_f32_16x16x32_bf16(b, a, acc, 0, 0, 0); }
        E.template apply<KD>(w, TP + 16 * rb + fr, 16 * cb + 4 * fq, acc);
    }
}
template <class Epi>
__device__ __forceinline__ void gemm_sample(const Ctx& C, const bf16_t* A0, const bf16_t* B0, const bf16_t* A1, const bf16_t* B1, int N, const Epi& E) {
    const int gw = C.bid * NWAVES + C.wave, NGW = C.G * NWAVES, ncb = N / 16;
    for (int it = gw; it < 8 * ncb; it += NGW) {
        const int cb = it >> 3, rb = it & 7; const int kd = E.kind(cb >> 4);
        if constexpr (Epi::NK == 1) sample_tile<0>(C, A0, B0, A1, B1, rb, cb, E);
        else { if (kd == 0) sample_tile<0>(C, A0, B0, A1, B1, rb, cb, E); else if (kd == 1) sample_tile<1>(C, A0, B0, A1, B1, rb, cb, E);
            else if constexpr (Epi::NK > 2) { if (kd == 2) sample_tile<2>(C, A0, B0, A1, B1, rb, cb, E); else if (kd == 3) sample_tile<3>(C, A0, B0, A1, B1, rb, cb, E); else sample_tile<4>(C, A0, B0, A1, B1, rb, cb, E); } }
    }
}
template <class Epi>
__device__ __forceinline__ void gemm_run(const Ctx& C, const bf16_t* A0, const bf16_t* B0, const bf16_t* A1, const bf16_t* B1, int N, const Epi& E) {
    gemm_sample(C, A0, B0, A1, B1, N, E);
    pg8::Sched S; S.nM = TP / 256; S.nN = N / 256; S.nW = A1 ? 2 : 1; S.nwg = S.nM * S.nN; S.G = C.G; S.c = C.bid;
    S.A0 = (const char*)A0; S.B0 = (const char*)B0; S.A1 = (const char*)A1; S.B1 = (const char*)B1;
    pg8::gemm_phase<Epi>(C.lds, C.tid, DM, S, E);
    __syncthreads();
}

__device__ __forceinline__ unsigned cvt_pk_bf16(float lo, float hi) { unsigned r; asm volatile("v_cvt_pk_bf16_f32 %0, %1, %2" : "=v"(r) : "v"(lo), "v"(hi)); return r; }
__device__ __forceinline__ bf16x8 pack_acc(const f32x16& a, int t) {
    u32x4 w;
    if (t == 0) { w.x = cvt_pk_bf16(a[0], a[1]); w.y = cvt_pk_bf16(a[2], a[3]); w.z = cvt_pk_bf16(a[4], a[5]); w.w = cvt_pk_bf16(a[6], a[7]); }
    else { w.x = cvt_pk_bf16(a[8], a[9]); w.y = cvt_pk_bf16(a[10], a[11]); w.z = cvt_pk_bf16(a[12], a[13]); w.w = cvt_pk_bf16(a[14], a[15]); }
    return __builtin_bit_cast(bf16x8, w);
}
__device__ __forceinline__ int sig_pos(int s) { return (s & ~15) | (((s >> 2) & 1) << 3) | (((s >> 3) & 1) << 2) | (s & 3); }
constexpr int SROW = 144;

template <int WSTR>
__device__ __forceinline__ void conv8(const u32x4 (&rw)[4], const LAS float* wl, float (&v)[8]) {
    f32x4 w[5][2];
#pragma unroll
    for (int k = 0; k < 5; ++k) { w[k][0] = *(const LAS f32x4*)(wl + k * WSTR); w[k][1] = *(const LAS f32x4*)(wl + k * WSTR + 4); }
#pragma unroll
    for (int e = 0; e < 8; ++e) { const int dw = e >> 1; const bool hi = e & 1;
        float x[4];
#pragma unroll
        for (int k = 0; k < 4; ++k) { const unsigned q = dw == 0 ? rw[k].x : (dw == 1 ? rw[k].y : (dw == 2 ? rw[k].z : rw[k].w)); x[k] = hi ? bfhi(q) : bflo(q); }
        v[e] = w[4][e >> 2][e & 3] + w[0][e >> 2][e & 3] * x[0] + w[1][e >> 2][e & 3] * x[1] + w[2][e >> 2][e & 3] * x[2] + w[3][e >> 2][e & 3] * x[3]; }
}
constexpr size_t WS_CBC = WS_EI;
__device__ __forceinline__ void phase_convbc(const Ctx& C, int l) {
    CParams& P = *C.P;
    const bf16_t* XBC = WSP(bf16_t, WS_B2); bf16_t* CBC = WSP(bf16_t, WS_CBC);
    const float* cw = as_global(P.in[IN_SCW]) + (size_t)l * 4 * 1280 + 1024; const float* cbp = as_global(P.in[IN_SCB]) + (size_t)l * 1280 + 1024;
    const float* cst = as_global(P.in[IN_SSDCONV]) + (size_t)l * 8 * 3 * 1280;
    const size_t items = (size_t)TT * 32, stride = (size_t)C.G * NTHREADS;
    for (size_t it = (size_t)C.bid * NTHREADS + C.tid; it < items; it += stride) {
        const int tok = (int)(it >> 5), cg = (int)(it & 31), ch = cg * 8;
        const bool smp = tok >= TP; const int b = smp ? (tok - TP) >> 4 : tok >> 11, t = smp ? (tok - TP) & 15 : tok & 2047, L = smp ? 16 : 2048, NB = smp ? 8 : 16;
        u32x4 rw[4];
#pragma unroll
        for (int k = 0; k < 4; ++k) { const int tr = t - 3 + k;
            if (tr >= 0) rw[k] = *(const u32x4*)(XBC + (size_t)(tok - t + tr) * 1280 + 1024 + ch);
            else if (smp) { const float* s0 = cst + ((size_t)b * 3 + (tr + 3)) * 1280 + 1024 + ch; const f32x4 a0 = *(const f32x4*)s0, a1 = *(const f32x4*)(s0 + 4);
                rw[k] = (u32x4){pk2(a0[0], a0[1]), pk2(a0[2], a0[3]), pk2(a1[0], a1[1]), pk2(a1[2], a1[3])}; }
            else rw[k] = (u32x4){0u, 0u, 0u, 0u}; }
        f32x4 w[5][2];
#pragma unroll
        for (int k = 0; k < 4; ++k) { w[k][0] = *(const f32x4*)(cw + k * 1280 + ch); w[k][1] = *(const f32x4*)(cw + k * 1280 + ch + 4); }
        w[4][0] = *(const f32x4*)(cbp + ch); w[4][1] = *(const f32x4*)(cbp + ch + 4);
        float v[8];
#pragma unroll
        for (int e = 0; e < 8; ++e) { const int dw = e >> 1; const bool hi = e & 1; float x[4];
#pragma unroll
            for (int k = 0; k < 4; ++k) { const unsigned q = dw == 0 ? rw[k].x : (dw == 1 ? rw[k].y : (dw == 2 ? rw[k].z : rw[k].w)); x[k] = hi ? bfhi(q) : bflo(q); }
            v[e] = siluf_(w[4][e >> 2][e & 3] + w[0][e >> 2][e & 3] * x[0] + w[1][e >> 2][e & 3] * x[1] + w[2][e >> 2][e & 3] * x[2] + w[3][e >> 2][e & 3] * x[3]); }
        *(u32x4*)(CBC + (size_t)tok * 256 + ch) = (u32x4){pk2(v[0], v[1]), pk2(v[2], v[3]), pk2(v[4], v[5]), pk2(v[6], v[7])};
        if (t >= L - 3) { float* co = C.out + (smp ? O_SSCONV : O_PSCONV) + ((size_t)(l * NB + b) * 3 + (t - (L - 3))) * 1280 + 1024 + ch; const u32x4 q = rw[3];
            *(f32x4*)co = (f32x4){bflo(q.x), bfhi(q.x), bflo(q.y), bfhi(q.y)}; *(f32x4*)(co + 4) = (f32x4){bflo(q.z), bfhi(q.z), bflo(q.w), bfhi(q.w)}; }
    }
}

#ifndef SCAN_SKIP
#define SCAN_SKIP 0
#endif
__device__ __forceinline__ void scan_item_fused(const Ctx& C, int l, int idx, bool dry) {
    const int skip = dry ? SCAN_SKIP : 0;
    CParams& P = *C.P; const int tid = C.tid, lane = C.lane, wave = C.wave;
    const bool smp = idx >= 256; const int ii = smp ? idx - 256 : idx; const int b = ii >> 4, head = ii & 15, g = head >> 3, j = head;
    const int tok0 = smp ? TP + b * 16 : b * 2048, L = smp ? 16 : 2048, NB = smp ? 8 : 16, nchunk = smp ? 1 : 32;
    const bf16_t* XBC = WSP(bf16_t, WS_B2); const bf16_t* CBC = WSP(bf16_t, WS_CBC); bf16_t* Z = WSP(bf16_t, WS_B1); const float* DT = WSP(float, WS_DT); float* SSQ = WSP(float, WS_SSQ);
    const float a_h = -__expf(as_global(P.in[IN_ALOG])[l * 16 + head]), Dh = as_global(P.in[IN_SSDD])[l * 16 + head];
    LAS unsigned char* bmR = C.lds; LAS unsigned char* cmR = C.lds + 9216; LAS unsigned char* xsR = C.lds + 18432; LAS unsigned char* bwR = C.lds + 30720;
    LAS float* ybuf = (LAS float*)(C.lds + 43008);
    LAS float* acum = (LAS float*)(C.lds + 59392); LAS float* dtv = acum + 64; LAS float* eac = acum + 128; LAS float* wsc = acum + 192; LAS float* misc = acum + 256; LAS float* cwl = acum + 320;
    const int t = tid >> 3, cg = tid & 7;
    const int chx = head * 64 + cg * 8, chb = 1024 + g * 64 + cg * 8, chc = 1152 + g * 64 + cg * 8;
    const float* scw = as_global(P.in[IN_SCW]) + (size_t)l * 4 * 1280; const float* scb = as_global(P.in[IN_SCB]) + (size_t)l * 1280;
    const float* scst = smp ? as_global(P.in[IN_SSDCONV]) + (size_t)(l * 8 + b) * 3 * 1280 : nullptr;
    const int qb = (wave >> 1) & 1, pb = wave & 1, r = lane & 31, hh = lane >> 5;
    f32x16 hacc[2];
#pragma unroll
    for (int nb = 0; nb < 2; ++nb)
#pragma unroll
        for (int i = 0; i < 16; ++i) hacc[nb][i] = 0.f;
    if (smp && wave < 4) {
        const float* hs = as_global(P.in[IN_SSD]) + ((size_t)((l * 8 + b) * 16 + head) * 64 + 32 * pb + r) * 64;
#pragma unroll
        for (int nb = 0; nb < 2; ++nb)
#pragma unroll
            for (int i4 = 0; i4 < 4; ++i4) { const f32x4 v = *(const f32x4*)(hs + 32 * nb + 8 * i4 + 4 * hh); hacc[nb][4 * i4] = v[0]; hacc[nb][4 * i4 + 1] = v[1]; hacc[nb][4 * i4 + 2] = v[2]; hacc[nb][4 * i4 + 3] = v[3]; }
    }
    const bf16_t* LX = WSP(bf16_t, WS_B3); bf16_t* LY = WSP(bf16_t, WS_B4);
    LAS unsigned char* LB = C.lds + 65536;
    LAS unsigned char* xcB = LB; LAS unsigned char* waT = LB + 9216; LAS unsigned char* wxT = LB + 18432;
    LAS float* xcF = (LAS float*)(LB + 27648); LAS float* aF = (LAS float*)(LB + 44032); LAS float* uF = (LAS float*)(LB + 60416); LAS float* lcwl = (LAS float*)(LB + 76800);
    const int ch0 = j * 64 + cg * 8;
    const float* lcw = as_global(P.in[IN_LCW]) + (size_t)l * 4 * DM; const float* lcb = as_global(P.in[IN_LCB]) + (size_t)l * DM;
    const float* lcst = smp ? as_global(P.in[IN_LRUCONV]) + (size_t)(l * 8 + b) * 3 * DM : nullptr;
    const int tb = qb, eb = pb, ech = j * 64 + 32 * eb + r;
    const float ba = as_global(P.in[IN_BA])[l * DM + ech], bxx = as_global(P.in[IN_BX])[l * DM + ech], sp8 = -8.0f * softplusf_(-as_global(P.in[IN_LAM])[l * DM + ech]);
    float hstate = (smp && wave == 4) ? as_global(P.in[IN_LRU])[(size_t)(l * 8 + b) * DM + j * 64 + lane] : 0.f;
    __syncthreads();
    for (int i = tid; i < 5 * 192; i += NTHREADS) { const int k = i / 192, cc = i % 192; const int ch = cc < 64 ? head * 64 + cc : (cc < 128 ? 1024 + g * 64 + (cc - 64) : 1152 + g * 64 + (cc - 128));
        cwl[i] = k < 4 ? scw[k * 1280 + ch] : scb[ch]; }
    { const float* wap = as_global(P.in[IN_WA]) + (size_t)(l * 16 + j) * 4096; const float* wxp = as_global(P.in[IN_WX]) + (size_t)(l * 16 + j) * 4096;
      for (int i = tid; i < 4096; i += NTHREADS) { const int d = i >> 6, e = i & 63; *(LAS bf16_t*)(waT + e * SROW + d * 2) = (bf16_t)f2bf(wap[i]); *(LAS bf16_t*)(wxT + e * SROW + d * 2) = (bf16_t)f2bf(wxp[i]); } }
    for (int i = tid; i < 5 * 64; i += NTHREADS) { const int k = i >> 6, cc = i & 63; lcwl[i] = k < 4 ? lcw[k * DM + j * 64 + cc] : lcb[j * 64 + cc]; }
    u32x4 rw[4], bcv, ccv, lrw[4], zs, lyv; float dtl = 0.f;
#define RAWROW(dst, base, ld, ch, cstp, tr) { if ((tr) >= 0) dst = ((tr) < L) ? *(const u32x4*)((base) + (size_t)(tok0 + (tr)) * (ld) + (ch)) : (u32x4){0u, 0u, 0u, 0u}; \
        else if (smp) { const float* s0_ = (cstp) + (size_t)((tr) + 3) * (ld) + (ch); const f32x4 a0_ = *(const f32x4*)s0_, a1_ = *(const f32x4*)(s0_ + 4); \
            dst = (u32x4){pk2(a0_[0], a0_[1]), pk2(a0_[2], a0_[3]), pk2(a1_[0], a1_[1]), pk2(a1_[2], a1_[3])}; } else dst = (u32x4){0u, 0u, 0u, 0u}; }
#define SSD_LOAD(c_) { const int tg_ = (c_) * 64 + t; _Pragma("unroll") for (int k = 0; k < 4; ++k) { RAWROW(rw[k], XBC, 1280, chx, scst, tg_ - 3 + k) } \
        const bool v_ = tg_ < L; bcv = v_ ? *(const u32x4*)(CBC + (size_t)(tok0 + tg_) * 256 + g * 64 + cg * 8) : (u32x4){0u, 0u, 0u, 0u}; ccv = v_ ? *(const u32x4*)(CBC + (size_t)(tok0 + tg_) * 256 + 128 + g * 64 + cg * 8) : (u32x4){0u, 0u, 0u, 0u}; \
        }
#define LRU_LOAD(c_) { const int tg_ = (c_) * 64 + t; _Pragma("unroll") for (int k = 0; k < 4; ++k) { RAWROW(lrw[k], LX, DM, ch0, lcst, tg_ - 3 + k) } }
#define TAIL_LOAD(c_) { const int tg_ = (c_) * 64 + t; const bool v_ = tg_ < L; zs = v_ ? *(const u32x4*)(Z + (size_t)(tok0 + tg_) * DM + chx) : (u32x4){0u, 0u, 0u, 0u}; lyv = v_ ? *(const u32x4*)(LY + (size_t)(tok0 + tg_) * DM + ch0) : (u32x4){0u, 0u, 0u, 0u}; }
    SSD_LOAD(0) LRU_LOAD(0) TAIL_LOAD(0)
    if (wave == 0) dtl = (lane < L) ? DT[(size_t)(tok0 + lane) * 16 + head] : 0.f;
    __syncthreads();
    for (int c = 0; c < nchunk; ++c) {
        int lt_ = tid; asm volatile("" : "+v"(lt_));
        const int t = lt_ >> 3, cg = lt_ & 7, lane = lt_ & 63, r = lane & 31, hh = lane >> 5;
        const int chx = head * 64 + cg * 8, chb = 1024 + g * 64 + cg * 8, chc = 1152 + g * 64 + cg * 8, ch0 = j * 64 + cg * 8;
        const int tg = c * 64 + t; const bool valid = tg < L;
        if (wave == 0 && !(skip & 128)) {
            float cs = dtl * a_h;
            { float o = shfl_f(cs, lane - 1); if (lane >= 1) cs += o; o = shfl_f(cs, lane - 2); if (lane >= 2) cs += o; o = shfl_f(cs, lane - 4); if (lane >= 4) cs += o;
              o = shfl_f(cs, lane - 8); if (lane >= 8) cs += o; o = shfl_f(cs, lane - 16); if (lane >= 16) cs += o; o = shfl_f(cs, lane - 32); if (lane >= 32) cs += o; }
            const float tot = shfl_f(cs, 63);
            acum[lane] = cs; dtv[lane] = dtl; eac[lane] = __expf(cs); wsc[lane] = __expf(tot - cs) * dtl; if (lane == 0) misc[0] = __expf(tot);
        }
        if (!(skip & 32)) {
            float v[8]; conv8<64>(lrw, lcwl + cg * 8, v);
            *(LAS u32x4*)(xcB + t * SROW + cg * 16) = (u32x4){pk2(v[0], v[1]), pk2(v[2], v[3]), pk2(v[4], v[5]), pk2(v[6], v[7])};
            *(LAS f32x4*)(xcF + t * 64 + cg * 8) = (f32x4){v[0], v[1], v[2], v[3]}; *(LAS f32x4*)(xcF + t * 64 + cg * 8 + 4) = (f32x4){v[4], v[5], v[6], v[7]};
            if (!dry && valid && tg >= L - 3) { float* co = C.out + (smp ? O_SLCONV : O_PLCONV) + ((size_t)(l * NB + b) * 3 + (tg - (L - 3))) * DM + ch0; const u32x4 q = lrw[3];
                *(f32x4*)co = (f32x4){bflo(q.x), bfhi(q.x), bflo(q.y), bfhi(q.y)}; *(f32x4*)(co + 4) = (f32x4){bflo(q.z), bfhi(q.z), bflo(q.w), bfhi(q.w)}; }
        }
        LRU_LOAD(c + 1)
        if (!(skip & 256)) __syncthreads();
        if (!(skip & 16)) {
            const float wsl = wsc[t];
            { float v[8]; conv8<192>(rw, cwl + cg * 8, v);
#pragma unroll
              for (int e = 0; e < 8; ++e) v[e] = valid ? siluf_(v[e]) : 0.f;
              if (!(skip & 1)) *(LAS u32x4*)(xsR + t * 192 + cg * 16) = (u32x4){pk2(v[0], v[1]), pk2(v[2], v[3]), pk2(v[4], v[5]), pk2(v[6], v[7])}; }
            *(LAS u32x4*)(bmR + t * SROW + cg * 16) = bcv;
            *(LAS u32x4*)(cmR + t * SROW + cg * 16) = ccv;
            if (!(skip & 1)) *(LAS u32x4*)(bwR + t * 192 + cg * 16) = (u32x4){pk2(bflo(bcv.x) * wsl, bfhi(bcv.x) * wsl), pk2(bflo(bcv.y) * wsl, bfhi(bcv.y) * wsl), pk2(bflo(bcv.z) * wsl, bfhi(bcv.z) * wsl), pk2(bflo(bcv.w) * wsl, bfhi(bcv.w) * wsl)};
            if (!dry && valid && tg >= L - 3) { float* co = C.out + (smp ? O_SSCONV : O_PSCONV) + ((size_t)(l * NB + b) * 3 + (tg - (L - 3))) * 1280 + chx; const u32x4 q = rw[3];
                *(f32x4*)co = (f32x4){bflo(q.x), bfhi(q.x), bflo(q.y), bfhi(q.y)}; *(f32x4*)(co + 4) = (f32x4){bflo(q.z), bfhi(q.z), bflo(q.w), bfhi(q.w)}; }
        }
        asm volatile("" ::: "memory");
        SSD_LOAD(c + 1)
        if (wave == 0) { const int tq_ = (c + 1) * 64 + lane; dtl = (tq_ < L) ? DT[(size_t)(tok0 + tq_) * 16 + head] : 0.f; }
        if (wave >= 4 && !(skip & 2)) {
            f32x16 ra, ia;
#pragma unroll
            for (int i = 0; i < 16; ++i) { ra[i] = 0.f; ia[i] = 0.f; }
#pragma unroll
            for (int ks = 0; ks < 4; ++ks) { const bf16x8 A = *(const LAS bf16x8*)(xcB + (32 * tb + r) * SROW + (16 * ks + 8 * hh) * 2);
                const bf16x8 Ba = *(const LAS bf16x8*)(waT + (32 * eb + r) * SROW + (16 * ks + 8 * hh) * 2), Bx = *(const LAS bf16x8*)(wxT + (32 * eb + r) * SROW + (16 * ks + 8 * hh) * 2);
                ra = MFMA32(A, Ba, ra); ia = MFMA32(A, Bx, ia); }
#pragma unroll
            for (int i = 0; i < 16; ++i) { const int tt = 32 * tb + (i & 3) + 8 * (i >> 2) + 4 * hh, e = 32 * eb + r;
                const float rg = sigmoidf_(ra[i] + ba), ig = sigmoidf_(ia[i] + bxx), log_a = rg * sp8, av = exp_fast(log_a);
                const float u = __builtin_amdgcn_sqrtf(fmaxf(1.0f - av * av, 0.f)) * (ig * xcF[tt * 64 + e]);
                aF[tt * 64 + e] = av; uF[tt * 64 + e] = u; }
        }
        if (!(skip & 256)) __syncthreads();
        if (wave < 4 && !(skip & 4)) {
            const int tri = lane & 15, trg = (lane >> 4) & 1;
            const int troff = (tri >> 2) * 192 + (16 * trg + 4 * (tri & 3)) * 2;
#define TRFRAG(tile, row0, rowstep, col0) ({ const LAS unsigned char* a_ = (tile) + (row0) * 192 + (col0) * 2 + troff; \
                const s16x4_ lo_ = __builtin_amdgcn_ds_read_tr16_b64_v4i16((LAS s16x4_*)a_), hi_ = __builtin_amdgcn_ds_read_tr16_b64_v4i16((LAS s16x4_*)(a_ + (rowstep) * 192)); \
                (bf16x8){lo_[0], lo_[1], lo_[2], lo_[3], hi_[0], hi_[1], hi_[2], hi_[3]}; })
            f32x16 y;
#pragma unroll
            for (int i = 0; i < 16; ++i) y[i] = 0.f;
#pragma unroll
            for (int nb = 0; nb < 2; ++nb)
#pragma unroll
                for (int tt = 0; tt < 2; ++tt) { const LAS unsigned char* ap = cmR + (32 * qb + r) * SROW + (32 * nb + 16 * tt + 4 * hh) * 2;
                    const u32x2 a0 = *(const LAS u32x2*)ap, a1 = *(const LAS u32x2*)(ap + 16);
                    y = MFMA32(__builtin_bit_cast(bf16x8, (u32x4){a0.x, a0.y, a1.x, a1.y}), pack_acc(hacc[nb], tt), y); }
#pragma unroll
            for (int i = 0; i < 16; ++i) y[i] *= eac[32 * qb + (i & 3) + 8 * (i >> 2) + 4 * hh];
            const float aq = acum[32 * qb + r]; const int qg = 32 * qb + r;
            for (int sb = 0; sb <= qb; ++sb) {
                f32x16 cbt;
#pragma unroll
                for (int i = 0; i < 16; ++i) cbt[i] = 0.f;
#pragma unroll
                for (int ks = 0; ks < 4; ++ks) { const bf16x8 A = *(const LAS bf16x8*)(bmR + (32 * sb + r) * SROW + (16 * ks + 8 * hh) * 2), B = *(const LAS bf16x8*)(cmR + (32 * qb + r) * SROW + (16 * ks + 8 * hh) * 2); cbt = MFMA32(A, B, cbt); }
#pragma unroll
                for (int i = 0; i < 16; ++i) { const int sg = 32 * sb + (i & 3) + 8 * (i >> 2) + 4 * hh;
                    float wv = cbt[i] * exp_fast(fminf(aq - acum[sg], 0.f)) * dtv[sg]; wv = sg > qg ? 0.f : wv; wv = sg == qg ? wv + Dh : wv; cbt[i] = wv; }
#pragma unroll
                for (int tt = 0; tt < 2; ++tt) { const bf16x8 B = TRFRAG(xsR, 32 * sb + 16 * tt + 4 * hh, 8, 32 * pb); y = MFMA32(pack_acc(cbt, tt), B, y); }
            }
#pragma unroll
            for (int i = 0; i < 16; ++i) ybuf[(32 * qb + (i & 3) + 8 * (i >> 2) + 4 * hh) * 64 + 32 * pb + r] = y[i];
            const float dec = misc[0];
#pragma unroll
            for (int nb = 0; nb < 2; ++nb) {
#pragma unroll
                for (int i = 0; i < 16; ++i) hacc[nb][i] *= dec;
#pragma unroll
                for (int ks = 0; ks < 4; ++ks) { const bf16x8 A = TRFRAG(bwR, 16 * ks + 8 * hh, 4, 32 * nb), B = TRFRAG(xsR, 16 * ks + 8 * hh, 4, 32 * pb); hacc[nb] = MFMA32(A, B, hacc[nb]); }
            }
#undef TRFRAG
        } else if (wave == 4 && !(skip & 8)) {
            const int nsteps = (L - c * 64) < 64 ? (L - c * 64) : 64;
            for (int s0 = 0; s0 < nsteps; s0 += 8) {
                float av[8], uv[8];
#pragma unroll
                for (int q = 0; q < 8; ++q) { av[q] = aF[(s0 + q) * 64 + lane]; uv[q] = uF[(s0 + q) * 64 + lane]; }
#pragma unroll
                for (int q = 0; q < 8; ++q) { hstate = (s0 + q < nsteps) ? av[q] * hstate + uv[q] : hstate; uF[(s0 + q) * 64 + lane] = hstate; }
            }
        }
        if (!(skip & 256)) __syncthreads();
        if (!(skip & 64)) {
            const f32x4 y0 = *(const LAS f32x4*)(ybuf + t * 64 + cg * 8), y1 = *(const LAS f32x4*)(ybuf + t * 64 + cg * 8 + 4);
            const float o0 = y0[0] * bflo(zs.x), o1 = y0[1] * bfhi(zs.x), o2 = y0[2] * bflo(zs.y), o3 = y0[3] * bfhi(zs.y);
            const float o4 = y1[0] * bflo(zs.z), o5 = y1[1] * bfhi(zs.z), o6 = y1[2] * bflo(zs.w), o7 = y1[3] * bfhi(zs.w);
            float ss = (o0 * o0 + o1 * o1) + (o2 * o2 + o3 * o3) + (o4 * o4 + o5 * o5) + (o6 * o6 + o7 * o7);
            ss = row8_sum(ss);
            const f32x4 h0 = *(const LAS f32x4*)(uF + t * 64 + cg * 8), h1 = *(const LAS f32x4*)(uF + t * 64 + cg * 8 + 4);
            asm volatile("" :: "v"(o0), "v"(o7), "v"(ss), "v"(h0[0]), "v"(h1[3]));
            if (valid && !dry) { *(u32x4*)(Z + (size_t)(tok0 + tg) * DM + chx) = (u32x4){pk2(o0, o1), pk2(o2, o3), pk2(o4, o5), pk2(o6, o7)};
                if (cg == 0) SSQ[(size_t)(tok0 + tg) * 16 + head] = ss;
                *(u32x4*)(LY + (size_t)(tok0 + tg) * DM + ch0) = (u32x4){pk2(h0[0] * bflo(lyv.x), h0[1] * bfhi(lyv.x)), pk2(h0[2] * bflo(lyv.y), h0[3] * bfhi(lyv.y)),
                                                                          pk2(h1[0] * bflo(lyv.z), h1[1] * bfhi(lyv.z)), pk2(h1[2] * bflo(lyv.w), h1[3] * bfhi(lyv.w))}; }
        }
        if (skip & 512) {
#pragma unroll
            for (int k = 0; k < 4; ++k) asm volatile("" :: "v"(rw[k].x), "v"(rw[k].w), "v"(lrw[k].x), "v"(lrw[k].w));
            asm volatile("" :: "v"(bcv.x), "v"(ccv.x), "v"(zs.x), "v"(lyv.x), "v"(dtl)); }
        TAIL_LOAD(c + 1)
    }
#undef RAWROW
#undef SSD_LOAD
#undef LRU_LOAD
#undef TAIL_LOAD
    if (!dry && wave < 4 && qb == 0) {
        float* so = C.out + (smp ? O_SSSD : O_PSSD) + ((size_t)((l * NB + b) * 16 + head) * 64 + 32 * pb + r) * 64;
#pragma unroll
        for (int nb = 0; nb < 2; ++nb)
#pragma unroll
            for (int i4 = 0; i4 < 4; ++i4) *(f32x4*)(so + 32 * nb + 8 * i4 + 4 * hh) = (f32x4){hacc[nb][4 * i4], hacc[nb][4 * i4 + 1], hacc[nb][4 * i4 + 2], hacc[nb][4 * i4 + 3]};
    }
    if (wave == 4 && !dry) C.out[(smp ? O_SLRU : O_PLRU) + (size_t)(l * NB + b) * DM + j * 64 + lane] = hstate;
    __syncthreads();
}

__device__ __forceinline__ void phase_scan(const Ctx& C, int l, bool dry = false) {
    for (int it = C.bid; it < 384; it += C.G) scan_item_fused(C, l, it, dry);
}

__device__ __forceinline__ unsigned mono(float f) { const unsigned u = __float_as_uint(f); return (u & 0x80000000u) ? ~u : (u | 0x80000000u); }
__device__ __forceinline__ float unmono(unsigned k) { const unsigned u = (k & 0x80000000u) ? (k & 0x7fffffffu) : ~k; return __uint_as_float(u); }
template <int CTRL> __device__ __forceinline__ unsigned dpp_u(unsigned v) { return (unsigned)__builtin_amdgcn_update_dpp(0, (int)v, CTRL, 0xf, 0xf, true); }
__device__ __forceinline__ unsigned row_max_u(unsigned m) {
    m = max(m, dpp_u<0xB1>(m)); m = max(m, dpp_u<0x4E>(m)); m = max(m, dpp_u<0x141>(m)); m = max(m, dpp_u<0x140>(m)); return m;
}
__device__ __forceinline__ float row_max_f(float m) {
    m = fmaxf(m, __uint_as_float(dpp_u<0xB1>(__float_as_uint(m)))); m = fmaxf(m, __uint_as_float(dpp_u<0x4E>(__float_as_uint(m))));
    m = fmaxf(m, __uint_as_float(dpp_u<0x141>(__float_as_uint(m)))); m = fmaxf(m, __uint_as_float(dpp_u<0x140>(__float_as_uint(m)))); return m;
}
__device__ __forceinline__ float row_sum_f(float m) {
    m += __uint_as_float(dpp_u<0xB1>(__float_as_uint(m))); m += __uint_as_float(dpp_u<0x4E>(__float_as_uint(m)));
    m += __uint_as_float(dpp_u<0x141>(__float_as_uint(m))); m += __uint_as_float(dpp_u<0x140>(__float_as_uint(m))); return m;
}
#define CE_(a, b) { const unsigned hi_ = max(a, b), lo_ = min(a, b); a = hi_; b = lo_; }
#define KEY8(k, a, b) unsigned k##0 = (mono(a[0]) & ~127u) | (unsigned)(127 - (li * 8 + 0)), k##1 = (mono(a[1]) & ~127u) | (unsigned)(127 - (li * 8 + 1)), k##2 = (mono(a[2]) & ~127u) | (unsigned)(127 - (li * 8 + 2)), \
        k##3 = (mono(a[3]) & ~127u) | (unsigned)(127 - (li * 8 + 3)), k##4 = (mono(b[0]) & ~127u) | (unsigned)(127 - (li * 8 + 4)), k##5 = (mono(b[1]) & ~127u) | (unsigned)(127 - (li * 8 + 5)), \
        k##6 = (mono(b[2]) & ~127u) | (unsigned)(127 - (li * 8 + 6)), k##7 = (mono(b[3]) & ~127u) | (unsigned)(127 - (li * 8 + 7));
#define SORT8(k) CE_(k##0, k##1) CE_(k##2, k##3) CE_(k##4, k##5) CE_(k##6, k##7)  CE_(k##0, k##2) CE_(k##1, k##3) CE_(k##4, k##6) CE_(k##5, k##7)  CE_(k##1, k##2) CE_(k##5, k##6) \
        CE_(k##0, k##4) CE_(k##1, k##5) CE_(k##2, k##6) CE_(k##3, k##7)  CE_(k##2, k##4) CE_(k##3, k##5)  CE_(k##1, k##2) CE_(k##3, k##4) CE_(k##5, k##6)
#define POP8(k, m, c) k##0 = c ? k##1 : k##0; k##1 = c ? k##2 : k##1; k##2 = c ? k##3 : k##2; k##3 = c ? k##4 : k##3; k##4 = c ? k##5 : k##4; k##5 = c ? k##6 : k##5; k##6 = c ? k##7 : k##6; k##7 = c ? 0u : k##7;
__device__ __forceinline__ void top16_row2(const f32x4 a0, const f32x4 b0, const f32x4 a1, const f32x4 b1, int li, unsigned& r0, unsigned& r1) {
    KEY8(x, a0, b0) KEY8(y, a1, b1)
    SORT8(x) SORT8(y)
    unsigned rx = 0u, ry = 0u;
#pragma unroll
    for (int r = 0; r < 16; ++r) {
        const unsigned mx = row_max_u(x0), my = row_max_u(y0); const bool cx = (x0 == mx), cy = (y0 == my);
        POP8(x, mx, cx) POP8(y, my, cy)
        rx = (li == r) ? mx : rx; ry = (li == r) ? my : ry;
    }
    r0 = rx; r1 = ry;
}
#undef KEY8
#undef SORT8
#undef POP8
__device__ __forceinline__ void phase_topk(const Ctx& C) {
    const float* SC = WSP(float, WS_SC); int* EI = WSP(int, WS_EI); float* GW = WSP(float, WS_GW);
    const int lane = C.lane, li = lane & 15, rowi = lane >> 4;
    LAS float* sv = (LAS float*)(C.lds + 4096 + C.wave * 1024);
    LAS int* si = (LAS int*)(sv + 128);
    LAS unsigned char* tab = (LAS unsigned char*)C.lds;
    if (C.tid < 64) { int c = C.tid, i = 0; for (; i < 16; ++i) { const int cnt = 16 / (i + 1); if (c < cnt) break; c -= cnt; } tab[C.tid] = (unsigned char)(C.tid < 50 ? (i | (c << 4)) : 0); }
    __syncthreads();
    int ica[4], jca[4];
#pragma unroll
    for (int q = 0; q < 4; ++q) { const int tb = tab[4 * li + q]; ica[q] = tb & 15; jca[q] = tb >> 4; }
    const int gw = C.bid * NWAVES + C.wave, NGW = C.G * NWAVES;
    f32x4 na0, nb0, na1, nb1;
    { const float* base = SC + (size_t)min(gw, TT * 2 - 1) * 1024;
      na0 = *(const f32x4*)(base + lane * 8); nb0 = *(const f32x4*)(base + lane * 8 + 4); na1 = *(const f32x4*)(base + 512 + lane * 8); nb1 = *(const f32x4*)(base + 512 + lane * 8 + 4); }
    for (int g4 = gw; g4 < TT * 2; g4 += NGW) {
        const int row = g4 >> 1, hd0 = (g4 & 1) * 4;
        const f32x4 a0 = na0, b0 = nb0, a1 = na1, b1 = nb1;
        { const float* base = SC + (size_t)min(g4 + NGW, TT * 2 - 1) * 1024;
          na0 = *(const f32x4*)(base + lane * 8); nb0 = *(const f32x4*)(base + lane * 8 + 4); na1 = *(const f32x4*)(base + 512 + lane * 8); nb1 = *(const f32x4*)(base + 512 + lane * 8 + 4); }
        unsigned r0, r1; top16_row2(a0, b0, a1, b1, li, r0, r1);
        sv[lane] = unmono(r0 & ~127u); si[lane] = 127 - (int)(r0 & 127u); sv[64 + lane] = unmono(r1 & ~127u); si[64 + lane] = 127 - (int)(r1 & 127u);
        LDS_WAIT();
        const LAS float* v1 = sv + rowi * 32; const LAS float* v2 = v1 + 16;
        unsigned k[4];
#pragma unroll
        for (int q = 0; q < 4; ++q) { const int c = 4 * li + q; const float sum = v1[ica[q]] + v2[jca[q]]; k[q] = (c < 50) ? ((mono(sum) & ~63u) | (unsigned)(63 - c)) : 0u; }
        CE_(k[0], k[1]) CE_(k[2], k[3]) CE_(k[0], k[2]) CE_(k[1], k[3]) CE_(k[1], k[2])
        unsigned res = 0u;
#pragma unroll
        for (int r = 0; r < 16; ++r) {
            const unsigned m = row_max_u(k[0]); const bool c = (k[0] == m);
            k[0] = c ? k[1] : k[0]; k[1] = c ? k[2] : k[1]; k[2] = c ? k[3] : k[2]; k[3] = c ? 0u : k[3];
            res = (li == r) ? m : res;
        }
        const int csel = 63 - (int)(res & 63u); const int tb = tab[csel];
        const int e1 = (si + rowi * 32)[tb & 15], e2 = (si + rowi * 32 + 16)[tb >> 4];
        const float svv = unmono(res & ~63u);
        const float mx = row_max_f(svv), ex = __expf(svv - mx), den = row_sum_f(ex);
        const size_t o = (size_t)row * 128 + (hd0 + rowi) * 16 + li;
        EI[o] = e1 * 128 + e2; GW[o] = ex / den;
        LDS_WAIT();
    }
    __syncthreads();
}

template <int CTRL> __device__ __forceinline__ float dpp_f(float v) { return __int_as_float(__builtin_amdgcn_update_dpp(0, __float_as_int(v), CTRL, 0xf, 0xf, true)); }
__device__ __forceinline__ float swap16_f(float v, int lane) { auto r = __builtin_amdgcn_permlane16_swap(__float_as_uint(v), __float_as_uint(v), false, false); return __uint_as_float((lane & 16) ? r[0] : r[1]); }
constexpr int PEER_SLICES = 8;
#define PEER_LOAD_E(E, t_) { const u32x4* ep_ = (const u32x4*)(EI + (size_t)(t_) * 128 + r8 * 16); E[0] = ep_[0]; E[1] = ep_[1]; E[2] = ep_[2]; E[3] = ep_[3]; }
#define PEER_GATHER(U, E, base_, coff_) { _Pragma("unroll") for (int q_ = 0; q_ < 4; ++q_) { U[4 * q_] = *(const u32x4*)((base_) + (E[q_].x * 128u + (coff_))); U[4 * q_ + 1] = *(const u32x4*)((base_) + (E[q_].y * 128u + (coff_))); \
        U[4 * q_ + 2] = *(const u32x4*)((base_) + (E[q_].z * 128u + (coff_))); U[4 * q_ + 3] = *(const u32x4*)((base_) + (E[q_].w * 128u + (coff_))); } }
#define FP8LO(d) __builtin_amdgcn_cvt_pk_f32_fp8((int)(d), false)
#define FP8HI(d) __builtin_amdgcn_cvt_pk_f32_fp8((int)(d), true)
__device__ __forceinline__ void peer_u_reduce(const u32x4 (&U)[16], const u32x4 hq0, const u32x4 hq1, float* po, int c, bool store) {
    f32x2 h[8];
    h[0] = (f32x2){bflo(hq0.x), bfhi(hq0.x)}; h[1] = (f32x2){bflo(hq0.y), bfhi(hq0.y)}; h[2] = (f32x2){bflo(hq0.z), bfhi(hq0.z)}; h[3] = (f32x2){bflo(hq0.w), bfhi(hq0.w)};
    h[4] = (f32x2){bflo(hq1.x), bfhi(hq1.x)}; h[5] = (f32x2){bflo(hq1.y), bfhi(hq1.y)}; h[6] = (f32x2){bflo(hq1.z), bfhi(hq1.z)}; h[7] = (f32x2){bflo(hq1.w), bfhi(hq1.w)};
    float p[16];
#pragma unroll
    for (int i = 0; i < 16; ++i) {
        f32x2 s0 = FP8LO(U[i].x) * h[0], s1 = FP8HI(U[i].x) * h[1];
        s0 = __builtin_elementwise_fma(FP8LO(U[i].y), h[2], s0); s1 = __builtin_elementwise_fma(FP8HI(U[i].y), h[3], s1);
        s0 = __builtin_elementwise_fma(FP8LO(U[i].z), h[4], s0); s1 = __builtin_elementwise_fma(FP8HI(U[i].z), h[5], s1);
        s0 = __builtin_elementwise_fma(FP8LO(U[i].w), h[6], s0); s1 = __builtin_elementwise_fma(FP8HI(U[i].w), h[7], s1);
        s0 = s0 + s1; p[i] = s0.x + s0.y;
    }
#pragma unroll
    for (int bq = 0; bq < 2; ++bq) { float* q = p + 8 * bq;
        { const bool up = (c & 4) != 0;
#pragma unroll
          for (int j = 0; j < 4; ++j) { const float mine = up ? q[j + 4] : q[j], send = up ? q[j] : q[j + 4]; q[j] = mine + dpp_f<0x141>(send); } }
        { const bool up = (c & 2) != 0;
#pragma unroll
          for (int j = 0; j < 2; ++j) { const float mine = up ? q[j + 2] : q[j], send = up ? q[j] : q[j + 2]; q[j] = mine + dpp_f<0x4E>(send); } }
        { const bool up = (c & 1) != 0; const float mine = up ? q[1] : q[0], send = up ? q[0] : q[1]; q[0] = mine + dpp_f<0xB1>(send); } }
    if (store) { po[0] = p[0]; po[8] = p[8]; }
}
__device__ __forceinline__ void phase_peer_u(const Ctx& C) {
    const int lane = C.lane, r8 = lane >> 3, c = lane & 7;
    const bf16_t* H2 = WSP(bf16_t, WS_B0); const unsigned char* U8 = C.ws + WS_U8; const int* EI = WSP(int, WS_EI); float* PA = WSP(float, WS_SC);
    const int s = C.bid & 7, wg = (C.bid >> 3) * NWAVES + C.wave, nwg = (C.G >> 3) * NWAVES;
    const int n = (TT - wg + nwg - 1) / nwg;
    const unsigned char* ub = U8 + (size_t)s * NE * 128; const unsigned coff = (unsigned)c * 16u; const bf16_t* hb = H2 + s * 128 + c * 16;
    float* pab = PA + (size_t)s * 128 + r8 * 16 + c;
#define TOK(i_) (min(wg + (i_) * nwg, TT - 1))
#define LOAD_H(H0, H1, t_) { const u32x4* hp_ = (const u32x4*)(hb + (size_t)(t_) * DM); H0 = hp_[0]; H1 = hp_[1]; }
    u32x4 uA[16], uB[16], en[4], enn[4], hc0, hc1, hn0, hn1, hnn0, hnn1;
    PEER_LOAD_E(en, TOK(0)); LOAD_H(hc0, hc1, TOK(0));
    PEER_GATHER(uA, en, ub, coff);
    PEER_LOAD_E(en, TOK(1)); LOAD_H(hn0, hn1, TOK(1));
    for (int i = 0; i < n; i += 2) {
        PEER_GATHER(uB, en, ub, coff);
        PEER_LOAD_E(enn, TOK(i + 2)); LOAD_H(hnn0, hnn1, TOK(i + 2));
        peer_u_reduce(uA, hc0, hc1, pab + (size_t)TOK(i) * (PEER_SLICES * 128), c, true);
        hc0 = hn0; hc1 = hn1; hn0 = hnn0; hn1 = hnn1;
        PEER_GATHER(uA, enn, ub, coff);
        PEER_LOAD_E(en, TOK(i + 3)); LOAD_H(hnn0, hnn1, TOK(i + 3));
        peer_u_reduce(uB, hc0, hc1, pab + (size_t)TOK(i + 1) * (PEER_SLICES * 128), c, i + 1 < n);
        hc0 = hn0; hc1 = hn1; hn0 = hnn0; hn1 = hnn1;
    }
#undef LOAD_H
#undef TOK
}
__device__ __forceinline__ void phase_peer_act(const Ctx& C) {
    const float* PA = WSP(float, WS_SC); float* GW = WSP(float, WS_GW); const int* EI = WSP(int, WS_EI); const float* SU = WSP(float, WS_SU); const float* SV = WSP(float, WS_SV);
    const size_t n = (size_t)TT * 128, stride = (size_t)C.G * NTHREADS;
    for (size_t i = (size_t)C.bid * NTHREADS + C.tid; i < n; i += stride) {
        const size_t t = i >> 7; const int k = (int)(i & 127); const float* pp = PA + t * (PEER_SLICES * 128) + k;
        float a = 0.f;
#pragma unroll
        for (int s = 0; s < PEER_SLICES; ++s) a += pp[s * 128];
        const int e = EI[i];
        GW[i] = geluf_(a * SU[e]) * GW[i] * SV[e];
    }
}
#define PEER_LOAD_A(A, t_) { const f32x4* ap_ = (const f32x4*)(ACT + (size_t)(t_) * 128 + r8 * 16); A[0] = ap_[0]; A[1] = ap_[1]; A[2] = ap_[2]; A[3] = ap_[3]; }
#define PEER_GATHER8(U, E0, E1, base_, coff_) { U[0] = *(const u32x4*)((base_) + (E0.x * 128u + (coff_))); U[1] = *(const u32x4*)((base_) + (E0.y * 128u + (coff_))); U[2] = *(const u32x4*)((base_) + (E0.z * 128u + (coff_))); U[3] = *(const u32x4*)((base_) + (E0.w * 128u + (coff_))); \
        U[4] = *(const u32x4*)((base_) + (E1.x * 128u + (coff_))); U[5] = *(const u32x4*)((base_) + (E1.y * 128u + (coff_))); U[6] = *(const u32x4*)((base_) + (E1.z * 128u + (coff_))); U[7] = *(const u32x4*)((base_) + (E1.w * 128u + (coff_))); }
__device__ __forceinline__ void peer_v_acc8(f32x2 (&o)[8], const u32x4 (&V)[8], const f32x4 A0, const f32x4 A1) {
#pragma unroll
    for (int i = 0; i < 8; ++i) { const float a = i < 4 ? A0[i & 3] : A1[i & 3]; const f32x2 a2 = (f32x2){a, a};
        o[0] = __builtin_elementwise_fma(FP8LO(V[i].x), a2, o[0]); o[1] = __builtin_elementwise_fma(FP8HI(V[i].x), a2, o[1]);
        o[2] = __builtin_elementwise_fma(FP8LO(V[i].y), a2, o[2]); o[3] = __builtin_elementwise_fma(FP8HI(V[i].y), a2, o[3]);
        o[4] = __builtin_elementwise_fma(FP8LO(V[i].z), a2, o[4]); o[5] = __builtin_elementwise_fma(FP8HI(V[i].z), a2, o[5]);
        o[6] = __builtin_elementwise_fma(FP8LO(V[i].w), a2, o[6]); o[7] = __builtin_elementwise_fma(FP8HI(V[i].w), a2, o[7]); }
}
__device__ __forceinline__ f32x2 peer_v_scatter(const f32x2 (&o2)[8], int lane) {
    float o[16];
#pragma unroll
    for (int j = 0; j < 8; ++j) { o[2 * j] = o2[j].x; o[2 * j + 1] = o2[j].y; }
    { const bool up = (lane & 32) != 0;
#pragma unroll
      for (int j = 0; j < 8; ++j) { const float mine = up ? o[j + 8] : o[j], send = up ? o[j] : o[j + 8]; o[j] = mine + shfx<32>(send, lane); } }
    { const bool up = (lane & 16) != 0;
#pragma unroll
      for (int j = 0; j < 4; ++j) { const float mine = up ? o[j + 4] : o[j], send = up ? o[j] : o[j + 4]; o[j] = mine + swap16_f(send, lane); } }
    { const bool up = (lane & 8) != 0;
#pragma unroll
      for (int j = 0; j < 2; ++j) { const float mine = up ? o[j + 2] : o[j], send = up ? o[j] : o[j + 2]; o[j] = mine + dpp_f<0x128>(send); } }
    return (f32x2){o[0], o[1]};
}
__device__ __forceinline__ void phase_peer_v(const Ctx& C, int l, bool dry = false) {
    const int lane = C.lane, r8 = lane >> 3, c = lane & 7;
    const unsigned char* V8 = C.ws + WS_V8; const int* EI = WSP(int, WS_EI); const float* ACT = WSP(float, WS_GW); const float* MOD = WSP(float, WS_MOD);
    const int s = C.bid & 7, wg = (C.bid >> 3) * NWAVES + C.wave, nwg = (C.G >> 3) * NWAVES;
    const int n = (TT - wg + nwg - 1) / nwg;
    const int jcol = ((lane >> 5) & 1) * 8 + ((lane >> 4) & 1) * 4 + ((lane >> 3) & 1) * 2;
    const int col = s * 128 + c * 16 + jcol;
    const unsigned char* vb = V8 + (size_t)s * NE * 128; const unsigned coff = (unsigned)c * 16u;
    float* xb = C.out + col; const float* g2 = MOD + (size_t)l * NBT * 6144 + 5120 + col;
#define TOK(i_) (min(wg + (i_) * nwg, TT - 1))
    u32x4 vA[8], vB[8], ec[4], en[4]; f32x4 ac[4], an[4];
    PEER_LOAD_E(ec, TOK(0)); PEER_LOAD_A(ac, TOK(0));
    PEER_GATHER8(vA, ec[0], ec[1], vb, coff);
    PEER_LOAD_E(en, TOK(1)); PEER_LOAD_A(an, TOK(1));
    for (int i = 0; i < n; ++i) {
        const int t = TOK(i);
        PEER_GATHER8(vB, ec[2], ec[3], vb, coff);
        const f32x2 xv = *(const f32x2*)(xb + (size_t)t * DM), gv = *(const f32x2*)(g2 + (size_t)row_batch(t) * 6144);
        f32x2 o[8];
#pragma unroll
        for (int j = 0; j < 8; ++j) o[j] = (f32x2){0.f, 0.f};
        peer_v_acc8(o, vA, ac[0], ac[1]);
        PEER_GATHER8(vA, en[0], en[1], vb, coff);
        peer_v_acc8(o, vB, ac[2], ac[3]);
#pragma unroll
        for (int q = 0; q < 4; ++q) { ec[q] = en[q]; ac[q] = an[q]; }
        PEER_LOAD_E(en, TOK(i + 2)); PEER_LOAD_A(an, TOK(i + 2));
        const f32x2 ov = peer_v_scatter(o, lane);
        asm volatile("" :: "v"(ov.x), "v"(ov.y));
        if (!dry) *(f32x2*)(xb + (size_t)t * DM) = xv + gv * ov;
    }
#undef TOK
}
#undef PEER_GATHER8
#undef PEER_LOAD_E
#undef PEER_LOAD_A
#undef PEER_GATHER
__device__ __forceinline__ void phase_final_norm(const Ctx& C) {
    const int gw = C.bid * NWAVES + C.wave, NGW = C.G * NWAVES; const float* fw = as_global(C.P->in[IN_FNW]);
    for (int row = gw; row < TT; row += NGW) {
        f32x4* xr = (f32x4*)(C.out + (size_t)row * DM) + C.lane;
        f32x4 v[4]; float s = 0.f;
#pragma unroll
        for (int j = 0; j < 4; ++j) { v[j] = xr[64 * j]; s += (v[j][0] * v[j][0] + v[j][1] * v[j][1]) + (v[j][2] * v[j][2] + v[j][3] * v[j][3]); }
        const float rstd = rsqrtf(wave_sum(s) * (1.f / DM) + EPS);
#pragma unroll
        for (int j = 0; j < 4; ++j) xr[64 * j] = v[j] * rstd * *(const f32x4*)(fw + C.lane * 4 + 256 * j);
    }
}


#define XB_TMO      128
#define XB_XCNT(j)  (256  + 64 * (j))
#define XB_XSUB(j)  (1280 + 64 * (j))
#define XB_XGEN(j)  (2304 + 64 * (j))
#define XB_TOP      3328
#define XB_TOPGEN   3392
#define XCD_BAR_WORDS 3456
#define XB_SPIN_CAP (1u << 22)
__device__ __forceinline__ unsigned xb_ld(unsigned* p)              { return __hip_atomic_load(p, __ATOMIC_RELAXED, __HIP_MEMORY_SCOPE_AGENT); }
__device__ __forceinline__ unsigned xb_add(unsigned* p, unsigned v) { return __hip_atomic_fetch_add(p, v, __ATOMIC_RELAXED, __HIP_MEMORY_SCOPE_AGENT); }
__device__ __forceinline__ unsigned xb_xcc_id() { return (unsigned)__builtin_amdgcn_s_getreg((3 << 11) | 20) & 0xFu; }
#define XB_SPIN(cond, bar) do { unsigned _sp = 0; while (cond) { __builtin_amdgcn_s_sleep(1); \
    if ((++_sp & 255u) == 0u) { if (xb_ld(&(bar)[XB_TMO])) break; if (_sp > XB_SPIN_CAP) { atomicAdd(&(bar)[XB_TMO], 1u); break; } } } } while (0)
struct XcdBarrier { unsigned* bar; unsigned x; volatile LAS unsigned* st; };
__device__ __forceinline__ XcdBarrier xcd_barrier_post(unsigned* bar, volatile LAS unsigned* st) {
    XcdBarrier b; b.bar = bar; b.x = xb_xcc_id(); b.st = st;
    if (threadIdx.x == 0) (void)xb_add(&bar[XB_XCNT(b.x)], 1u);
    return b;
}
__device__ __forceinline__ void xcd_barrier_complete(unsigned* bar, unsigned x, unsigned& nloc, unsigned& nx) {
    const unsigned G = gridDim.x * gridDim.y * gridDim.z;
    unsigned sum, cnt, mine, sp = 0u;
    for (;;) {
        sum = 0u; cnt = 0u; mine = 0u;
#pragma unroll
        for (unsigned j = 0; j < 16; ++j) { const unsigned c = xb_ld(&bar[XB_XCNT(j)]); sum += c; cnt += (c > 0u) ? 1u : 0u; mine = (j == x) ? c : mine; }
        if (sum == G) break;
        __builtin_amdgcn_s_sleep(1);
        if ((++sp & 255u) == 0u) { if (xb_ld(&bar[XB_TMO])) break; if (sp > XB_SPIN_CAP) { atomicAdd(&bar[XB_TMO], 1u); break; } }
    }
    nloc = mine > 0u ? mine : 1u; nx = cnt > 0u ? cnt : 1u;
}
__device__ __forceinline__ void xcd_barrier(const XcdBarrier& b) {
    asm volatile("s_waitcnt vmcnt(0)" ::: "memory");
    __syncthreads();
    if (threadIdx.x == 0) {
        unsigned* bar = b.bar;
        __builtin_amdgcn_s_waitcnt(0);
        unsigned nloc = b.st[0], nx = b.st[1];
        if (nloc == 0u) { xcd_barrier_complete(bar, b.x, nloc, nx); b.st[0] = nloc; b.st[1] = nx; }
        const unsigned old = xb_add(&bar[XB_XSUB(b.x)], 1u);
        const unsigned gen = old / nloc;
        if (old + 1u == (gen + 1u) * nloc) {
            __builtin_amdgcn_fence(__ATOMIC_RELEASE, "agent");
            asm volatile("s_waitcnt vmcnt(0)" ::: "memory");
            const unsigned og = xb_add(&bar[XB_TOP], 1u);
            const unsigned tg = og / nx;
            if (og + 1u == (tg + 1u) * nx) xb_add(&bar[XB_TOPGEN], 1u);
            else XB_SPIN(xb_ld(&bar[XB_TOPGEN]) == tg, bar);
            __builtin_amdgcn_fence(__ATOMIC_ACQUIRE, "agent");
            xb_add(&bar[XB_XGEN(b.x)], 1u);
            asm volatile("s_waitcnt vmcnt(0)" ::: "memory");
        } else {
            XB_SPIN(xb_ld(&bar[XB_XGEN(b.x)]) == gen, bar);
            __builtin_amdgcn_fence(__ATOMIC_ACQUIRE, "agent");
            asm volatile("s_waitcnt vmcnt(0)" ::: "memory");
        }
    }
    __syncthreads();
}

__device__ __forceinline__ Ctx relaunder(const Ctx& C) {
    Ctx D = C; int t = C.tid; asm volatile("" : "+v"(t)); D.tid = t; D.lane = t & 63;
    unsigned char* w = C.ws; float* o = C.out; asm volatile("" : "+s"(w), "+s"(o)); D.ws = as_global(w); D.out = as_global(o); return D;
}
constexpr int NPL = 13, NPH = 2 + 2 * NPL;
__device__ __forceinline__ void run_phase(const Ctx& C0, int ph, bool dry) {
    if (ph == 0) { const Ctx C = relaunder(C0); phase_prep(C); return; }
    if (ph == NPH - 1) { const Ctx C = relaunder(C0); phase_final_norm(C); return; }
    const int l = (ph - 1) / NPL, k = (ph - 1) % NPL;
    switch (k) {
    case 0: { const Ctx C = relaunder(C0); phase_norm(C, l, 0); } break;
    case 1: { const Ctx C = relaunder(C0); CParams& P = *C.P; Epi1 E{WSP(bf16_t, WS_B1), WSP(bf16_t, WS_B2), WSP(bf16_t, WS_B3), WSP(bf16_t, WS_B4), WSP(float, WS_DT), as_global(P.in[IN_DTB]) + l * 16};
              gemm_run(C, WSP(bf16_t, WS_B0), WSP(bf16_t, WS_W1T) + (size_t)l * N1 * DM, nullptr, nullptr, N1, E); } break;
    case 2: { const Ctx C = relaunder(C0); phase_convbc(C, l); } break;
    case 3: { const Ctx C = relaunder(C0); phase_scan(C, l, dry); } break;
    case 4: { const Ctx C = relaunder(C0); Epi2 E{WSP(bf16_t, WS_GS), WSP(bf16_t, WS_GL)};
              gemm_run(C, WSP(bf16_t, WS_B0), WSP(bf16_t, WS_WGT) + (size_t)l * NG * DM, nullptr, nullptr, NG, E); } break;
    case 5: { const Ctx C = relaunder(C0); Epi3 E{WSP(bf16_t, WS_GS), WSP(bf16_t, WS_GL), WSP(float, WS_SSQ), WSP(bf16_t, WS_B0)};
              gemm_run(C, WSP(bf16_t, WS_B1), WSP(bf16_t, WS_WBS) + (size_t)l * DM * DM, WSP(bf16_t, WS_B4), WSP(bf16_t, WS_WBL) + (size_t)l * DM * DM, DM, E); } break;
    case 6: { const Ctx C = relaunder(C0); CParams& P = *C.P; Epi4 E{as_global(P.in[IN_XP]), as_global(P.in[IN_XS]), C.out, WSP(float, WS_MOD) + (size_t)l * NBT * 6144, l};
              gemm_run(C, WSP(bf16_t, WS_B0), WSP(bf16_t, WS_WO) + (size_t)l * DM * DM, nullptr, nullptr, DM, E); } break;
    case 7: { const Ctx C = relaunder(C0); phase_norm(C, l, 1); } break;
    case 8: { const Ctx C = relaunder(C0); Epi5 E{WSP(float, WS_SC)};
              gemm_run(C, WSP(bf16_t, WS_B0), WSP(bf16_t, WS_WC) + (size_t)l * 2048 * DM, nullptr, nullptr, 2048, E); } break;
    case 9: { const Ctx C = relaunder(C0); phase_topk(C); } break;
    case 10: { const Ctx C = relaunder(C0); phase_peer_u(C); } break;
    case 11: { const Ctx C = relaunder(C0); phase_peer_act(C); } break;
    case 12: { const Ctx C = relaunder(C0); phase_peer_v(C, l, dry); } break;
    }
}

__global__ void __launch_bounds__(NTHREADS, 2) fwd(Params P) {
    extern __shared__ __attribute__((aligned(16))) unsigned char lds_raw[];
    const int ph_lo = P.ph_lo, ph_hi = P.ph_hi;
    volatile LAS unsigned* bst = (volatile LAS unsigned*)((LAS unsigned char*)lds_raw + LDS_BYTES - 64);
    if (threadIdx.x == 0) { bst[0] = 0u; bst[1] = 0u; }
    __syncthreads();
    (void)xcd_barrier_post((unsigned*)(P.ws + WS_CTL), bst);
    for (int ph = ph_lo; ph < ph_hi; ++ph) {
        CParams* Pp = (CParams*)__builtin_amdgcn_kernarg_segment_ptr(); asm volatile("" : "+s"(Pp));
        Ctx C; C.P = Pp; C.lds = (LAS unsigned char*)lds_raw;
        int tid = threadIdx.x; asm volatile("" : "+v"(tid));
        unsigned char* ws = Pp->ws; float* out = Pp->out; asm volatile("" : "+s"(ws), "+s"(out));
        C.ws = ws; C.out = out;
        C.tid = tid; C.lane = tid & 63; C.wave = __builtin_amdgcn_readfirstlane(tid >> 6); C.bid = blockIdx.x; C.G = gridDim.x;
#ifdef PROBE_K
        { const bool hit = (PROBE_K == 100) ? ph == 0 : ((PROBE_K == 101) ? ph == NPH - 1 : (ph > 0 && ph < NPH - 1 && (ph - 1) % NPL == PROBE_K));
          if (hit) for (int rep = 0; rep < PROBE_N; ++rep) { run_phase(C, ph, true); __syncthreads(); } }
#endif
        run_phase(C, ph, false);
        if (ph + 1 < ph_hi) { if (ph == 0) cg::this_grid().sync();
            else { XcdBarrier xb; xb.bar = (unsigned*)(ws + WS_CTL); xb.x = xb_xcc_id(); xb.st = (volatile LAS unsigned*)((LAS unsigned char*)lds_raw + LDS_BYTES - 64); xcd_barrier(xb); } }
    }
}

extern "C" void kernel_launch(void* const* d_in, const int* in_sizes, int n_in, void* d_out, int out_size, void* d_ws, size_t ws_size, hipStream_t stream) {
    static int grid = 0;
    if (grid == 0) {
        if (n_in != N_IN || (size_t)out_size != O_END || ws_size < WS_END) { fprintf(stderr, "kernel_launch: unexpected shapes n_in %d out %d ws %zu (need %zu)\n", n_in, out_size, ws_size, (size_t)WS_END); grid = -1; return; }
        int dev = 0, cus = 0, per_cu = 0;
        hipGetDevice(&dev); hipDeviceGetAttribute(&cus, hipDeviceAttributeMultiprocessorCount, dev);
        hipFuncSetAttribute((const void*)fwd, hipFuncAttributeMaxDynamicSharedMemorySize, LDS_BYTES);
        hipOccupancyMaxActiveBlocksPerMultiprocessor(&per_cu, (const void*)fwd, NTHREADS, LDS_BYTES);
        if (per_cu < 1) { fprintf(stderr, "kernel_launch: occupancy query says %d blocks/CU\n", per_cu); per_cu = 1; }
        grid = cus;
        fprintf(stderr, "kernel_launch: cus %d per_cu %d grid %d ws %zu\n", cus, per_cu, grid, ws_size);
    }
    if (grid < 0) return;
    Params p{};
    for (int i = 0; i < N_IN; ++i) p.in[i] = (const float*)d_in[i];
    p.out = (float*)d_out; p.ws = (unsigned char*)d_ws;
    hipMemsetAsync((char*)d_ws + WS_CTL, 0, 65536, stream);
#if MEGA
    p.ph_lo = 0; p.ph_hi = NPH;
    void* args[] = {&p};
    hipError_t e = hipLaunchCooperativeKernel((const void*)fwd, dim3(grid), dim3(NTHREADS), args, LDS_BYTES, stream);
    if (e != hipSuccess) fprintf(stderr, "cooperative launch failed: %s\n", hipGetErrorString(e));
#else
    for (int ph = 0; ph < NPH; ++ph) { p.ph_lo = ph; p.ph_hi = ph + 1; hipLaunchKernelGGL(fwd, dim3(grid), dim3(NTHREADS), LDS_BYTES, stream, p); }
#endif
}
```

```cpp
#include <hip/hip_runtime.h>
#include <hip/hip_cooperative_groups.h>
#include <cstdio>
#include <cstdint>
namespace cg = cooperative_groups;

#ifndef MEGA
#define MEGA 1
#endif

#define LAS __attribute__((address_space(3)))
typedef unsigned short bf16_t;
typedef __bf16 bf16x2_t __attribute__((ext_vector_type(2)));
typedef short bf16x8 __attribute__((ext_vector_type(8)));
typedef float f32x4 __attribute__((ext_vector_type(4)));
typedef float f32x16 __attribute__((ext_vector_type(16)));
typedef unsigned u32x4 __attribute__((ext_vector_type(4)));
typedef unsigned u32x2 __attribute__((ext_vector_type(2)));

constexpr int DM = 1024;
constexpr int TP = 32768, TS = 128, TT = TP + TS, MT = 33024;
constexpr int NBT = 24;
constexpr int N1 = 4608;
constexpr int NG = 2048;
constexpr int NE = 16384;
constexpr int INC = 6416;
constexpr float EPS = 1e-6f;
constexpr int NWAVES = 8, NTHREADS = 512;
constexpr int LDS_BYTES = 150528;

enum { IN_XP = 0, IN_XS, IN_CP, IN_CS, IN_SSD, IN_SSDCONV, IN_LRU, IN_LRUCONV, IN_LN1, IN_LN2, IN_WMOD, IN_BMOD, IN_WIN, IN_SCW, IN_SCB, IN_DTB,
       IN_ALOG, IN_SSDD, IN_SNW, IN_LCW, IN_LCB, IN_WA, IN_BA, IN_WX, IN_BX, IN_LAM, IN_WBS, IN_WBL, IN_WO, IN_WQ, IN_K1, IN_K2, IN_U, IN_V, IN_FNW, N_IN };

constexpr size_t O_Y = 0, O_PSSD = 33685504, O_PSCONV = 35782656, O_PLRU = 35905536, O_PLCONV = 35938304,
                 O_SSSD = 36036608, O_SSCONV = 37085184, O_SLRU = 37146624, O_SLCONV = 37163008, O_END = 37212160;

constexpr size_t al256(size_t x) { return (x + 255) & ~(size_t)255; }
constexpr size_t WS_CTL = 0;
constexpr size_t WS_MOD = 1u << 20;
constexpr size_t WS_DT = al256(WS_MOD + (size_t)2 * NBT * 6144 * 4);
constexpr size_t WS_SSQ = al256(WS_DT + (size_t)MT * 16 * 4);
constexpr size_t WS_W1T = al256(WS_SSQ + (size_t)MT * 16 * 4);
constexpr size_t WS_WGT = al256(WS_W1T + (size_t)2 * N1 * DM * 2);
constexpr size_t WS_WBS = al256(WS_WGT + (size_t)2 * NG * DM * 2);
constexpr size_t WS_WBL = al256(WS_WBS + (size_t)2 * DM * DM * 2);
constexpr size_t WS_WO = al256(WS_WBL + (size_t)2 * DM * DM * 2);
constexpr size_t WS_WC = al256(WS_WO + (size_t)2 * DM * DM * 2);
constexpr size_t WS_U16 = al256(WS_WC + (size_t)2 * 2048 * DM * 2);
constexpr size_t WS_V16 = al256(WS_U16 + (size_t)NE * DM * 2);
constexpr size_t WS_EI = al256(WS_V16 + (size_t)NE * DM * 2);
constexpr size_t WS_GW = al256(WS_EI + (size_t)MT * 128 * 4);
constexpr size_t WS_B0 = al256(WS_GW + (size_t)MT * 128 * 4);
constexpr size_t WS_B1 = al256(WS_B0 + (size_t)MT * DM * 2);
constexpr size_t WS_B2 = al256(WS_B1 + (size_t)MT * DM * 2);
constexpr size_t WS_B3 = al256(WS_B2 + (size_t)MT * 1280 * 2);
constexpr size_t WS_B4 = al256(WS_B3 + (size_t)MT * DM * 2);
constexpr size_t WS_END = al256(WS_B4 + (size_t)MT * DM * 2);
constexpr size_t WS_GS = WS_B2, WS_GL = WS_B2 + (size_t)MT * DM * 2;
constexpr size_t WS_SC = WS_B1;
static_assert(WS_GL + (size_t)MT * DM * 2 <= WS_B4, "gate overlay");
static_assert(WS_SC + (size_t)MT * 2048 * 4 <= WS_END, "score overlay");
static_assert(WS_END <= (size_t)512 << 20, "d_ws budget");

struct Params {
    const float* in[N_IN];
    float* out;
    unsigned char* ws;
    int ph_lo, ph_hi;
};

__device__ __forceinline__ unsigned f2bf(float f) { return (unsigned)__builtin_bit_cast(unsigned short, (__bf16)f); }
__device__ __forceinline__ float bf2f(unsigned b) { return __uint_as_float(b << 16); }
__device__ __forceinline__ unsigned pk2(float lo, float hi) { typedef float f32x2_ __attribute__((ext_vector_type(2))); return __builtin_bit_cast(unsigned, __builtin_convertvector((f32x2_){lo, hi}, bf16x2_t)); }
__device__ __forceinline__ float bflo(unsigned w) { return __uint_as_float(w << 16); }
__device__ __forceinline__ float bfhi(unsigned w) { return __uint_as_float(w & 0xffff0000u); }
template <int M> __device__ __forceinline__ int shfx_i(int v, int lane) {
    if constexpr (M == 32) { auto r = __builtin_amdgcn_permlane32_swap((unsigned)v, (unsigned)v, false, false); return (int)((lane & 32) ? r[0] : r[1]); }
    else return __builtin_amdgcn_ds_swizzle(v, 0x1f | (M << 10));
}
template <int M> __device__ __forceinline__ float shfx(float v, int lane) { return __int_as_float(shfx_i<M>(__float_as_int(v), lane)); }
__device__ __forceinline__ float shfl_f(float v, int src) { return __int_as_float(__builtin_amdgcn_ds_bpermute(src << 2, __float_as_int(v))); }
__device__ __forceinline__ int shfl_i(int v, int src) { return __builtin_amdgcn_ds_bpermute(src << 2, v); }
template <int CTRL> __device__ __forceinline__ float dppf_(float v) { return __int_as_float(__builtin_amdgcn_update_dpp(0, __float_as_int(v), CTRL, 0xf, 0xf, true)); }
__device__ __forceinline__ float row8_sum(float v) { v += dppf_<0xB1>(v); v += dppf_<0x4E>(v); v += dppf_<0x141>(v); return v; }
__device__ __forceinline__ float wave_sum(float v) {
    v += dppf_<0xB1>(v); v += dppf_<0x4E>(v); v += dppf_<0x141>(v); v += dppf_<0x140>(v);
    { auto r = __builtin_amdgcn_permlane16_swap(__float_as_uint(v), __float_as_uint(v), false, false); v = __uint_as_float(r[0]) + __uint_as_float(r[1]); }
    { auto r = __builtin_amdgcn_permlane32_swap(__float_as_uint(v), __float_as_uint(v), false, false); v = __uint_as_float(r[0]) + __uint_as_float(r[1]); }
    return v;
}
__device__ __forceinline__ float exp_fast(float x) { return __builtin_amdgcn_exp2f(x * 1.4426950408889634f); }
__device__ __forceinline__ float sigmoidf_(float x) { return __builtin_amdgcn_rcpf(1.0f + exp_fast(-x)); }
__device__ __forceinline__ float siluf_(float x) { return x * __builtin_amdgcn_rcpf(1.0f + exp_fast(-x)); }
__device__ __forceinline__ float geluf_(float x) { const float u = 1.5957691216057308f * (x + 0.044715f * x * x * x); return x * __builtin_amdgcn_rcpf(1.0f + exp_fast(-u)); }
__device__ __forceinline__ float softplusf_(float x) { return fmaxf(x, 0.f) + log1pf(__expf(-fabsf(x))); }
__device__ __forceinline__ int row_batch(int row) { return row < TP ? (row >> 11) : (row < TT ? 16 + ((row - TP) >> 4) : 23); }
__device__ __forceinline__ float dot2bf(unsigned a, unsigned b, float acc) { return __builtin_amdgcn_fdot2_f32_bf16(__builtin_bit_cast(bf16x2_t, a), __builtin_bit_cast(bf16x2_t, b), acc, false); }
__device__ __forceinline__ float rl(float v, int lane) { return __int_as_float(__builtin_amdgcn_readlane(__float_as_int(v), lane)); }
#define LDS_WAIT() asm volatile("s_waitcnt lgkmcnt(0)" ::: "memory")
#define MFMA32(a, b, c) __builtin_amdgcn_mfma_f32_32x32x16_bf16((a), (b), (c), 0, 0, 0)

typedef const __attribute__((address_space(4))) Params CParams;
template <class T> __device__ __forceinline__ T* as_global(T* p) { __attribute__((address_space(1))) T* g = (__attribute__((address_space(1))) T*)p; asm volatile("" : "+s"(g)); return (T*)g; }
struct Ctx {
    CParams* P; LAS unsigned char* lds; unsigned char* ws; float* out;
    int tid, lane, wave, bid, G;
};
#define WSP(T, off) (as_global((T*)(C.ws + (off))))

__device__ __forceinline__ void tr_item(const float* W, int ldw, int src_col0, int valid, const float* kscale, int k0, bf16_t* dst, LAS float* scr, int lane) {
    const int c4 = lane & 7, r0 = lane >> 3;
    f32x4 v[8];
#pragma unroll
    for (int i = 0; i < 8; ++i) { const int kk = r0 + 8 * i; v[i] = (4 * c4 < valid) ? *(const f32x4*)(W + (size_t)(k0 + kk) * ldw + src_col0 + 4 * c4) : (f32x4){0.f, 0.f, 0.f, 0.f}; }
#pragma unroll
    for (int i = 0; i < 8; ++i) { const int kk = r0 + 8 * i; const float ks = kscale ? kscale[k0 + kk] : 1.0f; LAS float* s = scr + kk * 33 + 4 * c4;
        s[0] = v[i][0] * ks; s[1] = v[i][1] * ks; s[2] = v[i][2] * ks; s[3] = v[i][3] * ks; }
    LDS_WAIT();
    const int c8 = lane & 7;
#pragma unroll
    for (int j = 0; j < 4; ++j) { const int n = (lane >> 3) + 8 * j; const LAS float* s = scr + (8 * c8) * 33 + n;
        u32x4 o; o.x = pk2(s[0 * 33], s[1 * 33]); o.y = pk2(s[2 * 33], s[3 * 33]); o.z = pk2(s[4 * 33], s[5 * 33]); o.w = pk2(s[6 * 33], s[7 * 33]);
        *(u32x4*)(dst + (size_t)n * DM + k0 + 8 * c8) = o; }
    LDS_WAIT();
}
typedef float f32x2 __attribute__((ext_vector_type(2)));
typedef short s16x4_ __attribute__((ext_vector_type(4)));
constexpr size_t WS_U8 = WS_U16, WS_SU = WS_U16 + ((size_t)16 << 20), WS_V8 = WS_V16, WS_SV = WS_V16 + ((size_t)16 << 20);
__device__ __forceinline__ float wave_max(float v) {
    v = fmaxf(v, shfx<1>(v, 0)); v = fmaxf(v, shfx<2>(v, 0)); v = fmaxf(v, shfx<4>(v, 0)); v = fmaxf(v, shfx<8>(v, 0)); v = fmaxf(v, shfx<16>(v, 0));
    auto r = __builtin_amdgcn_permlane32_swap(__float_as_uint(v), __float_as_uint(v), false, false);
    return fmaxf(__uint_as_float(r[0]), __uint_as_float(r[1]));
}
__device__ __forceinline__ void convert_tables(const Ctx& C, int l) {
    const int gw = C.bid * NWAVES + C.wave, NGW = C.G * NWAVES, lane = C.lane;
    const float* up = as_global(C.P->in[IN_U]) + (size_t)l * NE * DM; const float* vp = as_global(C.P->in[IN_V]) + (size_t)l * NE * DM;
#define TROW(it_) (((it_) >= NE ? vp + (size_t)((it_) - NE) * DM : up + (size_t)(it_) * DM) + lane * 4)
    f32x4 nv[4];
    { const float* s0 = TROW(min(gw, 2 * NE - 1));
#pragma unroll
      for (int j = 0; j < 4; ++j) nv[j] = *(const f32x4*)(s0 + 256 * j); }
    for (int it = gw; it < 2 * NE; it += NGW) {
        const bool isv = it >= NE; const int e = isv ? it - NE : it;
        unsigned char* dst = C.ws + (isv ? WS_V8 : WS_U8); float* sc = (float*)(C.ws + (isv ? WS_SV : WS_SU));
        f32x4 v[4]; float m = 0.f;
#pragma unroll
        for (int j = 0; j < 4; ++j) { v[j] = nv[j]; m = fmaxf(m, fmaxf(fmaxf(fabsf(v[j][0]), fabsf(v[j][1])), fmaxf(fabsf(v[j][2]), fabsf(v[j][3])))); }
        { const float* s0 = TROW(min(it + NGW, 2 * NE - 1));
#pragma unroll
          for (int j = 0; j < 4; ++j) nv[j] = *(const f32x4*)(s0 + 256 * j); }
        m = wave_max(m);
        const float scale = m > 0.f ? m * (1.0f / 440.0f) : 1.0f, inv = 1.0f / scale;
        if (lane == 0) sc[e] = scale;
#pragma unroll
        for (int j = 0; j < 4; ++j) { int w = __builtin_amdgcn_cvt_pk_fp8_f32(v[j][0] * inv, v[j][1] * inv, 0, false); w = __builtin_amdgcn_cvt_pk_fp8_f32(v[j][2] * inv, v[j][3] * inv, w, true);
            const int slice = 2 * j + (lane >> 5);
            *(int*)(dst + ((size_t)slice * NE + e) * 128 + (lane & 31) * 4) = w; }
    }
#undef TROW
}
__device__ __forceinline__ void phase_prep(const Ctx& C) {
    CParams& P = *C.P;
    {
        LAS float* Kh = (LAS float*)C.lds;
        LAS float* Wq = (LAS float*)(C.lds + 128 * 132 * 4);
        bf16_t* WcT = WSP(bf16_t, WS_WC);
        for (int it = C.bid; it < 512; it += C.G) {
            const int l = it >> 8, h = (it >> 5) & 7, half = (it >> 4) & 1, jb = it & 15;
            const float* ksrc = as_global(P.in[half ? IN_K2 : IN_K1]) + (size_t)l * 128 * 128;
            const float* wsrc = as_global(P.in[IN_WQ]) + (size_t)l * DM * 2048 + (size_t)(jb * 64) * 2048 + h * 256 + half * 128;
            __syncthreads();
            for (int i = C.tid; i < 128 * 32; i += NTHREADS) { const int r = i >> 5, c4 = i & 31; *(LAS f32x4*)(Kh + r * 132 + c4 * 4) = *(const f32x4*)(ksrc + r * 128 + c4 * 4); }
            for (int i = C.tid; i < 64 * 32; i += NTHREADS) { const int r = i >> 5, c4 = i & 31; *(LAS f32x4*)(Wq + r * 132 + c4 * 4) = *(const f32x4*)(wsrc + (size_t)r * 2048 + c4 * 4); }
            __syncthreads();
            const int tk = C.tid & 31, tj = C.tid >> 5;
            float acc[4][4];
#pragma unroll
            for (int a = 0; a < 4; ++a)
#pragma unroll
                for (int b = 0; b < 4; ++b) acc[a][b] = 0.f;
            for (int d4 = 0; d4 < 32; ++d4) {
                f32x4 kv[4], wv[4];
#pragma unroll
                for (int a = 0; a < 4; ++a) { kv[a] = *(LAS f32x4*)(Kh + (tk + 32 * a) * 132 + d4 * 4); wv[a] = *(LAS f32x4*)(Wq + (4 * tj + a) * 132 + d4 * 4); }
#pragma unroll
                for (int a = 0; a < 4; ++a)
#pragma unroll
                    for (int b = 0; b < 4; ++b) acc[a][b] += kv[a][0] * wv[b][0] + kv[a][1] * wv[b][1] + kv[a][2] * wv[b][2] + kv[a][3] * wv[b][3];
            }
#pragma unroll
            for (int a = 0; a < 4; ++a) { const int n = h * 256 + half * 128 + tk + 32 * a;
                u32x2 o; o.x = pk2(acc[a][0], acc[a][1]); o.y = pk2(acc[a][2], acc[a][3]);
                *(u32x2*)(WcT + ((size_t)l * 2048 + n) * DM + jb * 64 + 4 * tj) = o; }
        }
        __syncthreads();
    }
    {
        LAS float* sc = (LAS float*)C.lds;
        LAS float* red = (LAS float*)(C.lds + 98304);
        for (int i = C.tid; i < NBT * DM; i += NTHREADS) { const int bb = i >> 10, k = i & 1023;
            const float cv = bb < 16 ? as_global(P.in[IN_CP])[bb * DM + k] : as_global(P.in[IN_CS])[(bb - 16) * DM + k]; sc[i] = siluf_(cv); }
        __syncthreads();
        float* MOD = WSP(float, WS_MOD);
        for (int it = C.bid; it < 192; it += C.G) {
            const int l = it / 96, cg_ = it % 96, j = cg_ * 64 + C.lane;
            const float* wm = as_global(P.in[IN_WMOD]) + (size_t)l * DM * 6144 + j;
            float acc[NBT];
#pragma unroll
            for (int bb = 0; bb < NBT; ++bb) acc[bb] = 0.f;
            const int k0 = C.wave * 128;
#pragma unroll 16
            for (int k = 0; k < 128; ++k) { const float w = wm[(size_t)(k0 + k) * 6144];
#pragma unroll
                for (int bb = 0; bb < NBT; ++bb) acc[bb] += sc[bb * DM + k0 + k] * w; }
#pragma unroll
            for (int bb = 0; bb < NBT; ++bb) red[(C.wave * NBT + bb) * 64 + C.lane] = acc[bb];
            __syncthreads();
            const float bm = as_global(P.in[IN_BMOD])[l * 6144 + j];
#pragma unroll
            for (int q = 0; q < 3; ++q) { const int bb = 3 * C.wave + q; float a = bm;
#pragma unroll
                for (int w8 = 0; w8 < 8; ++w8) a += red[(w8 * NBT + bb) * 64 + C.lane];
                MOD[((size_t)l * NBT + bb) * 6144 + j] = a; }
            __syncthreads();
        }
        __syncthreads();
    }
    {
        LAS float* scr = (LAS float*)(C.lds + C.wave * 16384);
        const int gw = C.bid * NWAVES + C.wave, NGW = C.G * NWAVES;
        constexpr int I_W1 = 144 * 16, I_WG = 64 * 16, I_SQ = 32 * 16, PER_L = I_W1 + I_WG + 3 * I_SQ;
        for (int it = gw; it < 2 * PER_L; it += NGW) {
            const int l = it / PER_L; int r = it % PER_L;
            if (r < I_W1) { const int nb = r >> 4, kb = r & 15, n0 = nb * 32; int src, valid;
                if (n0 < 2304) { src = n0; valid = 32; } else if (n0 < 4352) { src = n0 + 16; valid = 32; } else if (n0 == 4352) { src = 2304; valid = 16; } else { src = 0; valid = 0; }
                tr_item(as_global(P.in[IN_WIN]) + (size_t)l * DM * INC, INC, src, valid, nullptr, kb * 64, WSP(bf16_t, WS_W1T) + ((size_t)l * N1 + n0) * DM, scr, C.lane); continue; }
            r -= I_W1;
            if (r < I_WG) { const int nb = r >> 4, kb = r & 15, n0 = nb * 32;
                tr_item(as_global(P.in[IN_WIN]) + (size_t)l * DM * INC, INC, 4368 + n0, 32, nullptr, kb * 64, WSP(bf16_t, WS_WGT) + ((size_t)l * NG + n0) * DM, scr, C.lane); continue; }
            r -= I_WG;
            const int which = r / I_SQ; r %= I_SQ; const int nb = r >> 4, kb = r & 15, n0 = nb * 32;
            const float* src = as_global(P.in[which == 0 ? IN_WBS : (which == 1 ? IN_WBL : IN_WO)]) + (size_t)l * DM * DM;
            bf16_t* dst = WSP(bf16_t, which == 0 ? WS_WBS : (which == 1 ? WS_WBL : WS_WO)) + ((size_t)l * DM + n0) * DM;
            tr_item(src, DM, n0, 32, which == 0 ? as_global(P.in[IN_SNW]) + l * DM : nullptr, kb * 64, dst, scr, C.lane);
        }
    }
    convert_tables(C, 0);
}

__device__ __forceinline__ void phase_norm(const Ctx& C, int l, int which) {
    CParams& P = *C.P;
    const int gw = C.bid * NWAVES + C.wave, NGW = C.G * NWAVES;
    bf16_t* H = WSP(bf16_t, WS_B0);
    const float* lw = as_global(P.in[which ? IN_LN2 : IN_LN1]) + l * DM;
    const float* MOD = WSP(float, WS_MOD);
    const float* xpp = as_global(P.in[IN_XP]); const float* xsp = as_global(P.in[IN_XS]);
#define NORM_SRC(row_) ((which == 0 && l == 0) ? ((row_) < TP ? xpp + (size_t)(row_) * DM : xsp + (size_t)((row_) - TP) * DM) : C.out + (size_t)(row_) * DM)
    f32x4 nv[4];
    { const f32x4* xr = (const f32x4*)NORM_SRC(min(gw, TT - 1)) + C.lane;
#pragma unroll
      for (int j = 0; j < 4; ++j) nv[j] = xr[64 * j]; }
    for (int row = gw; row < TT; row += NGW) {
        u32x2* o8 = (u32x2*)(H + (size_t)row * DM) + C.lane;
        f32x4 v[4]; float s = 0.f;
#pragma unroll
        for (int j = 0; j < 4; ++j) { v[j] = nv[j]; s += (v[j][0] * v[j][0] + v[j][1] * v[j][1]) + (v[j][2] * v[j][2] + v[j][3] * v[j][3]); }
        { const f32x4* xr = (const f32x4*)NORM_SRC(min(row + NGW, TT - 1)) + C.lane;
#pragma unroll
          for (int j = 0; j < 4; ++j) nv[j] = xr[64 * j]; }
        const float rstd = rsqrtf(wave_sum(s) * (1.f / DM) + EPS);
        const float* md = MOD + ((size_t)l * NBT + row_batch(row)) * 6144 + (which ? 3072 : 0);
#pragma unroll
        for (int j = 0; j < 4; ++j) { const int col = C.lane * 4 + 256 * j;
            const f32x4 w = *(const f32x4*)(lw + col), sh = *(const f32x4*)(md + col), scv = *(const f32x4*)(md + 1024 + col);
            const f32x4 y = (v[j] * rstd * w) * (scv + 1.0f) + sh;
            o8[64 * j] = (u32x2){pk2(y[0], y[1]), pk2(y[2], y[3])}; }
    }
#undef NORM_SRC
    if (which == 0 && l == 1) convert_tables(C, 1);
}

struct Epi1 {
    __device__ __forceinline__ bool idem() const { return true; }
    static constexpr int NK = 5; static constexpr bool PERM = true;
    bf16_t *Z, *XBC, *LX, *LY; float* DT; const float* dtb;
    __device__ __forceinline__ int kind(int pn) const { return pn < 4 ? 0 : (pn < 9 ? 1 : (pn < 13 ? 2 : (pn < 17 ? 3 : 4))); }
    template <int KD> __device__ __forceinline__ void apply(int, int row, int col, f32x4 v) const {
        if constexpr (KD == 0) { *(u32x2*)(Z + (size_t)row * DM + col) = (u32x2){pk2(siluf_(v[0]), siluf_(v[1])), pk2(siluf_(v[2]), siluf_(v[3]))}; }
        else if constexpr (KD == 1) { *(u32x2*)(XBC + (size_t)row * 1280 + (col - 1024)) = (u32x2){pk2(v[0], v[1]), pk2(v[2], v[3])}; }
        else if constexpr (KD == 2) { *(u32x2*)(LX + (size_t)row * DM + (col - 2304)) = (u32x2){pk2(v[0], v[1]), pk2(v[2], v[3])}; }
        else if constexpr (KD == 3) { *(u32x2*)(LY + (size_t)row * DM + (col - 3328)) = (u32x2){pk2(geluf_(v[0]), geluf_(v[1])), pk2(geluf_(v[2]), geluf_(v[3]))}; }
        else { if (col < 4368) { const int c = col - 4352; const f32x4 b = *(const f32x4*)(dtb + c);
            *(f32x4*)(DT + (size_t)row * 16 + c) = (f32x4){softplusf_(v[0] + b[0]), softplusf_(v[1] + b[1]), softplusf_(v[2] + b[2]), softplusf_(v[3] + b[3])}; } }
    }
    template <int KD> __device__ __forceinline__ void apply8(int w, int row, int col, f32x4 a, f32x4 b) const {
        if constexpr (KD == 0) { *(u32x4*)(Z + (size_t)row * DM + col) = (u32x4){pk2(siluf_(a[0]), siluf_(a[1])), pk2(siluf_(a[2]), siluf_(a[3])), pk2(siluf_(b[0]), siluf_(b[1])), pk2(siluf_(b[2]), siluf_(b[3]))}; }
        else if constexpr (KD == 1) { *(u32x4*)(XBC + (size_t)row * 1280 + (col - 1024)) = (u32x4){pk2(a[0], a[1]), pk2(a[2], a[3]), pk2(b[0], b[1]), pk2(b[2], b[3])}; }
        else if constexpr (KD == 2) { *(u32x4*)(LX + (size_t)row * DM + (col - 2304)) = (u32x4){pk2(a[0], a[1]), pk2(a[2], a[3]), pk2(b[0], b[1]), pk2(b[2], b[3])}; }
        else if constexpr (KD == 3) { *(u32x4*)(LY + (size_t)row * DM + (col - 3328)) = (u32x4){pk2(geluf_(a[0]), geluf_(a[1])), pk2(geluf_(a[2]), geluf_(a[3])), pk2(geluf_(b[0]), geluf_(b[1])), pk2(geluf_(b[2]), geluf_(b[3]))}; }
        else { apply<KD>(w, row, col, a); apply<KD>(w, row, col + 4, b); }
    }
};
struct Epi2 {
    __device__ __forceinline__ bool idem() const { return true; }
    static constexpr int NK = 2; static constexpr bool PERM = true;
    bf16_t *GS, *GL;
    __device__ __forceinline__ int kind(int pn) const { return pn < 4 ? 0 : 1; }
    template <int KD> __device__ __forceinline__ void apply(int, int row, int col, f32x4 v) const {
        bf16_t* d = (KD == 0 ? GS + (size_t)row * DM + col : GL + (size_t)row * DM + (col - 1024));
        *(u32x2*)d = (u32x2){pk2(sigmoidf_(v[0]), sigmoidf_(v[1])), pk2(sigmoidf_(v[2]), sigmoidf_(v[3]))};
    }
    template <int KD> __device__ __forceinline__ void apply8(int, int row, int col, f32x4 a, f32x4 b) const {
        bf16_t* d = (KD == 0 ? GS + (size_t)row * DM + col : GL + (size_t)row * DM + (col - 1024));
        *(u32x4*)d = (u32x4){pk2(sigmoidf_(a[0]), sigmoidf_(a[1])), pk2(sigmoidf_(a[2]), sigmoidf_(a[3])), pk2(sigmoidf_(b[0]), sigmoidf_(b[1])), pk2(sigmoidf_(b[2]), sigmoidf_(b[3]))};
    }
};
struct Epi3 {
    __device__ __forceinline__ bool idem() const { return true; }
    static constexpr int NK = 1; static constexpr bool PERM = true;
    const bf16_t *GS, *GL; const float* SSQ; bf16_t* MG;
    __device__ __forceinline__ int kind(int) const { return 0; }
    __device__ __forceinline__ float rstd_of(int row) const { const f32x4* q = (const f32x4*)(SSQ + (size_t)row * 16); const f32x4 a = q[0] + q[1] + q[2] + q[3];
        return rsqrtf(((a[0] + a[1]) + (a[2] + a[3])) * (1.f / DM) + EPS); }
    template <int KD> __device__ __forceinline__ void apply(int w, int row, int col, f32x4 v) const {
        u32x2* m = (u32x2*)(MG + (size_t)row * DM + col);
        if (w == 0) { const float rstd = rstd_of(row);
            const u32x2 g = *(const u32x2*)(GS + (size_t)row * DM + col);
            *m = (u32x2){pk2(bflo(g.x) * rstd * v[0], bfhi(g.x) * rstd * v[1]), pk2(bflo(g.y) * rstd * v[2], bfhi(g.y) * rstd * v[3])};
        } else {
            const u32x2 g = *(const u32x2*)(GL + (size_t)row * DM + col); const u32x2 p = *m;
            *m = (u32x2){pk2(bflo(p.x) + bflo(g.x) * v[0], bfhi(p.x) + bfhi(g.x) * v[1]), pk2(bflo(p.y) + bflo(g.y) * v[2], bfhi(p.y) + bfhi(g.y) * v[3])};
        }
    }
    template <int KD> __device__ __forceinline__ void apply8(int w, int row, int col, f32x4 a, f32x4 b) const {
        u32x4* m = (u32x4*)(MG + (size_t)row * DM + col);
        if (w == 0) { const float rstd = rstd_of(row);
            const u32x4 g = *(const u32x4*)(GS + (size_t)row * DM + col);
            *m = (u32x4){pk2(bflo(g.x) * rstd * a[0], bfhi(g.x) * rstd * a[1]), pk2(bflo(g.y) * rstd * a[2], bfhi(g.y) * rstd * a[3]), pk2(bflo(g.z) * rstd * b[0], bfhi(g.z) * rstd * b[1]), pk2(bflo(g.w) * rstd * b[2], bfhi(g.w) * rstd * b[3])};
        } else {
            const u32x4 g = *(const u32x4*)(GL + (size_t)row * DM + col); const u32x4 p = *m;
            *m = (u32x4){pk2(bflo(p.x) + bflo(g.x) * a[0], bfhi(p.x) + bfhi(g.x) * a[1]), pk2(bflo(p.y) + bflo(g.y) * a[2], bfhi(p.y) + bfhi(g.y) * a[3]),
                         pk2(bflo(p.z) + bflo(g.z) * b[0], bfhi(p.z) + bfhi(g.z) * b[1]), pk2(bflo(p.w) + bflo(g.w) * b[2], bfhi(p.w) + bfhi(g.w) * b[3])};
        }
    }
};
struct Epi4 {
    static constexpr bool PERM = true;
    __device__ __forceinline__ bool idem() const { return layer == 0; }
    static constexpr int NK = 1;
    const float *xp, *xs; float* XR; const float* MODl; int layer;
    __device__ __forceinline__ int kind(int) const { return 0; }
    template <int KD> __device__ __forceinline__ void apply(int, int row, int col, f32x4 v) const {
        if (row >= TT) return;
        const float* src = layer == 0 ? (row < TP ? xp + (size_t)row * DM : xs + (size_t)(row - TP) * DM) : XR + (size_t)row * DM;
        const f32x4 x = *(const f32x4*)(src + col), g = *(const f32x4*)(MODl + (size_t)row_batch(row) * 6144 + 2048 + col);
        *(f32x4*)(XR + (size_t)row * DM + col) = x + g * v;
    }
    template <int KD> __device__ __forceinline__ void apply8(int, int row, int col, f32x4 a, f32x4 b) const {
        const float* src = (layer == 0 ? xp : XR) + (size_t)row * DM + col; const float* gp = MODl + (size_t)(row >> 11) * 6144 + 2048 + col;
        const f32x4 x0 = *(const f32x4*)src, x1 = *(const f32x4*)(src + 4), g0 = *(const f32x4*)gp, g1 = *(const f32x4*)(gp + 4);
        float* d = XR + (size_t)row * DM + col; *(f32x4*)d = x0 + g0 * a; *(f32x4*)(d + 4) = x1 + g1 * b;
    }
};
struct Epi5 {
    static constexpr bool PERM = true;
    __device__ __forceinline__ bool idem() const { return true; }
    static constexpr int NK = 1;
    float* SC;
    __device__ __forceinline__ int kind(int) const { return 0; }
    template <int KD> __device__ __forceinline__ void apply(int, int row, int col, f32x4 v) const { *(f32x4*)(SC + (size_t)row * 2048 + col) = v; }
    template <int KD> __device__ __forceinline__ void apply8(int, int row, int col, f32x4 a, f32x4 b) const { float* d = SC + (size_t)row * 2048 + col; *(f32x4*)d = a; *(f32x4*)(d + 4) = b; }
};

namespace pg8 {
constexpr int BM = 256, BK = 64, HALF = 128, HTB = HALF * BK * 2, STAGE_BYTES = 8 * HTB, NXCD = 8, WGM = 8;
__host__ __device__ __forceinline__ int lds_byte(int r, int c) { const int st = (r >> 4) * 2 + (c >> 5), rr = r & 15, cc = c & 31, ob = rr * 64 + cc * 2; return st * 1024 + (ob ^ (((ob >> 9) & 1) << 5)); }
__host__ __device__ __forceinline__ void stage_rc(int b, int& R, int& C) { const int st = b / 1024, sb = b % 1024, swz = sb ^ (((sb >> 9) & 1) << 5); R = (st >> 1) * 16 + swz / 64; C = (st & 1) * 32 + (swz % 64) / 2; }
struct Unit { int pm, pn, w; };
struct Sched {
    int nM, nN, nW, nwg, G, c; const char *A0, *B0, *A1, *B1;
    __device__ __forceinline__ bool next(int i, Unit& u) const {
        const int ti = i / nW; u.w = i - ti * nW;
        const long L = (long)ti * G + c; if (L >= nwg) return false;
        int wgid = (int)L; { const int q = nwg / NXCD, r = nwg % NXCD, xcd = wgid % NXCD, off = wgid / NXCD; wgid = (xcd < r ? xcd * (q + 1) : r * (q + 1) + (xcd - r) * q) + off; }
        const int nig = WGM * nN, gid = wgid / nig, fm = gid * WGM, gsz = (nM - fm) < WGM ? (nM - fm) : WGM;
        u.pm = fm + ((wgid % nig) % gsz); u.pn = (wgid % nig) / gsz; return true;
    }
};
__host__ __device__ __forceinline__ int perm32(int rho) { const int n = rho >> 4, i = rho & 15; return 8 * (i >> 2) + 4 * n + (i & 3); }
template <int KD, class Epi>
__device__ __forceinline__ void epi_tile(const Epi& E, const f32x4 (&acc)[2][2][4][2], const Unit& u, int wr, int wc, int fr, int fq) {
#pragma unroll
    for (int ai = 0; ai < 2; ++ai)
#pragma unroll
        for (int m = 0; m < 4; ++m) { const int row = u.pm * BM + ai * HALF + wr * 64 + m * 16 + fr;
#pragma unroll
            for (int bj = 0; bj < 2; ++bj) {
                if constexpr (Epi::PERM) E.template apply8<KD>(u.w, row, u.pn * BM + bj * HALF + wc * 32 + 8 * fq, acc[ai][bj][m][0], acc[ai][bj][m][1]);
                else {
#pragma unroll
                    for (int n = 0; n < 2; ++n) E.template apply<KD>(u.w, row, u.pn * BM + bj * HALF + wc * 32 + n * 16 + 4 * fq, acc[ai][bj][m][n]); } } }
}
template <class Epi>
__device__ __forceinline__ void epi_apply(const Epi& E, const f32x4 (&acc)[2][2][4][2], const Unit& u, int wr, int wc, int fr, int fq) {
    if constexpr (Epi::NK == 1) epi_tile<0>(E, acc, u, wr, wc, fr, fq);
    else { const int kd = E.kind(u.pn);
        if (kd == 0) epi_tile<0>(E, acc, u, wr, wc, fr, fq);
        else if (kd == 1) epi_tile<1>(E, acc, u, wr, wc, fr, fq);
        else if constexpr (Epi::NK > 2) { if (kd == 2) epi_tile<2>(E, acc, u, wr, wc, fr, fq); else if (kd == 3) epi_tile<3>(E, acc, u, wr, wc, fr, fq); else epi_tile<4>(E, acc, u, wr, wc, fr, fq); } }
}
template <class Epi, bool ALIGN_EPI = true, bool SP2 = true>
__device__ __forceinline__ void gemm_phase(LAS unsigned char* lds, int tid, int K, const Sched& S, const Epi& E) {
    const int wid = __builtin_amdgcn_readfirstlane(tid >> 6), lane = tid & 63, wr = wid >> 2, wc = wid & 3, fr = lane & 15, fq = lane >> 4;
    const int nt = K / BK;
    unsigned voffA[2], voffB[2];
#pragma unroll
    for (int i = 0; i < 2; ++i) { int R, Cc; stage_rc(tid * 16 + i * 8192, R, Cc); const int Rb = Epi::PERM ? ((R & ~31) + perm32(R & 31)) : R;
        voffA[i] = (unsigned)(R * K + Cc) * 2u; voffB[i] = (unsigned)(Rb * K + Cc) * 2u; }
    const size_t kstep = (size_t)(BK * 2);
    const size_t hstep = (size_t)HALF * K * 2;
    const size_t tstep = 2 * hstep;
    const unsigned ldsw = (unsigned)wid * 1024u;
    const int aoff = lds_byte(wr * 64 + fr, fq * 8), boff = lds_byte(wc * 32 + fr, fq * 8);
#define PG8_SA(b, h) (((b) * 2 + (h)) * HTB)
#define PG8_SB(b, h) ((4 + (b) * 2 + (h)) * HTB)
#define PG8_STAGE(bufoff, gbase, voff) do { _Pragma("unroll") for (int _i = 0; _i < 2; ++_i) \
        __builtin_amdgcn_global_load_lds((const unsigned*)((const char*)(gbase) + (voff)[_i]), (LAS unsigned*)(lds + (bufoff) + ldsw + _i * 8192), 16, 0, 0); } while (0)
#define PG8_LDA(dst, b, h) do { _Pragma("unroll") for (int m = 0; m < 4; ++m) _Pragma("unroll") for (int k = 0; k < 2; ++k) dst[m][k] = *(const LAS bf16x8*)(lds + PG8_SA(b, h) + aoff + m * 2048 + k * 1024); } while (0)
#define PG8_LDB(dst, b, h) do { _Pragma("unroll") for (int n = 0; n < 2; ++n) _Pragma("unroll") for (int k = 0; k < 2; ++k) dst[n][k] = *(const LAS bf16x8*)(lds + PG8_SB(b, h) + boff + n * 2048 + k * 1024); } while (0)
#define PG8_MMA(ai, bj, At, Bt) do { __builtin_amdgcn_s_setprio(1); _Pragma("unroll") for (int m = 0; m < 4; ++m) _Pragma("unroll") for (int n = 0; n < 2; ++n) _Pragma("unroll") for (int k = 0; k < 2; ++k) \
        acc[ai][bj][m][n] = __builtin_amdgcn_mfma_f32_16x16x32_bf16(Bt[n][k], At[m][k], acc[ai][bj][m][n], 0, 0, 0); __builtin_amdgcn_s_setprio(0); } while (0)
#define PG8_WAIT_V(n) asm volatile("s_waitcnt vmcnt(" #n ")" ::: "memory")
#define PG8_WAIT_L(n) asm volatile("s_waitcnt lgkmcnt(" #n ")" ::: "memory")
#define PG8_BAR __builtin_amdgcn_s_barrier()
#define PG8_SCHED __builtin_amdgcn_sched_barrier(0)
    Unit cur, nxt; int ui = 0;
    if (!S.next(0, cur)) return;
    f32x4 acc[2][2][4][2];
#pragma unroll
    for (int a = 0; a < 2; ++a)
#pragma unroll
        for (int b = 0; b < 2; ++b)
#pragma unroll
            for (int m = 0; m < 4; ++m)
#pragma unroll
                for (int n = 0; n < 2; ++n) acc[a][b][m][n] = (f32x4){0.f, 0.f, 0.f, 0.f};
    bf16x8 At[4][2], B0[2][2], B1[2][2];
    const char* cA = (cur.w ? S.A1 : S.A0) + (size_t)cur.pm * tstep; const char* cB = (cur.w ? S.B1 : S.B0) + (size_t)cur.pn * tstep;
    if constexpr (SP2) {
        PG8_STAGE(PG8_SB(0, 0), cB, voffB); PG8_STAGE(PG8_SB(0, 1), cB + hstep, voffB); PG8_STAGE(PG8_SA(0, 0), cA, voffA); PG8_STAGE(PG8_SA(0, 1), cA + hstep, voffA);
        if (wr == 1) PG8_BAR;
        PG8_WAIT_V(2); PG8_BAR;
        PG8_STAGE(PG8_SB(1, 0), cB + kstep, voffB); PG8_STAGE(PG8_SA(1, 0), cA + kstep, voffA); PG8_STAGE(PG8_SB(1, 1), cB + hstep + kstep, voffB);
        PG8_WAIT_V(6); PG8_BAR;
    } else {
        PG8_STAGE(PG8_SB(0, 0), cB, voffB); PG8_STAGE(PG8_SA(0, 0), cA, voffA); PG8_STAGE(PG8_SB(0, 1), cB + hstep, voffB); PG8_STAGE(PG8_SA(0, 1), cA + hstep, voffA);
        if (wr == 1) PG8_BAR;
        PG8_WAIT_V(4); PG8_BAR;
        PG8_STAGE(PG8_SB(1, 0), cB + kstep, voffB); PG8_STAGE(PG8_SA(1, 0), cA + kstep, voffA); PG8_STAGE(PG8_SB(1, 1), cB + hstep + kstep, voffB);
        PG8_WAIT_V(6); PG8_BAR;
    }
    for (;;) {
        const bool has_next = S.next(ui + 1, nxt);
        const char* nA = has_next ? (nxt.w ? S.A1 : S.A0) + (size_t)nxt.pm * tstep : cA; const char* nB = has_next ? (nxt.w ? S.B1 : S.B0) + (size_t)nxt.pn * tstep : cB;
        for (int t = 0; t < nt; t += 2) {
            const bool last = (t == nt - 2);
            const char* a1 = cA + (size_t)(t + 1) * kstep;
            const char* a2 = last ? nA : cA + (size_t)(t + 2) * kstep; const char* b2 = last ? nB : cB + (size_t)(t + 2) * kstep;
            const char* a3 = a2 + kstep; const char* b3 = b2 + kstep;
            if constexpr (SP2) {
            PG8_LDB(B0, 0, 0); PG8_LDB(B1, 0, 1); PG8_SCHED; PG8_LDA(At, 0, 0); PG8_STAGE(PG8_SA(1, 1), a1 + hstep, voffA);
            PG8_WAIT_V(8); PG8_WAIT_L(0); PG8_BAR; PG8_MMA(0, 0, At, B0); PG8_MMA(0, 1, At, B1); PG8_BAR; PG8_SCHED;
            PG8_LDA(At, 0, 1); PG8_STAGE(PG8_SB(0, 0), b2, voffB); PG8_STAGE(PG8_SB(0, 1), b2 + hstep, voffB); PG8_STAGE(PG8_SA(0, 0), a2, voffA);
            PG8_WAIT_V(8); PG8_WAIT_L(0); PG8_BAR; PG8_MMA(1, 0, At, B0); PG8_MMA(1, 1, At, B1); PG8_BAR; PG8_SCHED;
            PG8_LDB(B0, 1, 0); PG8_LDB(B1, 1, 1); PG8_SCHED; PG8_LDA(At, 1, 0); PG8_STAGE(PG8_SA(0, 1), a2 + hstep, voffA);
            PG8_WAIT_V(8); PG8_WAIT_L(0); PG8_BAR; PG8_MMA(0, 0, At, B0); PG8_MMA(0, 1, At, B1); PG8_BAR; PG8_SCHED;
            PG8_LDA(At, 1, 1); PG8_STAGE(PG8_SB(1, 0), b3, voffB); PG8_STAGE(PG8_SB(1, 1), b3 + hstep, voffB); PG8_STAGE(PG8_SA(1, 0), a3, voffA);
            PG8_WAIT_V(8); PG8_WAIT_L(0); PG8_BAR; PG8_MMA(1, 0, At, B0); PG8_MMA(1, 1, At, B1); PG8_BAR; PG8_SCHED;
            } else {
            PG8_LDB(B0, 0, 0); PG8_SCHED; PG8_LDA(At, 0, 0); PG8_STAGE(PG8_SA(1, 1), a1 + hstep, voffA);
            PG8_WAIT_L(8); PG8_BAR; PG8_WAIT_L(0); PG8_MMA(0, 0, At, B0); PG8_BAR; PG8_SCHED;
            PG8_LDB(B1, 0, 1); PG8_STAGE(PG8_SB(0, 0), b2, voffB);
            PG8_BAR; PG8_WAIT_L(0); PG8_MMA(0, 1, At, B1); PG8_BAR;
            PG8_LDA(At, 0, 1); PG8_STAGE(PG8_SA(0, 0), a2, voffA);
            PG8_BAR; PG8_WAIT_L(0); PG8_MMA(1, 0, At, B0); PG8_BAR; PG8_SCHED;
            PG8_STAGE(PG8_SB(0, 1), b2 + hstep, voffB);
            PG8_WAIT_V(6); PG8_BAR; PG8_MMA(1, 1, At, B1); PG8_BAR;
            PG8_LDB(B0, 1, 0); PG8_SCHED; PG8_LDA(At, 1, 0); PG8_STAGE(PG8_SA(0, 1), a2 + hstep, voffA);
            PG8_WAIT_L(8); PG8_BAR; PG8_WAIT_L(0); PG8_MMA(0, 0, At, B0); PG8_BAR; PG8_SCHED;
            PG8_LDB(B1, 1, 1); PG8_STAGE(PG8_SB(1, 0), b3, voffB);
            PG8_BAR; PG8_WAIT_L(0); PG8_MMA(0, 1, At, B1); PG8_BAR;
            PG8_LDA(At, 1, 1); PG8_STAGE(PG8_SA(1, 0), a3, voffA);
            PG8_BAR; PG8_WAIT_L(0); PG8_MMA(1, 0, At, B0); PG8_BAR; PG8_SCHED;
            PG8_STAGE(PG8_SB(1, 1), b3 + hstep, voffB);
            PG8_WAIT_V(6); PG8_BAR; PG8_MMA(1, 1, At, B1); PG8_BAR;
            }
        }
        if constexpr (ALIGN_EPI) { if (wr == 0) PG8_BAR; }
        epi_apply(E, acc, cur, wr, wc, fr, fq);
        if (!has_next) break;
#pragma unroll
        for (int a = 0; a < 2; ++a)
#pragma unroll
            for (int b = 0; b < 2; ++b)
#pragma unroll
                for (int m = 0; m < 4; ++m)
#pragma unroll
                    for (int n = 0; n < 2; ++n) acc[a][b][m][n] = (f32x4){0.f, 0.f, 0.f, 0.f};
        cur = nxt; cA = nA; cB = nB; ++ui;
        if constexpr (ALIGN_EPI) { if (wr == 1) PG8_BAR; }
    }
    PG8_WAIT_V(0);
    if constexpr (!ALIGN_EPI) { if (wr == 0) PG8_BAR; }
    PG8_BAR;
#undef PG8_SA
#undef PG8_SB
#undef PG8_STAGE
#undef PG8_LDA
#undef PG8_LDB
#undef PG8_MMA
#undef PG8_WAIT_V
#undef PG8_WAIT_L
#undef PG8_BAR
#undef PG8_SCHED
}
}
template <int KD, class Epi>
__device__ __forceinline__ void sample_tile(const Ctx& C, const bf16_t* A0, const bf16_t* B0, const bf16_t* A1, const bf16_t* B1, int rb, int cb, const Epi& E) {
    const int fr = C.lane & 15, fq = C.lane >> 4;
    for (int w = 0; w < (A1 ? 2 : 1); ++w) {
        const bf16_t* ap = (w ? A1 : A0) + (size_t)(TP + 16 * rb + fr) * DM + 8 * fq; const bf16_t* bp = (w ? B1 : B0) + (size_t)(16 * cb + fr) * DM + 8 * fq;
        f32x4 acc = (f32x4){0.f, 0.f, 0.f, 0.f};
#pragma unroll 16
        for (int ks = 0; ks < DM / 32; ++ks) { const bf16x8 a = *(const bf16x8*)(ap + 32 * ks), b = *(const bf16x8*)(bp + 32 * ks); acc = __builtin_amdgcn_mfma_f32_16x16x32_bf16(b, a, acc, 0, 0, 0); }
        E.template apply<KD>(w, TP + 16 * rb + fr, 16 * cb + 4 * fq, acc);
    }
}
template <class Epi>
__device__ __forceinline__ void gemm_sample(const Ctx& C, const bf16_t* A0, const bf16_t* B0, const bf16_t* A1, const bf16_t* B1, int N, const Epi& E) {
    const int gw = C.bid * NWAVES + C.wave, NGW = C.G * NWAVES, ncb = N / 16;
    for (int it = gw; it < 8 * ncb; it += NGW) {
        const int cb = it >> 3, rb = it & 7; const int kd = E.kind(cb >> 4);
        if constexpr (Epi::NK == 1) sample_tile<0>(C, A0, B0, A1, B1, rb, cb, E);
        else { if (kd == 0) sample_tile<0>(C, A0, B0, A1, B1, rb, cb, E); else if (kd == 1) sample_tile<1>(C, A0, B0, A1, B1, rb, cb, E);
            else if constexpr (Epi::NK > 2) { if (kd == 2) sample_tile<2>(C, A0, B0, A1, B1, rb, cb, E); else if (kd == 3) sample_tile<3>(C, A0, B0, A1, B1, rb, cb, E); else sample_tile<4>(C, A0, B0, A1, B1, rb, cb, E); } }
    }
}
template <class Epi>
__device__ __forceinline__ void gemm_run(const Ctx& C, const bf16_t* A0, const bf16_t* B0, const bf16_t* A1, const bf16_t* B1, int N, const Epi& E) {
    gemm_sample(C, A0, B0, A1, B1, N, E);
    pg8::Sched S; S.nM = TP / 256; S.nN = N / 256; S.nW = A1 ? 2 : 1; S.nwg = S.nM * S.nN; S.G = C.G; S.c = C.bid;
    S.A0 = (const char*)A0; S.B0 = (const char*)B0; S.A1 = (const char*)A1; S.B1 = (const char*)B1;
    pg8::gemm_phase<Epi>(C.lds, C.tid, DM, S, E);
    __syncthreads();
}

__device__ __forceinline__ unsigned cvt_pk_bf16(float lo, float hi) { unsigned r; asm volatile("v_cvt_pk_bf16_f32 %0, %1, %2" : "=v"(r) : "v"(lo), "v"(hi)); return r; }
__device__ __forceinline__ bf16x8 pack_acc(const f32x16& a, int t) {
    u32x4 w;
    if (t == 0) { w.x = cvt_pk_bf16(a[0], a[1]); w.y = cvt_pk_bf16(a[2], a[3]); w.z = cvt_pk_bf16(a[4], a[5]); w.w = cvt_pk_bf16(a[6], a[7]); }
    else { w.x = cvt_pk_bf16(a[8], a[9]); w.y = cvt_pk_bf16(a[10], a[11]); w.z = cvt_pk_bf16(a[12], a[13]); w.w = cvt_pk_bf16(a[14], a[15]); }
    return __builtin_bit_cast(bf16x8, w);
}
__device__ __forceinline__ int sig_pos(int s) { return (s & ~15) | (((s >> 2) & 1) << 3) | (((s >> 3) & 1) << 2) | (s & 3); }
constexpr int SROW = 144;

template <int WSTR>
__device__ __forceinline__ void conv8(const u32x4 (&rw)[4], const LAS float* wl, float (&v)[8]) {
    f32x4 w[5][2];
#pragma unroll
    for (int k = 0; k < 5; ++k) { w[k][0] = *(const LAS f32x4*)(wl + k * WSTR); w[k][1] = *(const LAS f32x4*)(wl + k * WSTR + 4); }
#pragma unroll
    for (int e = 0; e < 8; ++e) { const int dw = e >> 1; const bool hi = e & 1;
        float x[4];
#pragma unroll
        for (int k = 0; k < 4; ++k) { const unsigned q = dw == 0 ? rw[k].x : (dw == 1 ? rw[k].y : (dw == 2 ? rw[k].z : rw[k].w)); x[k] = hi ? bfhi(q) : bflo(q); }
        v[e] = w[4][e >> 2][e & 3] + w[0][e >> 2][e & 3] * x[0] + w[1][e >> 2][e & 3] * x[1] + w[2][e >> 2][e & 3] * x[2] + w[3][e >> 2][e & 3] * x[3]; }
}
constexpr size_t WS_CBC = WS_EI;
__device__ __forceinline__ void phase_convbc(const Ctx& C, int l) {
    CParams& P = *C.P;
    const bf16_t* XBC = WSP(bf16_t, WS_B2); bf16_t* CBC = WSP(bf16_t, WS_CBC);
    const float* cw = as_global(P.in[IN_SCW]) + (size_t)l * 4 * 1280 + 1024; const float* cbp = as_global(P.in[IN_SCB]) + (size_t)l * 1280 + 1024;
    const float* cst = as_global(P.in[IN_SSDCONV]) + (size_t)l * 8 * 3 * 1280;
    const size_t items = (size_t)TT * 32, stride = (size_t)C.G * NTHREADS;
    for (size_t it = (size_t)C.bid * NTHREADS + C.tid; it < items; it += stride) {
        const int tok = (int)(it >> 5), cg = (int)(it & 31), ch = cg * 8;
        const bool smp = tok >= TP; const int b = smp ? (tok - TP) >> 4 : tok >> 11, t = smp ? (tok - TP) & 15 : tok & 2047, L = smp ? 16 : 2048, NB = smp ? 8 : 16;
        u32x4 rw[4];
#pragma unroll
        for (int k = 0; k < 4; ++k) { const int tr = t - 3 + k;
            if (tr >= 0) rw[k] = *(const u32x4*)(XBC + (size_t)(tok - t + tr) * 1280 + 1024 + ch);
            else if (smp) { const float* s0 = cst + ((size_t)b * 3 + (tr + 3)) * 1280 + 1024 + ch; const f32x4 a0 = *(const f32x4*)s0, a1 = *(const f32x4*)(s0 + 4);
                rw[k] = (u32x4){pk2(a0[0], a0[1]), pk2(a0[2], a0[3]), pk2(a1[0], a1[1]), pk2(a1[2], a1[3])}; }
            else rw[k] = (u32x4){0u, 0u, 0u, 0u}; }
        f32x4 w[5][2];
#pragma unroll
        for (int k = 0; k < 4; ++k) { w[k][0] = *(const f32x4*)(cw + k * 1280 + ch); w[k][1] = *(const f32x4*)(cw + k * 1280 + ch + 4); }
        w[4][0] = *(const f32x4*)(cbp + ch); w[4][1] = *(const f32x4*)(cbp + ch + 4);
        float v[8];
#pragma unroll
        for (int e = 0; e < 8; ++e) { const int dw = e >> 1; const bool hi = e & 1; float x[4];
#pragma unroll
            for (int k = 0; k < 4; ++k) { const unsigned q = dw == 0 ? rw[k].x : (dw == 1 ? rw[k].y : (dw == 2 ? rw[k].z : rw[k].w)); x[k] = hi ? bfhi(q) : bflo(q); }
            v[e] = siluf_(w[4][e >> 2][e & 3] + w[0][e >> 2][e & 3] * x[0] + w[1][e >> 2][e & 3] * x[1] + w[2][e >> 2][e & 3] * x[2] + w[3][e >> 2][e & 3] * x[3]); }
        *(u32x4*)(CBC + (size_t)tok * 256 + ch) = (u32x4){pk2(v[0], v[1]), pk2(v[2], v[3]), pk2(v[4], v[5]), pk2(v[6], v[7])};
        if (t >= L - 3) { float* co = C.out + (smp ? O_SSCONV : O_PSCONV) + ((size_t)(l * NB + b) * 3 + (t - (L - 3))) * 1280 + 1024 + ch; const u32x4 q = rw[3];
            *(f32x4*)co = (f32x4){bflo(q.x), bfhi(q.x), bflo(q.y), bfhi(q.y)}; *(f32x4*)(co + 4) = (f32x4){bflo(q.z), bfhi(q.z), bflo(q.w), bfhi(q.w)}; }
    }
}

#ifndef SCAN_SKIP
#define SCAN_SKIP 0
#endif
__device__ __forceinline__ void scan_item_fused(const Ctx& C, int l, int idx, bool dry) {
    const int skip = dry ? SCAN_SKIP : 0;
    CParams& P = *C.P; const int tid = C.tid, lane = C.lane, wave = C.wave;
    const bool smp = idx >= 256; const int ii = smp ? idx - 256 : idx; const int b = ii >> 4, head = ii & 15, g = head >> 3, j = head;
    const int tok0 = smp ? TP + b * 16 : b * 2048, L = smp ? 16 : 2048, NB = smp ? 8 : 16, nchunk = smp ? 1 : 32;
    const bf16_t* XBC = WSP(bf16_t, WS_B2); const bf16_t* CBC = WSP(bf16_t, WS_CBC); bf16_t* Z = WSP(bf16_t, WS_B1); const float* DT = WSP(float, WS_DT); float* SSQ = WSP(float, WS_SSQ);
    const float a_h = -__expf(as_global(P.in[IN_ALOG])[l * 16 + head]), Dh = as_global(P.in[IN_SSDD])[l * 16 + head];
    LAS unsigned char* bmR = C.lds; LAS unsigned char* cmR = C.lds + 9216; LAS unsigned char* xsR = C.lds + 18432; LAS unsigned char* bwR = C.lds + 30720;
    LAS float* ybuf = (LAS float*)(C.lds + 43008);
    LAS float* acum = (LAS float*)(C.lds + 59392); LAS float* dtv = acum + 64; LAS float* eac = acum + 128; LAS float* wsc = acum + 192; LAS float* misc = acum + 256; LAS float* cwl = acum + 320;
    const int t = tid >> 3, cg = tid & 7;
    const int chx = head * 64 + cg * 8, chb = 1024 + g * 64 + cg * 8, chc = 1152 + g * 64 + cg * 8;
    const float* scw = as_global(P.in[IN_SCW]) + (size_t)l * 4 * 1280; const float* scb = as_global(P.in[IN_SCB]) + (size_t)l * 1280;
    const float* scst = smp ? as_global(P.in[IN_SSDCONV]) + (size_t)(l * 8 + b) * 3 * 1280 : nullptr;
    const int qb = (wave >> 1) & 1, pb = wave & 1, r = lane & 31, hh = lane >> 5;
    f32x16 hacc[2];
#pragma unroll
    for (int nb = 0; nb < 2; ++nb)
#pragma unroll
        for (int i = 0; i < 16; ++i) hacc[nb][i] = 0.f;
    if (smp && wave < 4) {
        const float* hs = as_global(P.in[IN_SSD]) + ((size_t)((l * 8 + b) * 16 + head) * 64 + 32 * pb + r) * 64;
#pragma unroll
        for (int nb = 0; nb < 2; ++nb)
#pragma unroll
            for (int i4 = 0; i4 < 4; ++i4) { const f32x4 v = *(const f32x4*)(hs + 32 * nb + 8 * i4 + 4 * hh); hacc[nb][4 * i4] = v[0]; hacc[nb][4 * i4 + 1] = v[1]; hacc[nb][4 * i4 + 2] = v[2]; hacc[nb][4 * i4 + 3] = v[3]; }
    }
    const bf16_t* LX = WSP(bf16_t, WS_B3); bf16_t* LY = WSP(bf16_t, WS_B4);
    LAS unsigned char* LB = C.lds + 65536;
    LAS unsigned char* xcB = LB; LAS unsigned char* waT = LB + 9216; LAS unsigned char* wxT = LB + 18432;
    LAS float* xcF = (LAS float*)(LB + 27648); LAS float* aF = (LAS float*)(LB + 44032); LAS float* uF = (LAS float*)(LB + 60416); LAS float* lcwl = (LAS float*)(LB + 76800);
    const int ch0 = j * 64 + cg * 8;
    const float* lcw = as_global(P.in[IN_LCW]) + (size_t)l * 4 * DM; const float* lcb = as_global(P.in[IN_LCB]) + (size_t)l * DM;
    const float* lcst = smp ? as_global(P.in[IN_LRUCONV]) + (size_t)(l * 8 + b) * 3 * DM : nullptr;
    const int tb = qb, eb = pb, ech = j * 64 + 32 * eb + r;
    const float ba = as_global(P.in[IN_BA])[l * DM + ech], bxx = as_global(P.in[IN_BX])[l * DM + ech], sp8 = -8.0f * softplusf_(-as_global(P.in[IN_LAM])[l * DM + ech]);
    float hstate = (smp && wave == 4) ? as_global(P.in[IN_LRU])[(size_t)(l * 8 + b) * DM + j * 64 + lane] : 0.f;
    __syncthreads();
    for (int i = tid; i < 5 * 192; i += NTHREADS) { const int k = i / 192, cc = i % 192; const int ch = cc < 64 ? head * 64 + cc : (cc < 128 ? 1024 + g * 64 + (cc - 64) : 1152 + g * 64 + (cc - 128));
        cwl[i] = k < 4 ? scw[k * 1280 + ch] : scb[ch]; }
    { const float* wap = as_global(P.in[IN_WA]) + (size_t)(l * 16 + j) * 4096; const float* wxp = as_global(P.in[IN_WX]) + (size_t)(l * 16 + j) * 4096;
      for (int i = tid; i < 4096; i += NTHREADS) { const int d = i >> 6, e = i & 63; *(LAS bf16_t*)(waT + e * SROW + d * 2) = (bf16_t)f2bf(wap[i]); *(LAS bf16_t*)(wxT + e * SROW + d * 2) = (bf16_t)f2bf(wxp[i]); } }
    for (int i = tid; i < 5 * 64; i += NTHREADS) { const int k = i >> 6, cc = i & 63; lcwl[i] = k < 4 ? lcw[k * DM + j * 64 + cc] : lcb[j * 64 + cc]; }
    u32x4 rw[4], bcv, ccv, lrw[4], zs, lyv; float dtl = 0.f;
#define RAWROW(dst, base, ld, ch, cstp, tr) { if ((tr) >= 0) dst = ((tr) < L) ? *(const u32x4*)((base) + (size_t)(tok0 + (tr)) * (ld) + (ch)) : (u32x4){0u, 0u, 0u, 0u}; \
        else if (smp) { const float* s0_ = (cstp) + (size_t)((tr) + 3) * (ld) + (ch); const f32x4 a0_ = *(const f32x4*)s0_, a1_ = *(const f32x4*)(s0_ + 4); \
            dst = (u32x4){pk2(a0_[0], a0_[1]), pk2(a0_[2], a0_[3]), pk2(a1_[0], a1_[1]), pk2(a1_[2], a1_[3])}; } else dst = (u32x4){0u, 0u, 0u, 0u}; }
#define SSD_LOAD(c_) { const int tg_ = (c_) * 64 + t; _Pragma("unroll") for (int k = 0; k < 4; ++k) { RAWROW(rw[k], XBC, 1280, chx, scst, tg_ - 3 + k) } \
        const bool v_ = tg_ < L; bcv = v_ ? *(const u32x4*)(CBC + (size_t)(tok0 + tg_) * 256 + g * 64 + cg * 8) : (u32x4){0u, 0u, 0u, 0u}; ccv = v_ ? *(const u32x4*)(CBC + (size_t)(tok0 + tg_) * 256 + 128 + g * 64 + cg * 8) : (u32x4){0u, 0u, 0u, 0u}; \
        }
#define LRU_LOAD(c_) { const int tg_ = (c_) * 64 + t; _Pragma("unroll") for (int k = 0; k < 4; ++k) { RAWROW(lrw[k], LX, DM, ch0, lcst, tg_ - 3 + k) } }
#define TAIL_LOAD(c_) { const int tg_ = (c_) * 64 + t; const bool v_ = tg_ < L; zs = v_ ? *(const u32x4*)(Z + (size_t)(tok0 + tg_) * DM + chx) : (u32x4){0u, 0u, 0u, 0u}; lyv = v_ ? *(const u32x4*)(LY + (size_t)(tok0 + tg_) * DM + ch0) : (u32x4){0u, 0u, 0u, 0u}; }
    SSD_LOAD(0) LRU_LOAD(0) TAIL_LOAD(0)
    if (wave == 0) dtl = (lane < L) ? DT[(size_t)(tok0 + lane) * 16 + head] : 0.f;
    __syncthreads();
    for (int c = 0; c < nchunk; ++c) {
        int lt_ = tid; asm volatile("" : "+v"(lt_));
        const int t = lt_ >> 3, cg = lt_ & 7, lane = lt_ & 63, r = lane & 31, hh = lane >> 5;
        const int chx = head * 64 + cg * 8, chb = 1024 + g * 64 + cg * 8, chc = 1152 + g * 64 + cg * 8, ch0 = j * 64 + cg * 8;
        const int tg = c * 64 + t; const bool valid = tg < L;
        if (wave == 0 && !(skip & 128)) {
            float cs = dtl * a_h;
            { float o = shfl_f(cs, lane - 1); if (lane >= 1) cs += o; o = shfl_f(cs, lane - 2); if (lane >= 2) cs += o; o = shfl_f(cs, lane - 4); if (lane >= 4) cs += o;
              o = shfl_f(cs, lane - 8); if (lane >= 8) cs += o; o = shfl_f(cs, lane - 16); if (lane >= 16) cs += o; o = shfl_f(cs, lane - 32); if (lane >= 32) cs += o; }
            const float tot = shfl_f(cs, 63);
            acum[lane] = cs; dtv[lane] = dtl; eac[lane] = __expf(cs); wsc[lane] = __expf(tot - cs) * dtl; if (lane == 0) misc[0] = __expf(tot);
        }
        if (!(skip & 32)) {
            float v[8]; conv8<64>(lrw, lcwl + cg * 8, v);
            *(LAS u32x4*)(xcB + t * SROW + cg * 16) = (u32x4){pk2(v[0], v[1]), pk2(v[2], v[3]), pk2(v[4], v[5]), pk2(v[6], v[7])};
            *(LAS f32x4*)(xcF + t * 64 + cg * 8) = (f32x4){v[0], v[1], v[2], v[3]}; *(LAS f32x4*)(xcF + t * 64 + cg * 8 + 4) = (f32x4){v[4], v[5], v[6], v[7]};
            if (!dry && valid && tg >= L - 3) { float* co = C.out + (smp ? O_SLCONV : O_PLCONV) + ((size_t)(l * NB + b) * 3 + (tg - (L - 3))) * DM + ch0; const u32x4 q = lrw[3];
                *(f32x4*)co = (f32x4){bflo(q.x), bfhi(q.x), bflo(q.y), bfhi(q.y)}; *(f32x4*)(co + 4) = (f32x4){bflo(q.z), bfhi(q.z), bflo(q.w), bfhi(q.w)}; }
        }
        LRU_LOAD(c + 1)
        if (!(skip & 256)) __syncthreads();
        if (!(skip & 16)) {
            const float wsl = wsc[t];
            { float v[8]; conv8<192>(rw, cwl + cg * 8, v);
#pragma unroll
              for (int e = 0; e < 8; ++e) v[e] = valid ? siluf_(v[e]) : 0.f;
              if (!(skip & 1)) *(LAS u32x4*)(xsR + t * 192 + cg * 16) = (u32x4){pk2(v[0], v[1]), pk2(v[2], v[3]), pk2(v[4], v[5]), pk2(v[6], v[7])}; }
            *(LAS u32x4*)(bmR + t * SROW + cg * 16) = bcv;
            *(LAS u32x4*)(cmR + t * SROW + cg * 16) = ccv;
            if (!(skip & 1)) *(LAS u32x4*)(bwR + t * 192 + cg * 16) = (u32x4){pk2(bflo(bcv.x) * wsl, bfhi(bcv.x) * wsl), pk2(bflo(bcv.y) * wsl, bfhi(bcv.y) * wsl), pk2(bflo(bcv.z) * wsl, bfhi(bcv.z) * wsl), pk2(bflo(bcv.w) * wsl, bfhi(bcv.w) * wsl)};
            if (!dry && valid && tg >= L - 3) { float* co = C.out + (smp ? O_SSCONV : O_PSCONV) + ((size_t)(l * NB + b) * 3 + (tg - (L - 3))) * 1280 + chx; const u32x4 q = rw[3];
                *(f32x4*)co = (f32x4){bflo(q.x), bfhi(q.x), bflo(q.y), bfhi(q.y)}; *(f32x4*)(co + 4) = (f32x4){bflo(q.z), bfhi(q.z), bflo(q.w), bfhi(q.w)}; }
        }
        asm volatile("" ::: "memory");
        SSD_LOAD(c + 1)
        if (wave == 0) { const int tq_ = (c + 1) * 64 + lane; dtl = (tq_ < L) ? DT[(size_t)(tok0 + tq_) * 16 + head] : 0.f; }
        if (wave >= 4 && !(skip & 2)) {
            f32x16 ra, ia;
#pragma unroll
            for (int i = 0; i < 16; ++i) { ra[i] = 0.f; ia[i] = 0.f; }
#pragma unroll
            for (int ks = 0; ks < 4; ++ks) { const bf16x8 A = *(const LAS bf16x8*)(xcB + (32 * tb + r) * SROW + (16 * ks + 8 * hh) * 2);
                const bf16x8 Ba = *(const LAS bf16x8*)(waT + (32 * eb + r) * SROW + (16 * ks + 8 * hh) * 2), Bx = *(const LAS bf16x8*)(wxT + (32 * eb + r) * SROW + (16 * ks + 8 * hh) * 2);
                ra = MFMA32(A, Ba, ra); ia = MFMA32(A, Bx, ia); }
#pragma unroll
            for (int i = 0; i < 16; ++i) { const int tt = 32 * tb + (i & 3) + 8 * (i >> 2) + 4 * hh, e = 32 * eb + r;
                const float rg = sigmoidf_(ra[i] + ba), ig = sigmoidf_(ia[i] + bxx), log_a = rg * sp8, av = exp_fast(log_a);
                const float u = __builtin_amdgcn_sqrtf(fmaxf(1.0f - av * av, 0.f)) * (ig * xcF[tt * 64 + e]);
                aF[tt * 64 + e] = av; uF[tt * 64 + e] = u; }
        }
        if (!(skip & 256)) __syncthreads();
        if (wave < 4 && !(skip & 4)) {
            const int tri = lane & 15, trg = (lane >> 4) & 1;
            const int troff = (tri >> 2) * 192 + (16 * trg + 4 * (tri & 3)) * 2;
#define TRFRAG(tile, row0, rowstep, col0) ({ const LAS unsigned char* a_ = (tile) + (row0) * 192 + (col0) * 2 + troff; \
                const s16x4_ lo_ = __builtin_amdgcn_ds_read_tr16_b64_v4i16((LAS s16x4_*)a_), hi_ = __builtin_amdgcn_ds_read_tr16_b64_v4i16((LAS s16x4_*)(a_ + (rowstep) * 192)); \
                (bf16x8){lo_[0], lo_[1], lo_[2], lo_[3], hi_[0], hi_[1], hi_[2], hi_[3]}; })
            f32x16 y;
#pragma unroll
            for (int i = 0; i < 16; ++i) y[i] = 0.f;
#pragma unroll
            for (int nb = 0; nb < 2; ++nb)
#pragma unroll
                for (int tt = 0; tt < 2; ++tt) { const LAS unsigned char* ap = cmR + (32 * qb + r) * SROW + (32 * nb + 16 * tt + 4 * hh) * 2;
                    const u32x2 a0 = *(const LAS u32x2*)ap, a1 = *(const LAS u32x2*)(ap + 16);
                    y = MFMA32(__builtin_bit_cast(bf16x8, (u32x4){a0.x, a0.y, a1.x, a1.y}), pack_acc(hacc[nb], tt), y); }
#pragma unroll
            for (int i = 0; i < 16; ++i) y[i] *= eac[32 * qb + (i & 3) + 8 * (i >> 2) + 4 * hh];
            const float aq = acum[32 * qb + r]; const int qg = 32 * qb + r;
            for (int sb = 0; sb <= qb; ++sb) {
                f32x16 cbt;
#pragma unroll
                for (int i = 0; i < 16; ++i) cbt[i] = 0.f;
#pragma unroll
                for (int ks = 0; ks < 4; ++ks) { const bf16x8 A = *(const LAS bf16x8*)(bmR + (32 * sb + r) * SROW + (16 * ks + 8 * hh) * 2), B = *(const LAS bf16x8*)(cmR + (32 * qb + r) * SROW + (16 * ks + 8 * hh) * 2); cbt = MFMA32(A, B, cbt); }
#pragma unroll
                for (int i = 0; i < 16; ++i) { const int sg = 32 * sb + (i & 3) + 8 * (i >> 2) + 4 * hh;
                    float wv = cbt[i] * exp_fast(fminf(aq - acum[sg], 0.f)) * dtv[sg]; wv = sg > qg ? 0.f : wv; wv = sg == qg ? wv + Dh : wv; cbt[i] = wv; }
#pragma unroll
                for (int tt = 0; tt < 2; ++tt) { const bf16x8 B = TRFRAG(xsR, 32 * sb + 16 * tt + 4 * hh, 8, 32 * pb); y = MFMA32(pack_acc(cbt, tt), B, y); }
            }
#pragma unroll
            for (int i = 0; i < 16; ++i) ybuf[(32 * qb + (i & 3) + 8 * (i >> 2) + 4 * hh) * 64 + 32 * pb + r] = y[i];
            const float dec = misc[0];
#pragma unroll
            for (int nb = 0; nb < 2; ++nb) {
#pragma unroll
                for (int i = 0; i < 16; ++i) hacc[nb][i] *= dec;
#pragma unroll
                for (int ks = 0; ks < 4; ++ks) { const bf16x8 A = TRFRAG(bwR, 16 * ks + 8 * hh, 4, 32 * nb), B = TRFRAG(xsR, 16 * ks + 8 * hh, 4, 32 * pb); hacc[nb] = MFMA32(A, B, hacc[nb]); }
            }
#undef TRFRAG
        } else if (wave == 4 && !(skip & 8)) {
            const int nsteps = (L - c * 64) < 64 ? (L - c * 64) : 64;
            for (int s0 = 0; s0 < nsteps; s0 += 8) {
                float av[8], uv[8];
#pragma unroll
                for (int q = 0; q < 8; ++q) { av[q] = aF[(s0 + q) * 64 + lane]; uv[q] = uF[(s0 + q) * 64 + lane]; }
#pragma unroll
                for (int q = 0; q < 8; ++q) { hstate = (s0 + q < nsteps) ? av[q] * hstate + uv[q] : hstate; uF[(s0 + q) * 64 + lane] = hstate; }
            }
        }
        if (!(skip & 256)) __syncthreads();
        if (!(skip & 64)) {
            const f32x4 y0 = *(const LAS f32x4*)(ybuf + t * 64 + cg * 8), y1 = *(const LAS f32x4*)(ybuf + t * 64 + cg * 8 + 4);
            const float o0 = y0[0] * bflo(zs.x), o1 = y0[1] * bfhi(zs.x), o2 = y0[2] * bflo(zs.y), o3 = y0[3] * bfhi(zs.y);
            const float o4 = y1[0] * bflo(zs.z), o5 = y1[1] * bfhi(zs.z), o6 = y1[2] * bflo(zs.w), o7 = y1[3] * bfhi(zs.w);
            float ss = (o0 * o0 + o1 * o1) + (o2 * o2 + o3 * o3) + (o4 * o4 + o5 * o5) + (o6 * o6 + o7 * o7);
            ss = row8_sum(ss);
            const f32x4 h0 = *(const LAS f32x4*)(uF + t * 64 + cg * 8), h1 = *(const LAS f32x4*)(uF + t * 64 + cg * 8 + 4);
            asm volatile("" :: "v"(o0), "v"(o7), "v"(ss), "v"(h0[0]), "v"(h1[3]));
            if (valid && !dry) { *(u32x4*)(Z + (size_t)(tok0 + tg) * DM + chx) = (u32x4){pk2(o0, o1), pk2(o2, o3), pk2(o4, o5), pk2(o6, o7)};
                if (cg == 0) SSQ[(size_t)(tok0 + tg) * 16 + head] = ss;
                *(u32x4*)(LY + (size_t)(tok0 + tg) * DM + ch0) = (u32x4){pk2(h0[0] * bflo(lyv.x), h0[1] * bfhi(lyv.x)), pk2(h0[2] * bflo(lyv.y), h0[3] * bfhi(lyv.y)),
                                                                          pk2(h1[0] * bflo(lyv.z), h1[1] * bfhi(lyv.z)), pk2(h1[2] * bflo(lyv.w), h1[3] * bfhi(lyv.w))}; }
        }
        if (skip & 512) {
#pragma unroll
            for (int k = 0; k < 4; ++k) asm volatile("" :: "v"(rw[k].x), "v"(rw[k].w), "v"(lrw[k].x), "v"(lrw[k].w));
            asm volatile("" :: "v"(bcv.x), "v"(ccv.x), "v"(zs.x), "v"(lyv.x), "v"(dtl)); }
        TAIL_LOAD(c + 1)
    }
#undef RAWROW
#undef SSD_LOAD
#undef LRU_LOAD
#undef TAIL_LOAD
    if (!dry && wave < 4 && qb == 0) {
        float* so = C.out + (smp ? O_SSSD : O_PSSD) + ((size_t)((l * NB + b) * 16 + head) * 64 + 32 * pb + r) * 64;
#pragma unroll
        for (int nb = 0; nb < 2; ++nb)
#pragma unroll
            for (int i4 = 0; i4 < 4; ++i4) *(f32x4*)(so + 32 * nb + 8 * i4 + 4 * hh) = (f32x4){hacc[nb][4 * i4], hacc[nb][4 * i4 + 1], hacc[nb][4 * i4 + 2], hacc[nb][4 * i4 + 3]};
    }
    if (wave == 4 && !dry) C.out[(smp ? O_SLRU : O_PLRU) + (size_t)(l * NB + b) * DM + j * 64 + lane] = hstate;
    __syncthreads();
}

__device__ __forceinline__ void phase_scan(const Ctx& C, int l, bool dry = false) {
    for (int it = C.bid; it < 384; it += C.G) scan_item_fused(C, l, it, dry);
}

__device__ __forceinline__ unsigned mono(float f) { const unsigned u = __float_as_uint(f); return (u & 0x80000000u) ? ~u : (u | 0x80000000u); }
__device__ __forceinline__ float unmono(unsigned k) { const unsigned u = (k & 0x80000000u) ? (k & 0x7fffffffu) : ~k; return __uint_as_float(u); }
template <int CTRL> __device__ __forceinline__ unsigned dpp_u(unsigned v) { return (unsigned)__builtin_amdgcn_update_dpp(0, (int)v, CTRL, 0xf, 0xf, true); }
__device__ __forceinline__ unsigned row_max_u(unsigned m) {
    m = max(m, dpp_u<0xB1>(m)); m = max(m, dpp_u<0x4E>(m)); m = max(m, dpp_u<0x141>(m)); m = max(m, dpp_u<0x140>(m)); return m;
}
__device__ __forceinline__ float row_max_f(float m) {
    m = fmaxf(m, __uint_as_float(dpp_u<0xB1>(__float_as_uint(m)))); m = fmaxf(m, __uint_as_float(dpp_u<0x4E>(__float_as_uint(m))));
    m = fmaxf(m, __uint_as_float(dpp_u<0x141>(__float_as_uint(m)))); m = fmaxf(m, __uint_as_float(dpp_u<0x140>(__float_as_uint(m)))); return m;
}
__device__ __forceinline__ float row_sum_f(float m) {
    m += __uint_as_float(dpp_u<0xB1>(__float_as_uint(m))); m += __uint_as_float(dpp_u<0x4E>(__float_as_uint(m)));
    m += __uint_as_float(dpp_u<0x141>(__float_as_uint(m))); m += __uint_as_float(dpp_u<0x140>(__float_as_uint(m))); return m;
}
#define CE_(a, b) { const unsigned hi_ = max(a, b), lo_ = min(a, b); a = hi_; b = lo_; }
#define KEY8(k, a, b) unsigned k##0 = (mono(a[0]) & ~127u) | (unsigned)(127 - (li * 8 + 0)), k##1 = (mono(a[1]) & ~127u) | (unsigned)(127 - (li * 8 + 1)), k##2 = (mono(a[2]) & ~127u) | (unsigned)(127 - (li * 8 + 2)), \
        k##3 = (mono(a[3]) & ~127u) | (unsigned)(127 - (li * 8 + 3)), k##4 = (mono(b[0]) & ~127u) | (unsigned)(127 - (li * 8 + 4)), k##5 = (mono(b[1]) & ~127u) | (unsigned)(127 - (li * 8 + 5)), \
        k##6 = (mono(b[2]) & ~127u) | (unsigned)(127 - (li * 8 + 6)), k##7 = (mono(b[3]) & ~127u) | (unsigned)(127 - (li * 8 + 7));
#define SORT8(k) CE_(k##0, k##1) CE_(k##2, k##3) CE_(k##4, k##5) CE_(k##6, k##7)  CE_(k##0, k##2) CE_(k##1, k##3) CE_(k##4, k##6) CE_(k##5, k##7)  CE_(k##1, k##2) CE_(k##5, k##6) \
        CE_(k##0, k##4) CE_(k##1, k##5) CE_(k##2, k##6) CE_(k##3, k##7)  CE_(k##2, k##4) CE_(k##3, k##5)  CE_(k##1, k##2) CE_(k##3, k##4) CE_(k##5, k##6)
#define POP8(k, m, c) k##0 = c ? k##1 : k##0; k##1 = c ? k##2 : k##1; k##2 = c ? k##3 : k##2; k##3 = c ? k##4 : k##3; k##4 = c ? k##5 : k##4; k##5 = c ? k##6 : k##5; k##6 = c ? k##7 : k##6; k##7 = c ? 0u : k##7;
__device__ __forceinline__ void top16_row2(const f32x4 a0, const f32x4 b0, const f32x4 a1, const f32x4 b1, int li, unsigned& r0, unsigned& r1) {
    KEY8(x, a0, b0) KEY8(y, a1, b1)
    SORT8(x) SORT8(y)
    unsigned rx = 0u, ry = 0u;
#pragma unroll
    for (int r = 0; r < 16; ++r) {
        const unsigned mx = row_max_u(x0), my = row_max_u(y0); const bool cx = (x0 == mx), cy = (y0 == my);
        POP8(x, mx, cx) POP8(y, my, cy)
        rx = (li == r) ? mx : rx; ry = (li == r) ? my : ry;
    }
    r0 = rx; r1 = ry;
}
#undef KEY8
#undef SORT8
#undef POP8
__device__ __forceinline__ void phase_topk(const Ctx& C) {
    const float* SC = WSP(float, WS_SC); int* EI = WSP(int, WS_EI); float* GW = WSP(float, WS_GW);
    const int lane = C.lane, li = lane & 15, rowi = lane >> 4;
    LAS float* sv = (LAS float*)(C.lds + 4096 + C.wave * 1024);
    LAS int* si = (LAS int*)(sv + 128);
    LAS unsigned char* tab = (LAS unsigned char*)C.lds;
    if (C.tid < 64) { int c = C.tid, i = 0; for (; i < 16; ++i) { const int cnt = 16 / (i + 1); if (c < cnt) break; c -= cnt; } tab[C.tid] = (unsigned char)(C.tid < 50 ? (i | (c << 4)) : 0); }
    __syncthreads();
    int ica[4], jca[4];
#pragma unroll
    for (int q = 0; q < 4; ++q) { const int tb = tab[4 * li + q]; ica[q] = tb & 15; jca[q] = tb >> 4; }
    const int gw = C.bid * NWAVES + C.wave, NGW = C.G * NWAVES;
    f32x4 na0, nb0, na1, nb1;
    { const float* base = SC + (size_t)min(gw, TT * 2 - 1) * 1024;
      na0 = *(const f32x4*)(base + lane * 8); nb0 = *(const f32x4*)(base + lane * 8 + 4); na1 = *(const f32x4*)(base + 512 + lane * 8); nb1 = *(const f32x4*)(base + 512 + lane * 8 + 4); }
    for (int g4 = gw; g4 < TT * 2; g4 += NGW) {
        const int row = g4 >> 1, hd0 = (g4 & 1) * 4;
        const f32x4 a0 = na0, b0 = nb0, a1 = na1, b1 = nb1;
        { const float* base = SC + (size_t)min(g4 + NGW, TT * 2 - 1) * 1024;
          na0 = *(const f32x4*)(base + lane * 8); nb0 = *(const f32x4*)(base + lane * 8 + 4); na1 = *(const f32x4*)(base + 512 + lane * 8); nb1 = *(const f32x4*)(base + 512 + lane * 8 + 4); }
        unsigned r0, r1; top16_row2(a0, b0, a1, b1, li, r0, r1);
        sv[lane] = unmono(r0 & ~127u); si[lane] = 127 - (int)(r0 & 127u); sv[64 + lane] = unmono(r1 & ~127u); si[64 + lane] = 127 - (int)(r1 & 127u);
        LDS_WAIT();
        const LAS float* v1 = sv + rowi * 32; const LAS float* v2 = v1 + 16;
        unsigned k[4];
#pragma unroll
        for (int q = 0; q < 4; ++q) { const int c = 4 * li + q; const float sum = v1[ica[q]] + v2[jca[q]]; k[q] = (c < 50) ? ((mono(sum) & ~63u) | (unsigned)(63 - c)) : 0u; }
        CE_(k[0], k[1]) CE_(k[2], k[3]) CE_(k[0], k[2]) CE_(k[1], k[3]) CE_(k[1], k[2])
        unsigned res = 0u;
#pragma unroll
        for (int r = 0; r < 16; ++r) {
            const unsigned m = row_max_u(k[0]); const bool c = (k[0] == m);
            k[0] = c ? k[1] : k[0]; k[1] = c ? k[2] : k[1]; k[2] = c ? k[3] : k[2]; k[3] = c ? 0u : k[3];
            res = (li == r) ? m : res;
        }
        const int csel = 63 - (int)(res & 63u); const int tb = tab[csel];
        const int e1 = (si + rowi * 32)[tb & 15], e2 = (si + rowi * 32 + 16)[tb >> 4];
        const float svv = unmono(res & ~63u);
        const float mx = row_max_f(svv), ex = __expf(svv - mx), den = row_sum_f(ex);
        const size_t o = (size_t)row * 128 + (hd0 + rowi) * 16 + li;
        EI[o] = e1 * 128 + e2; GW[o] = ex / den;
        LDS_WAIT();
    }
    __syncthreads();
}

template <int CTRL> __device__ __forceinline__ float dpp_f(float v) { return __int_as_float(__builtin_amdgcn_update_dpp(0, __float_as_int(v), CTRL, 0xf, 0xf, true)); }
__device__ __forceinline__ float swap16_f(float v, int lane) { auto r = __builtin_amdgcn_permlane16_swap(__float_as_uint(v), __float_as_uint(v), false, false); return __uint_as_float((lane & 16) ? r[0] : r[1]); }
constexpr int PEER_SLICES = 8;
#define PEER_LOAD_E(E, t_) { const u32x4* ep_ = (const u32x4*)(EI + (size_t)(t_) * 128 + r8 * 16); E[0] = ep_[0]; E[1] = ep_[1]; E[2] = ep_[2]; E[3] = ep_[3]; }
#define PEER_GATHER(U, E, base_, coff_) { _Pragma("unroll") for (int q_ = 0; q_ < 4; ++q_) { U[4 * q_] = *(const u32x4*)((base_) + (E[q_].x * 128u + (coff_))); U[4 * q_ + 1] = *(const u32x4*)((base_) + (E[q_].y * 128u + (coff_))); \
        U[4 * q_ + 2] = *(const u32x4*)((base_) + (E[q_].z * 128u + (coff_))); U[4 * q_ + 3] = *(const u32x4*)((base_) + (E[q_].w * 128u + (coff_))); } }
#define FP8LO(d) __builtin_amdgcn_cvt_pk_f32_fp8((int)(d), false)
#define FP8HI(d) __builtin_amdgcn_cvt_pk_f32_fp8((int)(d), true)
__device__ __forceinline__ void peer_u_reduce(const u32x4 (&U)[16], const u32x4 hq0, const u32x4 hq1, float* po, int c, bool store) {
    f32x2 h[8];
    h[0] = (f32x2){bflo(hq0.x), bfhi(hq0.x)}; h[1] = (f32x2){bflo(hq0.y), bfhi(hq0.y)}; h[2] = (f32x2){bflo(hq0.z), bfhi(hq0.z)}; h[3] = (f32x2){bflo(hq0.w), bfhi(hq0.w)};
    h[4] = (f32x2){bflo(hq1.x), bfhi(hq1.x)}; h[5] = (f32x2){bflo(hq1.y), bfhi(hq1.y)}; h[6] = (f32x2){bflo(hq1.z), bfhi(hq1.z)}; h[7] = (f32x2){bflo(hq1.w), bfhi(hq1.w)};
    float p[16];
#pragma unroll
    for (int i = 0; i < 16; ++i) {
        f32x2 s0 = FP8LO(U[i].x) * h[0], s1 = FP8HI(U[i].x) * h[1];
        s0 = __builtin_elementwise_fma(FP8LO(U[i].y), h[2], s0); s1 = __builtin_elementwise_fma(FP8HI(U[i].y), h[3], s1);
        s0 = __builtin_elementwise_fma(FP8LO(U[i].z), h[4], s0); s1 = __builtin_elementwise_fma(FP8HI(U[i].z), h[5], s1);
        s0 = __builtin_elementwise_fma(FP8LO(U[i].w), h[6], s0); s1 = __builtin_elementwise_fma(FP8HI(U[i].w), h[7], s1);
        s0 = s0 + s1; p[i] = s0.x + s0.y;
    }
#pragma unroll
    for (int bq = 0; bq < 2; ++bq) { float* q = p + 8 * bq;
        { const bool up = (c & 4) != 0;
#pragma unroll
          for (int j = 0; j < 4; ++j) { const float mine = up ? q[j + 4] : q[j], send = up ? q[j] : q[j + 4]; q[j] = mine + dpp_f<0x141>(send); } }
        { const bool up = (c & 2) != 0;
#pragma unroll
          for (int j = 0; j < 2; ++j) { const float mine = up ? q[j + 2] : q[j], send = up ? q[j] : q[j + 2]; q[j] = mine + dpp_f<0x4E>(send); } }
        { const bool up = (c & 1) != 0; const float mine = up ? q[1] : q[0], send = up ? q[0] : q[1]; q[0] = mine + dpp_f<0xB1>(send); } }
    if (store) { po[0] = p[0]; po[8] = p[8]; }
}
__device__ __forceinline__ void phase_peer_u(const Ctx& C) {
    const int lane = C.lane, r8 = lane >> 3, c = lane & 7;
    const bf16_t* H2 = WSP(bf16_t, WS_B0); const unsigned char* U8 = C.ws + WS_U8; const int* EI = WSP(int, WS_EI); float* PA = WSP(float, WS_SC);
    const int s = C.bid & 7, wg = (C.bid >> 3) * NWAVES + C.wave, nwg = (C.G >> 3) * NWAVES;
    const int n = (TT - wg + nwg - 1) / nwg;
    const unsigned char* ub = U8 + (size_t)s * NE * 128; const unsigned coff = (unsigned)c * 16u; const bf16_t* hb = H2 + s * 128 + c * 16;
    float* pab = PA + (size_t)s * 128 + r8 * 16 + c;
#define TOK(i_) (min(wg + (i_) * nwg, TT - 1))
#define LOAD_H(H0, H1, t_) { const u32x4* hp_ = (const u32x4*)(hb + (size_t)(t_) * DM); H0 = hp_[0]; H1 = hp_[1]; }
    u32x4 uA[16], uB[16], en[4], enn[4], hc0, hc1, hn0, hn1, hnn0, hnn1;
    PEER_LOAD_E(en, TOK(0)); LOAD_H(hc0, hc1, TOK(0));
    PEER_GATHER(uA, en, ub, coff);
    PEER_LOAD_E(en, TOK(1)); LOAD_H(hn0, hn1, TOK(1));
    for (int i = 0; i < n; i += 2) {
        PEER_GATHER(uB, en, ub, coff);
        PEER_LOAD_E(enn, TOK(i + 2)); LOAD_H(hnn0, hnn1, TOK(i + 2));
        peer_u_reduce(uA, hc0, hc1, pab + (size_t)TOK(i) * (PEER_SLICES * 128), c, true);
        hc0 = hn0; hc1 = hn1; hn0 = hnn0; hn1 = hnn1;
        PEER_GATHER(uA, enn, ub, coff);
        PEER_LOAD_E(en, TOK(i + 3)); LOAD_H(hnn0, hnn1, TOK(i + 3));
        peer_u_reduce(uB, hc0, hc1, pab + (size_t)TOK(i + 1) * (PEER_SLICES * 128), c, i + 1 < n);
        hc0 = hn0; hc1 = hn1; hn0 = hnn0; hn1 = hnn1;
    }
#undef LOAD_H
#undef TOK
}
__device__ __forceinline__ void phase_peer_act(const Ctx& C) {
    const float* PA = WSP(float, WS_SC); float* GW = WSP(float, WS_GW); const int* EI = WSP(int, WS_EI); const float* SU = WSP(float, WS_SU); const float* SV = WSP(float, WS_SV);
    const size_t n = (size_t)TT * 128, stride = (size_t)C.G * NTHREADS;
    for (size_t i = (size_t)C.bid * NTHREADS + C.tid; i < n; i += stride) {
        const size_t t = i >> 7; const int k = (int)(i & 127); const float* pp = PA + t * (PEER_SLICES * 128) + k;
        float a = 0.f;
#pragma unroll
        for (int s = 0; s < PEER_SLICES; ++s) a += pp[s * 128];
        const int e = EI[i];
        GW[i] = geluf_(a * SU[e]) * GW[i] * SV[e];
    }
}
#define PEER_LOAD_A(A, t_) { const f32x4* ap_ = (const f32x4*)(ACT + (size_t)(t_) * 128 + r8 * 16); A[0] = ap_[0]; A[1] = ap_[1]; A[2] = ap_[2]; A[3] = ap_[3]; }
#define PEER_GATHER8(U, E0, E1, base_, coff_) { U[0] = *(const u32x4*)((base_) + (E0.x * 128u + (coff_))); U[1] = *(const u32x4*)((base_) + (E0.y * 128u + (coff_))); U[2] = *(const u32x4*)((base_) + (E0.z * 128u + (coff_))); U[3] = *(const u32x4*)((base_) + (E0.w * 128u + (coff_))); \
        U[4] = *(const u32x4*)((base_) + (E1.x * 128u + (coff_))); U[5] = *(const u32x4*)((base_) + (E1.y * 128u + (coff_))); U[6] = *(const u32x4*)((base_) + (E1.z * 128u + (coff_))); U[7] = *(const u32x4*)((base_) + (E1.w * 128u + (coff_))); }
__device__ __forceinline__ void peer_v_acc8(f32x2 (&o)[8], const u32x4 (&V)[8], const f32x4 A0, const f32x4 A1) {
#pragma unroll
    for (int i = 0; i < 8; ++i) { const float a = i < 4 ? A0[i & 3] : A1[i & 3]; const f32x2 a2 = (f32x2){a, a};
        o[0] = __builtin_elementwise_fma(FP8LO(V[i].x), a2, o[0]); o[1] = __builtin_elementwise_fma(FP8HI(V[i].x), a2, o[1]);
        o[2] = __builtin_elementwise_fma(FP8LO(V[i].y), a2, o[2]); o[3] = __builtin_elementwise_fma(FP8HI(V[i].y), a2, o[3]);
        o[4] = __builtin_elementwise_fma(FP8LO(V[i].z), a2, o[4]); o[5] = __builtin_elementwise_fma(FP8HI(V[i].z), a2, o[5]);
        o[6] = __builtin_elementwise_fma(FP8LO(V[i].w), a2, o[6]); o[7] = __builtin_elementwise_fma(FP8HI(V[i].w), a2, o[7]); }
}
__device__ __forceinline__ f32x2 peer_v_scatter(const f32x2 (&o2)[8], int lane) {
    float o[16];
#pragma unroll
    for (int j = 0; j < 8; ++j) { o[2 * j] = o2[j].x; o[2 * j + 1] = o2[j].y; }
    { const bool up = (lane & 32) != 0;
#pragma unroll
      for (int j = 0; j < 8; ++j) { const float mine = up ? o[j + 8] : o[j], send = up ? o[j] : o[j + 8]; o[j] = mine + shfx<32>(send, lane); } }
    { const bool up = (lane & 16) != 0;
#pragma unroll
      for (int j = 0; j < 4; ++j) { const float mine = up ? o[j + 4] : o[j], send = up ? o[j] : o[j + 4]; o[j] = mine + swap16_f(send, lane); } }
    { const bool up = (lane & 8) != 0;
#pragma unroll
      for (int j = 0; j < 2; ++j) { const float mine = up ? o[j + 2] : o[j], send = up ? o[j] : o[j + 2]; o[j] = mine + dpp_f<0x128>(send); } }
    return (f32x2){o[0], o[1]};
}
__device__ __forceinline__ void phase_peer_v(const Ctx& C, int l, bool dry = false) {
    const int lane = C.lane, r8 = lane >> 3, c = lane & 7;
    const unsigned char* V8 = C.ws + WS_V8; const int* EI = WSP(int, WS_EI); const float* ACT = WSP(float, WS_GW); const float* MOD = WSP(float, WS_MOD);
    const int s = C.bid & 7, wg = (C.bid >> 3) * NWAVES + C.wave, nwg = (C.G >> 3) * NWAVES;
    const int n = (TT - wg + nwg - 1) / nwg;
    const int jcol = ((lane >> 5) & 1) * 8 + ((lane >> 4) & 1) * 4 + ((lane >> 3) & 1) * 2;
    const int col = s * 128 + c * 16 + jcol;
    const unsigned char* vb = V8 + (size_t)s * NE * 128; const unsigned coff = (unsigned)c * 16u;
    float* xb = C.out + col; const float* g2 = MOD + (size_t)l * NBT * 6144 + 5120 + col;
#define TOK(i_) (min(wg + (i_) * nwg, TT - 1))
    u32x4 vA[8], vB[8], ec[4], en[4]; f32x4 ac[4], an[4];
    PEER_LOAD_E(ec, TOK(0)); PEER_LOAD_A(ac, TOK(0));
    PEER_GATHER8(vA, ec[0], ec[1], vb, coff);
    PEER_LOAD_E(en, TOK(1)); PEER_LOAD_A(an, TOK(1));
    for (int i = 0; i < n; ++i) {
        const int t = TOK(i);
        PEER_GATHER8(vB, ec[2], ec[3], vb, coff);
        const f32x2 xv = *(const f32x2*)(xb + (size_t)t * DM), gv = *(const f32x2*)(g2 + (size_t)row_batch(t) * 6144);
        f32x2 o[8];
#pragma unroll
        for (int j = 0; j < 8; ++j) o[j] = (f32x2){0.f, 0.f};
        peer_v_acc8(o, vA, ac[0], ac[1]);
        PEER_GATHER8(vA, en[0], en[1], vb, coff);
        peer_v_acc8(o, vB, ac[2], ac[3]);
#pragma unroll
        for (int q = 0; q < 4; ++q) { ec[q] = en[q]; ac[q] = an[q]; }
        PEER_LOAD_E(en, TOK(i + 2)); PEER_LOAD_A(an, TOK(i + 2));
        const f32x2 ov = peer_v_scatter(o, lane);
        asm volatile("" :: "v"(ov.x), "v"(ov.y));
        if (!dry) *(f32x2*)(xb + (size_t)t * DM) = xv + gv * ov;
    }
#undef TOK
}
#undef PEER_GATHER8
#undef PEER_LOAD_E
#undef PEER_LOAD_A
#undef PEER_GATHER
__device__ __forceinline__ void phase_final_norm(const Ctx& C) {
    const int gw = C.bid * NWAVES + C.wave, NGW = C.G * NWAVES; const float* fw = as_global(C.P->in[IN_FNW]);
    for (int row = gw; row < TT; row += NGW) {
        f32x4* xr = (f32x4*)(C.out + (size_t)row * DM) + C.lane;
        f32x4 v[4]; float s = 0.f;
#pragma unroll
        for (int j = 0; j < 4; ++j) { v[j] = xr[64 * j]; s += (v[j][0] * v[j][0] + v[j][1] * v[j][1]) + (v[j][2] * v[j][2] + v[j][3] * v[j][3]); }
        const float rstd = rsqrtf(wave_sum(s) * (1.f / DM) + EPS);
#pragma unroll
        for (int j = 0; j < 4; ++j) xr[64 * j] = v[j] * rstd * *(const f32x4*)(fw + C.lane * 4 + 256 * j);
    }
}


#define XB_TMO      128
#define XB_XCNT(j)  (256  + 64 * (j))
#define XB_XSUB(j)  (1280 + 64 * (j))
#define XB_XGEN(j)  (2304 + 64 * (j))
#define XB_TOP      3328
#define XB_TOPGEN   3392
#define XCD_BAR_WORDS 3456
#define XB_SPIN_CAP (1u << 22)
__device__ __forceinline__ unsigned xb_ld(unsigned* p)              { return __hip_atomic_load(p, __ATOMIC_RELAXED, __HIP_MEMORY_SCOPE_AGENT); }
__device__ __forceinline__ unsigned xb_add(unsigned* p, unsigned v) { return __hip_atomic_fetch_add(p, v, __ATOMIC_RELAXED, __HIP_MEMORY_SCOPE_AGENT); }
__device__ __forceinline__ unsigned xb_xcc_id() { return (unsigned)__builtin_amdgcn_s_getreg((3 << 11) | 20) & 0xFu; }
#define XB_SPIN(cond, bar) do { unsigned _sp = 0; while (cond) { __builtin_amdgcn_s_sleep(1); \
    if ((++_sp & 255u) == 0u) { if (xb_ld(&(bar)[XB_TMO])) break; if (_sp > XB_SPIN_CAP) { atomicAdd(&(bar)[XB_TMO], 1u); break; } } } } while (0)
struct XcdBarrier { unsigned* bar; unsigned x; volatile LAS unsigned* st; };
__device__ __forceinline__ XcdBarrier xcd_barrier_post(unsigned* bar, volatile LAS unsigned* st) {
    XcdBarrier b; b.bar = bar; b.x = xb_xcc_id(); b.st = st;
    if (threadIdx.x == 0) (void)xb_add(&bar[XB_XCNT(b.x)], 1u);
    return b;
}
__device__ __forceinline__ void xcd_barrier_complete(unsigned* bar, unsigned x, unsigned& nloc, unsigned& nx) {
    const unsigned G = gridDim.x * gridDim.y * gridDim.z;
    unsigned sum, cnt, mine, sp = 0u;
    for (;;) {
        sum = 0u; cnt = 0u; mine = 0u;
#pragma unroll
        for (unsigned j = 0; j < 16; ++j) { const unsigned c = xb_ld(&bar[XB_XCNT(j)]); sum += c; cnt += (c > 0u) ? 1u : 0u; mine = (j == x) ? c : mine; }
        if (sum == G) break;
        __builtin_amdgcn_s_sleep(1);
        if ((++sp & 255u) == 0u) { if (xb_ld(&bar[XB_TMO])) break; if (sp > XB_SPIN_CAP) { atomicAdd(&bar[XB_TMO], 1u); break; } }
    }
    nloc = mine > 0u ? mine : 1u; nx = cnt > 0u ? cnt : 1u;
}
__device__ __forceinline__ void xcd_barrier(const XcdBarrier& b) {
    asm volatile("s_waitcnt vmcnt(0)" ::: "memory");
    __syncthreads();
    if (threadIdx.x == 0) {
        unsigned* bar = b.bar;
        __builtin_amdgcn_s_waitcnt(0);
        unsigned nloc = b.st[0], nx = b.st[1];
        if (nloc == 0u) { xcd_barrier_complete(bar, b.x, nloc, nx); b.st[0] = nloc; b.st[1] = nx; }
        const unsigned old = xb_add(&bar[XB_XSUB(b.x)], 1u);
        const unsigned gen = old / nloc;
        if (old + 1u == (gen + 1u) * nloc) {
            __builtin_amdgcn_fence(__ATOMIC_RELEASE, "agent");
            asm volatile("s_waitcnt vmcnt(0)" ::: "memory");
            const unsigned og = xb_add(&bar[XB_TOP], 1u);
            const unsigned tg = og / nx;
            if (og + 1u == (tg + 1u) * nx) xb_add(&bar[XB_TOPGEN], 1u);
            else XB_SPIN(xb_ld(&bar[XB_TOPGEN]) == tg, bar);
            __builtin_amdgcn_fence(__ATOMIC_ACQUIRE, "agent");
            xb_add(&bar[XB_XGEN(b.x)], 1u);
            asm volatile("s_waitcnt vmcnt(0)" ::: "memory");
        } else {
            XB_SPIN(xb_ld(&bar[XB_XGEN(b.x)]) == gen, bar);
            __builtin_amdgcn_fence(__ATOMIC_ACQUIRE, "agent");
            asm volatile("s_waitcnt vmcnt(0)" ::: "memory");
        }
    }
    __syncthreads();
}

__device__ __forceinline__ Ctx relaunder(const Ctx& C) {
    Ctx D = C; int t = C.tid; asm volatile("" : "+v"(t)); D.tid = t; D.lane = t & 63;
    unsigned char* w = C.ws; float* o = C.out; asm volatile("" : "+s"(w), "+s"(o)); D.ws = as_global(w); D.out = as_global(o); return D;
}
constexpr int NPL = 13, NPH = 2 + 2 * NPL;
__device__ __forceinline__ void run_phase(const Ctx& C0, int ph, bool dry) {
    if (ph == 0) { const Ctx C = relaunder(C0); phase_prep(C); return; }
    if (ph == NPH - 1) { const Ctx C = relaunder(C0); phase_final_norm(C); return; }
    const int l = (ph - 1) / NPL, k = (ph - 1) % NPL;
    switch (k) {
    case 0: { const Ctx C = relaunder(C0); phase_norm(C, l, 0); } break;
    case 1: { const Ctx C = relaunder(C0); CParams& P = *C.P; Epi1 E{WSP(bf16_t, WS_B1), WSP(bf16_t, WS_B2), WSP(bf16_t, WS_B3), WSP(bf16_t, WS_B4), WSP(float, WS_DT), as_global(P.in[IN_DTB]) + l * 16};
              gemm_run(C, WSP(bf16_t, WS_B0), WSP(bf16_t, WS_W1T) + (size_t)l * N1 * DM, nullptr, nullptr, N1, E); } break;
    case 2: { const Ctx C = relaunder(C0); phase_convbc(C, l); } break;
    case 3: { const Ctx C = relaunder(C0); phase_scan(C, l, dry); } break;
    case 4: { const Ctx C = relaunder(C0); Epi2 E{WSP(bf16_t, WS_GS), WSP(bf16_t, WS_GL)};
              gemm_run(C, WSP(bf16_t, WS_B0), WSP(bf16_t, WS_WGT) + (size_t)l * NG * DM, nullptr, nullptr, NG, E); } break;
    case 5: { const Ctx C = relaunder(C0); Epi3 E{WSP(bf16_t, WS_GS), WSP(bf16_t, WS_GL), WSP(float, WS_SSQ), WSP(bf16_t, WS_B0)};
              gemm_run(C, WSP(bf16_t, WS_B1), WSP(bf16_t, WS_WBS) + (size_t)l * DM * DM, WSP(bf16_t, WS_B4), WSP(bf16_t, WS_WBL) + (size_t)l * DM * DM, DM, E); } break;
    case 6: { const Ctx C = relaunder(C0); CParams& P = *C.P; Epi4 E{as_global(P.in[IN_XP]), as_global(P.in[IN_XS]), C.out, WSP(float, WS_MOD) + (size_t)l * NBT * 6144, l};
              gemm_run(C, WSP(bf16_t, WS_B0), WSP(bf16_t, WS_WO) + (size_t)l * DM * DM, nullptr, nullptr, DM, E); } break;
    case 7: { const Ctx C = relaunder(C0); phase_norm(C, l, 1); } break;
    case 8: { const Ctx C = relaunder(C0); Epi5 E{WSP(float, WS_SC)};
              gemm_run(C, WSP(bf16_t, WS_B0), WSP(bf16_t, WS_WC) + (size_t)l * 2048 * DM, nullptr, nullptr, 2048, E); } break;
    case 9: { const Ctx C = relaunder(C0); phase_topk(C); } break;
    case 10: { const Ctx C = relaunder(C0); phase_peer_u(C); } break;
    case 11: { const Ctx C = relaunder(C0); phase_peer_act(C); } break;
    case 12: { const Ctx C = relaunder(C0); phase_peer_v(C, l, dry); } break;
    }
}

__global__ void __launch_bounds__(NTHREADS, 2) fwd(Params P) {
    extern __shared__ __attribute__((aligned(16))) unsigned char lds_raw[];
    const int ph_lo = P.ph_lo, ph_hi = P.ph_hi;
    volatile LAS unsigned* bst = (volatile LAS unsigned*)((LAS unsigned char*)lds_raw + LDS_BYTES - 64);
    if (threadIdx.x == 0) { bst[0] = 0u; bst[1] = 0u; }
    __syncthreads();
    (void)xcd_barrier_post((unsigned*)(P.ws + WS_CTL), bst);
    for (int ph = ph_lo; ph < ph_hi; ++ph) {
        CParams* Pp = (CParams*)__builtin_amdgcn_kernarg_segment_ptr(); asm volatile("" : "+s"(Pp));
        Ctx C; C.P = Pp; C.lds = (LAS unsigned char*)lds_raw;
        int tid = threadIdx.x; asm volatile("" : "+v"(tid));
        unsigned char* ws = Pp->ws; float* out = Pp->out; asm volatile("" : "+s"(ws), "+s"(out));
        C.ws = ws; C.out = out;
        C.tid = tid; C.lane = tid & 63; C.wave = __builtin_amdgcn_readfirstlane(tid >> 6); C.bid = blockIdx.x; C.G = gridDim.x;
#ifdef PROBE_K
        { const bool hit = (PROBE_K == 100) ? ph == 0 : ((PROBE_K == 101) ? ph == NPH - 1 : (ph > 0 && ph < NPH - 1 && (ph - 1) % NPL == PROBE_K));
          if (hit) for (int rep = 0; rep < PROBE_N; ++rep) { run_phase(C, ph, true); __syncthreads(); } }
#endif
        run_phase(C, ph, false);
        if (ph + 1 < ph_hi) { if (ph == 0) cg::this_grid().sync();
            else { XcdBarrier xb; xb.bar = (unsigned*)(ws + WS_CTL); xb.x = xb_xcc_id(); xb.st = (volatile LAS unsigned*)((LAS unsigned char*)lds_raw + LDS_BYTES - 64); xcd_barrier(xb); } }
    }
}

extern "C" void kernel_launch(void* const* d_in, const int* in_sizes, int n_in, void* d_out, int out_size, void* d_ws, size_t ws_size, hipStream_t stream) {
    static int grid = 0;
    if (grid == 0) {
        if (n_in != N_IN || (size_t)out_size != O_END || ws_size < WS_END) { fprintf(stderr, "kernel_launch: unexpected shapes n_in %d out %d ws %zu (need %zu)\n", n_in, out_size, ws_size, (size_t)WS_END); grid = -1; return; }
        int dev = 0, cus = 0, per_cu = 0;
        hipGetDevice(&dev); hipDeviceGetAttribute(&cus, hipDeviceAttributeMultiprocessorCount, dev);
        hipFuncSetAttribute((const void*)fwd, hipFuncAttributeMaxDynamicSharedMemorySize, LDS_BYTES);
        hipOccupancyMaxActiveBlocksPerMultiprocessor(&per_cu, (const void*)fwd, NTHREADS, LDS_BYTES);
        if (per_cu < 1) { fprintf(stderr, "kernel_launch: occupancy query says %d blocks/CU\n", per_cu); per_cu = 1; }
        grid = cus;
        fprintf(stderr, "kernel_launch: cus %d per_cu %d grid %d ws %zu\n", cus, per_cu, grid, ws_size);
    }
    if (grid < 0) return;
    Params p{};
    for (int i = 0; i < N_IN; ++i) p.in[i] = (const float*)d_in[i];
    p.out = (float*)d_out; p.ws = (unsigned char*)d_ws;
    hipMemsetAsync((char*)d_ws + WS_CTL, 0, 65536, stream);
#if MEGA
    p.ph_lo = 0; p.ph_hi = NPH;
    void* args[] = {&p};
    hipError_t e = hipLaunchCooperativeKernel((const void*)fwd, dim3(grid), dim3(NTHREADS), args, LDS_BYTES, stream);
    if (e != hipSuccess) fprintf(stderr, "cooperative launch failed: %s\n", hipGetErrorString(e));
#else
    for (int ph = 0; ph < NPH; ++ph) { p.ph_lo = ph; p.ph_hi = ph + 1; hipLaunchKernelGGL(fwd, dim3(grid), dim3(NTHREADS), LDS_BYTES, stream, p); }
#endif
}
```

```cpp
#include <hip/hip_runtime.h>
#include <hip/hip_cooperative_groups.h>
#include <cstdio>
#include <cstdint>
namespace cg = cooperative_groups;

#ifndef MEGA
#define MEGA 1
#endif

#define LAS __attribute__((address_space(3)))
typedef unsigned short bf16_t;
typedef __bf16 bf16x2_t __attribute__((ext_vector_type(2)));
typedef short bf16x8 __attribute__((ext_vector_type(8)));
typedef float f32x4 __attribute__((ext_vector_type(4)));
typedef float f32x16 __attribute__((ext_vector_type(16)));
typedef unsigned u32x4 __attribute__((ext_vector_type(4)));
typedef unsigned u32x2 __attribute__((ext_vector_type(2)));

constexpr int DM = 1024;
constexpr int TP = 32768, TS = 128, TT = TP + TS, MT = 33024;
constexpr int NBT = 24;
constexpr int N1 = 4608;
constexpr int NG = 2048;
constexpr int NE = 16384;
constexpr int INC = 6416;
constexpr float EPS = 1e-6f;
constexpr int NWAVES = 8, NTHREADS = 512;
constexpr int LDS_BYTES = 150528;

enum { IN_XP = 0, IN_XS, IN_CP, IN_CS, IN_SSD, IN_SSDCONV, IN_LRU, IN_LRUCONV, IN_LN1, IN_LN2, IN_WMOD, IN_BMOD, IN_WIN, IN_SCW, IN_SCB, IN_DTB,
       IN_ALOG, IN_SSDD, IN_SNW, IN_LCW, IN_LCB, IN_WA, IN_BA, IN_WX, IN_BX, IN_LAM, IN_WBS, IN_WBL, IN_WO, IN_WQ, IN_K1, IN_K2, IN_U, IN_V, IN_FNW, N_IN };

constexpr size_t O_Y = 0, O_PSSD = 33685504, O_PSCONV = 35782656, O_PLRU = 35905536, O_PLCONV = 35938304,
                 O_SSSD = 36036608, O_SSCONV = 37085184, O_SLRU = 37146624, O_SLCONV = 37163008, O_END = 37212160;

constexpr size_t al256(size_t x) { return (x + 255) & ~(size_t)255; }
constexpr size_t WS_CTL = 0;
constexpr size_t WS_MOD = 1u << 20;
constexpr size_t WS_DT = al256(WS_MOD + (size_t)2 * NBT * 6144 * 4);
constexpr size_t WS_SSQ = al256(WS_DT + (size_t)MT * 16 * 4);
constexpr size_t WS_W1T = al256(WS_SSQ + (size_t)MT * 16 * 4);
constexpr size_t WS_WGT = al256(WS_W1T + (size_t)2 * N1 * DM * 2);
constexpr size_t WS_WBS = al256(WS_WGT + (size_t)2 * NG * DM * 2);
constexpr size_t WS_WBL = al256(WS_WBS + (size_t)2 * DM * DM * 2);
constexpr size_t WS_WO = al256(WS_WBL + (size_t)2 * DM * DM * 2);
constexpr size_t WS_WC = al256(WS_WO + (size_t)2 * DM * DM * 2);
constexpr size_t WS_U16 = al256(WS_WC + (size_t)2 * 2048 * DM * 2);
constexpr size_t WS_V16 = al256(WS_U16 + (size_t)NE * DM * 2);
constexpr size_t WS_EI = al256(WS_V16 + (size_t)NE * DM * 2);
constexpr size_t WS_GW = al256(WS_EI + (size_t)MT * 128 * 4);
constexpr size_t WS_B0 = al256(WS_GW + (size_t)MT * 128 * 4);
constexpr size_t WS_B1 = al256(WS_B0 + (size_t)MT * DM * 2);
constexpr size_t WS_B2 = al256(WS_B1 + (size_t)MT * DM * 2);
constexpr size_t WS_B3 = al256(WS_B2 + (size_t)MT * 1280 * 2);
constexpr size_t WS_B4 = al256(WS_B3 + (size_t)MT * DM * 2);
constexpr size_t WS_END = al256(WS_B4 + (size_t)MT * DM * 2);
constexpr size_t WS_GS = WS_B2, WS_GL = WS_B2 + (size_t)MT * DM * 2;
constexpr size_t WS_SC = WS_B1;
static_assert(WS_GL + (size_t)MT * DM * 2 <= WS_B4, "gate overlay");
static_assert(WS_SC + (size_t)MT * 2048 * 4 <= WS_END, "score overlay");
static_assert(WS_END <= (size_t)512 << 20, "d_ws budget");

struct Params {
    const float* in[N_IN];
    float* out;
    unsigned char* ws;
    int ph_lo, ph_hi;
};

__device__ __forceinline__ unsigned f2bf(float f) { return (unsigned)__builtin_bit_cast(unsigned short, (__bf16)f); }
__device__ __forceinline__ float bf2f(unsigned b) { return __uint_as_float(b << 16); }
__device__ __forceinline__ unsigned pk2(float lo, float hi) { typedef float f32x2_ __attribute__((ext_vector_type(2))); return __builtin_bit_cast(unsigned, __builtin_convertvector((f32x2_){lo, hi}, bf16x2_t)); }
__device__ __forceinline__ float bflo(unsigned w) { return __uint_as_float(w << 16); }
__device__ __forceinline__ float bfhi(unsigned w) { return __uint_as_float(w & 0xffff0000u); }
template <int M> __device__ __forceinline__ int shfx_i(int v, int lane) {
    if constexpr (M == 32) { auto r = __builtin_amdgcn_permlane32_swap((unsigned)v, (unsigned)v, false, false); return (int)((lane & 32) ? r[0] : r[1]); }
    else return __builtin_amdgcn_ds_swizzle(v, 0x1f | (M << 10));
}
template <int M> __device__ __forceinline__ float shfx(float v, int lane) { return __int_as_float(shfx_i<M>(__float_as_int(v), lane)); }
__device__ __forceinline__ float shfl_f(float v, int src) { return __int_as_float(__builtin_amdgcn_ds_bpermute(src << 2, __float_as_int(v))); }
__device__ __forceinline__ int shfl_i(int v, int src) { return __builtin_amdgcn_ds_bpermute(src << 2, v); }
template <int CTRL> __device__ __forceinline__ float dppf_(float v) { return __int_as_float(__builtin_amdgcn_update_dpp(0, __float_as_int(v), CTRL, 0xf, 0xf, true)); }
__device__ __forceinline__ float row8_sum(float v) { v += dppf_<0xB1>(v); v += dppf_<0x4E>(v); v += dppf_<0x141>(v); return v; }
__device__ __forceinline__ float wave_sum(float v) {
    v += dppf_<0xB1>(v); v += dppf_<0x4E>(v); v += dppf_<0x141>(v); v += dppf_<0x140>(v);
    { auto r = __builtin_amdgcn_permlane16_swap(__float_as_uint(v), __float_as_uint(v), false, false); v = __uint_as_float(r[0]) + __uint_as_float(r[1]); }
    { auto r = __builtin_amdgcn_permlane32_swap(__float_as_uint(v), __float_as_uint(v), false, false); v = __uint_as_float(r[0]) + __uint_as_float(r[1]); }
    return v;
}
__device__ __forceinline__ float exp_fast(float x) { return __builtin_amdgcn_exp2f(x * 1.4426950408889634f); }
__device__ __forceinline__ float sigmoidf_(float x) { return __builtin_amdgcn_rcpf(1.0f + exp_fast(-x)); }
__device__ __forceinline__ float siluf_(float x) { return x * __builtin_amdgcn_rcpf(1.0f + exp_fast(-x)); }
__device__ __forceinline__ float geluf_(float x) { const float u = 1.5957691216057308f * (x + 0.044715f * x * x * x); return x * __builtin_amdgcn_rcpf(1.0f + exp_fast(-u)); }
__device__ __forceinline__ float softplusf_(float x) { return fmaxf(x, 0.f) + log1pf(__expf(-fabsf(x))); }
__device__ __forceinline__ int row_batch(int row) { return row < TP ? (row >> 11) : (row < TT ? 16 + ((row - TP) >> 4) : 23); }
__device__ __forceinline__ float dot2bf(unsigned a, unsigned b, float acc) { return __builtin_amdgcn_fdot2_f32_bf16(__builtin_bit_cast(bf16x2_t, a), __builtin_bit_cast(bf16x2_t, b), acc, false); }
__device__ __forceinline__ float rl(float v, int lane) { return __int_as_float(__builtin_amdgcn_readlane(__float_as_int(v), lane)); }
#define LDS_WAIT() asm volatile("s_waitcnt lgkmcnt(0)" ::: "memory")
#define MFMA32(a, b, c) __builtin_amdgcn_mfma_f32_32x32x16_bf16((a), (b), (c), 0, 0, 0)

typedef const __attribute__((address_space(4))) Params CParams;
template <class T> __device__ __forceinline__ T* as_global(T* p) { __attribute__((address_space(1))) T* g = (__attribute__((address_space(1))) T*)p; asm volatile("" : "+s"(g)); return (T*)g; }
struct Ctx {
    CParams* P; LAS unsigned char* lds; unsigned char* ws; float* out;
    int tid, lane, wave, bid, G;
};
#define WSP(T, off) (as_global((T*)(C.ws + (off))))

__device__ __forceinline__ void tr_item(const float* W, int ldw, int src_col0, int valid, const float* kscale, int k0, bf16_t* dst, LAS float* scr, int lane) {
    const int c4 = lane & 7, r0 = lane >> 3;
    f32x4 v[8];
#pragma unroll
    for (int i = 0; i < 8; ++i) { const int kk = r0 + 8 * i; v[i] = (4 * c4 < valid) ? *(const f32x4*)(W + (size_t)(k0 + kk) * ldw + src_col0 + 4 * c4) : (f32x4){0.f, 0.f, 0.f, 0.f}; }
#pragma unroll
    for (int i = 0; i < 8; ++i) { const int kk = r0 + 8 * i; const float ks = kscale ? kscale[k0 + kk] : 1.0f; LAS float* s = scr + kk * 33 + 4 * c4;
        s[0] = v[i][0] * ks; s[1] = v[i][1] * ks; s[2] = v[i][2] * ks; s[3] = v[i][3] * ks; }
    LDS_WAIT();
    const int c8 = lane & 7;
#pragma unroll
    for (int j = 0; j < 4; ++j) { const int n = (lane >> 3) + 8 * j; const LAS float* s = scr + (8 * c8) * 33 + n;
        u32x4 o; o.x = pk2(s[0 * 33], s[1 * 33]); o.y = pk2(s[2 * 33], s[3 * 33]); o.z = pk2(s[4 * 33], s[5 * 33]); o.w = pk2(s[6 * 33], s[7 * 33]);
        *(u32x4*)(dst + (size_t)n * DM + k0 + 8 * c8) = o; }
    LDS_WAIT();
}
typedef float f32x2 __attribute__((ext_vector_type(2)));
typedef short s16x4_ __attribute__((ext_vector_type(4)));
constexpr size_t WS_U8 = WS_U16, WS_SU = WS_U16 + ((size_t)16 << 20), WS_V8 = WS_V16, WS_SV = WS_V16 + ((size_t)16 << 20);
__device__ __forceinline__ float wave_max(float v) {
    v = fmaxf(v, shfx<1>(v, 0)); v = fmaxf(v, shfx<2>(v, 0)); v = fmaxf(v, shfx<4>(v, 0)); v = fmaxf(v, shfx<8>(v, 0)); v = fmaxf(v, shfx<16>(v, 0));
    auto r = __builtin_amdgcn_permlane32_swap(__float_as_uint(v), __float_as_uint(v), false, false);
    return fmaxf(__uint_as_float(r[0]), __uint_as_float(r[1]));
}
__device__ __forceinline__ void convert_tables(const Ctx& C, int l) {
    const int gw = C.bid * NWAVES + C.wave, NGW = C.G * NWAVES, lane = C.lane;
    const float* up = as_global(C.P->in[IN_U]) + (size_t)l * NE * DM; const float* vp = as_global(C.P->in[IN_V]) + (size_t)l * NE * DM;
#define TROW(it_) (((it_) >= NE ? vp + (size_t)((it_) - NE) * DM : up + (size_t)(it_) * DM) + lane * 4)
    f32x4 nv[4];
    { const float* s0 = TROW(min(gw, 2 * NE - 1));
#pragma unroll
      for (int j = 0; j < 4; ++j) nv[j] = *(const f32x4*)(s0 + 256 * j); }
    for (int it = gw; it < 2 * NE; it += NGW) {
        const bool isv = it >= NE; const int e = isv ? it - NE : it;
        unsigned char* dst = C.ws + (isv ? WS_V8 : WS_U8); float* sc = (float*)(C.ws + (isv ? WS_SV : WS_SU));
        f32x4 v[4]; float m = 0.f;
#pragma unroll
        for (int j = 0; j < 4; ++j) { v[j] = nv[j]; m = fmaxf(m, fmaxf(fmaxf(fabsf(v[j][0]), fabsf(v[j][1])), fmaxf(fabsf(v[j][2]), fabsf(v[j][3])))); }
        { const float* s0 = TROW(min(it + NGW, 2 * NE - 1));
#pragma unroll
          for (int j = 0; j < 4; ++j) nv[j] = *(const f32x4*)(s0 + 256 * j); }
        m = wave_max(m);
        const float scale = m > 0.f ? m * (1.0f / 440.0f) : 1.0f, inv = 1.0f / scale;
        if (lane == 0) sc[e] = scale;
#pragma unroll
        for (int j = 0; j < 4; ++j) { int w = __builtin_amdgcn_cvt_pk_fp8_f32(v[j][0] * inv, v[j][1] * inv, 0, false); w = __builtin_amdgcn_cvt_pk_fp8_f32(v[j][2] * inv, v[j][3] * inv, w, true);
            const int slice = 2 * j + (lane >> 5);
            *(int*)(dst + ((size_t)slice * NE + e) * 128 + (lane & 31) * 4) = w; }
    }
#undef TROW
}
__device__ __forceinline__ void phase_prep(const Ctx& C) {
    CParams& P = *C.P;
    {
        LAS float* Kh = (LAS float*)C.lds;
        LAS float* Wq = (LAS float*)(C.lds + 128 * 132 * 4);
        bf16_t* WcT = WSP(bf16_t, WS_WC);
        for (int it = C.bid; it < 512; it += C.G) {
            const int l = it >> 8, h = (it >> 5) & 7, half = (it >> 4) & 1, jb = it & 15;
            const float* ksrc = as_global(P.in[half ? IN_K2 : IN_K1]) + (size_t)l * 128 * 128;
            const float* wsrc = as_global(P.in[IN_WQ]) + (size_t)l * DM * 2048 + (size_t)(jb * 64) * 2048 + h * 256 + half * 128;
            __syncthreads();
            for (int i = C.tid; i < 128 * 32; i += NTHREADS) { const int r = i >> 5, c4 = i & 31; *(LAS f32x4*)(Kh + r * 132 + c4 * 4) = *(const f32x4*)(ksrc + r * 128 + c4 * 4); }
            for (int i = C.tid; i < 64 * 32; i += NTHREADS) { const int r = i >> 5, c4 = i & 31; *(LAS f32x4*)(Wq + r * 132 + c4 * 4) = *(const f32x4*)(wsrc + (size_t)r * 2048 + c4 * 4); }
            __syncthreads();
            const int tk = C.tid & 31, tj = C.tid >> 5;
            float acc[4][4];
#pragma unroll
            for (int a = 0; a < 4; ++a)
#pragma unroll
                for (int b = 0; b < 4; ++b) acc[a][b] = 0.f;
            for (int d4 = 0; d4 < 32; ++d4) {
                f32x4 kv[4], wv[4];
#pragma unroll
                for (int a = 0; a < 4; ++a) { kv[a] = *(LAS f32x4*)(Kh + (tk + 32 * a) * 132 + d4 * 4); wv[a] = *(LAS f32x4*)(Wq + (4 * tj + a) * 132 + d4 * 4); }
#pragma unroll
                for (int a = 0; a < 4; ++a)
#pragma unroll
                    for (int b = 0; b < 4; ++b) acc[a][b] += kv[a][0] * wv[b][0] + kv[a][1] * wv[b][1] + kv[a][2] * wv[b][2] + kv[a][3] * wv[b][3];
            }
#pragma unroll
            for (int a = 0; a < 4; ++a) { const int n = h * 256 + half * 128 + tk + 32 * a;
                u32x2 o; o.x = pk2(acc[a][0], acc[a][1]); o.y = pk2(acc[a][2], acc[a][3]);
                *(u32x2*)(WcT + ((size_t)l * 2048 + n) * DM + jb * 64 + 4 * tj) = o; }
        }
        __syncthreads();
    }
    {
        LAS float* sc = (LAS float*)C.lds;
        LAS float* red = (LAS float*)(C.lds + 98304);
        for (int i = C.tid; i < NBT * DM; i += NTHREADS) { const int bb = i >> 10, k = i & 1023;
            const float cv = bb < 16 ? as_global(P.in[IN_CP])[bb * DM + k] : as_global(P.in[IN_CS])[(bb - 16) * DM + k]; sc[i] = siluf_(cv); }
        __syncthreads();
        float* MOD = WSP(float, WS_MOD);
        for (int it = C.bid; it < 192; it += C.G) {
            const int l = it / 96, cg_ = it % 96, j = cg_ * 64 + C.lane;
            const float* wm = as_global(P.in[IN_WMOD]) + (size_t)l * DM * 6144 + j;
            float acc[NBT];
#pragma unroll
            for (int bb = 0; bb < NBT; ++bb) acc[bb] = 0.f;
            const int k0 = C.wave * 128;
#pragma unroll 16
            for (int k = 0; k < 128; ++k) { const float w = wm[(size_t)(k0 + k) * 6144];
#pragma unroll
                for (int bb = 0; bb < NBT; ++bb) acc[bb] += sc[bb * DM + k0 + k] * w; }
#pragma unroll
            for (int bb = 0; bb < NBT; ++bb) red[(C.wave * NBT + bb) * 64 + C.lane] = acc[bb];
            __syncthreads();
            const float bm = as_global(P.in[IN_BMOD])[l * 6144 + j];
#pragma unroll
            for (int q = 0; q < 3; ++q) { const int bb = 3 * C.wave + q; float a = bm;
#pragma unroll
                for (int w8 = 0; w8 < 8; ++w8) a += red[(w8 * NBT + bb) * 64 + C.lane];
                MOD[((size_t)l * NBT + bb) * 6144 + j] = a; }
            __syncthreads();
        }
        __syncthreads();
    }
    {
        LAS float* scr = (LAS float*)(C.lds + C.wave * 16384);
        const int gw = C.bid * NWAVES + C.wave, NGW = C.G * NWAVES;
        constexpr int I_W1 = 144 * 16, I_WG = 64 * 16, I_SQ = 32 * 16, PER_L = I_W1 + I_WG + 3 * I_SQ;
        for (int it = gw; it < 2 * PER_L; it += NGW) {
            const int l = it / PER_L; int r = it % PER_L;
            if (r < I_W1) { const int nb = r >> 4, kb = r & 15, n0 = nb * 32; int src, valid;
                if (n0 < 2304) { src = n0; valid = 32; } else if (n0 < 4352) { src = n0 + 16; valid = 32; } else if (n0 == 4352) { src = 2304; valid = 16; } else { src = 0; valid = 0; }
                tr_item(as_global(P.in[IN_WIN]) + (size_t)l * DM * INC, INC, src, valid, nullptr, kb * 64, WSP(bf16_t, WS_W1T) + ((size_t)l * N1 + n0) * DM, scr, C.lane); continue; }
            r -= I_W1;
            if (r < I_WG) { const int nb = r >> 4, kb = r & 15, n0 = nb * 32;
                tr_item(as_global(P.in[IN_WIN]) + (size_t)l * DM * INC, INC, 4368 + n0, 32, nullptr, kb * 64, WSP(bf16_t, WS_WGT) + ((size_t)l * NG + n0) * DM, scr, C.lane); continue; }
            r -= I_WG;
            const int which = r / I_SQ; r %= I_SQ; const int nb = r >> 4, kb = r & 15, n0 = nb * 32;
            const float* src = as_global(P.in[which == 0 ? IN_WBS : (which == 1 ? IN_WBL : IN_WO)]) + (size_t)l * DM * DM;
            bf16_t* dst = WSP(bf16_t, which == 0 ? WS_WBS : (which == 1 ? WS_WBL : WS_WO)) + ((size_t)l * DM + n0) * DM;
            tr_item(src, DM, n0, 32, which == 0 ? as_global(P.in[IN_SNW]) + l * DM : nullptr, kb * 64, dst, scr, C.lane);
        }
    }
    convert_tables(C, 0);
}

__device__ __forceinline__ void phase_norm(const Ctx& C, int l, int which) {
    CParams& P = *C.P;
    const int gw = C.bid * NWAVES + C.wave, NGW = C.G * NWAVES;
    bf16_t* H = WSP(bf16_t, WS_B0);
    const float* lw = as_global(P.in[which ? IN_LN2 : IN_LN1]) + l * DM;
    const float* MOD = WSP(float, WS_MOD);
    const float* xpp = as_global(P.in[IN_XP]); const float* xsp = as_global(P.in[IN_XS]);
#define NORM_SRC(row_) ((which == 0 && l == 0) ? ((row_) < TP ? xpp + (size_t)(row_) * DM : xsp + (size_t)((row_) - TP) * DM) : C.out + (size_t)(row_) * DM)
    const int c0 = 8 * C.lane;
    f32x4 lwv[4];
#pragma unroll
    for (int j = 0; j < 4; ++j) lwv[j] = *(const f32x4*)(lw + (j >> 1) * 512 + c0 + (j & 1) * 4);
    f32x4 nv[4];
    { const float* xr = NORM_SRC(min(gw, TT - 1)) + c0;
#pragma unroll
      for (int j = 0; j < 4; ++j) nv[j] = *(const f32x4*)(xr + (j >> 1) * 512 + (j & 1) * 4); }
    for (int row = gw; row < TT; row += NGW) {
        f32x4 v[4]; float s = 0.f;
#pragma unroll
        for (int j = 0; j < 4; ++j) { v[j] = nv[j]; s += (v[j][0] * v[j][0] + v[j][1] * v[j][1]) + (v[j][2] * v[j][2] + v[j][3] * v[j][3]); }
        { const float* xr = NORM_SRC(min(row + NGW, TT - 1)) + c0;
#pragma unroll
          for (int j = 0; j < 4; ++j) nv[j] = *(const f32x4*)(xr + (j >> 1) * 512 + (j & 1) * 4); }
        const float rstd = rsqrtf(wave_sum(s) * (1.f / DM) + EPS);
        const float* md = MOD + ((size_t)l * NBT + row_batch(row)) * 6144 + (which ? 3072 : 0) + c0;
        f32x4 y[4];
#pragma unroll
        for (int j = 0; j < 4; ++j) { const int co = (j >> 1) * 512 + (j & 1) * 4;
            const f32x4 sh = *(const f32x4*)(md + co), scv = *(const f32x4*)(md + 1024 + co);
            y[j] = (v[j] * rstd * lwv[j]) * (scv + 1.0f) + sh; }
        bf16_t* hp = H + (size_t)row * DM + c0;
        *(u32x4*)hp = (u32x4){pk2(y[0][0], y[0][1]), pk2(y[0][2], y[0][3]), pk2(y[1][0], y[1][1]), pk2(y[1][2], y[1][3])};
        *(u32x4*)(hp + 512) = (u32x4){pk2(y[2][0], y[2][1]), pk2(y[2][2], y[2][3]), pk2(y[3][0], y[3][1]), pk2(y[3][2], y[3][3])};
    }
#undef NORM_SRC
    if (which == 0 && l == 1) convert_tables(C, 1);
}

struct Epi1 {
    __device__ __forceinline__ bool idem() const { return true; }
    static constexpr int NK = 5; static constexpr bool PERM = true;
    bf16_t *Z, *XBC, *LX, *LY; float* DT; const float* dtb;
    __device__ __forceinline__ int kind(int pn) const { return pn < 4 ? 0 : (pn < 9 ? 1 : (pn < 13 ? 2 : (pn < 17 ? 3 : 4))); }
    template <int KD> __device__ __forceinline__ void apply(int, int row, int col, f32x4 v) const {
        if constexpr (KD == 0) { *(u32x2*)(Z + (size_t)row * DM + col) = (u32x2){pk2(siluf_(v[0]), siluf_(v[1])), pk2(siluf_(v[2]), siluf_(v[3]))}; }
        else if constexpr (KD == 1) { *(u32x2*)(XBC + (size_t)row * 1280 + (col - 1024)) = (u32x2){pk2(v[0], v[1]), pk2(v[2], v[3])}; }
        else if constexpr (KD == 2) { *(u32x2*)(LX + (size_t)row * DM + (col - 2304)) = (u32x2){pk2(v[0], v[1]), pk2(v[2], v[3])}; }
        else if constexpr (KD == 3) { *(u32x2*)(LY + (size_t)row * DM + (col - 3328)) = (u32x2){pk2(geluf_(v[0]), geluf_(v[1])), pk2(geluf_(v[2]), geluf_(v[3]))}; }
        else { if (col < 4368) { const int c = col - 4352; const f32x4 b = *(const f32x4*)(dtb + c);
            *(f32x4*)(DT + (size_t)row * 16 + c) = (f32x4){softplusf_(v[0] + b[0]), softplusf_(v[1] + b[1]), softplusf_(v[2] + b[2]), softplusf_(v[3] + b[3])}; } }
    }
    template <int KD> __device__ __forceinline__ void apply8(int w, int row, int col, f32x4 a, f32x4 b) const {
        if constexpr (KD == 0) { *(u32x4*)(Z + (size_t)row * DM + col) = (u32x4){pk2(siluf_(a[0]), siluf_(a[1])), pk2(siluf_(a[2]), siluf_(a[3])), pk2(siluf_(b[0]), siluf_(b[1])), pk2(siluf_(b[2]), siluf_(b[3]))}; }
        else if constexpr (KD == 1) { *(u32x4*)(XBC + (size_t)row * 1280 + (col - 1024)) = (u32x4){pk2(a[0], a[1]), pk2(a[2], a[3]), pk2(b[0], b[1]), pk2(b[2], b[3])}; }
        else if constexpr (KD == 2) { *(u32x4*)(LX + (size_t)row * DM + (col - 2304)) = (u32x4){pk2(a[0], a[1]), pk2(a[2], a[3]), pk2(b[0], b[1]), pk2(b[2], b[3])}; }
        else if constexpr (KD == 3) { *(u32x4*)(LY + (size_t)row * DM + (col - 3328)) = (u32x4){pk2(geluf_(a[0]), geluf_(a[1])), pk2(geluf_(a[2]), geluf_(a[3])), pk2(geluf_(b[0]), geluf_(b[1])), pk2(geluf_(b[2]), geluf_(b[3]))}; }
        else { apply<KD>(w, row, col, a); apply<KD>(w, row, col + 4, b); }
    }
};
struct Epi2 {
    __device__ __forceinline__ bool idem() const { return true; }
    static constexpr int NK = 2; static constexpr bool PERM = true;
    bf16_t *GS, *GL;
    __device__ __forceinline__ int kind(int pn) const { return pn < 4 ? 0 : 1; }
    template <int KD> __device__ __forceinline__ void apply(int, int row, int col, f32x4 v) const {
        bf16_t* d = (KD == 0 ? GS + (size_t)row * DM + col : GL + (size_t)row * DM + (col - 1024));
        *(u32x2*)d = (u32x2){pk2(sigmoidf_(v[0]), sigmoidf_(v[1])), pk2(sigmoidf_(v[2]), sigmoidf_(v[3]))};
    }
    template <int KD> __device__ __forceinline__ void apply8(int, int row, int col, f32x4 a, f32x4 b) const {
        bf16_t* d = (KD == 0 ? GS + (size_t)row * DM + col : GL + (size_t)row * DM + (col - 1024));
        *(u32x4*)d = (u32x4){pk2(sigmoidf_(a[0]), sigmoidf_(a[1])), pk2(sigmoidf_(a[2]), sigmoidf_(a[3])), pk2(sigmoidf_(b[0]), sigmoidf_(b[1])), pk2(sigmoidf_(b[2]), sigmoidf_(b[3]))};
    }
};
struct Epi3 {
    __device__ __forceinline__ bool idem() const { return true; }
    static constexpr int NK = 1; static constexpr bool PERM = true;
    const bf16_t *GS, *GL; const float* SSQ; bf16_t* MG;
    __device__ __forceinline__ int kind(int) const { return 0; }
    __device__ __forceinline__ float rstd_of(int row) const { const f32x4* q = (const f32x4*)(SSQ + (size_t)row * 16); const f32x4 a = q[0] + q[1] + q[2] + q[3];
        return rsqrtf(((a[0] + a[1]) + (a[2] + a[3])) * (1.f / DM) + EPS); }
    template <int KD> __device__ __forceinline__ void apply(int w, int row, int col, f32x4 v) const {
        u32x2* m = (u32x2*)(MG + (size_t)row * DM + col);
        if (w == 0) { const float rstd = rstd_of(row);
            const u32x2 g = *(const u32x2*)(GS + (size_t)row * DM + col);
            *m = (u32x2){pk2(bflo(g.x) * rstd * v[0], bfhi(g.x) * rstd * v[1]), pk2(bflo(g.y) * rstd * v[2], bfhi(g.y) * rstd * v[3])};
        } else {
            const u32x2 g = *(const u32x2*)(GL + (size_t)row * DM + col); const u32x2 p = *m;
            *m = (u32x2){pk2(bflo(p.x) + bflo(g.x) * v[0], bfhi(p.x) + bfhi(g.x) * v[1]), pk2(bflo(p.y) + bflo(g.y) * v[2], bfhi(p.y) + bfhi(g.y) * v[3])};
        }
    }
    template <int KD> __device__ __forceinline__ void apply8(int w, int row, int col, f32x4 a, f32x4 b) const {
        u32x4* m = (u32x4*)(MG + (size_t)row * DM + col);
        if (w == 0) { const float rstd = rstd_of(row);
            const u32x4 g = *(const u32x4*)(GS + (size_t)row * DM + col);
            *m = (u32x4){pk2(bflo(g.x) * rstd * a[0], bfhi(g.x) * rstd * a[1]), pk2(bflo(g.y) * rstd * a[2], bfhi(g.y) * rstd * a[3]), pk2(bflo(g.z) * rstd * b[0], bfhi(g.z) * rstd * b[1]), pk2(bflo(g.w) * rstd * b[2], bfhi(g.w) * rstd * b[3])};
        } else {
            const u32x4 g = *(const u32x4*)(GL + (size_t)row * DM + col); const u32x4 p = *m;
            *m = (u32x4){pk2(bflo(p.x) + bflo(g.x) * a[0], bfhi(p.x) + bfhi(g.x) * a[1]), pk2(bflo(p.y) + bflo(g.y) * a[2], bfhi(p.y) + bfhi(g.y) * a[3]),
                         pk2(bflo(p.z) + bflo(g.z) * b[0], bfhi(p.z) + bfhi(g.z) * b[1]), pk2(bflo(p.w) + bflo(g.w) * b[2], bfhi(p.w) + bfhi(g.w) * b[3])};
        }
    }
};
struct Epi4 {
    static constexpr bool PERM = true;
    __device__ __forceinline__ bool idem() const { return layer == 0; }
    static constexpr int NK = 1;
    const float *xp, *xs; float* XR; const float* MODl; int layer;
    __device__ __forceinline__ int kind(int) const { return 0; }
    template <int KD> __device__ __forceinline__ void apply(int, int row, int col, f32x4 v) const {
        if (row >= TT) return;
        const float* src = layer == 0 ? (row < TP ? xp + (size_t)row * DM : xs + (size_t)(row - TP) * DM) : XR + (size_t)row * DM;
        const f32x4 x = *(const f32x4*)(src + col), g = *(const f32x4*)(MODl + (size_t)row_batch(row) * 6144 + 2048 + col);
        *(f32x4*)(XR + (size_t)row * DM + col) = x + g * v;
    }
    template <int KD> __device__ __forceinline__ void apply8(int, int row, int col, f32x4 a, f32x4 b) const {
        const float* src = (layer == 0 ? xp : XR) + (size_t)row * DM + col; const float* gp = MODl + (size_t)(row >> 11) * 6144 + 2048 + col;
        const f32x4 x0 = *(const f32x4*)src, x1 = *(const f32x4*)(src + 4), g0 = *(const f32x4*)gp, g1 = *(const f32x4*)(gp + 4);
        float* d = XR + (size_t)row * DM + col; *(f32x4*)d = x0 + g0 * a; *(f32x4*)(d + 4) = x1 + g1 * b;
    }
};
struct Epi5 {
    static constexpr bool PERM = true;
    __device__ __forceinline__ bool idem() const { return true; }
    static constexpr int NK = 1;
    float* SC;
    __device__ __forceinline__ int kind(int) const { return 0; }
    template <int KD> __device__ __forceinline__ void apply(int, int row, int col, f32x4 v) const { *(f32x4*)(SC + (size_t)row * 2048 + col) = v; }
    template <int KD> __device__ __forceinline__ void apply8(int, int row, int col, f32x4 a, f32x4 b) const { float* d = SC + (size_t)row * 2048 + col; *(f32x4*)d = a; *(f32x4*)(d + 4) = b; }
};

namespace pg8 {
constexpr int BM = 256, BK = 64, HALF = 128, HTB = HALF * BK * 2, STAGE_BYTES = 8 * HTB, NXCD = 8, WGM = 8;
__host__ __device__ __forceinline__ int lds_byte(int r, int c) { const int st = (r >> 4) * 2 + (c >> 5), rr = r & 15, cc = c & 31, ob = rr * 64 + cc * 2; return st * 1024 + (ob ^ (((ob >> 9) & 1) << 5)); }
__host__ __device__ __forceinline__ void stage_rc(int b, int& R, int& C) { const int st = b / 1024, sb = b % 1024, swz = sb ^ (((sb >> 9) & 1) << 5); R = (st >> 1) * 16 + swz / 64; C = (st & 1) * 32 + (swz % 64) / 2; }
struct Unit { int pm, pn, w; };
struct Sched {
    int nM, nN, nW, nwg, G, c; const char *A0, *B0, *A1, *B1;
    __device__ __forceinline__ bool next(int i, Unit& u) const {
        const int ti = i / nW; u.w = i - ti * nW;
        const long L = (long)ti * G + c; if (L >= nwg) return false;
        int wgid = (int)L; { const int q = nwg / NXCD, r = nwg % NXCD, xcd = wgid % NXCD, off = wgid / NXCD; wgid = (xcd < r ? xcd * (q + 1) : r * (q + 1) + (xcd - r) * q) + off; }
        const int nig = WGM * nN, gid = wgid / nig, fm = gid * WGM, gsz = (nM - fm) < WGM ? (nM - fm) : WGM;
        u.pm = fm + ((wgid % nig) % gsz); u.pn = (wgid % nig) / gsz; return true;
    }
};
__host__ __device__ __forceinline__ int perm32(int rho) { const int n = rho >> 4, i = rho & 15; return 8 * (i >> 2) + 4 * n + (i & 3); }
template <int KD, class Epi>
__device__ __forceinline__ void epi_tile(const Epi& E, const f32x4 (&acc)[2][2][4][2], const Unit& u, int wr, int wc, int fr, int fq) {
#pragma unroll
    for (int ai = 0; ai < 2; ++ai)
#pragma unroll
        for (int m = 0; m < 4; ++m) { const int row = u.pm * BM + ai * HALF + wr * 64 + m * 16 + fr;
#pragma unroll
            for (int bj = 0; bj < 2; ++bj) {
                if constexpr (Epi::PERM) E.template apply8<KD>(u.w, row, u.pn * BM + bj * HALF + wc * 32 + 8 * fq, acc[ai][bj][m][0], acc[ai][bj][m][1]);
                else {
#pragma unroll
                    for (int n = 0; n < 2; ++n) E.template apply<KD>(u.w, row, u.pn * BM + bj * HALF + wc * 32 + n * 16 + 4 * fq, acc[ai][bj][m][n]); } } }
}
template <class Epi>
__device__ __forceinline__ void epi_apply(const Epi& E, const f32x4 (&acc)[2][2][4][2], const Unit& u, int wr, int wc, int fr, int fq) {
    if constexpr (Epi::NK == 1) epi_tile<0>(E, acc, u, wr, wc, fr, fq);
    else { const int kd = E.kind(u.pn);
        if (kd == 0) epi_tile<0>(E, acc, u, wr, wc, fr, fq);
        else if (kd == 1) epi_tile<1>(E, acc, u, wr, wc, fr, fq);
        else if constexpr (Epi::NK > 2) { if (kd == 2) epi_tile<2>(E, acc, u, wr, wc, fr, fq); else if (kd == 3) epi_tile<3>(E, acc, u, wr, wc, fr, fq); else epi_tile<4>(E, acc, u, wr, wc, fr, fq); } }
}
template <class Epi, bool ALIGN_EPI = true, bool SP2 = true>
__device__ __forceinline__ void gemm_phase(LAS unsigned char* lds, int tid, int K, const Sched& S, const Epi& E) {
    const int wid = __builtin_amdgcn_readfirstlane(tid >> 6), lane = tid & 63, wr = wid >> 2, wc = wid & 3, fr = lane & 15, fq = lane >> 4;
    const int nt = K / BK;
    unsigned voffA[2], voffB[2];
#pragma unroll
    for (int i = 0; i < 2; ++i) { int R, Cc; stage_rc(tid * 16 + i * 8192, R, Cc); const int Rb = Epi::PERM ? ((R & ~31) + perm32(R & 31)) : R;
        voffA[i] = (unsigned)(R * K + Cc) * 2u; voffB[i] = (unsigned)(Rb * K + Cc) * 2u; }
    const size_t kstep = (size_t)(BK * 2);
    const size_t hstep = (size_t)HALF * K * 2;
    const size_t tstep = 2 * hstep;
    const unsigned ldsw = (unsigned)wid * 1024u;
    const int aoff = lds_byte(wr * 64 + fr, fq * 8), boff = lds_byte(wc * 32 + fr, fq * 8);
#define PG8_SA(b, h) (((b) * 2 + (h)) * HTB)
#define PG8_SB(b, h) ((4 + (b) * 2 + (h)) * HTB)
#define PG8_STAGE(bufoff, gbase, voff) do { _Pragma("unroll") for (int _i = 0; _i < 2; ++_i) \
        __builtin_amdgcn_global_load_lds((const unsigned*)((const char*)(gbase) + (voff)[_i]), (LAS unsigned*)(lds + (bufoff) + ldsw + _i * 8192), 16, 0, 0); } while (0)
#define PG8_LDA(dst, b, h) do { _Pragma("unroll") for (int m = 0; m < 4; ++m) _Pragma("unroll") for (int k = 0; k < 2; ++k) dst[m][k] = *(const LAS bf16x8*)(lds + PG8_SA(b, h) + aoff + m * 2048 + k * 1024); } while (0)
#define PG8_LDB(dst, b, h) do { _Pragma("unroll") for (int n = 0; n < 2; ++n) _Pragma("unroll") for (int k = 0; k < 2; ++k) dst[n][k] = *(const LAS bf16x8*)(lds + PG8_SB(b, h) + boff + n * 2048 + k * 1024); } while (0)
#define PG8_MMA(ai, bj, At, Bt) do { __builtin_amdgcn_s_setprio(1); _Pragma("unroll") for (int m = 0; m < 4; ++m) _Pragma("unroll") for (int n = 0; n < 2; ++n) _Pragma("unroll") for (int k = 0; k < 2; ++k) \
        acc[ai][bj][m][n] = __builtin_amdgcn_mfma_f32_16x16x32_bf16(Bt[n][k], At[m][k], acc[ai][bj][m][n], 0, 0, 0); __builtin_amdgcn_s_setprio(0); } while (0)
#define PG8_WAIT_V(n) asm volatile("s_waitcnt vmcnt(" #n ")" ::: "memory")
#define PG8_WAIT_L(n) asm volatile("s_waitcnt lgkmcnt(" #n ")" ::: "memory")
#define PG8_BAR __builtin_amdgcn_s_barrier()
#define PG8_SCHED __builtin_amdgcn_sched_barrier(0)
    Unit cur, nxt; int ui = 0;
    if (!S.next(0, cur)) return;
    f32x4 acc[2][2][4][2];
#pragma unroll
    for (int a = 0; a < 2; ++a)
#pragma unroll
        for (int b = 0; b < 2; ++b)
#pragma unroll
            for (int m = 0; m < 4; ++m)
#pragma unroll
                for (int n = 0; n < 2; ++n) acc[a][b][m][n] = (f32x4){0.f, 0.f, 0.f, 0.f};
    bf16x8 At[4][2], B0[2][2], B1[2][2];
    const char* cA = (cur.w ? S.A1 : S.A0) + (size_t)cur.pm * tstep; const char* cB = (cur.w ? S.B1 : S.B0) + (size_t)cur.pn * tstep;
    if constexpr (SP2) {
        PG8_STAGE(PG8_SB(0, 0), cB, voffB); PG8_STAGE(PG8_SB(0, 1), cB + hstep, voffB); PG8_STAGE(PG8_SA(0, 0), cA, voffA); PG8_STAGE(PG8_SA(0, 1), cA + hstep, voffA);
        if (wr == 1) PG8_BAR;
        PG8_WAIT_V(2); PG8_BAR;
        PG8_STAGE(PG8_SB(1, 0), cB + kstep, voffB); PG8_STAGE(PG8_SA(1, 0), cA + kstep, voffA); PG8_STAGE(PG8_SB(1, 1), cB + hstep + kstep, voffB);
        PG8_WAIT_V(6); PG8_BAR;
    } else {
        PG8_STAGE(PG8_SB(0, 0), cB, voffB); PG8_STAGE(PG8_SA(0, 0), cA, voffA); PG8_STAGE(PG8_SB(0, 1), cB + hstep, voffB); PG8_STAGE(PG8_SA(0, 1), cA + hstep, voffA);
        if (wr == 1) PG8_BAR;
        PG8_WAIT_V(4); PG8_BAR;
        PG8_STAGE(PG8_SB(1, 0), cB + kstep, voffB); PG8_STAGE(PG8_SA(1, 0), cA + kstep, voffA); PG8_STAGE(PG8_SB(1, 1), cB + hstep + kstep, voffB);
        PG8_WAIT_V(6); PG8_BAR;
    }
    for (;;) {
        const bool has_next = S.next(ui + 1, nxt);
        const char* nA = has_next ? (nxt.w ? S.A1 : S.A0) + (size_t)nxt.pm * tstep : cA; const char* nB = has_next ? (nxt.w ? S.B1 : S.B0) + (size_t)nxt.pn * tstep : cB;
        for (int t = 0; t < nt; t += 2) {
            const bool last = (t == nt - 2);
            const char* a1 = cA + (size_t)(t + 1) * kstep;
            const char* a2 = last ? nA : cA + (size_t)(t + 2) * kstep; const char* b2 = last ? nB : cB + (size_t)(t + 2) * kstep;
            const char* a3 = a2 + kstep; const char* b3 = b2 + kstep;
            if constexpr (SP2) {
            PG8_LDB(B0, 0, 0); PG8_LDB(B1, 0, 1); PG8_SCHED; PG8_LDA(At, 0, 0); PG8_STAGE(PG8_SA(1, 1), a1 + hstep, voffA);
            PG8_WAIT_V(8); PG8_WAIT_L(0); PG8_BAR; PG8_MMA(0, 0, At, B0); PG8_MMA(0, 1, At, B1); PG8_BAR; PG8_SCHED;
            PG8_LDA(At, 0, 1); PG8_STAGE(PG8_SB(0, 0), b2, voffB); PG8_STAGE(PG8_SB(0, 1), b2 + hstep, voffB); PG8_STAGE(PG8_SA(0, 0), a2, voffA);
            PG8_WAIT_V(8); PG8_WAIT_L(0); PG8_BAR; PG8_MMA(1, 0, At, B0); PG8_MMA(1, 1, At, B1); PG8_BAR; PG8_SCHED;
            PG8_LDB(B0, 1, 0); PG8_LDB(B1, 1, 1); PG8_SCHED; PG8_LDA(At, 1, 0); PG8_STAGE(PG8_SA(0, 1), a2 + hstep, voffA);
            PG8_WAIT_V(8); PG8_WAIT_L(0); PG8_BAR; PG8_MMA(0, 0, At, B0); PG8_MMA(0, 1, At, B1); PG8_BAR; PG8_SCHED;
            PG8_LDA(At, 1, 1); PG8_STAGE(PG8_SB(1, 0), b3, voffB); PG8_STAGE(PG8_SB(1, 1), b3 + hstep, voffB); PG8_STAGE(PG8_SA(1, 0), a3, voffA);
            PG8_WAIT_V(8); PG8_WAIT_L(0); PG8_BAR; PG8_MMA(1, 0, At, B0); PG8_MMA(1, 1, At, B1); PG8_BAR; PG8_SCHED;
            } else {
            PG8_LDB(B0, 0, 0); PG8_SCHED; PG8_LDA(At, 0, 0); PG8_STAGE(PG8_SA(1, 1), a1 + hstep, voffA);
            PG8_WAIT_L(8); PG8_BAR; PG8_WAIT_L(0); PG8_MMA(0, 0, At, B0); PG8_BAR; PG8_SCHED;
            PG8_LDB(B1, 0, 1); PG8_STAGE(PG8_SB(0, 0), b2, voffB);
            PG8_BAR; PG8_WAIT_L(0); PG8_MMA(0, 1, At, B1); PG8_BAR;
            PG8_LDA(At, 0, 1); PG8_STAGE(PG8_SA(0, 0), a2, voffA);
            PG8_BAR; PG8_WAIT_L(0); PG8_MMA(1, 0, At, B0); PG8_BAR; PG8_SCHED;
            PG8_STAGE(PG8_SB(0, 1), b2 + hstep, voffB);
            PG8_WAIT_V(6); PG8_BAR; PG8_MMA(1, 1, At, B1); PG8_BAR;
            PG8_LDB(B0, 1, 0); PG8_SCHED; PG8_LDA(At, 1, 0); PG8_STAGE(PG8_SA(0, 1), a2 + hstep, voffA);
            PG8_WAIT_L(8); PG8_BAR; PG8_WAIT_L(0); PG8_MMA(0, 0, At, B0); PG8_BAR; PG8_SCHED;
            PG8_LDB(B1, 1, 1); PG8_STAGE(PG8_SB(1, 0), b3, voffB);
            PG8_BAR; PG8_WAIT_L(0); PG8_MMA(0, 1, At, B1); PG8_BAR;
            PG8_LDA(At, 1, 1); PG8_STAGE(PG8_SA(1, 0), a3, voffA);
            PG8_BAR; PG8_WAIT_L(0); PG8_MMA(1, 0, At, B0); PG8_BAR; PG8_SCHED;
            PG8_STAGE(PG8_SB(1, 1), b3 + hstep, voffB);
            PG8_WAIT_V(6); PG8_BAR; PG8_MMA(1, 1, At, B1); PG8_BAR;
            }
        }
        if constexpr (ALIGN_EPI) { if (wr == 0) PG8_BAR; }
        epi_apply(E, acc, cur, wr, wc, fr, fq);
        if (!has_next) break;
#pragma unroll
        for (int a = 0; a < 2; ++a)
#pragma unroll
            for (int b = 0; b < 2; ++b)
#pragma unroll
                for (int m = 0; m < 4; ++m)
#pragma unroll
                    for (int n = 0; n < 2; ++n) acc[a][b][m][n] = (f32x4){0.f, 0.f, 0.f, 0.f};
        cur = nxt; cA = nA; cB = nB; ++ui;
        if constexpr (ALIGN_EPI) { if (wr == 1) PG8_BAR; }
    }
    PG8_WAIT_V(0);
    if constexpr (!ALIGN_EPI) { if (wr == 0) PG8_BAR; }
    PG8_BAR;
#undef PG8_SA
#undef PG8_SB
#undef PG8_STAGE
#undef PG8_LDA
#undef PG8_LDB
#undef PG8_MMA
#undef PG8_WAIT_V
#undef PG8_WAIT_L
#undef PG8_BAR
#undef PG8_SCHED
}
}
template <int KD, class Epi>
__device__ __forceinline__ void sample_tile(const Ctx& C, const bf16_t* A0, const bf16_t* B0, const bf16_t* A1, const bf16_t* B1, int rb, int cb, const Epi& E) {
    const int fr = C.lane & 15, fq = C.lane >> 4;
    for (int w = 0; w < (A1 ? 2 : 1); ++w) {
        const bf16_t* ap = (w ? A1 : A0) + (size_t)(TP + 16 * rb + fr) * DM + 8 * fq; const bf16_t* bp = (w ? B1 : B0) + (size_t)(16 * cb + fr) * DM + 8 * fq;
        f32x4 acc = (f32x4){0.f, 0.f, 0.f, 0.f};
#pragma unroll 16
        for (int ks = 0; ks < DM / 32; ++ks) { const bf16x8 a = *(const bf16x8*)(ap + 32 * ks), b = *(const bf16x8*)(bp + 32 * ks); acc = __builtin_amdgcn_mfma_f32_16x16x32_bf16(b, a, acc, 0, 0, 0); }
        E.template apply<KD>(w, TP + 16 * rb + fr, 16 * cb + 4 * fq, acc);
    }
}
template <class Epi>
__device__ __forceinline__ void gemm_sample(const Ctx& C, const bf16_t* A0, const bf16_t* B0, const bf16_t* A1, const bf16_t* B1, int N, const Epi& E) {
    const int gw = C.bid * NWAVES + C.wave, NGW = C.G * NWAVES, ncb = N / 16;
    for (int it = gw; it < 8 * ncb; it += NGW) {
        const int cb = it >> 3, rb = it & 7; const int kd = E.kind(cb >> 4);
        if constexpr (Epi::NK == 1) sample_tile<0>(C, A0, B0, A1, B1, rb, cb, E);
        else { if (kd == 0) sample_tile<0>(C, A0, B0, A1, B1, rb, cb, E); else if (kd == 1) sample_tile<1>(C, A0, B0, A1, B1, rb, cb, E);
            else if constexpr (Epi::NK > 2) { if (kd == 2) sample_tile<2>(C, A0, B0, A1, B1, rb, cb, E); else if (kd == 3) sample_tile<3>(C, A0, B0, A1, B1, rb, cb, E); else sample_tile<4>(C, A0, B0, A1, B1, rb, cb, E); } }
    }
}
template <class Epi>
__device__ __forceinline__ void gemm_run(const Ctx& C, const bf16_t* A0, const bf16_t* B0, const bf16_t* A1, const bf16_t* B1, int N, const Epi& E) {
    gemm_sample(C, A0, B0, A1, B1, N, E);
    pg8::Sched S; S.nM = TP / 256; S.nN = N / 256; S.nW = A1 ? 2 : 1; S.nwg = S.nM * S.nN; S.G = C.G; S.c = C.bid;
    S.A0 = (const char*)A0; S.B0 = (const char*)B0; S.A1 = (const char*)A1; S.B1 = (const char*)B1;
    pg8::gemm_phase<Epi>(C.lds, C.tid, DM, S, E);
    __syncthreads();
}

__device__ __forceinline__ unsigned cvt_pk_bf16(float lo, float hi) { unsigned r; asm volatile("v_cvt_pk_bf16_f32 %0, %1, %2" : "=v"(r) : "v"(lo), "v"(hi)); return r; }
__device__ __forceinline__ bf16x8 pack_acc(const f32x16& a, int t) {
    u32x4 w;
    if (t == 0) { w.x = cvt_pk_bf16(a[0], a[1]); w.y = cvt_pk_bf16(a[2], a[3]); w.z = cvt_pk_bf16(a[4], a[5]); w.w = cvt_pk_bf16(a[6], a[7]); }
    else { w.x = cvt_pk_bf16(a[8], a[9]); w.y = cvt_pk_bf16(a[10], a[11]); w.z = cvt_pk_bf16(a[12], a[13]); w.w = cvt_pk_bf16(a[14], a[15]); }
    return __builtin_bit_cast(bf16x8, w);
}
__device__ __forceinline__ int sig_pos(int s) { return (s & ~15) | (((s >> 2) & 1) << 3) | (((s >> 3) & 1) << 2) | (s & 3); }
constexpr int SROW = 144;

template <int WSTR>
__device__ __forceinline__ void conv8(const u32x4 (&rw)[4], const LAS float* wl, float (&v)[8]) {
    f32x4 w[5][2];
#pragma unroll
    for (int k = 0; k < 5; ++k) { w[k][0] = *(const LAS f32x4*)(wl + k * WSTR); w[k][1] = *(const LAS f32x4*)(wl + k * WSTR + 4); }
#pragma unroll
    for (int e = 0; e < 8; ++e) { const int dw = e >> 1; const bool hi = e & 1;
        float x[4];
#pragma unroll
        for (int k = 0; k < 4; ++k) { const unsigned q = dw == 0 ? rw[k].x : (dw == 1 ? rw[k].y : (dw == 2 ? rw[k].z : rw[k].w)); x[k] = hi ? bfhi(q) : bflo(q); }
        v[e] = w[4][e >> 2][e & 3] + w[0][e >> 2][e & 3] * x[0] + w[1][e >> 2][e & 3] * x[1] + w[2][e >> 2][e & 3] * x[2] + w[3][e >> 2][e & 3] * x[3]; }
}
constexpr size_t WS_CBC = WS_EI;
__device__ __forceinline__ void phase_convbc(const Ctx& C, int l) {
    CParams& P = *C.P;
    const bf16_t* XBC = WSP(bf16_t, WS_B2); bf16_t* CBC = WSP(bf16_t, WS_CBC);
    const float* cw = as_global(P.in[IN_SCW]) + (size_t)l * 4 * 1280 + 1024; const float* cbp = as_global(P.in[IN_SCB]) + (size_t)l * 1280 + 1024;
    const float* cst = as_global(P.in[IN_SSDCONV]) + (size_t)l * 8 * 3 * 1280;
    const size_t items = (size_t)TT * 32, stride = (size_t)C.G * NTHREADS;
    for (size_t it = (size_t)C.bid * NTHREADS + C.tid; it < items; it += stride) {
        const int tok = (int)(it >> 5), cg = (int)(it & 31), ch = cg * 8;
        const bool smp = tok >= TP; const int b = smp ? (tok - TP) >> 4 : tok >> 11, t = smp ? (tok - TP) & 15 : tok & 2047, L = smp ? 16 : 2048, NB = smp ? 8 : 16;
        u32x4 rw[4];
#pragma unroll
        for (int k = 0; k < 4; ++k) { const int tr = t - 3 + k;
            if (tr >= 0) rw[k] = *(const u32x4*)(XBC + (size_t)(tok - t + tr) * 1280 + 1024 + ch);
            else if (smp) { const float* s0 = cst + ((size_t)b * 3 + (tr + 3)) * 1280 + 1024 + ch; const f32x4 a0 = *(const f32x4*)s0, a1 = *(const f32x4*)(s0 + 4);
                rw[k] = (u32x4){pk2(a0[0], a0[1]), pk2(a0[2], a0[3]), pk2(a1[0], a1[1]), pk2(a1[2], a1[3])}; }
            else rw[k] = (u32x4){0u, 0u, 0u, 0u}; }
        f32x4 w[5][2];
#pragma unroll
        for (int k = 0; k < 4; ++k) { w[k][0] = *(const f32x4*)(cw + k * 1280 + ch); w[k][1] = *(const f32x4*)(cw + k * 1280 + ch + 4); }
        w[4][0] = *(const f32x4*)(cbp + ch); w[4][1] = *(const f32x4*)(cbp + ch + 4);
        float v[8];
#pragma unroll
        for (int e = 0; e < 8; ++e) { const int dw = e >> 1; const bool hi = e & 1; float x[4];
#pragma unroll
            for (int k = 0; k < 4; ++k) { const unsigned q = dw == 0 ? rw[k].x : (dw == 1 ? rw[k].y : (dw == 2 ? rw[k].z : rw[k].w)); x[k] = hi ? bfhi(q) : bflo(q); }
            v[e] = siluf_(w[4][e >> 2][e & 3] + w[0][e >> 2][e & 3] * x[0] + w[1][e >> 2][e & 3] * x[1] + w[2][e >> 2][e & 3] * x[2] + w[3][e >> 2][e & 3] * x[3]); }
        *(u32x4*)(CBC + (size_t)tok * 256 + ch) = (u32x4){pk2(v[0], v[1]), pk2(v[2], v[3]), pk2(v[4], v[5]), pk2(v[6], v[7])};
        if (t >= L - 3) { float* co = C.out + (smp ? O_SSCONV : O_PSCONV) + ((size_t)(l * NB + b) * 3 + (t - (L - 3))) * 1280 + 1024 + ch; const u32x4 q = rw[3];
            *(f32x4*)co = (f32x4){bflo(q.x), bfhi(q.x), bflo(q.y), bfhi(q.y)}; *(f32x4*)(co + 4) = (f32x4){bflo(q.z), bfhi(q.z), bflo(q.w), bfhi(q.w)}; }
    }
}

#ifndef SCAN_SKIP
#define SCAN_SKIP 0
#endif
__device__ __forceinline__ void scan_item_fused(const Ctx& C, int l, int idx, bool dry) {
    const int skip = dry ? SCAN_SKIP : 0;
    CParams& P = *C.P; const int tid = C.tid, lane = C.lane, wave = C.wave;
    const bool smp = idx >= 256; const int ii = smp ? idx - 256 : idx; const int b = ii >> 4, head = ii & 15, g = head >> 3, j = head;
    const int tok0 = smp ? TP + b * 16 : b * 2048, L = smp ? 16 : 2048, NB = smp ? 8 : 16, nchunk = smp ? 1 : 32;
    const bf16_t* XBC = WSP(bf16_t, WS_B2); const bf16_t* CBC = WSP(bf16_t, WS_CBC); bf16_t* Z = WSP(bf16_t, WS_B1); const float* DT = WSP(float, WS_DT); float* SSQ = WSP(float, WS_SSQ);
    const float a_h = -__expf(as_global(P.in[IN_ALOG])[l * 16 + head]), Dh = as_global(P.in[IN_SSDD])[l * 16 + head];
    LAS unsigned char* bmR = C.lds; LAS unsigned char* cmR = C.lds + 9216; LAS unsigned char* xsR = C.lds + 18432; LAS unsigned char* bwR = C.lds + 30720;
    LAS float* ybuf = (LAS float*)(C.lds + 43008);
    LAS float* acum = (LAS float*)(C.lds + 59392); LAS float* dtv = acum + 64; LAS float* eac = acum + 128; LAS float* wsc = acum + 192; LAS float* misc = acum + 256; LAS float* cwl = acum + 320;
    const int t = tid >> 3, cg = tid & 7;
    const int chx = head * 64 + cg * 8, chb = 1024 + g * 64 + cg * 8, chc = 1152 + g * 64 + cg * 8;
    const float* scw = as_global(P.in[IN_SCW]) + (size_t)l * 4 * 1280; const float* scb = as_global(P.in[IN_SCB]) + (size_t)l * 1280;
    const float* scst = smp ? as_global(P.in[IN_SSDCONV]) + (size_t)(l * 8 + b) * 3 * 1280 : nullptr;
    const int qb = (wave >> 1) & 1, pb = wave & 1, r = lane & 31, hh = lane >> 5;
    f32x16 hacc[2];
#pragma unroll
    for (int nb = 0; nb < 2; ++nb)
#pragma unroll
        for (int i = 0; i < 16; ++i) hacc[nb][i] = 0.f;
    if (smp && wave < 4) {
        const float* hs = as_global(P.in[IN_SSD]) + ((size_t)((l * 8 + b) * 16 + head) * 64 + 32 * pb + r) * 64;
#pragma unroll
        for (int nb = 0; nb < 2; ++nb)
#pragma unroll
            for (int i4 = 0; i4 < 4; ++i4) { const f32x4 v = *(const f32x4*)(hs + 32 * nb + 8 * i4 + 4 * hh); hacc[nb][4 * i4] = v[0]; hacc[nb][4 * i4 + 1] = v[1]; hacc[nb][4 * i4 + 2] = v[2]; hacc[nb][4 * i4 + 3] = v[3]; }
    }
    const bf16_t* LX = WSP(bf16_t, WS_B3); bf16_t* LY = WSP(bf16_t, WS_B4);
    LAS unsigned char* LB = C.lds + 65536;
    LAS unsigned char* xcB = LB; LAS unsigned char* waT = LB + 9216; LAS unsigned char* wxT = LB + 18432;
    LAS float* xcF = (LAS float*)(LB + 27648); LAS float* aF = (LAS float*)(LB + 44032); LAS float* uF = (LAS float*)(LB + 60416); LAS float* lcwl = (LAS float*)(LB + 76800);
    const int ch0 = j * 64 + cg * 8;
    const float* lcw = as_global(P.in[IN_LCW]) + (size_t)l * 4 * DM; const float* lcb = as_global(P.in[IN_LCB]) + (size_t)l * DM;
    const float* lcst = smp ? as_global(P.in[IN_LRUCONV]) + (size_t)(l * 8 + b) * 3 * DM : nullptr;
    const int tb = qb, eb = pb, ech = j * 64 + 32 * eb + r;
    const float ba = as_global(P.in[IN_BA])[l * DM + ech], bxx = as_global(P.in[IN_BX])[l * DM + ech], sp8 = -8.0f * softplusf_(-as_global(P.in[IN_LAM])[l * DM + ech]);
    float hstate = (smp && wave == 4) ? as_global(P.in[IN_LRU])[(size_t)(l * 8 + b) * DM + j * 64 + lane] : 0.f;
    __syncthreads();
    for (int i = tid; i < 5 * 192; i += NTHREADS) { const int k = i / 192, cc = i % 192; const int ch = cc < 64 ? head * 64 + cc : (cc < 128 ? 1024 + g * 64 + (cc - 64) : 1152 + g * 64 + (cc - 128));
        cwl[i] = k < 4 ? scw[k * 1280 + ch] : scb[ch]; }
    { const float* wap = as_global(P.in[IN_WA]) + (size_t)(l * 16 + j) * 4096; const float* wxp = as_global(P.in[IN_WX]) + (size_t)(l * 16 + j) * 4096;
      for (int i = tid; i < 4096; i += NTHREADS) { const int d = i >> 6, e = i & 63; *(LAS bf16_t*)(waT + e * SROW + d * 2) = (bf16_t)f2bf(wap[i]); *(LAS bf16_t*)(wxT + e * SROW + d * 2) = (bf16_t)f2bf(wxp[i]); } }
    for (int i = tid; i < 5 * 64; i += NTHREADS) { const int k = i >> 6, cc = i & 63; lcwl[i] = k < 4 ? lcw[k * DM + j * 64 + cc] : lcb[j * 64 + cc]; }
    u32x4 rw[4], bcv, ccv, lrw[4], zs, lyv; float dtl = 0.f;
#define RAWROW(dst, base, ld, ch, cstp, tr) { if ((tr) >= 0) dst = ((tr) < L) ? *(const u32x4*)((base) + (size_t)(tok0 + (tr)) * (ld) + (ch)) : (u32x4){0u, 0u, 0u, 0u}; \
        else if (smp) { const float* s0_ = (cstp) + (size_t)((tr) + 3) * (ld) + (ch); const f32x4 a0_ = *(const f32x4*)s0_, a1_ = *(const f32x4*)(s0_ + 4); \
            dst = (u32x4){pk2(a0_[0], a0_[1]), pk2(a0_[2], a0_[3]), pk2(a1_[0], a1_[1]), pk2(a1_[2], a1_[3])}; } else dst = (u32x4){0u, 0u, 0u, 0u}; }
#define SSD_LOAD(c_) { const int tg_ = (c_) * 64 + t; _Pragma("unroll") for (int k = 0; k < 4; ++k) { RAWROW(rw[k], XBC, 1280, chx, scst, tg_ - 3 + k) } \
        const bool v_ = tg_ < L; bcv = v_ ? *(const u32x4*)(CBC + (size_t)(tok0 + tg_) * 256 + g * 64 + cg * 8) : (u32x4){0u, 0u, 0u, 0u}; ccv = v_ ? *(const u32x4*)(CBC + (size_t)(tok0 + tg_) * 256 + 128 + g * 64 + cg * 8) : (u32x4){0u, 0u, 0u, 0u}; \
        }
#define LRU_LOAD(c_) { const int tg_ = (c_) * 64 + t; _Pragma("unroll") for (int k = 0; k < 4; ++k) { RAWROW(lrw[k], LX, DM, ch0, lcst, tg_ - 3 + k) } }
#define TAIL_LOAD(c_) { const int tg_ = (c_) * 64 + t; const bool v_ = tg_ < L; zs = v_ ? *(const u32x4*)(Z + (size_t)(tok0 + tg_) * DM + chx) : (u32x4){0u, 0u, 0u, 0u}; lyv = v_ ? *(const u32x4*)(LY + (size_t)(tok0 + tg_) * DM + ch0) : (u32x4){0u, 0u, 0u, 0u}; }
    SSD_LOAD(0) LRU_LOAD(0) TAIL_LOAD(0)
    if (wave == 0) dtl = (lane < L) ? DT[(size_t)(tok0 + lane) * 16 + head] : 0.f;
    __syncthreads();
    for (int c = 0; c < nchunk; ++c) {
        int lt_ = tid; asm volatile("" : "+v"(lt_));
        const int t = lt_ >> 3, cg = lt_ & 7, lane = lt_ & 63, r = lane & 31, hh = lane >> 5;
        const int chx = head * 64 + cg * 8, chb = 1024 + g * 64 + cg * 8, chc = 1152 + g * 64 + cg * 8, ch0 = j * 64 + cg * 8;
        const int tg = c * 64 + t; const bool valid = tg < L;
        if (wave == 0 && !(skip & 128)) {
            float cs = dtl * a_h;
            { float o = shfl_f(cs, lane - 1); if (lane >= 1) cs += o; o = shfl_f(cs, lane - 2); if (lane >= 2) cs += o; o = shfl_f(cs, lane - 4); if (lane >= 4) cs += o;
              o = shfl_f(cs, lane - 8); if (lane >= 8) cs += o; o = shfl_f(cs, lane - 16); if (lane >= 16) cs += o; o = shfl_f(cs, lane - 32); if (lane >= 32) cs += o; }
            const float tot = shfl_f(cs, 63);
            acum[lane] = cs; dtv[lane] = dtl; eac[lane] = __expf(cs); wsc[lane] = __expf(tot - cs) * dtl; if (lane == 0) misc[0] = __expf(tot);
        }
        if (!(skip & 32)) {
            float v[8]; conv8<64>(lrw, lcwl + cg * 8, v);
            *(LAS u32x4*)(xcB + t * SROW + cg * 16) = (u32x4){pk2(v[0], v[1]), pk2(v[2], v[3]), pk2(v[4], v[5]), pk2(v[6], v[7])};
            *(LAS f32x4*)(xcF + t * 64 + cg * 8) = (f32x4){v[0], v[1], v[2], v[3]}; *(LAS f32x4*)(xcF + t * 64 + cg * 8 + 4) = (f32x4){v[4], v[5], v[6], v[7]};
            if (!dry && valid && tg >= L - 3) { float* co = C.out + (smp ? O_SLCONV : O_PLCONV) + ((size_t)(l * NB + b) * 3 + (tg - (L - 3))) * DM + ch0; const u32x4 q = lrw[3];
                *(f32x4*)co = (f32x4){bflo(q.x), bfhi(q.x), bflo(q.y), bfhi(q.y)}; *(f32x4*)(co + 4) = (f32x4){bflo(q.z), bfhi(q.z), bflo(q.w), bfhi(q.w)}; }
        }
        LRU_LOAD(c + 1)
        if (!(skip & 256)) __syncthreads();
        if (!(skip & 16)) {
            const float wsl = wsc[t];
            { float v[8]; conv8<192>(rw, cwl + cg * 8, v);
#pragma unroll
              for (int e = 0; e < 8; ++e) v[e] = valid ? siluf_(v[e]) : 0.f;
              if (!(skip & 1)) *(LAS u32x4*)(xsR + t * 192 + cg * 16) = (u32x4){pk2(v[0], v[1]), pk2(v[2], v[3]), pk2(v[4], v[5]), pk2(v[6], v[7])}; }
            *(LAS u32x4*)(bmR + t * SROW + cg * 16) = bcv;
            *(LAS u32x4*)(cmR + t * SROW + cg * 16) = ccv;
            if (!(skip & 1)) *(LAS u32x4*)(bwR + t * 192 + cg * 16) = (u32x4){pk2(bflo(bcv.x) * wsl, bfhi(bcv.x) * wsl), pk2(bflo(bcv.y) * wsl, bfhi(bcv.y) * wsl), pk2(bflo(bcv.z) * wsl, bfhi(bcv.z) * wsl), pk2(bflo(bcv.w) * wsl, bfhi(bcv.w) * wsl)};
            if (!dry && valid && tg >= L - 3) { float* co = C.out + (smp ? O_SSCONV : O_PSCONV) + ((size_t)(l * NB + b) * 3 + (tg - (L - 3))) * 1280 + chx; const u32x4 q = rw[3];
                *(f32x4*)co = (f32x4){bflo(q.x), bfhi(q.x), bflo(q.y), bfhi(q.y)}; *(f32x4*)(co + 4) = (f32x4){bflo(q.z), bfhi(q.z), bflo(q.w), bfhi(q.w)}; }
        }
        asm volatile("" ::: "memory");
        SSD_LOAD(c + 1)
        if (wave == 0) { const int tq_ = (c + 1) * 64 + lane; dtl = (tq_ < L) ? DT[(size_t)(tok0 + tq_) * 16 + head] : 0.f; }
        if (wave >= 4 && !(skip & 2)) {
            f32x16 ra, ia;
#pragma unroll
            for (int i = 0; i < 16; ++i) { ra[i] = 0.f; ia[i] = 0.f; }
#pragma unroll
            for (int ks = 0; ks < 4; ++ks) { const bf16x8 A = *(const LAS bf16x8*)(xcB + (32 * tb + r) * SROW + (16 * ks + 8 * hh) * 2);
                const bf16x8 Ba = *(const LAS bf16x8*)(waT + (32 * eb + r) * SROW + (16 * ks + 8 * hh) * 2), Bx = *(const LAS bf16x8*)(wxT + (32 * eb + r) * SROW + (16 * ks + 8 * hh) * 2);
                ra = MFMA32(A, Ba, ra); ia = MFMA32(A, Bx, ia); }
#pragma unroll
            for (int i = 0; i < 16; ++i) { const int tt = 32 * tb + (i & 3) + 8 * (i >> 2) + 4 * hh, e = 32 * eb + r;
                const float rg = sigmoidf_(ra[i] + ba), ig = sigmoidf_(ia[i] + bxx), log_a = rg * sp8, av = exp_fast(log_a);
                const float u = __builtin_amdgcn_sqrtf(fmaxf(1.0f - av * av, 0.f)) * (ig * xcF[tt * 64 + e]);
                aF[tt * 64 + e] = av; uF[tt * 64 + e] = u; }
        }
        if (!(skip & 256)) __syncthreads();
        if (wave < 4 && !(skip & 4)) {
            const int tri = lane & 15, trg = (lane >> 4) & 1;
            const int troff = (tri >> 2) * 192 + (16 * trg + 4 * (tri & 3)) * 2;
#define TRFRAG(tile, row0, rowstep, col0) ({ const LAS unsigned char* a_ = (tile) + (row0) * 192 + (col0) * 2 + troff; \
                const s16x4_ lo_ = __builtin_amdgcn_ds_read_tr16_b64_v4i16((LAS s16x4_*)a_), hi_ = __builtin_amdgcn_ds_read_tr16_b64_v4i16((LAS s16x4_*)(a_ + (rowstep) * 192)); \
                (bf16x8){lo_[0], lo_[1], lo_[2], lo_[3], hi_[0], hi_[1], hi_[2], hi_[3]}; })
            f32x16 y;
#pragma unroll
            for (int i = 0; i < 16; ++i) y[i] = 0.f;
#pragma unroll
            for (int nb = 0; nb < 2; ++nb)
#pragma unroll
                for (int tt = 0; tt < 2; ++tt) { const LAS unsigned char* ap = cmR + (32 * qb + r) * SROW + (32 * nb + 16 * tt + 4 * hh) * 2;
                    const u32x2 a0 = *(const LAS u32x2*)ap, a1 = *(const LAS u32x2*)(ap + 16);
                    y = MFMA32(__builtin_bit_cast(bf16x8, (u32x4){a0.x, a0.y, a1.x, a1.y}), pack_acc(hacc[nb], tt), y); }
#pragma unroll
            for (int i = 0; i < 16; ++i) y[i] *= eac[32 * qb + (i & 3) + 8 * (i >> 2) + 4 * hh];
            const float aq = acum[32 * qb + r]; const int qg = 32 * qb + r;
            for (int sb = 0; sb <= qb; ++sb) {
                f32x16 cbt;
#pragma unroll
                for (int i = 0; i < 16; ++i) cbt[i] = 0.f;
#pragma unroll
                for (int ks = 0; ks < 4; ++ks) { const bf16x8 A = *(const LAS bf16x8*)(bmR + (32 * sb + r) * SROW + (16 * ks + 8 * hh) * 2), B = *(const LAS bf16x8*)(cmR + (32 * qb + r) * SROW + (16 * ks + 8 * hh) * 2); cbt = MFMA32(A, B, cbt); }
#pragma unroll
                for (int i = 0; i < 16; ++i) { const int sg = 32 * sb + (i & 3) + 8 * (i >> 2) + 4 * hh;
                    float wv = cbt[i] * exp_fast(fminf(aq - acum[sg], 0.f)) * dtv[sg]; wv = sg > qg ? 0.f : wv; wv = sg == qg ? wv + Dh : wv; cbt[i] = wv; }
#pragma unroll
                for (int tt = 0; tt < 2; ++tt) { const bf16x8 B = TRFRAG(xsR, 32 * sb + 16 * tt + 4 * hh, 8, 32 * pb); y = MFMA32(pack_acc(cbt, tt), B, y); }
            }
#pragma unroll
            for (int i = 0; i < 16; ++i) ybuf[(32 * qb + (i & 3) + 8 * (i >> 2) + 4 * hh) * 64 + 32 * pb + r] = y[i];
            const float dec = misc[0];
#pragma unroll
            for (int nb = 0; nb < 2; ++nb) {
#pragma unroll
                for (int i = 0; i < 16; ++i) hacc[nb][i] *= dec;
#pragma unroll
                for (int ks = 0; ks < 4; ++ks) { const bf16x8 A = TRFRAG(bwR, 16 * ks + 8 * hh, 4, 32 * nb), B = TRFRAG(xsR, 16 * ks + 8 * hh, 4, 32 * pb); hacc[nb] = MFMA32(A, B, hacc[nb]); }
            }
#undef TRFRAG
        } else if (wave == 4 && !(skip & 8)) {
            const int nsteps = (L - c * 64) < 64 ? (L - c * 64) : 64;
            for (int s0 = 0; s0 < nsteps; s0 += 8) {
                float av[8], uv[8];
#pragma unroll
                for (int q = 0; q < 8; ++q) { av[q] = aF[(s0 + q) * 64 + lane]; uv[q] = uF[(s0 + q) * 64 + lane]; }
#pragma unroll
                for (int q = 0; q < 8; ++q) { hstate = (s0 + q < nsteps) ? av[q] * hstate + uv[q] : hstate; uF[(s0 + q) * 64 + lane] = hstate; }
            }
        }
        if (!(skip & 256)) __syncthreads();
        if (!(skip & 64)) {
            const f32x4 y0 = *(const LAS f32x4*)(ybuf + t * 64 + cg * 8), y1 = *(const LAS f32x4*)(ybuf + t * 64 + cg * 8 + 4);
            const float o0 = y0[0] * bflo(zs.x), o1 = y0[1] * bfhi(zs.x), o2 = y0[2] * bflo(zs.y), o3 = y0[3] * bfhi(zs.y);
            const float o4 = y1[0] * bflo(zs.z), o5 = y1[1] * bfhi(zs.z), o6 = y1[2] * bflo(zs.w), o7 = y1[3] * bfhi(zs.w);
            float ss = (o0 * o0 + o1 * o1) + (o2 * o2 + o3 * o3) + (o4 * o4 + o5 * o5) + (o6 * o6 + o7 * o7);
            ss = row8_sum(ss);
            const f32x4 h0 = *(const LAS f32x4*)(uF + t * 64 + cg * 8), h1 = *(const LAS f32x4*)(uF + t * 64 + cg * 8 + 4);
            asm volatile("" :: "v"(o0), "v"(o7), "v"(ss), "v"(h0[0]), "v"(h1[3]));
            if (valid && !dry) { *(u32x4*)(Z + (size_t)(tok0 + tg) * DM + chx) = (u32x4){pk2(o0, o1), pk2(o2, o3), pk2(o4, o5), pk2(o6, o7)};
                if (cg == 0) SSQ[(size_t)(tok0 + tg) * 16 + head] = ss;
                *(u32x4*)(LY + (size_t)(tok0 + tg) * DM + ch0) = (u32x4){pk2(h0[0] * bflo(lyv.x), h0[1] * bfhi(lyv.x)), pk2(h0[2] * bflo(lyv.y), h0[3] * bfhi(lyv.y)),
                                                                          pk2(h1[0] * bflo(lyv.z), h1[1] * bfhi(lyv.z)), pk2(h1[2] * bflo(lyv.w), h1[3] * bfhi(lyv.w))}; }
        }
        if (skip & 512) {
#pragma unroll
            for (int k = 0; k < 4; ++k) asm volatile("" :: "v"(rw[k].x), "v"(rw[k].w), "v"(lrw[k].x), "v"(lrw[k].w));
            asm volatile("" :: "v"(bcv.x), "v"(ccv.x), "v"(zs.x), "v"(lyv.x), "v"(dtl)); }
        TAIL_LOAD(c + 1)
    }
#undef RAWROW
#undef SSD_LOAD
#undef LRU_LOAD
#undef TAIL_LOAD
    if (!dry && wave < 4 && qb == 0) {
        float* so = C.out + (smp ? O_SSSD : O_PSSD) + ((size_t)((l * NB + b) * 16 + head) * 64 + 32 * pb + r) * 64;
#pragma unroll
        for (int nb = 0; nb < 2; ++nb)
#pragma unroll
            for (int i4 = 0; i4 < 4; ++i4) *(f32x4*)(so + 32 * nb + 8 * i4 + 4 * hh) = (f32x4){hacc[nb][4 * i4], hacc[nb][4 * i4 + 1], hacc[nb][4 * i4 + 2], hacc[nb][4 * i4 + 3]};
    }
    if (wave == 4 && !dry) C.out[(smp ? O_SLRU : O_PLRU) + (size_t)(l * NB + b) * DM + j * 64 + lane] = hstate;
    __syncthreads();
}

__device__ __forceinline__ void phase_scan(const Ctx& C, int l, bool dry = false) {
    for (int it = C.bid; it < 384; it += C.G) scan_item_fused(C, l, it, dry);
}

__device__ __forceinline__ unsigned mono(float f) { const unsigned u = __float_as_uint(f); return (u & 0x80000000u) ? ~u : (u | 0x80000000u); }
__device__ __forceinline__ float unmono(unsigned k) { const unsigned u = (k & 0x80000000u) ? (k & 0x7fffffffu) : ~k; return __uint_as_float(u); }
template <int CTRL> __device__ __forceinline__ unsigned dpp_u(unsigned v) { return (unsigned)__builtin_amdgcn_update_dpp(0, (int)v, CTRL, 0xf, 0xf, true); }
__device__ __forceinline__ unsigned row_max_u(unsigned m) {
    m = max(m, dpp_u<0xB1>(m)); m = max(m, dpp_u<0x4E>(m)); m = max(m, dpp_u<0x141>(m)); m = max(m, dpp_u<0x140>(m)); return m;
}
__device__ __forceinline__ float row_max_f(float m) {
    m = fmaxf(m, __uint_as_float(dpp_u<0xB1>(__float_as_uint(m)))); m = fmaxf(m, __uint_as_float(dpp_u<0x4E>(__float_as_uint(m))));
    m = fmaxf(m, __uint_as_float(dpp_u<0x141>(__float_as_uint(m)))); m = fmaxf(m, __uint_as_float(dpp_u<0x140>(__float_as_uint(m)))); return m;
}
__device__ __forceinline__ float row_sum_f(float m) {
    m += __uint_as_float(dpp_u<0xB1>(__float_as_uint(m))); m += __uint_as_float(dpp_u<0x4E>(__float_as_uint(m)));
    m += __uint_as_float(dpp_u<0x141>(__float_as_uint(m))); m += __uint_as_float(dpp_u<0x140>(__float_as_uint(m))); return m;
}
#define CE_(a, b) { const unsigned hi_ = max(a, b), lo_ = min(a, b); a = hi_; b = lo_; }
#define KEY8(k, a, b) unsigned k##0 = (mono(a[0]) & ~127u) | (unsigned)(127 - (li * 8 + 0)), k##1 = (mono(a[1]) & ~127u) | (unsigned)(127 - (li * 8 + 1)), k##2 = (mono(a[2]) & ~127u) | (unsigned)(127 - (li * 8 + 2)), \
        k##3 = (mono(a[3]) & ~127u) | (unsigned)(127 - (li * 8 + 3)), k##4 = (mono(b[0]) & ~127u) | (unsigned)(127 - (li * 8 + 4)), k##5 = (mono(b[1]) & ~127u) | (unsigned)(127 - (li * 8 + 5)), \
        k##6 = (mono(b[2]) & ~127u) | (unsigned)(127 - (li * 8 + 6)), k##7 = (mono(b[3]) & ~127u) | (unsigned)(127 - (li * 8 + 7));
#define SORT8(k) CE_(k##0, k##1) CE_(k##2, k##3) CE_(k##4, k##5) CE_(k##6, k##7)  CE_(k##0, k##2) CE_(k##1, k##3) CE_(k##4, k##6) CE_(k##5, k##7)  CE_(k##1, k##2) CE_(k##5, k##6) \
        CE_(k##0, k##4) CE_(k##1, k##5) CE_(k##2, k##6) CE_(k##3, k##7)  CE_(k##2, k##4) CE_(k##3, k##5)  CE_(k##1, k##2) CE_(k##3, k##4) CE_(k##5, k##6)
#define POP8(k, m, c) k##0 = c ? k##1 : k##0; k##1 = c ? k##2 : k##1; k##2 = c ? k##3 : k##2; k##3 = c ? k##4 : k##3; k##4 = c ? k##5 : k##4; k##5 = c ? k##6 : k##5; k##6 = c ? k##7 : k##6; k##7 = c ? 0u : k##7;
__device__ __forceinline__ void top16_row2(const f32x4 a0, const f32x4 b0, const f32x4 a1, const f32x4 b1, int li, unsigned& r0, unsigned& r1) {
    KEY8(x, a0, b0) KEY8(y, a1, b1)
    SORT8(x) SORT8(y)
    unsigned rx = 0u, ry = 0u;
#pragma unroll
    for (int r = 0; r < 16; ++r) {
        const unsigned mx = row_max_u(x0), my = row_max_u(y0); const bool cx = (x0 == mx), cy = (y0 == my);
        POP8(x, mx, cx) POP8(y, my, cy)
        rx = (li == r) ? mx : rx; ry = (li == r) ? my : ry;
    }
    r0 = rx; r1 = ry;
}
#undef KEY8
#undef SORT8
#undef POP8
__device__ __forceinline__ void phase_topk(const Ctx& C) {
    const float* SC = WSP(float, WS_SC); int* EI = WSP(int, WS_EI); float* GW = WSP(float, WS_GW);
    const int lane = C.lane, li = lane & 15, rowi = lane >> 4;
    LAS float* sv = (LAS float*)(C.lds + 4096 + C.wave * 1024);
    LAS int* si = (LAS int*)(sv + 128);
    LAS unsigned char* tab = (LAS unsigned char*)C.lds;
    if (C.tid < 64) { int c = C.tid, i = 0; for (; i < 16; ++i) { const int cnt = 16 / (i + 1); if (c < cnt) break; c -= cnt; } tab[C.tid] = (unsigned char)(C.tid < 50 ? (i | (c << 4)) : 0); }
    __syncthreads();
    int ica[4], jca[4];
#pragma unroll
    for (int q = 0; q < 4; ++q) { const int tb = tab[4 * li + q]; ica[q] = tb & 15; jca[q] = tb >> 4; }
    const int gw = C.bid * NWAVES + C.wave, NGW = C.G * NWAVES;
    f32x4 na0, nb0, na1, nb1;
    { const float* base = SC + (size_t)min(gw, TT * 2 - 1) * 1024;
      na0 = *(const f32x4*)(base + lane * 8); nb0 = *(const f32x4*)(base + lane * 8 + 4); na1 = *(const f32x4*)(base + 512 + lane * 8); nb1 = *(const f32x4*)(base + 512 + lane * 8 + 4); }
    for (int g4 = gw; g4 < TT * 2; g4 += NGW) {
        const int row = g4 >> 1, hd0 = (g4 & 1) * 4;
        const f32x4 a0 = na0, b0 = nb0, a1 = na1, b1 = nb1;
        { const float* base = SC + (size_t)min(g4 + NGW, TT * 2 - 1) * 1024;
          na0 = *(const f32x4*)(base + lane * 8); nb0 = *(const f32x4*)(base + lane * 8 + 4); na1 = *(const f32x4*)(base + 512 + lane * 8); nb1 = *(const f32x4*)(base + 512 + lane * 8 + 4); }
        unsigned r0, r1; top16_row2(a0, b0, a1, b1, li, r0, r1);
        sv[lane] = unmono(r0 & ~127u); si[lane] = 127 - (int)(r0 & 127u); sv[64 + lane] = unmono(r1 & ~127u); si[64 + lane] = 127 - (int)(r1 & 127u);
        LDS_WAIT();
        const LAS float* v1 = sv + rowi * 32; const LAS float* v2 = v1 + 16;
        unsigned k[4];
#pragma unroll
        for (int q = 0; q < 4; ++q) { const int c = 4 * li + q; const float sum = v1[ica[q]] + v2[jca[q]]; k[q] = (c < 50) ? ((mono(sum) & ~63u) | (unsigned)(63 - c)) : 0u; }
        CE_(k[0], k[1]) CE_(k[2], k[3]) CE_(k[0], k[2]) CE_(k[1], k[3]) CE_(k[1], k[2])
        unsigned res = 0u;
#pragma unroll
        for (int r = 0; r < 16; ++r) {
            const unsigned m = row_max_u(k[0]); const bool c = (k[0] == m);
            k[0] = c ? k[1] : k[0]; k[1] = c ? k[2] : k[1]; k[2] = c ? k[3] : k[2]; k[3] = c ? 0u : k[3];
            res = (li == r) ? m : res;
        }
        const int csel = 63 - (int)(res & 63u); const int tb = tab[csel];
        const int e1 = (si + rowi * 32)[tb & 15], e2 = (si + rowi * 32 + 16)[tb >> 4];
        const float svv = unmono(res & ~63u);
        const float mx = row_max_f(svv), ex = __expf(svv - mx), den = row_sum_f(ex);
        const size_t o = (size_t)row * 128 + (hd0 + rowi) * 16 + li;
        EI[o] = e1 * 128 + e2; GW[o] = ex / den;
        LDS_WAIT();
    }
    __syncthreads();
}

template <int CTRL> __device__ __forceinline__ float dpp_f(float v) { return __int_as_float(__builtin_amdgcn_update_dpp(0, __float_as_int(v), CTRL, 0xf, 0xf, true)); }
__device__ __forceinline__ float swap16_f(float v, int lane) { auto r = __builtin_amdgcn_permlane16_swap(__float_as_uint(v), __float_as_uint(v), false, false); return __uint_as_float((lane & 16) ? r[0] : r[1]); }
constexpr int PEER_SLICES = 8;
#define PEER_LOAD_E(E, t_) { const u32x4* ep_ = (const u32x4*)(EI + (size_t)(t_) * 128 + r8 * 16); E[0] = ep_[0]; E[1] = ep_[1]; E[2] = ep_[2]; E[3] = ep_[3]; }
#define PEER_GATHER(U, E, base_, coff_) { _Pragma("unroll") for (int q_ = 0; q_ < 4; ++q_) { U[4 * q_] = *(const u32x4*)((base_) + (E[q_].x * 128u + (coff_))); U[4 * q_ + 1] = *(const u32x4*)((base_) + (E[q_].y * 128u + (coff_))); \
        U[4 * q_ + 2] = *(const u32x4*)((base_) + (E[q_].z * 128u + (coff_))); U[4 * q_ + 3] = *(const u32x4*)((base_) + (E[q_].w * 128u + (coff_))); } }
#define FP8LO(d) __builtin_amdgcn_cvt_pk_f32_fp8((int)(d), false)
#define FP8HI(d) __builtin_amdgcn_cvt_pk_f32_fp8((int)(d), true)
__device__ __forceinline__ void peer_u_reduce(const u32x4 (&U)[16], const u32x4 hq0, const u32x4 hq1, float* po, int c, bool store) {
    f32x2 h[8];
    h[0] = (f32x2){bflo(hq0.x), bfhi(hq0.x)}; h[1] = (f32x2){bflo(hq0.y), bfhi(hq0.y)}; h[2] = (f32x2){bflo(hq0.z), bfhi(hq0.z)}; h[3] = (f32x2){bflo(hq0.w), bfhi(hq0.w)};
    h[4] = (f32x2){bflo(hq1.x), bfhi(hq1.x)}; h[5] = (f32x2){bflo(hq1.y), bfhi(hq1.y)}; h[6] = (f32x2){bflo(hq1.z), bfhi(hq1.z)}; h[7] = (f32x2){bflo(hq1.w), bfhi(hq1.w)};
    float p[16];
#pragma unroll
    for (int i = 0; i < 16; ++i) {
        f32x2 s0 = FP8LO(U[i].x) * h[0], s1 = FP8HI(U[i].x) * h[1];
        s0 = __builtin_elementwise_fma(FP8LO(U[i].y), h[2], s0); s1 = __builtin_elementwise_fma(FP8HI(U[i].y), h[3], s1);
        s0 = __builtin_elementwise_fma(FP8LO(U[i].z), h[4], s0); s1 = __builtin_elementwise_fma(FP8HI(U[i].z), h[5], s1);
        s0 = __builtin_elementwise_fma(FP8LO(U[i].w), h[6], s0); s1 = __builtin_elementwise_fma(FP8HI(U[i].w), h[7], s1);
        s0 = s0 + s1; p[i] = s0.x + s0.y;
    }
#pragma unroll
    for (int bq = 0; bq < 2; ++bq) { float* q = p + 8 * bq;
        { const bool up = (c & 4) != 0;
#pragma unroll
          for (int j = 0; j < 4; ++j) { const float mine = up ? q[j + 4] : q[j], send = up ? q[j] : q[j + 4]; q[j] = mine + dpp_f<0x141>(send); } }
        { const bool up = (c & 2) != 0;
#pragma unroll
          for (int j = 0; j < 2; ++j) { const float mine = up ? q[j + 2] : q[j], send = up ? q[j] : q[j + 2]; q[j] = mine + dpp_f<0x4E>(send); } }
        { const bool up = (c & 1) != 0; const float mine = up ? q[1] : q[0], send = up ? q[0] : q[1]; q[0] = mine + dpp_f<0xB1>(send); } }
    if (store) { po[0] = p[0]; po[8] = p[8]; }
}
__device__ __forceinline__ void phase_peer_u(const Ctx& C) {
    const int lane = C.lane, r8 = lane >> 3, c = lane & 7;
    const bf16_t* H2 = WSP(bf16_t, WS_B0); const unsigned char* U8 = C.ws + WS_U8; const int* EI = WSP(int, WS_EI); float* PA = WSP(float, WS_SC);
    const int s = C.bid & 7, wg = (C.bid >> 3) * NWAVES + C.wave, nwg = (C.G >> 3) * NWAVES;
    const int n = (TT - wg + nwg - 1) / nwg;
    const unsigned char* ub = U8 + (size_t)s * NE * 128; const unsigned coff = (unsigned)c * 16u; const bf16_t* hb = H2 + s * 128 + c * 16;
    float* pab = PA + (size_t)s * 128 + r8 * 16 + c;
#define TOK(i_) (min(wg + (i_) * nwg, TT - 1))
#define LOAD_H(H0, H1, t_) { const u32x4* hp_ = (const u32x4*)(hb + (size_t)(t_) * DM); H0 = hp_[0]; H1 = hp_[1]; }
    u32x4 uA[16], uB[16], en[4], enn[4], hc0, hc1, hn0, hn1, hnn0, hnn1;
    PEER_LOAD_E(en, TOK(0)); LOAD_H(hc0, hc1, TOK(0));
    PEER_GATHER(uA, en, ub, coff);
    PEER_LOAD_E(en, TOK(1)); LOAD_H(hn0, hn1, TOK(1));
    for (int i = 0; i < n; i += 2) {
        PEER_GATHER(uB, en, ub, coff);
        PEER_LOAD_E(enn, TOK(i + 2)); LOAD_H(hnn0, hnn1, TOK(i + 2));
        peer_u_reduce(uA, hc0, hc1, pab + (size_t)TOK(i) * (PEER_SLICES * 128), c, true);
        hc0 = hn0; hc1 = hn1; hn0 = hnn0; hn1 = hnn1;
        PEER_GATHER(uA, enn, ub, coff);
        PEER_LOAD_E(en, TOK(i + 3)); LOAD_H(hnn0, hnn1, TOK(i + 3));
        peer_u_reduce(uB, hc0, hc1, pab + (size_t)TOK(i + 1) * (PEER_SLICES * 128), c, i + 1 < n);
        hc0 = hn0; hc1 = hn1; hn0 = hnn0; hn1 = hnn1;
    }
#undef LOAD_H
#undef TOK
}
__device__ __forceinline__ void phase_peer_act(const Ctx& C) {
    const float* PA = WSP(float, WS_SC); float* GW = WSP(float, WS_GW); const int* EI = WSP(int, WS_EI); const float* SU = WSP(float, WS_SU); const float* SV = WSP(float, WS_SV);
    const size_t n = (size_t)TT * 128, stride = (size_t)C.G * NTHREADS;
    for (size_t i = (size_t)C.bid * NTHREADS + C.tid; i < n; i += stride) {
        const size_t t = i >> 7; const int k = (int)(i & 127); const float* pp = PA + t * (PEER_SLICES * 128) + k;
        float a = 0.f;
#pragma unroll
        for (int s = 0; s < PEER_SLICES; ++s) a += pp[s * 128];
        const int e = EI[i];
        GW[i] = geluf_(a * SU[e]) * GW[i] * SV[e];
    }
}
#define PEER_LOAD_A(A, t_) { const f32x4* ap_ = (const f32x4*)(ACT + (size_t)(t_) * 128 + r8 * 16); A[0] = ap_[0]; A[1] = ap_[1]; A[2] = ap_[2]; A[3] = ap_[3]; }
#define PEER_GATHER8(U, E0, E1, base_, coff_) { U[0] = *(const u32x4*)((base_) + (E0.x * 128u + (coff_))); U[1] = *(const u32x4*)((base_) + (E0.y * 128u + (coff_))); U[2] = *(const u32x4*)((base_) + (E0.z * 128u + (coff_))); U[3] = *(const u32x4*)((base_) + (E0.w * 128u + (coff_))); \
        U[4] = *(const u32x4*)((base_) + (E1.x * 128u + (coff_))); U[5] = *(const u32x4*)((base_) + (E1.y * 128u + (coff_))); U[6] = *(const u32x4*)((base_) + (E1.z * 128u + (coff_))); U[7] = *(const u32x4*)((base_) + (E1.w * 128u + (coff_))); }
__device__ __forceinline__ void peer_v_acc8(f32x2 (&o)[8], const u32x4 (&V)[8], const f32x4 A0, const f32x4 A1) {
#pragma unroll
    for (int i = 0; i < 8; ++i) { const float a = i < 4 ? A0[i & 3] : A1[i & 3]; const f32x2 a2 = (f32x2){a, a};
        o[0] = __builtin_elementwise_fma(FP8LO(V[i].x), a2, o[0]); o[1] = __builtin_elementwise_fma(FP8HI(V[i].x), a2, o[1]);
        o[2] = __builtin_elementwise_fma(FP8LO(V[i].y), a2, o[2]); o[3] = __builtin_elementwise_fma(FP8HI(V[i].y), a2, o[3]);
        o[4] = __builtin_elementwise_fma(FP8LO(V[i].z), a2, o[4]); o[5] = __builtin_elementwise_fma(FP8HI(V[i].z), a2, o[5]);
        o[6] = __builtin_elementwise_fma(FP8LO(V[i].w), a2, o[6]); o[7] = __builtin_elementwise_fma(FP8HI(V[i].w), a2, o[7]); }
}
__device__ __forceinline__ f32x2 peer_v_scatter(const f32x2 (&o2)[8], int lane) {
    float o[16];
#pragma unroll
    for (int j = 0; j < 8; ++j) { o[2 * j] = o2[j].x; o[2 * j + 1] = o2[j].y; }
    { const bool up = (lane & 32) != 0;
#pragma unroll
      for (int j = 0; j < 8; ++j) { const float mine = up ? o[j + 8] : o[j], send = up ? o[j] : o[j + 8]; o[j] = mine + shfx<32>(send, lane); } }
    { const bool up = (lane & 16) != 0;
#pragma unroll
      for (int j = 0; j < 4; ++j) { const float mine = up ? o[j + 4] : o[j], send = up ? o[j] : o[j + 4]; o[j] = mine + swap16_f(send, lane); } }
    { const bool up = (lane & 8) != 0;
#pragma unroll
      for (int j = 0; j < 2; ++j) { const float mine = up ? o[j + 2] : o[j], send = up ? o[j] : o[j + 2]; o[j] = mine + dpp_f<0x128>(send); } }
    return (f32x2){o[0], o[1]};
}
__device__ __forceinline__ void phase_peer_v(const Ctx& C, int l, bool dry = false) {
    const int lane = C.lane, r8 = lane >> 3, c = lane & 7;
    const unsigned char* V8 = C.ws + WS_V8; const int* EI = WSP(int, WS_EI); const float* ACT = WSP(float, WS_GW); const float* MOD = WSP(float, WS_MOD);
    const int s = C.bid & 7, wg = (C.bid >> 3) * NWAVES + C.wave, nwg = (C.G >> 3) * NWAVES;
    const int n = (TT - wg + nwg - 1) / nwg;
    const int jcol = ((lane >> 5) & 1) * 8 + ((lane >> 4) & 1) * 4 + ((lane >> 3) & 1) * 2;
    const int col = s * 128 + c * 16 + jcol;
    const unsigned char* vb = V8 + (size_t)s * NE * 128; const unsigned coff = (unsigned)c * 16u;
    float* xb = C.out + col; const float* g2 = MOD + (size_t)l * NBT * 6144 + 5120 + col;
#define TOK(i_) (min(wg + (i_) * nwg, TT - 1))
    u32x4 vA[8], vB[8], ec[4], en[4]; f32x4 ac[4], an[4];
    PEER_LOAD_E(ec, TOK(0)); PEER_LOAD_A(ac, TOK(0));
    PEER_GATHER8(vA, ec[0], ec[1], vb, coff);
    PEER_LOAD_E(en, TOK(1)); PEER_LOAD_A(an, TOK(1));
    for (int i = 0; i < n; ++i) {
        const int t = TOK(i);
        PEER_GATHER8(vB, ec[2], ec[3], vb, coff);
        const f32x2 xv = *(const f32x2*)(xb + (size_t)t * DM), gv = *(const f32x2*)(g2 + (size_t)row_batch(t) * 6144);
        f32x2 o[8];
#pragma unroll
        for (int j = 0; j < 8; ++j) o[j] = (f32x2){0.f, 0.f};
        peer_v_acc8(o, vA, ac[0], ac[1]);
        PEER_GATHER8(vA, en[0], en[1], vb, coff);
        peer_v_acc8(o, vB, ac[2], ac[3]);
#pragma unroll
        for (int q = 0; q < 4; ++q) { ec[q] = en[q]; ac[q] = an[q]; }
        PEER_LOAD_E(en, TOK(i + 2)); PEER_LOAD_A(an, TOK(i + 2));
        const f32x2 ov = peer_v_scatter(o, lane);
        asm volatile("" :: "v"(ov.x), "v"(ov.y));
        if (!dry) *(f32x2*)(xb + (size_t)t * DM) = xv + gv * ov;
    }
#undef TOK
}
#undef PEER_GATHER8
#undef PEER_LOAD_E
#undef PEER_LOAD_A
#undef PEER_GATHER
__device__ __forceinline__ void phase_final_norm(const Ctx& C) {
    const int gw = C.bid * NWAVES + C.wave, NGW = C.G * NWAVES; const float* fw = as_global(C.P->in[IN_FNW]);
    for (int row = gw; row < TT; row += NGW) {
        f32x4* xr = (f32x4*)(C.out + (size_t)row * DM) + C.lane;
        f32x4 v[4]; float s = 0.f;
#pragma unroll
        for (int j = 0; j < 4; ++j) { v[j] = xr[64 * j]; s += (v[j][0] * v[j][0] + v[j][1] * v[j][1]) + (v[j][2] * v[j][2] + v[j][3] * v[j][3]); }
        const float rstd = rsqrtf(wave_sum(s) * (1.f / DM) + EPS);
#pragma unroll
        for (int j = 0; j < 4; ++j) xr[64 * j] = v[j] * rstd * *(const f32x4*)(fw + C.lane * 4 + 256 * j);
    }
}


#define XB_TMO      128
#define XB_XCNT(j)  (256  + 64 * (j))
#define XB_XSUB(j)  (1280 + 64 * (j))
#define XB_XGEN(j)  (2304 + 64 * (j))
#define XB_TOP      3328
#define XB_TOPGEN   3392
#define XCD_BAR_WORDS 3456
#define XB_SPIN_CAP (1u << 22)
__device__ __forceinline__ unsigned xb_ld(unsigned* p)              { return __hip_atomic_load(p, __ATOMIC_RELAXED, __HIP_MEMORY_SCOPE_AGENT); }
__device__ __forceinline__ unsigned xb_add(unsigned* p, unsigned v) { return __hip_atomic_fetch_add(p, v, __ATOMIC_RELAXED, __HIP_MEMORY_SCOPE_AGENT); }
__device__ __forceinline__ unsigned xb_xcc_id() { return (unsigned)__builtin_amdgcn_s_getreg((3 << 11) | 20) & 0xFu; }
#define XB_SPIN(cond, bar) do { unsigned _sp = 0; while (cond) { __builtin_amdgcn_s_sleep(1); \
    if ((++_sp & 255u) == 0u) { if (xb_ld(&(bar)[XB_TMO])) break; if (_sp > XB_SPIN_CAP) { atomicAdd(&(bar)[XB_TMO], 1u); break; } } } } while (0)
struct XcdBarrier { unsigned* bar; unsigned x; volatile LAS unsigned* st; };
__device__ __forceinline__ XcdBarrier xcd_barrier_post(unsigned* bar, volatile LAS unsigned* st) {
    XcdBarrier b; b.bar = bar; b.x = xb_xcc_id(); b.st = st;
    if (threadIdx.x == 0) (void)xb_add(&bar[XB_XCNT(b.x)], 1u);
    return b;
}
__device__ __forceinline__ void xcd_barrier_complete(unsigned* bar, unsigned x, unsigned& nloc, unsigned& nx) {
    const unsigned G = gridDim.x * gridDim.y * gridDim.z;
    unsigned sum, cnt, mine, sp = 0u;
    for (;;) {
        sum = 0u; cnt = 0u; mine = 0u;
#pragma unroll
        for (unsigned j = 0; j < 16; ++j) { const unsigned c = xb_ld(&bar[XB_XCNT(j)]); sum += c; cnt += (c > 0u) ? 1u : 0u; mine = (j == x) ? c : mine; }
        if (sum == G) break;
        __builtin_amdgcn_s_sleep(1);
        if ((++sp & 255u) == 0u) { if (xb_ld(&bar[XB_TMO])) break; if (sp > XB_SPIN_CAP) { atomicAdd(&bar[XB_TMO], 1u); break; } }
    }
    nloc = mine > 0u ? mine : 1u; nx = cnt > 0u ? cnt : 1u;
}
__device__ __forceinline__ void xcd_barrier(const XcdBarrier& b) {
    asm volatile("s_waitcnt vmcnt(0)" ::: "memory");
    __syncthreads();
    if (threadIdx.x == 0) {
        unsigned* bar = b.bar;
        __builtin_amdgcn_s_waitcnt(0);
        unsigned nloc = b.st[0], nx = b.st[1];
        if (nloc == 0u) { xcd_barrier_complete(bar, b.x, nloc, nx); b.st[0] = nloc; b.st[1] = nx; }
        const unsigned old = xb_add(&bar[XB_XSUB(b.x)], 1u);
        const unsigned gen = old / nloc;
        if (old + 1u == (gen + 1u) * nloc) {
            __builtin_amdgcn_fence(__ATOMIC_RELEASE, "agent");
            asm volatile("s_waitcnt vmcnt(0)" ::: "memory");
            const unsigned og = xb_add(&bar[XB_TOP], 1u);
            const unsigned tg = og / nx;
            if (og + 1u == (tg + 1u) * nx) xb_add(&bar[XB_TOPGEN], 1u);
            else XB_SPIN(xb_ld(&bar[XB_TOPGEN]) == tg, bar);
            __builtin_amdgcn_fence(__ATOMIC_ACQUIRE, "agent");
            xb_add(&bar[XB_XGEN(b.x)], 1u);
            asm volatile("s_waitcnt vmcnt(0)" ::: "memory");
        } else {
            XB_SPIN(xb_ld(&bar[XB_XGEN(b.x)]) == gen, bar);
            __builtin_amdgcn_fence(__ATOMIC_ACQUIRE, "agent");
            asm volatile("s_waitcnt vmcnt(0)" ::: "memory");
        }
    }
    __syncthreads();
}

__device__ __forceinline__ Ctx relaunder(const Ctx& C) {
    Ctx D = C; int t = C.tid; asm volatile("" : "+v"(t)); D.tid = t; D.lane = t & 63;
    unsigned char* w = C.ws; float* o = C.out; asm volatile("" : "+s"(w), "+s"(o)); D.ws = as_global(w); D.out = as_global(o); return D;
}
constexpr int NPL = 13, NPH = 2 + 2 * NPL;
__device__ __forceinline__ void run_phase(const Ctx& C0, int ph, bool dry) {
    if (ph == 0) { const Ctx C = relaunder(C0); phase_prep(C); return; }
    if (ph == NPH - 1) { const Ctx C = relaunder(C0); phase_final_norm(C); return; }
    const int l = (ph - 1) / NPL, k = (ph - 1) % NPL;
    switch (k) {
    case 0: { const Ctx C = relaunder(C0); phase_norm(C, l, 0); } break;
    case 1: { const Ctx C = relaunder(C0); CParams& P = *C.P; Epi1 E{WSP(bf16_t, WS_B1), WSP(bf16_t, WS_B2), WSP(bf16_t, WS_B3), WSP(bf16_t, WS_B4), WSP(float, WS_DT), as_global(P.in[IN_DTB]) + l * 16};
              gemm_run(C, WSP(bf16_t, WS_B0), WSP(bf16_t, WS_W1T) + (size_t)l * N1 * DM, nullptr, nullptr, N1, E); } break;
    case 2: { const Ctx C = relaunder(C0); phase_convbc(C, l); } break;
    case 3: { const Ctx C = relaunder(C0); phase_scan(C, l, dry); } break;
    case 4: { const Ctx C = relaunder(C0); Epi2 E{WSP(bf16_t, WS_GS), WSP(bf16_t, WS_GL)};
              gemm_run(C, WSP(bf16_t, WS_B0), WSP(bf16_t, WS_WGT) + (size_t)l * NG * DM, nullptr, nullptr, NG, E); } break;
    case 5: { const Ctx C = relaunder(C0); Epi3 E{WSP(bf16_t, WS_GS), WSP(bf16_t, WS_GL), WSP(float, WS_SSQ), WSP(bf16_t, WS_B0)};
              gemm_run(C, WSP(bf16_t, WS_B1), WSP(bf16_t, WS_WBS) + (size_t)l * DM * DM, WSP(bf16_t, WS_B4), WSP(bf16_t, WS_WBL) + (size_t)l * DM * DM, DM, E); } break;
    case 6: { const Ctx C = relaunder(C0); CParams& P = *C.P; Epi4 E{as_global(P.in[IN_XP]), as_global(P.in[IN_XS]), C.out, WSP(float, WS_MOD) + (size_t)l * NBT * 6144, l};
              gemm_run(C, WSP(bf16_t, WS_B0), WSP(bf16_t, WS_WO) + (size_t)l * DM * DM, nullptr, nullptr, DM, E); } break;
    case 7: { const Ctx C = relaunder(C0); phase_norm(C, l, 1); } break;
    case 8: { const Ctx C = relaunder(C0); Epi5 E{WSP(float, WS_SC)};
              gemm_run(C, WSP(bf16_t, WS_B0), WSP(bf16_t, WS_WC) + (size_t)l * 2048 * DM, nullptr, nullptr, 2048, E); } break;
    case 9: { const Ctx C = relaunder(C0); phase_topk(C); } break;
    case 10: { const Ctx C = relaunder(C0); phase_peer_u(C); } break;
    case 11: { const Ctx C = relaunder(C0); phase_peer_act(C); } break;
    case 12: { const Ctx C = relaunder(C0); phase_peer_v(C, l, dry); } break;
    }
}

__global__ void __launch_bounds__(NTHREADS, 2) fwd(Params P) {
    extern __shared__ __attribute__((aligned(16))) unsigned char lds_raw[];
    const int ph_lo = P.ph_lo, ph_hi = P.ph_hi;
    volatile LAS unsigned* bst = (volatile LAS unsigned*)((LAS unsigned char*)lds_raw + LDS_BYTES - 64);
    if (threadIdx.x == 0) { bst[0] = 0u; bst[1] = 0u; }
    __syncthreads();
    (void)xcd_barrier_post((unsigned*)(P.ws + WS_CTL), bst);
    for (int ph = ph_lo; ph < ph_hi; ++ph) {
        CParams* Pp = (CParams*)__builtin_amdgcn_kernarg_segment_ptr(); asm volatile("" : "+s"(Pp));
        Ctx C; C.P = Pp; C.lds = (LAS unsigned char*)lds_raw;
        int tid = threadIdx.x; asm volatile("" : "+v"(tid));
        unsigned char* ws = Pp->ws; float* out = Pp->out; asm volatile("" : "+s"(ws), "+s"(out));
        C.ws = ws; C.out = out;
        C.tid = tid; C.lane = tid & 63; C.wave = __builtin_amdgcn_readfirstlane(tid >> 6); C.bid = blockIdx.x; C.G = gridDim.x;
#ifdef PROBE_K
        { const bool hit = (PROBE_K == 100) ? ph == 0 : ((PROBE_K == 101) ? ph == NPH - 1 : (ph > 0 && ph < NPH - 1 && (ph - 1) % NPL == PROBE_K));
          if (hit) for (int rep = 0; rep < PROBE_N; ++rep) { run_phase(C, ph, true); __syncthreads(); } }
#endif
        run_phase(C, ph, false);
        if (ph + 1 < ph_hi) { if (ph == 0) cg::this_grid().sync();
            else { XcdBarrier xb; xb.bar = (unsigned*)(ws + WS_CTL); xb.x = xb_xcc_id(); xb.st = (volatile LAS unsigned*)((LAS unsigned char*)lds_raw + LDS_BYTES - 64); xcd_barrier(xb); } }
    }
}

extern "C" void kernel_launch(void* const* d_in, const int* in_sizes, int n_in, void* d_out, int out_size, void* d_ws, size_t ws_size, hipStream_t stream) {
    static int grid = 0;
    if (grid == 0) {
        if (n_in != N_IN || (size_t)out_size != O_END || ws_size < WS_END) { fprintf(stderr, "kernel_launch: unexpected shapes n_in %d out %d ws %zu (need %zu)\n", n_in, out_size, ws_size, (size_t)WS_END); grid = -1; return; }
        int dev = 0, cus = 0, per_cu = 0;
        hipGetDevice(&dev); hipDeviceGetAttribute(&cus, hipDeviceAttributeMultiprocessorCount, dev);
        hipFuncSetAttribute((const void*)fwd, hipFuncAttributeMaxDynamicSharedMemorySize, LDS_BYTES);
        hipOccupancyMaxActiveBlocksPerMultiprocessor(&per_cu, (const void*)fwd, NTHREADS, LDS_BYTES);
        if (per_cu < 1) { fprintf(stderr, "kernel_launch: occupancy query says %d blocks/CU\n", per_cu); per_cu = 1; }
        grid = cus;
        fprintf(stderr, "kernel_launch: cus %d per_cu %d grid %d ws %zu\n", cus, per_cu, grid, ws_size);
    }
    if (grid < 0) return;
    Params p{};
    for (int i = 0; i < N_IN; ++i) p.in[i] = (const float*)d_in[i];
    p.out = (float*)d_out; p.ws = (unsigned char*)d_ws;
    hipMemsetAsync((char*)d_ws + WS_CTL, 0, 65536, stream);
#if MEGA
    p.ph_lo = 0; p.ph_hi = NPH;
    void* args[] = {&p};
    hipError_t e = hipLaunchCooperativeKernel((const void*)fwd, dim3(grid), dim3(NTHREADS), args, LDS_BYTES, stream);
    if (e != hipSuccess) fprintf(stderr, "cooperative launch failed: %s\n", hipGetErrorString(e));
#else
    for (int ph = 0; ph < NPH; ++ph) { p.ph_lo = ph; p.ph_hi = ph + 1; hipLaunchKernelGGL(fwd, dim3(grid), dim3(NTHREADS), LDS_BYTES, stream, p); }
#endif
}
```

```cpp
#include <hip/hip_runtime.h>
#include <hip/hip_cooperative_groups.h>
#include <cstdio>
#include <cstdint>
namespace cg = cooperative_groups;

#ifndef MEGA
#define MEGA 1
#endif

#define LAS __attribute__((address_space(3)))
typedef unsigned short bf16_t;
typedef __bf16 bf16x2_t __attribute__((ext_vector_type(2)));
typedef short bf16x8 __attribute__((ext_vector_type(8)));
typedef float f32x4 __attribute__((ext_vector_type(4)));
typedef float f32x16 __attribute__((ext_vector_type(16)));
typedef unsigned u32x4 __attribute__((ext_vector_type(4)));
typedef unsigned u32x2 __attribute__((ext_vector_type(2)));

constexpr int DM = 1024;
constexpr int TP = 32768, TS = 128, TT = TP + TS, MT = 33024;
constexpr int NBT = 24;
constexpr int N1 = 4608;
constexpr int NG = 2048;
constexpr int NE = 16384;
constexpr int INC = 6416;
constexpr float EPS = 1e-6f;
constexpr int NWAVES = 8, NTHREADS = 512;
constexpr int LDS_BYTES = 150528;

enum { IN_XP = 0, IN_XS, IN_CP, IN_CS, IN_SSD, IN_SSDCONV, IN_LRU, IN_LRUCONV, IN_LN1, IN_LN2, IN_WMOD, IN_BMOD, IN_WIN, IN_SCW, IN_SCB, IN_DTB,
       IN_ALOG, IN_SSDD, IN_SNW, IN_LCW, IN_LCB, IN_WA, IN_BA, IN_WX, IN_BX, IN_LAM, IN_WBS, IN_WBL, IN_WO, IN_WQ, IN_K1, IN_K2, IN_U, IN_V, IN_FNW, N_IN };

constexpr size_t O_Y = 0, O_PSSD = 33685504, O_PSCONV = 35782656, O_PLRU = 35905536, O_PLCONV = 35938304,
                 O_SSSD = 36036608, O_SSCONV = 37085184, O_SLRU = 37146624, O_SLCONV = 37163008, O_END = 37212160;

constexpr size_t al256(size_t x) { return (x + 255) & ~(size_t)255; }
constexpr size_t WS_CTL = 0;
constexpr size_t WS_LRUW = 131072;
constexpr size_t WS_MOD = 1u << 20;
constexpr size_t WS_DT = al256(WS_MOD + (size_t)2 * NBT * 6144 * 4);
constexpr size_t WS_SSQ = al256(WS_DT + (size_t)MT * 16 * 4);
constexpr size_t WS_W1T = al256(WS_SSQ + (size_t)MT * 16 * 4);
constexpr size_t WS_WGT = al256(WS_W1T + (size_t)2 * N1 * DM * 2);
constexpr size_t WS_WBS = al256(WS_WGT + (size_t)2 * NG * DM * 2);
constexpr size_t WS_WBL = al256(WS_WBS + (size_t)2 * DM * DM * 2);
constexpr size_t WS_WO = al256(WS_WBL + (size_t)2 * DM * DM * 2);
constexpr size_t WS_WC = al256(WS_WO + (size_t)2 * DM * DM * 2);
constexpr size_t WS_U16 = al256(WS_WC + (size_t)2 * 2048 * DM * 2);
constexpr size_t WS_V16 = al256(WS_U16 + (size_t)NE * DM * 2);
constexpr size_t WS_EI = al256(WS_V16 + (size_t)NE * DM * 2);
constexpr size_t WS_GW = al256(WS_EI + (size_t)MT * 128 * 4);
constexpr size_t WS_B0 = al256(WS_GW + (size_t)MT * 128 * 4);
constexpr size_t WS_B1 = al256(WS_B0 + (size_t)MT * DM * 2);
constexpr size_t WS_B2 = al256(WS_B1 + (size_t)MT * DM * 2);
constexpr size_t WS_B3 = al256(WS_B2 + (size_t)MT * 1280 * 2);
constexpr size_t WS_B4 = al256(WS_B3 + (size_t)MT * DM * 2);
constexpr size_t WS_END = al256(WS_B4 + (size_t)MT * DM * 2);
constexpr size_t WS_GS = WS_B2, WS_GL = WS_B2 + (size_t)MT * DM * 2;
constexpr size_t WS_SC = WS_B1;
static_assert(WS_GL + (size_t)MT * DM * 2 <= WS_B4, "gate overlay");
static_assert(WS_SC + (size_t)MT * 2048 * 4 <= WS_END, "score overlay");
static_assert(WS_END <= (size_t)512 << 20, "d_ws budget");

struct Params {
    const float* in[N_IN];
    float* out;
    unsigned char* ws;
    int ph_lo, ph_hi;
};

__device__ __forceinline__ unsigned f2bf(float f) { return (unsigned)__builtin_bit_cast(unsigned short, (__bf16)f); }
__device__ __forceinline__ float bf2f(unsigned b) { return __uint_as_float(b << 16); }
__device__ __forceinline__ unsigned pk2(float lo, float hi) { typedef float f32x2_ __attribute__((ext_vector_type(2))); return __builtin_bit_cast(unsigned, __builtin_convertvector((f32x2_){lo, hi}, bf16x2_t)); }
__device__ __forceinline__ float bflo(unsigned w) { return __uint_as_float(w << 16); }
__device__ __forceinline__ float bfhi(unsigned w) { return __uint_as_float(w & 0xffff0000u); }
template <int M> __device__ __forceinline__ int shfx_i(int v, int lane) {
    if constexpr (M == 32) { auto r = __builtin_amdgcn_permlane32_swap((unsigned)v, (unsigned)v, false, false); return (int)((lane & 32) ? r[0] : r[1]); }
    else return __builtin_amdgcn_ds_swizzle(v, 0x1f | (M << 10));
}
template <int M> __device__ __forceinline__ float shfx(float v, int lane) { return __int_as_float(shfx_i<M>(__float_as_int(v), lane)); }
__device__ __forceinline__ float shfl_f(float v, int src) { return __int_as_float(__builtin_amdgcn_ds_bpermute(src << 2, __float_as_int(v))); }
__device__ __forceinline__ int shfl_i(int v, int src) { return __builtin_amdgcn_ds_bpermute(src << 2, v); }
template <int CTRL> __device__ __forceinline__ float dppf_(float v) { return __int_as_float(__builtin_amdgcn_update_dpp(0, __float_as_int(v), CTRL, 0xf, 0xf, true)); }
__device__ __forceinline__ float row8_sum(float v) { v += dppf_<0xB1>(v); v += dppf_<0x4E>(v); v += dppf_<0x141>(v); return v; }
__device__ __forceinline__ float wave_sum(float v) {
    v += dppf_<0xB1>(v); v += dppf_<0x4E>(v); v += dppf_<0x141>(v); v += dppf_<0x140>(v);
    { auto r = __builtin_amdgcn_permlane16_swap(__float_as_uint(v), __float_as_uint(v), false, false); v = __uint_as_float(r[0]) + __uint_as_float(r[1]); }
    { auto r = __builtin_amdgcn_permlane32_swap(__float_as_uint(v), __float_as_uint(v), false, false); v = __uint_as_float(r[0]) + __uint_as_float(r[1]); }
    return v;
}
__device__ __forceinline__ float exp_fast(float x) { return __builtin_amdgcn_exp2f(x * 1.4426950408889634f); }
__device__ __forceinline__ float sigmoidf_(float x) { return __builtin_amdgcn_rcpf(1.0f + exp_fast(-x)); }
__device__ __forceinline__ float siluf_(float x) { return x * __builtin_amdgcn_rcpf(1.0f + exp_fast(-x)); }
__device__ __forceinline__ float geluf_(float x) { const float u = 1.5957691216057308f * (x + 0.044715f * x * x * x); return x * __builtin_amdgcn_rcpf(1.0f + exp_fast(-u)); }
__device__ __forceinline__ float softplusf_(float x) { return fmaxf(x, 0.f) + log1pf(__expf(-fabsf(x))); }
__device__ __forceinline__ int row_batch(int row) { return row < TP ? (row >> 11) : (row < TT ? 16 + ((row - TP) >> 4) : 23); }
__device__ __forceinline__ float dot2bf(unsigned a, unsigned b, float acc) { return __builtin_amdgcn_fdot2_f32_bf16(__builtin_bit_cast(bf16x2_t, a), __builtin_bit_cast(bf16x2_t, b), acc, false); }
__device__ __forceinline__ float rl(float v, int lane) { return __int_as_float(__builtin_amdgcn_readlane(__float_as_int(v), lane)); }
#define LDS_WAIT() asm volatile("s_waitcnt lgkmcnt(0)" ::: "memory")
#define MFMA32(a, b, c) __builtin_amdgcn_mfma_f32_32x32x16_bf16((a), (b), (c), 0, 0, 0)

typedef const __attribute__((address_space(4))) Params CParams;
template <class T> __device__ __forceinline__ T* as_global(T* p) { __attribute__((address_space(1))) T* g = (__attribute__((address_space(1))) T*)p; asm volatile("" : "+s"(g)); return (T*)g; }
struct Ctx {
    CParams* P; LAS unsigned char* lds; unsigned char* ws; float* out;
    int tid, lane, wave, bid, G;
};
#define WSP(T, off) (as_global((T*)(C.ws + (off))))

__device__ __forceinline__ void tr_item(const float* W, int ldw, int src_col0, int valid, const float* kscale, int k0, bf16_t* dst, LAS float* scr, int lane) {
    const int c4 = lane & 7, r0 = lane >> 3;
    f32x4 v[8];
#pragma unroll
    for (int i = 0; i < 8; ++i) { const int kk = r0 + 8 * i; v[i] = (4 * c4 < valid) ? *(const f32x4*)(W + (size_t)(k0 + kk) * ldw + src_col0 + 4 * c4) : (f32x4){0.f, 0.f, 0.f, 0.f}; }
#pragma unroll
    for (int i = 0; i < 8; ++i) { const int kk = r0 + 8 * i; const float ks = kscale ? kscale[k0 + kk] : 1.0f; LAS float* s = scr + kk * 33 + 4 * c4;
        s[0] = v[i][0] * ks; s[1] = v[i][1] * ks; s[2] = v[i][2] * ks; s[3] = v[i][3] * ks; }
    LDS_WAIT();
    const int c8 = lane & 7;
#pragma unroll
    for (int j = 0; j < 4; ++j) { const int n = (lane >> 3) + 8 * j; const LAS float* s = scr + (8 * c8) * 33 + n;
        u32x4 o; o.x = pk2(s[0 * 33], s[1 * 33]); o.y = pk2(s[2 * 33], s[3 * 33]); o.z = pk2(s[4 * 33], s[5 * 33]); o.w = pk2(s[6 * 33], s[7 * 33]);
        *(u32x4*)(dst + (size_t)n * DM + k0 + 8 * c8) = o; }
    LDS_WAIT();
}
typedef float f32x2 __attribute__((ext_vector_type(2)));
typedef short s16x4_ __attribute__((ext_vector_type(4)));
constexpr size_t WS_U8 = WS_U16, WS_SU = WS_U16 + ((size_t)16 << 20), WS_V8 = WS_V16, WS_SV = WS_V16 + ((size_t)16 << 20);
__device__ __forceinline__ float wave_max(float v) {
    v = fmaxf(v, shfx<1>(v, 0)); v = fmaxf(v, shfx<2>(v, 0)); v = fmaxf(v, shfx<4>(v, 0)); v = fmaxf(v, shfx<8>(v, 0)); v = fmaxf(v, shfx<16>(v, 0));
    auto r = __builtin_amdgcn_permlane32_swap(__float_as_uint(v), __float_as_uint(v), false, false);
    return fmaxf(__uint_as_float(r[0]), __uint_as_float(r[1]));
}
__device__ __forceinline__ void convert_tables(const Ctx& C, int l) {
    const int gw = C.bid * NWAVES + C.wave, NGW = C.G * NWAVES, lane = C.lane;
    const float* up = as_global(C.P->in[IN_U]) + (size_t)l * NE * DM; const float* vp = as_global(C.P->in[IN_V]) + (size_t)l * NE * DM;
#define TROW(it_) (((it_) >= NE ? vp + (size_t)((it_) - NE) * DM : up + (size_t)(it_) * DM) + lane * 4)
    f32x4 nv[4];
    { const float* s0 = TROW(min(gw, 2 * NE - 1));
#pragma unroll
      for (int j = 0; j < 4; ++j) nv[j] = *(const f32x4*)(s0 + 256 * j); }
    for (int it = gw; it < 2 * NE; it += NGW) {
        const bool isv = it >= NE; const int e = isv ? it - NE : it;
        unsigned char* dst = C.ws + (isv ? WS_V8 : WS_U8); float* sc = (float*)(C.ws + (isv ? WS_SV : WS_SU));
        f32x4 v[4]; float m = 0.f;
#pragma unroll
        for (int j = 0; j < 4; ++j) { v[j] = nv[j]; m = fmaxf(m, fmaxf(fmaxf(fabsf(v[j][0]), fabsf(v[j][1])), fmaxf(fabsf(v[j][2]), fabsf(v[j][3])))); }
        { const float* s0 = TROW(min(it + NGW, 2 * NE - 1));
#pragma unroll
          for (int j = 0; j < 4; ++j) nv[j] = *(const f32x4*)(s0 + 256 * j); }
        m = wave_max(m);
        const float scale = m > 0.f ? m * (1.0f / 440.0f) : 1.0f, inv = 1.0f / scale;
        if (lane == 0) sc[e] = scale;
#pragma unroll
        for (int j = 0; j < 4; ++j) { int w = __builtin_amdgcn_cvt_pk_fp8_f32(v[j][0] * inv, v[j][1] * inv, 0, false); w = __builtin_amdgcn_cvt_pk_fp8_f32(v[j][2] * inv, v[j][3] * inv, w, true);
            const int slice = 2 * j + (lane >> 5);
            *(int*)(dst + ((size_t)slice * NE + e) * 128 + (lane & 31) * 4) = w; }
    }
#undef TROW
}
__device__ __forceinline__ void phase_prep(const Ctx& C) {
    CParams& P = *C.P;
    {
        LAS float* Kh = (LAS float*)C.lds;
        LAS float* Wq = (LAS float*)(C.lds + 128 * 132 * 4);
        bf16_t* WcT = WSP(bf16_t, WS_WC);
        for (int it = C.bid; it < 512; it += C.G) {
            const int l = it >> 8, h = (it >> 5) & 7, half = (it >> 4) & 1, jb = it & 15;
            const float* ksrc = as_global(P.in[half ? IN_K2 : IN_K1]) + (size_t)l * 128 * 128;
            const float* wsrc = as_global(P.in[IN_WQ]) + (size_t)l * DM * 2048 + (size_t)(jb * 64) * 2048 + h * 256 + half * 128;
            __syncthreads();
            for (int i = C.tid; i < 128 * 32; i += NTHREADS) { const int r = i >> 5, c4 = i & 31; *(LAS f32x4*)(Kh + r * 132 + c4 * 4) = *(const f32x4*)(ksrc + r * 128 + c4 * 4); }
            for (int i = C.tid; i < 64 * 32; i += NTHREADS) { const int r = i >> 5, c4 = i & 31; *(LAS f32x4*)(Wq + r * 132 + c4 * 4) = *(const f32x4*)(wsrc + (size_t)r * 2048 + c4 * 4); }
            __syncthreads();
            const int tk = C.tid & 31, tj = C.tid >> 5;
            float acc[4][4];
#pragma unroll
            for (int a = 0; a < 4; ++a)
#pragma unroll
                for (int b = 0; b < 4; ++b) acc[a][b] = 0.f;
            for (int d4 = 0; d4 < 32; ++d4) {
                f32x4 kv[4], wv[4];
#pragma unroll
                for (int a = 0; a < 4; ++a) { kv[a] = *(LAS f32x4*)(Kh + (tk + 32 * a) * 132 + d4 * 4); wv[a] = *(LAS f32x4*)(Wq + (4 * tj + a) * 132 + d4 * 4); }
#pragma unroll
                for (int a = 0; a < 4; ++a)
#pragma unroll
                    for (int b = 0; b < 4; ++b) acc[a][b] += kv[a][0] * wv[b][0] + kv[a][1] * wv[b][1] + kv[a][2] * wv[b][2] + kv[a][3] * wv[b][3];
            }
#pragma unroll
            for (int a = 0; a < 4; ++a) { const int n = h * 256 + half * 128 + tk + 32 * a;
                u32x2 o; o.x = pk2(acc[a][0], acc[a][1]); o.y = pk2(acc[a][2], acc[a][3]);
                *(u32x2*)(WcT + ((size_t)l * 2048 + n) * DM + jb * 64 + 4 * tj) = o; }
        }
        __syncthreads();
    }
    {
        LAS float* sc = (LAS float*)C.lds;
        LAS float* red = (LAS float*)(C.lds + 98304);
        for (int i = C.tid; i < NBT * DM; i += NTHREADS) { const int bb = i >> 10, k = i & 1023;
            const float cv = bb < 16 ? as_global(P.in[IN_CP])[bb * DM + k] : as_global(P.in[IN_CS])[(bb - 16) * DM + k]; sc[i] = siluf_(cv); }
        __syncthreads();
        float* MOD = WSP(float, WS_MOD);
        for (int it = C.bid; it < 192; it += C.G) {
            const int l = it / 96, cg_ = it % 96, j = cg_ * 64 + C.lane;
            const float* wm = as_global(P.in[IN_WMOD]) + (size_t)l * DM * 6144 + j;
            float acc[NBT];
#pragma unroll
            for (int bb = 0; bb < NBT; ++bb) acc[bb] = 0.f;
            const int k0 = C.wave * 128;
#pragma unroll 16
            for (int k = 0; k < 128; ++k) { const float w = wm[(size_t)(k0 + k) * 6144];
#pragma unroll
                for (int bb = 0; bb < NBT; ++bb) acc[bb] += sc[bb * DM + k0 + k] * w; }
#pragma unroll
            for (int bb = 0; bb < NBT; ++bb) red[(C.wave * NBT + bb) * 64 + C.lane] = acc[bb];
            __syncthreads();
            const float bm = as_global(P.in[IN_BMOD])[l * 6144 + j];
#pragma unroll
            for (int q = 0; q < 3; ++q) { const int bb = 3 * C.wave + q; float a = bm;
#pragma unroll
                for (int w8 = 0; w8 < 8; ++w8) a += red[(w8 * NBT + bb) * 64 + C.lane];
                MOD[((size_t)l * NBT + bb) * 6144 + j] = a; }
            __syncthreads();
        }
        __syncthreads();
    }
    {
        LAS float* scr = (LAS float*)(C.lds + C.wave * 16384);
        const int gw = C.bid * NWAVES + C.wave, NGW = C.G * NWAVES;
        constexpr int I_W1 = 144 * 16, I_WG = 64 * 16, I_SQ = 32 * 16, PER_L = I_W1 + I_WG + 3 * I_SQ;
        for (int it = gw; it < 2 * PER_L; it += NGW) {
            const int l = it / PER_L; int r = it % PER_L;
            if (r < I_W1) { const int nb = r >> 4, kb = r & 15, n0 = nb * 32; int src, valid;
                if (n0 < 2304) { src = n0; valid = 32; } else if (n0 < 4352) { src = n0 + 16; valid = 32; } else if (n0 == 4352) { src = 2304; valid = 16; } else { src = 0; valid = 0; }
                tr_item(as_global(P.in[IN_WIN]) + (size_t)l * DM * INC, INC, src, valid, nullptr, kb * 64, WSP(bf16_t, WS_W1T) + ((size_t)l * N1 + n0) * DM, scr, C.lane); continue; }
            r -= I_W1;
            if (r < I_WG) { const int nb = r >> 4, kb = r & 15, n0 = nb * 32;
                tr_item(as_global(P.in[IN_WIN]) + (size_t)l * DM * INC, INC, 4368 + n0, 32, nullptr, kb * 64, WSP(bf16_t, WS_WGT) + ((size_t)l * NG + n0) * DM, scr, C.lane); continue; }
            r -= I_WG;
            const int which = r / I_SQ; r %= I_SQ; const int nb = r >> 4, kb = r & 15, n0 = nb * 32;
            const float* src = as_global(P.in[which == 0 ? IN_WBS : (which == 1 ? IN_WBL : IN_WO)]) + (size_t)l * DM * DM;
            bf16_t* dst = WSP(bf16_t, which == 0 ? WS_WBS : (which == 1 ? WS_WBL : WS_WO)) + ((size_t)l * DM + n0) * DM;
            tr_item(src, DM, n0, 32, which == 0 ? as_global(P.in[IN_SNW]) + l * DM : nullptr, kb * 64, dst, scr, C.lane);
        }
    }
    {
        bf16_t* LW = (bf16_t*)(C.ws + WS_LRUW);
        const float* wap = as_global(P.in[IN_WA]); const float* wxp = as_global(P.in[IN_WX]);
        for (int i = C.bid * NTHREADS + C.tid; i < 2 * 16 * 2 * 4096; i += C.G * NTHREADS) {
            const int d = i & 63, e = (i >> 6) & 63, gate = (i >> 12) & 1, lj = i >> 13;
            LW[i] = (bf16_t)f2bf((gate ? wxp : wap)[(size_t)lj * 4096 + d * 64 + e]);
        }
    }
    convert_tables(C, 0);
}

__device__ __forceinline__ void phase_norm(const Ctx& C, int l, int which) {
    CParams& P = *C.P;
    const int gw = C.bid * NWAVES + C.wave, NGW = C.G * NWAVES;
    bf16_t* H = WSP(bf16_t, WS_B0);
    const float* lw = as_global(P.in[which ? IN_LN2 : IN_LN1]) + l * DM;
    const float* MOD = WSP(float, WS_MOD);
    const float* xpp = as_global(P.in[IN_XP]); const float* xsp = as_global(P.in[IN_XS]);
#define NORM_SRC(row_) ((which == 0 && l == 0) ? ((row_) < TP ? xpp + (size_t)(row_) * DM : xsp + (size_t)((row_) - TP) * DM) : C.out + (size_t)(row_) * DM)
    const int c0 = 8 * C.lane;
    f32x4 lwv[4];
#pragma unroll
    for (int j = 0; j < 4; ++j) lwv[j] = *(const f32x4*)(lw + (j >> 1) * 512 + c0 + (j & 1) * 4);
    f32x4 nv[4];
    { const float* xr = NORM_SRC(min(gw, TT - 1)) + c0;
#pragma unroll
      for (int j = 0; j < 4; ++j) nv[j] = *(const f32x4*)(xr + (j >> 1) * 512 + (j & 1) * 4); }
    for (int row = gw; row < TT; row += NGW) {
        f32x4 v[4]; float s = 0.f;
#pragma unroll
        for (int j = 0; j < 4; ++j) { v[j] = nv[j]; s += (v[j][0] * v[j][0] + v[j][1] * v[j][1]) + (v[j][2] * v[j][2] + v[j][3] * v[j][3]); }
        { const float* xr = NORM_SRC(min(row + NGW, TT - 1)) + c0;
#pragma unroll
          for (int j = 0; j < 4; ++j) nv[j] = *(const f32x4*)(xr + (j >> 1) * 512 + (j & 1) * 4); }
        const float rstd = rsqrtf(wave_sum(s) * (1.f / DM) + EPS);
        const float* md = MOD + ((size_t)l * NBT + row_batch(row)) * 6144 + (which ? 3072 : 0) + c0;
        f32x4 y[4];
#pragma unroll
        for (int j = 0; j < 4; ++j) { const int co = (j >> 1) * 512 + (j & 1) * 4;
            const f32x4 sh = *(const f32x4*)(md + co), scv = *(const f32x4*)(md + 1024 + co);
            y[j] = (v[j] * rstd * lwv[j]) * (scv + 1.0f) + sh; }
        bf16_t* hp = H + (size_t)row * DM + c0;
        *(u32x4*)hp = (u32x4){pk2(y[0][0], y[0][1]), pk2(y[0][2], y[0][3]), pk2(y[1][0], y[1][1]), pk2(y[1][2], y[1][3])};
        *(u32x4*)(hp + 512) = (u32x4){pk2(y[2][0], y[2][1]), pk2(y[2][2], y[2][3]), pk2(y[3][0], y[3][1]), pk2(y[3][2], y[3][3])};
    }
#undef NORM_SRC
    if (which == 0 && l == 1) convert_tables(C, 1);
}

struct Epi1 {
    __device__ __forceinline__ bool idem() const { return true; }
    static constexpr int NK = 5; static constexpr bool PERM = true;
    bf16_t *Z, *XBC, *LX, *LY; float* DT; const float* dtb;
    __device__ __forceinline__ int kind(int pn) const { return pn < 4 ? 0 : (pn < 9 ? 1 : (pn < 13 ? 2 : (pn < 17 ? 3 : 4))); }
    template <int KD> __device__ __forceinline__ void apply(int, int row, int col, f32x4 v) const {
        if constexpr (KD == 0) { *(u32x2*)(Z + (size_t)row * DM + col) = (u32x2){pk2(siluf_(v[0]), siluf_(v[1])), pk2(siluf_(v[2]), siluf_(v[3]))}; }
        else if constexpr (KD == 1) { *(u32x2*)(XBC + (size_t)row * 1280 + (col - 1024)) = (u32x2){pk2(v[0], v[1]), pk2(v[2], v[3])}; }
        else if constexpr (KD == 2) { *(u32x2*)(LX + (size_t)row * DM + (col - 2304)) = (u32x2){pk2(v[0], v[1]), pk2(v[2], v[3])}; }
        else if constexpr (KD == 3) { *(u32x2*)(LY + (size_t)row * DM + (col - 3328)) = (u32x2){pk2(geluf_(v[0]), geluf_(v[1])), pk2(geluf_(v[2]), geluf_(v[3]))}; }
        else { if (col < 4368) { const int c = col - 4352; const f32x4 b = *(const f32x4*)(dtb + c);
            *(f32x4*)(DT + (size_t)row * 16 + c) = (f32x4){softplusf_(v[0] + b[0]), softplusf_(v[1] + b[1]), softplusf_(v[2] + b[2]), softplusf_(v[3] + b[3])}; } }
    }
    template <int KD> __device__ __forceinline__ void apply8(int w, int row, int col, f32x4 a, f32x4 b) const {
        if constexpr (KD == 0) { *(u32x4*)(Z + (size_t)row * DM + col) = (u32x4){pk2(siluf_(a[0]), siluf_(a[1])), pk2(siluf_(a[2]), siluf_(a[3])), pk2(siluf_(b[0]), siluf_(b[1])), pk2(siluf_(b[2]), siluf_(b[3]))}; }
        else if constexpr (KD == 1) { *(u32x4*)(XBC + (size_t)row * 1280 + (col - 1024)) = (u32x4){pk2(a[0], a[1]), pk2(a[2], a[3]), pk2(b[0], b[1]), pk2(b[2], b[3])}; }
        else if constexpr (KD == 2) { *(u32x4*)(LX + (size_t)row * DM + (col - 2304)) = (u32x4){pk2(a[0], a[1]), pk2(a[2], a[3]), pk2(b[0], b[1]), pk2(b[2], b[3])}; }
        else if constexpr (KD == 3) { *(u32x4*)(LY + (size_t)row * DM + (col - 3328)) = (u32x4){pk2(geluf_(a[0]), geluf_(a[1])), pk2(geluf_(a[2]), geluf_(a[3])), pk2(geluf_(b[0]), geluf_(b[1])), pk2(geluf_(b[2]), geluf_(b[3]))}; }
        else { apply<KD>(w, row, col, a); apply<KD>(w, row, col + 4, b); }
    }
};
struct Epi2 {
    __device__ __forceinline__ bool idem() const { return true; }
    static constexpr int NK = 2; static constexpr bool PERM = true;
    bf16_t *GS, *GL;
    __device__ __forceinline__ int kind(int pn) const { return pn < 4 ? 0 : 1; }
    template <int KD> __device__ __forceinline__ void apply(int, int row, int col, f32x4 v) const {
        bf16_t* d = (KD == 0 ? GS + (size_t)row * DM + col : GL + (size_t)row * DM + (col - 1024));
        *(u32x2*)d = (u32x2){pk2(sigmoidf_(v[0]), sigmoidf_(v[1])), pk2(sigmoidf_(v[2]), sigmoidf_(v[3]))};
    }
    template <int KD> __device__ __forceinline__ void apply8(int, int row, int col, f32x4 a, f32x4 b) const {
        bf16_t* d = (KD == 0 ? GS + (size_t)row * DM + col : GL + (size_t)row * DM + (col - 1024));
        *(u32x4*)d = (u32x4){pk2(sigmoidf_(a[0]), sigmoidf_(a[1])), pk2(sigmoidf_(a[2]), sigmoidf_(a[3])), pk2(sigmoidf_(b[0]), sigmoidf_(b[1])), pk2(sigmoidf_(b[2]), sigmoidf_(b[3]))};
    }
};
struct Epi3 {
    __device__ __forceinline__ bool idem() const { return true; }
    static constexpr int NK = 1; static constexpr bool PERM = true;
    const bf16_t *GS, *GL; const float* SSQ; bf16_t* MG;
    __device__ __forceinline__ int kind(int) const { return 0; }
    __device__ __forceinline__ float rstd_of(int row) const { const f32x4* q = (const f32x4*)(SSQ + (size_t)row * 16); const f32x4 a = q[0] + q[1] + q[2] + q[3];
        return rsqrtf(((a[0] + a[1]) + (a[2] + a[3])) * (1.f / DM) + EPS); }
    template <int KD> __device__ __forceinline__ void apply(int w, int row, int col, f32x4 v) const {
        u32x2* m = (u32x2*)(MG + (size_t)row * DM + col);
        if (w == 0) { const float rstd = rstd_of(row);
            const u32x2 g = *(const u32x2*)(GS + (size_t)row * DM + col);
            *m = (u32x2){pk2(bflo(g.x) * rstd * v[0], bfhi(g.x) * rstd * v[1]), pk2(bflo(g.y) * rstd * v[2], bfhi(g.y) * rstd * v[3])};
        } else {
            const u32x2 g = *(const u32x2*)(GL + (size_t)row * DM + col); const u32x2 p = *m;
            *m = (u32x2){pk2(bflo(p.x) + bflo(g.x) * v[0], bfhi(p.x) + bfhi(g.x) * v[1]), pk2(bflo(p.y) + bflo(g.y) * v[2], bfhi(p.y) + bfhi(g.y) * v[3])};
        }
    }
    template <int KD> __device__ __forceinline__ void apply8(int w, int row, int col, f32x4 a, f32x4 b) const {
        u32x4* m = (u32x4*)(MG + (size_t)row * DM + col);
        if (w == 0) { const float rstd = rstd_of(row);
            const u32x4 g = *(const u32x4*)(GS + (size_t)row * DM + col);
            *m = (u32x4){pk2(bflo(g.x) * rstd * a[0], bfhi(g.x) * rstd * a[1]), pk2(bflo(g.y) * rstd * a[2], bfhi(g.y) * rstd * a[3]), pk2(bflo(g.z) * rstd * b[0], bfhi(g.z) * rstd * b[1]), pk2(bflo(g.w) * rstd * b[2], bfhi(g.w) * rstd * b[3])};
        } else {
            const u32x4 g = *(const u32x4*)(GL + (size_t)row * DM + col); const u32x4 p = *m;
            *m = (u32x4){pk2(bflo(p.x) + bflo(g.x) * a[0], bfhi(p.x) + bfhi(g.x) * a[1]), pk2(bflo(p.y) + bflo(g.y) * a[2], bfhi(p.y) + bfhi(g.y) * a[3]),
                         pk2(bflo(p.z) + bflo(g.z) * b[0], bfhi(p.z) + bfhi(g.z) * b[1]), pk2(bflo(p.w) + bflo(g.w) * b[2], bfhi(p.w) + bfhi(g.w) * b[3])};
        }
    }
};
struct Epi4 {
    static constexpr bool PERM = true;
    __device__ __forceinline__ bool idem() const { return layer == 0; }
    static constexpr int NK = 1;
    const float *xp, *xs; float* XR; const float* MODl; int layer;
    __device__ __forceinline__ int kind(int) const { return 0; }
    template <int KD> __device__ __forceinline__ void apply(int, int row, int col, f32x4 v) const {
        if (row >= TT) return;
        const float* src = layer == 0 ? (row < TP ? xp + (size_t)row * DM : xs + (size_t)(row - TP) * DM) : XR + (size_t)row * DM;
        const f32x4 x = *(const f32x4*)(src + col), g = *(const f32x4*)(MODl + (size_t)row_batch(row) * 6144 + 2048 + col);
        *(f32x4*)(XR + (size_t)row * DM + col) = x + g * v;
    }
    template <int KD> __device__ __forceinline__ void apply8(int, int row, int col, f32x4 a, f32x4 b) const {
        const float* src = (layer == 0 ? xp : XR) + (size_t)row * DM + col; const float* gp = MODl + (size_t)(row >> 11) * 6144 + 2048 + col;
        const f32x4 x0 = *(const f32x4*)src, x1 = *(const f32x4*)(src + 4), g0 = *(const f32x4*)gp, g1 = *(const f32x4*)(gp + 4);
        float* d = XR + (size_t)row * DM + col; *(f32x4*)d = x0 + g0 * a; *(f32x4*)(d + 4) = x1 + g1 * b;
    }
};
struct Epi5 {
    static constexpr bool PERM = true;
    __device__ __forceinline__ bool idem() const { return true; }
    static constexpr int NK = 1;
    float* SC;
    __device__ __forceinline__ int kind(int) const { return 0; }
    template <int KD> __device__ __forceinline__ void apply(int, int row, int col, f32x4 v) const { *(f32x4*)(SC + (size_t)row * 2048 + col) = v; }
    template <int KD> __device__ __forceinline__ void apply8(int, int row, int col, f32x4 a, f32x4 b) const { float* d = SC + (size_t)row * 2048 + col; *(f32x4*)d = a; *(f32x4*)(d + 4) = b; }
};

namespace pg8 {
constexpr int BM = 256, BK = 64, HALF = 128, HTB = HALF * BK * 2, STAGE_BYTES = 8 * HTB, NXCD = 8, WGM = 8;
__host__ __device__ __forceinline__ int lds_byte(int r, int c) { const int st = (r >> 4) * 2 + (c >> 5), rr = r & 15, cc = c & 31, ob = rr * 64 + cc * 2; return st * 1024 + (ob ^ (((ob >> 9) & 1) << 5)); }
__host__ __device__ __forceinline__ void stage_rc(int b, int& R, int& C) { const int st = b / 1024, sb = b % 1024, swz = sb ^ (((sb >> 9) & 1) << 5); R = (st >> 1) * 16 + swz / 64; C = (st & 1) * 32 + (swz % 64) / 2; }
struct Unit { int pm, pn, w; };
struct Sched {
    int nM, nN, nW, nwg, G, c; const char *A0, *B0, *A1, *B1;
    __device__ __forceinline__ bool next(int i, Unit& u) const {
        const int ti = i / nW; u.w = i - ti * nW;
        const long L = (long)ti * G + c; if (L >= nwg) return false;
        int wgid = (int)L; { const int q = nwg / NXCD, r = nwg % NXCD, xcd = wgid % NXCD, off = wgid / NXCD; wgid = (xcd < r ? xcd * (q + 1) : r * (q + 1) + (xcd - r) * q) + off; }
        const int nig = WGM * nN, gid = wgid / nig, fm = gid * WGM, gsz = (nM - fm) < WGM ? (nM - fm) : WGM;
        u.pm = fm + ((wgid % nig) % gsz); u.pn = (wgid % nig) / gsz; return true;
    }
};
__host__ __device__ __forceinline__ int perm32(int rho) { const int n = rho >> 4, i = rho & 15; return 8 * (i >> 2) + 4 * n + (i & 3); }
template <int KD, class Epi>
__device__ __forceinline__ void epi_tile(const Epi& E, const f32x4 (&acc)[2][2][4][2], const Unit& u, int wr, int wc, int fr, int fq) {
#pragma unroll
    for (int ai = 0; ai < 2; ++ai)
#pragma unroll
        for (int m = 0; m < 4; ++m) { const int row = u.pm * BM + ai * HALF + wr * 64 + m * 16 + fr;
#pragma unroll
            for (int bj = 0; bj < 2; ++bj) {
                if constexpr (Epi::PERM) E.template apply8<KD>(u.w, row, u.pn * BM + bj * HALF + wc * 32 + 8 * fq, acc[ai][bj][m][0], acc[ai][bj][m][1]);
                else {
#pragma unroll
                    for (int n = 0; n < 2; ++n) E.template apply<KD>(u.w, row, u.pn * BM + bj * HALF + wc * 32 + n * 16 + 4 * fq, acc[ai][bj][m][n]); } } }
}
template <class Epi>
__device__ __forceinline__ void epi_apply(const Epi& E, const f32x4 (&acc)[2][2][4][2], const Unit& u, int wr, int wc, int fr, int fq) {
    if constexpr (Epi::NK == 1) epi_tile<0>(E, acc, u, wr, wc, fr, fq);
    else { const int kd = E.kind(u.pn);
        if (kd == 0) epi_tile<0>(E, acc, u, wr, wc, fr, fq);
        else if (kd == 1) epi_tile<1>(E, acc, u, wr, wc, fr, fq);
        else if constexpr (Epi::NK > 2) { if (kd == 2) epi_tile<2>(E, acc, u, wr, wc, fr, fq); else if (kd == 3) epi_tile<3>(E, acc, u, wr, wc, fr, fq); else epi_tile<4>(E, acc, u, wr, wc, fr, fq); } }
}
template <class Epi, bool ALIGN_EPI = true, bool SP2 = true>
__device__ __forceinline__ void gemm_phase(LAS unsigned char* lds, int tid, int K, const Sched& S, const Epi& E) {
    const int wid = __builtin_amdgcn_readfirstlane(tid >> 6), lane = tid & 63, wr = wid >> 2, wc = wid & 3, fr = lane & 15, fq = lane >> 4;
    const int nt = K / BK;
    unsigned voffA[2], voffB[2];
#pragma unroll
    for (int i = 0; i < 2; ++i) { int R, Cc; stage_rc(tid * 16 + i * 8192, R, Cc); const int Rb = Epi::PERM ? ((R & ~31) + perm32(R & 31)) : R;
        voffA[i] = (unsigned)(R * K + Cc) * 2u; voffB[i] = (unsigned)(Rb * K + Cc) * 2u; }
    const size_t kstep = (size_t)(BK * 2);
    const size_t hstep = (size_t)HALF * K * 2;
    const size_t tstep = 2 * hstep;
    const unsigned ldsw = (unsigned)wid * 1024u;
    const int aoff = lds_byte(wr * 64 + fr, fq * 8), boff = lds_byte(wc * 32 + fr, fq * 8);
#define PG8_SA(b, h) (((b) * 2 + (h)) * HTB)
#define PG8_SB(b, h) ((4 + (b) * 2 + (h)) * HTB)
#define PG8_STAGE(bufoff, gbase, voff) do { _Pragma("unroll") for (int _i = 0; _i < 2; ++_i) \
        __builtin_amdgcn_global_load_lds((const unsigned*)((const char*)(gbase) + (voff)[_i]), (LAS unsigned*)(lds + (bufoff) + ldsw + _i * 8192), 16, 0, 0); } while (0)
#define PG8_LDA(dst, b, h) do { _Pragma("unroll") for (int m = 0; m < 4; ++m) _Pragma("unroll") for (int k = 0; k < 2; ++k) dst[m][k] = *(const LAS bf16x8*)(lds + PG8_SA(b, h) + aoff + m * 2048 + k * 1024); } while (0)
#define PG8_LDB(dst, b, h) do { _Pragma("unroll") for (int n = 0; n < 2; ++n) _Pragma("unroll") for (int k = 0; k < 2; ++k) dst[n][k] = *(const LAS bf16x8*)(lds + PG8_SB(b, h) + boff + n * 2048 + k * 1024); } while (0)
#define PG8_MMA(ai, bj, At, Bt) do { __builtin_amdgcn_s_setprio(1); _Pragma("unroll") for (int m = 0; m < 4; ++m) _Pragma("unroll") for (int n = 0; n < 2; ++n) _Pragma("unroll") for (int k = 0; k < 2; ++k) \
        acc[ai][bj][m][n] = __builtin_amdgcn_mfma_f32_16x16x32_bf16(Bt[n][k], At[m][k], acc[ai][bj][m][n], 0, 0, 0); __builtin_amdgcn_s_setprio(0); } while (0)
#define PG8_WAIT_V(n) asm volatile("s_waitcnt vmcnt(" #n ")" ::: "memory")
#define PG8_WAIT_L(n) asm volatile("s_waitcnt lgkmcnt(" #n ")" ::: "memory")
#define PG8_BAR __builtin_amdgcn_s_barrier()
#define PG8_SCHED __builtin_amdgcn_sched_barrier(0)
    Unit cur, nxt; int ui = 0;
    if (!S.next(0, cur)) return;
    f32x4 acc[2][2][4][2];
#pragma unroll
    for (int a = 0; a < 2; ++a)
#pragma unroll
        for (int b = 0; b < 2; ++b)
#pragma unroll
            for (int m = 0; m < 4; ++m)
#pragma unroll
                for (int n = 0; n < 2; ++n) acc[a][b][m][n] = (f32x4){0.f, 0.f, 0.f, 0.f};
    bf16x8 At[4][2], B0[2][2], B1[2][2];
    const char* cA = (cur.w ? S.A1 : S.A0) + (size_t)cur.pm * tstep; const char* cB = (cur.w ? S.B1 : S.B0) + (size_t)cur.pn * tstep;
    if constexpr (SP2) {
        PG8_STAGE(PG8_SB(0, 0), cB, voffB); PG8_STAGE(PG8_SB(0, 1), cB + hstep, voffB); PG8_STAGE(PG8_SA(0, 0), cA, voffA); PG8_STAGE(PG8_SA(0, 1), cA + hstep, voffA);
        if (wr == 1) PG8_BAR;
        PG8_WAIT_V(2); PG8_BAR;
        PG8_STAGE(PG8_SB(1, 0), cB + kstep, voffB); PG8_STAGE(PG8_SA(1, 0), cA + kstep, voffA); PG8_STAGE(PG8_SB(1, 1), cB + hstep + kstep, voffB);
        PG8_WAIT_V(6); PG8_BAR;
    } else {
        PG8_STAGE(PG8_SB(0, 0), cB, voffB); PG8_STAGE(PG8_SA(0, 0), cA, voffA); PG8_STAGE(PG8_SB(0, 1), cB + hstep, voffB); PG8_STAGE(PG8_SA(0, 1), cA + hstep, voffA);
        if (wr == 1) PG8_BAR;
        PG8_WAIT_V(4); PG8_BAR;
        PG8_STAGE(PG8_SB(1, 0), cB + kstep, voffB); PG8_STAGE(PG8_SA(1, 0), cA + kstep, voffA); PG8_STAGE(PG8_SB(1, 1), cB + hstep + kstep, voffB);
        PG8_WAIT_V(6); PG8_BAR;
    }
    for (;;) {
        const bool has_next = S.next(ui + 1, nxt);
        const char* nA = has_next ? (nxt.w ? S.A1 : S.A0) + (size_t)nxt.pm * tstep : cA; const char* nB = has_next ? (nxt.w ? S.B1 : S.B0) + (size_t)nxt.pn * tstep : cB;
        for (int t = 0; t < nt; t += 2) {
            const bool last = (t == nt - 2);
            const char* a1 = cA + (size_t)(t + 1) * kstep;
            const char* a2 = last ? nA : cA + (size_t)(t + 2) * kstep; const char* b2 = last ? nB : cB + (size_t)(t + 2) * kstep;
            const char* a3 = a2 + kstep; const char* b3 = b2 + kstep;
            if constexpr (SP2) {
            PG8_LDB(B0, 0, 0); PG8_LDB(B1, 0, 1); PG8_SCHED; PG8_LDA(At, 0, 0); PG8_STAGE(PG8_SA(1, 1), a1 + hstep, voffA);
            PG8_WAIT_V(8); PG8_WAIT_L(0); PG8_BAR; PG8_MMA(0, 0, At, B0); PG8_MMA(0, 1, At, B1); PG8_BAR; PG8_SCHED;
            PG8_LDA(At, 0, 1); PG8_STAGE(PG8_SB(0, 0), b2, voffB); PG8_STAGE(PG8_SB(0, 1), b2 + hstep, voffB); PG8_STAGE(PG8_SA(0, 0), a2, voffA);
            PG8_WAIT_V(8); PG8_WAIT_L(0); PG8_BAR; PG8_MMA(1, 0, At, B0); PG8_MMA(1, 1, At, B1); PG8_BAR; PG8_SCHED;
            PG8_LDB(B0, 1, 0); PG8_LDB(B1, 1, 1); PG8_SCHED; PG8_LDA(At, 1, 0); PG8_STAGE(PG8_SA(0, 1), a2 + hstep, voffA);
            PG8_WAIT_V(8); PG8_WAIT_L(0); PG8_BAR; PG8_MMA(0, 0, At, B0); PG8_MMA(0, 1, At, B1); PG8_BAR; PG8_SCHED;
            PG8_LDA(At, 1, 1); PG8_STAGE(PG8_SB(1, 0), b3, voffB); PG8_STAGE(PG8_SB(1, 1), b3 + hstep, voffB); PG8_STAGE(PG8_SA(1, 0), a3, voffA);
            PG8_WAIT_V(8); PG8_WAIT_L(0); PG8_BAR; PG8_MMA(1, 0, At, B0); PG8_MMA(1, 1, At, B1); PG8_BAR; PG8_SCHED;
            } else {
            PG8_LDB(B0, 0, 0); PG8_SCHED; PG8_LDA(At, 0, 0); PG8_STAGE(PG8_SA(1, 1), a1 + hstep, voffA);
            PG8_WAIT_L(8); PG8_BAR; PG8_WAIT_L(0); PG8_MMA(0, 0, At, B0); PG8_BAR; PG8_SCHED;
            PG8_LDB(B1, 0, 1); PG8_STAGE(PG8_SB(0, 0), b2, voffB);
            PG8_BAR; PG8_WAIT_L(0); PG8_MMA(0, 1, At, B1); PG8_BAR;
            PG8_LDA(At, 0, 1); PG8_STAGE(PG8_SA(0, 0), a2, voffA);
            PG8_BAR; PG8_WAIT_L(0); PG8_MMA(1, 0, At, B0); PG8_BAR; PG8_SCHED;
            PG8_STAGE(PG8_SB(0, 1), b2 + hstep, voffB);
            PG8_WAIT_V(6); PG8_BAR; PG8_MMA(1, 1, At, B1); PG8_BAR;
            PG8_LDB(B0, 1, 0); PG8_SCHED; PG8_LDA(At, 1, 0); PG8_STAGE(PG8_SA(0, 1), a2 + hstep, voffA);
            PG8_WAIT_L(8); PG8_BAR; PG8_WAIT_L(0); PG8_MMA(0, 0, At, B0); PG8_BAR; PG8_SCHED;
            PG8_LDB(B1, 1, 1); PG8_STAGE(PG8_SB(1, 0), b3, voffB);
            PG8_BAR; PG8_WAIT_L(0); PG8_MMA(0, 1, At, B1); PG8_BAR;
            PG8_LDA(At, 1, 1); PG8_STAGE(PG8_SA(1, 0), a3, voffA);
            PG8_BAR; PG8_WAIT_L(0); PG8_MMA(1, 0, At, B0); PG8_BAR; PG8_SCHED;
            PG8_STAGE(PG8_SB(1, 1), b3 + hstep, voffB);
            PG8_WAIT_V(6); PG8_BAR; PG8_MMA(1, 1, At, B1); PG8_BAR;
            }
        }
        if constexpr (ALIGN_EPI) { if (wr == 0) PG8_BAR; }
        epi_apply(E, acc, cur, wr, wc, fr, fq);
        if (!has_next) break;
#pragma unroll
        for (int a = 0; a < 2; ++a)
#pragma unroll
            for (int b = 0; b < 2; ++b)
#pragma unroll
                for (int m = 0; m < 4; ++m)
#pragma unroll
                    for (int n = 0; n < 2; ++n) acc[a][b][m][n] = (f32x4){0.f, 0.f, 0.f, 0.f};
        cur = nxt; cA = nA; cB = nB; ++ui;
        if constexpr (ALIGN_EPI) { if (wr == 1) PG8_BAR; }
    }
    PG8_WAIT_V(0);
    if constexpr (!ALIGN_EPI) { if (wr == 0) PG8_BAR; }
    PG8_BAR;
#undef PG8_SA
#undef PG8_SB
#undef PG8_STAGE
#undef PG8_LDA
#undef PG8_LDB
#undef PG8_MMA
#undef PG8_WAIT_V
#undef PG8_WAIT_L
#undef PG8_BAR
#undef PG8_SCHED
}
}
template <int KD, class Epi>
__device__ __forceinline__ void sample_tile(const Ctx& C, const bf16_t* A0, const bf16_t* B0, const bf16_t* A1, const bf16_t* B1, int rb, int cb, const Epi& E) {
    const int fr = C.lane & 15, fq = C.lane >> 4;
    for (int w = 0; w < (A1 ? 2 : 1); ++w) {
        const bf16_t* ap = (w ? A1 : A0) + (size_t)(TP + 16 * rb + fr) * DM + 8 * fq; const bf16_t* bp = (w ? B1 : B0) + (size_t)(16 * cb + fr) * DM + 8 * fq;
        f32x4 acc = (f32x4){0.f, 0.f, 0.f, 0.f};
#pragma unroll 16
        for (int ks = 0; ks < DM / 32; ++ks) { const bf16x8 a = *(const bf16x8*)(ap + 32 * ks), b = *(const bf16x8*)(bp + 32 * ks); acc = __builtin_amdgcn_mfma_f32_16x16x32_bf16(b, a, acc, 0, 0, 0); }
        E.template apply<KD>(w, TP + 16 * rb + fr, 16 * cb + 4 * fq, acc);
    }
}
template <class Epi>
__device__ __forceinline__ void gemm_sample(const Ctx& C, const bf16_t* A0, const bf16_t* B0, const bf16_t* A1, const bf16_t* B1, int N, const Epi& E) {
    const int gw = C.bid * NWAVES + C.wave, NGW = C.G * NWAVES, ncb = N / 16;
    for (int it = gw; it < 8 * ncb; it += NGW) {
        const int cb = it >> 3, rb = it & 7; const int kd = E.kind(cb >> 4);
        if constexpr (Epi::NK == 1) sample_tile<0>(C, A0, B0, A1, B1, rb, cb, E);
        else { if (kd == 0) sample_tile<0>(C, A0, B0, A1, B1, rb, cb, E); else if (kd == 1) sample_tile<1>(C, A0, B0, A1, B1, rb, cb, E);
            else if constexpr (Epi::NK > 2) { if (kd == 2) sample_tile<2>(C, A0, B0, A1, B1, rb, cb, E); else if (kd == 3) sample_tile<3>(C, A0, B0, A1, B1, rb, cb, E); else sample_tile<4>(C, A0, B0, A1, B1, rb, cb, E); } }
    }
}
template <class Epi>
__device__ __forceinline__ void gemm_run(const Ctx& C, const bf16_t* A0, const bf16_t* B0, const bf16_t* A1, const bf16_t* B1, int N, const Epi& E) {
    gemm_sample(C, A0, B0, A1, B1, N, E);
    pg8::Sched S; S.nM = TP / 256; S.nN = N / 256; S.nW = A1 ? 2 : 1; S.nwg = S.nM * S.nN; S.G = C.G; S.c = C.bid;
    S.A0 = (const char*)A0; S.B0 = (const char*)B0; S.A1 = (const char*)A1; S.B1 = (const char*)B1;
    pg8::gemm_phase<Epi>(C.lds, C.tid, DM, S, E);
    __syncthreads();
}

__device__ __forceinline__ unsigned cvt_pk_bf16(float lo, float hi) { unsigned r; asm volatile("v_cvt_pk_bf16_f32 %0, %1, %2" : "=v"(r) : "v"(lo), "v"(hi)); return r; }
__device__ __forceinline__ bf16x8 pack_acc(const f32x16& a, int t) {
    u32x4 w;
    if (t == 0) { w.x = cvt_pk_bf16(a[0], a[1]); w.y = cvt_pk_bf16(a[2], a[3]); w.z = cvt_pk_bf16(a[4], a[5]); w.w = cvt_pk_bf16(a[6], a[7]); }
    else { w.x = cvt_pk_bf16(a[8], a[9]); w.y = cvt_pk_bf16(a[10], a[11]); w.z = cvt_pk_bf16(a[12], a[13]); w.w = cvt_pk_bf16(a[14], a[15]); }
    return __builtin_bit_cast(bf16x8, w);
}
__device__ __forceinline__ int sig_pos(int s) { return (s & ~15) | (((s >> 2) & 1) << 3) | (((s >> 3) & 1) << 2) | (s & 3); }
constexpr int SROW = 144;

template <int WSTR>
__device__ __forceinline__ void conv8(const u32x4 (&rw)[4], const LAS float* wl, float (&v)[8]) {
    f32x4 w[5][2];
#pragma unroll
    for (int k = 0; k < 5; ++k) { w[k][0] = *(const LAS f32x4*)(wl + k * WSTR); w[k][1] = *(const LAS f32x4*)(wl + k * WSTR + 4); }
#pragma unroll
    for (int e = 0; e < 8; ++e) { const int dw = e >> 1; const bool hi = e & 1;
        float x[4];
#pragma unroll
        for (int k = 0; k < 4; ++k) { const unsigned q = dw == 0 ? rw[k].x : (dw == 1 ? rw[k].y : (dw == 2 ? rw[k].z : rw[k].w)); x[k] = hi ? bfhi(q) : bflo(q); }
        v[e] = w[4][e >> 2][e & 3] + w[0][e >> 2][e & 3] * x[0] + w[1][e >> 2][e & 3] * x[1] + w[2][e >> 2][e & 3] * x[2] + w[3][e >> 2][e & 3] * x[3]; }
}
constexpr size_t WS_CBC = WS_EI;
__device__ __forceinline__ void phase_convbc(const Ctx& C, int l) {
    CParams& P = *C.P;
    const bf16_t* XBC = WSP(bf16_t, WS_B2); bf16_t* CBC = WSP(bf16_t, WS_CBC);
    const float* cw = as_global(P.in[IN_SCW]) + (size_t)l * 4 * 1280 + 1024; const float* cbp = as_global(P.in[IN_SCB]) + (size_t)l * 1280 + 1024;
    const float* cst = as_global(P.in[IN_SSDCONV]) + (size_t)l * 8 * 3 * 1280;
    const size_t items = (size_t)TT * 32, stride = (size_t)C.G * NTHREADS;
    for (size_t it = (size_t)C.bid * NTHREADS + C.tid; it < items; it += stride) {
        const int tok = (int)(it >> 5), cg = (int)(it & 31), ch = cg * 8;
        const bool smp = tok >= TP; const int b = smp ? (tok - TP) >> 4 : tok >> 11, t = smp ? (tok - TP) & 15 : tok & 2047, L = smp ? 16 : 2048, NB = smp ? 8 : 16;
        u32x4 rw[4];
#pragma unroll
        for (int k = 0; k < 4; ++k) { const int tr = t - 3 + k;
            if (tr >= 0) rw[k] = *(const u32x4*)(XBC + (size_t)(tok - t + tr) * 1280 + 1024 + ch);
            else if (smp) { const float* s0 = cst + ((size_t)b * 3 + (tr + 3)) * 1280 + 1024 + ch; const f32x4 a0 = *(const f32x4*)s0, a1 = *(const f32x4*)(s0 + 4);
                rw[k] = (u32x4){pk2(a0[0], a0[1]), pk2(a0[2], a0[3]), pk2(a1[0], a1[1]), pk2(a1[2], a1[3])}; }
            else rw[k] = (u32x4){0u, 0u, 0u, 0u}; }
        f32x4 w[5][2];
#pragma unroll
        for (int k = 0; k < 4; ++k) { w[k][0] = *(const f32x4*)(cw + k * 1280 + ch); w[k][1] = *(const f32x4*)(cw + k * 1280 + ch + 4); }
        w[4][0] = *(const f32x4*)(cbp + ch); w[4][1] = *(const f32x4*)(cbp + ch + 4);
        float v[8];
#pragma unroll
        for (int e = 0; e < 8; ++e) { const int dw = e >> 1; const bool hi = e & 1; float x[4];
#pragma unroll
            for (int k = 0; k < 4; ++k) { const unsigned q = dw == 0 ? rw[k].x : (dw == 1 ? rw[k].y : (dw == 2 ? rw[k].z : rw[k].w)); x[k] = hi ? bfhi(q) : bflo(q); }
            v[e] = siluf_(w[4][e >> 2][e & 3] + w[0][e >> 2][e & 3] * x[0] + w[1][e >> 2][e & 3] * x[1] + w[2][e >> 2][e & 3] * x[2] + w[3][e >> 2][e & 3] * x[3]); }
        *(u32x4*)(CBC + (size_t)tok * 256 + ch) = (u32x4){pk2(v[0], v[1]), pk2(v[2], v[3]), pk2(v[4], v[5]), pk2(v[6], v[7])};
        if (t >= L - 3) { float* co = C.out + (smp ? O_SSCONV : O_PSCONV) + ((size_t)(l * NB + b) * 3 + (t - (L - 3))) * 1280 + 1024 + ch; const u32x4 q = rw[3];
            *(f32x4*)co = (f32x4){bflo(q.x), bfhi(q.x), bflo(q.y), bfhi(q.y)}; *(f32x4*)(co + 4) = (f32x4){bflo(q.z), bfhi(q.z), bflo(q.w), bfhi(q.w)}; }
    }
}

#ifndef SCAN_SKIP
#define SCAN_SKIP 0
#endif
__device__ __forceinline__ void scan_item_fused(const Ctx& C, int l, int idx, bool dry) {
    const int skip = dry ? SCAN_SKIP : 0;
    CParams& P = *C.P; const int tid = C.tid, lane = C.lane, wave = C.wave;
    const bool smp = idx >= 256; const int ii = smp ? idx - 256 : idx; const int b = ii >> 4, head = ii & 15, g = head >> 3, j = head;
    const int tok0 = smp ? TP + b * 16 : b * 2048, L = smp ? 16 : 2048, NB = smp ? 8 : 16, nchunk = smp ? 1 : 32;
    const bf16_t* XBC = WSP(bf16_t, WS_B2); const bf16_t* CBC = WSP(bf16_t, WS_CBC); bf16_t* Z = WSP(bf16_t, WS_B1); const float* DT = WSP(float, WS_DT); float* SSQ = WSP(float, WS_SSQ);
    const float a_h = -__expf(as_global(P.in[IN_ALOG])[l * 16 + head]), Dh = as_global(P.in[IN_SSDD])[l * 16 + head];
    LAS unsigned char* bmR = C.lds; LAS unsigned char* cmR = C.lds + 9216; LAS unsigned char* xsR = C.lds + 18432; LAS unsigned char* bwR = C.lds + 30720;
    LAS float* ybuf = (LAS float*)(C.lds + 43008);
    LAS float* acum = (LAS float*)(C.lds + 59392); LAS float* dtv = acum + 64; LAS float* eac = acum + 128; LAS float* wsc = acum + 192; LAS float* misc = acum + 256; LAS float* cwl = acum + 320;
    const int t = tid >> 3, cg = tid & 7;
    const int chx = head * 64 + cg * 8, chb = 1024 + g * 64 + cg * 8, chc = 1152 + g * 64 + cg * 8;
    const float* scw = as_global(P.in[IN_SCW]) + (size_t)l * 4 * 1280; const float* scb = as_global(P.in[IN_SCB]) + (size_t)l * 1280;
    const float* scst = smp ? as_global(P.in[IN_SSDCONV]) + (size_t)(l * 8 + b) * 3 * 1280 : nullptr;
    const int qb = (wave >> 1) & 1, pb = wave & 1, r = lane & 31, hh = lane >> 5;
    f32x16 hacc[2];
#pragma unroll
    for (int nb = 0; nb < 2; ++nb)
#pragma unroll
        for (int i = 0; i < 16; ++i) hacc[nb][i] = 0.f;
    if (smp && wave < 4) {
        const float* hs = as_global(P.in[IN_SSD]) + ((size_t)((l * 8 + b) * 16 + head) * 64 + 32 * pb + r) * 64;
#pragma unroll
        for (int nb = 0; nb < 2; ++nb)
#pragma unroll
            for (int i4 = 0; i4 < 4; ++i4) { const f32x4 v = *(const f32x4*)(hs + 32 * nb + 8 * i4 + 4 * hh); hacc[nb][4 * i4] = v[0]; hacc[nb][4 * i4 + 1] = v[1]; hacc[nb][4 * i4 + 2] = v[2]; hacc[nb][4 * i4 + 3] = v[3]; }
    }
    const bf16_t* LX = WSP(bf16_t, WS_B3); bf16_t* LY = WSP(bf16_t, WS_B4);
    LAS unsigned char* LB = C.lds + 65536;
    LAS unsigned char* xcB = LB; LAS unsigned char* waT = LB + 9216; LAS unsigned char* wxT = LB + 18432;
    LAS float* xcF = (LAS float*)(LB + 27648); LAS float* aF = (LAS float*)(LB + 44032); LAS float* uF = (LAS float*)(LB + 60416); LAS float* lcwl = (LAS float*)(LB + 76800);
    const int ch0 = j * 64 + cg * 8;
    const float* lcw = as_global(P.in[IN_LCW]) + (size_t)l * 4 * DM; const float* lcb = as_global(P.in[IN_LCB]) + (size_t)l * DM;
    const float* lcst = smp ? as_global(P.in[IN_LRUCONV]) + (size_t)(l * 8 + b) * 3 * DM : nullptr;
    const int tb = qb, eb = pb, ech = j * 64 + 32 * eb + r;
    const float ba = as_global(P.in[IN_BA])[l * DM + ech], bxx = as_global(P.in[IN_BX])[l * DM + ech], sp8 = -8.0f * softplusf_(-as_global(P.in[IN_LAM])[l * DM + ech]);
    float hstate = (smp && wave == 4) ? as_global(P.in[IN_LRU])[(size_t)(l * 8 + b) * DM + j * 64 + lane] : 0.f;
    __syncthreads();
    for (int i = tid; i < 5 * 192; i += NTHREADS) { const int k = i / 192, cc = i % 192; const int ch = cc < 64 ? head * 64 + cc : (cc < 128 ? 1024 + g * 64 + (cc - 64) : 1152 + g * 64 + (cc - 128));
        cwl[i] = k < 4 ? scw[k * 1280 + ch] : scb[ch]; }
    { const u32x4* lw = (const u32x4*)(WSP(bf16_t, WS_LRUW) + (size_t)(l * 16 + j) * 8192);
      for (int i = tid; i < 1024; i += NTHREADS) { const int gate = i >> 9, e = (i >> 3) & 63, ck = i & 7; *(LAS u32x4*)((gate ? wxT : waT) + e * SROW + ck * 16) = lw[i]; } }
    for (int i = tid; i < 5 * 64; i += NTHREADS) { const int k = i >> 6, cc = i & 63; lcwl[i] = k < 4 ? lcw[k * DM + j * 64 + cc] : lcb[j * 64 + cc]; }
    u32x4 rw[4], bcv, ccv, lrw[4], zs, lyv; float dtl = 0.f;
#define RAWROW(dst, base, ld, ch, cstp, tr) { if ((tr) >= 0) dst = ((tr) < L) ? *(const u32x4*)((base) + (size_t)(tok0 + (tr)) * (ld) + (ch)) : (u32x4){0u, 0u, 0u, 0u}; \
        else if (smp) { const float* s0_ = (cstp) + (size_t)((tr) + 3) * (ld) + (ch); const f32x4 a0_ = *(const f32x4*)s0_, a1_ = *(const f32x4*)(s0_ + 4); \
            dst = (u32x4){pk2(a0_[0], a0_[1]), pk2(a0_[2], a0_[3]), pk2(a1_[0], a1_[1]), pk2(a1_[2], a1_[3])}; } else dst = (u32x4){0u, 0u, 0u, 0u}; }
#define SSD_LOAD(c_) { const int tg_ = (c_) * 64 + t; _Pragma("unroll") for (int k = 0; k < 4; ++k) { RAWROW(rw[k], XBC, 1280, chx, scst, tg_ - 3 + k) } \
        const bool v_ = tg_ < L; bcv = v_ ? *(const u32x4*)(CBC + (size_t)(tok0 + tg_) * 256 + g * 64 + cg * 8) : (u32x4){0u, 0u, 0u, 0u}; ccv = v_ ? *(const u32x4*)(CBC + (size_t)(tok0 + tg_) * 256 + 128 + g * 64 + cg * 8) : (u32x4){0u, 0u, 0u, 0u}; \
        }
#define LRU_LOAD(c_) { const int tg_ = (c_) * 64 + t; _Pragma("unroll") for (int k = 0; k < 4; ++k) { RAWROW(lrw[k], LX, DM, ch0, lcst, tg_ - 3 + k) } }
#define TAIL_LOAD(c_) { const int tg_ = (c_) * 64 + t; const bool v_ = tg_ < L; zs = v_ ? *(const u32x4*)(Z + (size_t)(tok0 + tg_) * DM + chx) : (u32x4){0u, 0u, 0u, 0u}; lyv = v_ ? *(const u32x4*)(LY + (size_t)(tok0 + tg_) * DM + ch0) : (u32x4){0u, 0u, 0u, 0u}; }
    SSD_LOAD(0) LRU_LOAD(0) TAIL_LOAD(0)
    if (wave == 0) dtl = (lane < L) ? DT[(size_t)(tok0 + lane) * 16 + head] : 0.f;
    __syncthreads();
    for (int c = 0; c < nchunk; ++c) {
        int lt_ = tid; asm volatile("" : "+v"(lt_));
        const int t = lt_ >> 3, cg = lt_ & 7, lane = lt_ & 63, r = lane & 31, hh = lane >> 5;
        const int chx = head * 64 + cg * 8, chb = 1024 + g * 64 + cg * 8, chc = 1152 + g * 64 + cg * 8, ch0 = j * 64 + cg * 8;
        const int tg = c * 64 + t; const bool valid = tg < L;
        if (wave == 0 && !(skip & 128)) {
            float cs = dtl * a_h;
            { float o = shfl_f(cs, lane - 1); if (lane >= 1) cs += o; o = shfl_f(cs, lane - 2); if (lane >= 2) cs += o; o = shfl_f(cs, lane - 4); if (lane >= 4) cs += o;
              o = shfl_f(cs, lane - 8); if (lane >= 8) cs += o; o = shfl_f(cs, lane - 16); if (lane >= 16) cs += o; o = shfl_f(cs, lane - 32); if (lane >= 32) cs += o; }
            const float tot = shfl_f(cs, 63);
            acum[lane] = cs; dtv[lane] = dtl; eac[lane] = __expf(cs); wsc[lane] = __expf(tot - cs) * dtl; if (lane == 0) misc[0] = __expf(tot);
        }
        if (!(skip & 32)) {
            float v[8]; conv8<64>(lrw, lcwl + cg * 8, v);
            *(LAS u32x4*)(xcB + t * SROW + cg * 16) = (u32x4){pk2(v[0], v[1]), pk2(v[2], v[3]), pk2(v[4], v[5]), pk2(v[6], v[7])};
            *(LAS f32x4*)(xcF + t * 64 + cg * 8) = (f32x4){v[0], v[1], v[2], v[3]}; *(LAS f32x4*)(xcF + t * 64 + cg * 8 + 4) = (f32x4){v[4], v[5], v[6], v[7]};
            if (!dry && valid && tg >= L - 3) { float* co = C.out + (smp ? O_SLCONV : O_PLCONV) + ((size_t)(l * NB + b) * 3 + (tg - (L - 3))) * DM + ch0; const u32x4 q = lrw[3];
                *(f32x4*)co = (f32x4){bflo(q.x), bfhi(q.x), bflo(q.y), bfhi(q.y)}; *(f32x4*)(co + 4) = (f32x4){bflo(q.z), bfhi(q.z), bflo(q.w), bfhi(q.w)}; }
        }
        LRU_LOAD(c + 1)
        if (!(skip & 256)) __syncthreads();
        if (!(skip & 16)) {
            const float wsl = wsc[t];
            { float v[8]; conv8<192>(rw, cwl + cg * 8, v);
#pragma unroll
              for (int e = 0; e < 8; ++e) v[e] = valid ? siluf_(v[e]) : 0.f;
              if (!(skip & 1)) *(LAS u32x4*)(xsR + t * 192 + cg * 16) = (u32x4){pk2(v[0], v[1]), pk2(v[2], v[3]), pk2(v[4], v[5]), pk2(v[6], v[7])}; }
            *(LAS u32x4*)(bmR + t * SROW + cg * 16) = bcv;
            *(LAS u32x4*)(cmR + t * SROW + cg * 16) = ccv;
            if (!(skip & 1)) *(LAS u32x4*)(bwR + t * 192 + cg * 16) = (u32x4){pk2(bflo(bcv.x) * wsl, bfhi(bcv.x) * wsl), pk2(bflo(bcv.y) * wsl, bfhi(bcv.y) * wsl), pk2(bflo(bcv.z) * wsl, bfhi(bcv.z) * wsl), pk2(bflo(bcv.w) * wsl, bfhi(bcv.w) * wsl)};
            if (!dry && valid && tg >= L - 3) { float* co = C.out + (smp ? O_SSCONV : O_PSCONV) + ((size_t)(l * NB + b) * 3 + (tg - (L - 3))) * 1280 + chx; const u32x4 q = rw[3];
                *(f32x4*)co = (f32x4){bflo(q.x), bfhi(q.x), bflo(q.y), bfhi(q.y)}; *(f32x4*)(co + 4) = (f32x4){bflo(q.z), bfhi(q.z), bflo(q.w), bfhi(q.w)}; }
        }
        asm volatile("" ::: "memory");
        SSD_LOAD(c + 1)
        if (wave == 0) { const int tq_ = (c + 1) * 64 + lane; dtl = (tq_ < L) ? DT[(size_t)(tok0 + tq_) * 16 + head] : 0.f; }
        if (wave >= 4 && !(skip & 2)) {
            f32x16 ra, ia;
#pragma unroll
            for (int i = 0; i < 16; ++i) { ra[i] = 0.f; ia[i] = 0.f; }
#pragma unroll
            for (int ks = 0; ks < 4; ++ks) { const bf16x8 A = *(const LAS bf16x8*)(xcB + (32 * tb + r) * SROW + (16 * ks + 8 * hh) * 2);
                const bf16x8 Ba = *(const LAS bf16x8*)(waT + (32 * eb + r) * SROW + (16 * ks + 8 * hh) * 2), Bx = *(const LAS bf16x8*)(wxT + (32 * eb + r) * SROW + (16 * ks + 8 * hh) * 2);
                ra = MFMA32(A, Ba, ra); ia = MFMA32(A, Bx, ia); }
#pragma unroll
            for (int i = 0; i < 16; ++i) { const int tt = 32 * tb + (i & 3) + 8 * (i >> 2) + 4 * hh, e = 32 * eb + r;
                const float rg = sigmoidf_(ra[i] + ba), ig = sigmoidf_(ia[i] + bxx), log_a = rg * sp8, av = exp_fast(log_a);
                const float u = __builtin_amdgcn_sqrtf(fmaxf(1.0f - av * av, 0.f)) * (ig * xcF[tt * 64 + e]);
                aF[tt * 64 + e] = av; uF[tt * 64 + e] = u; }
        }
        if (!(skip & 256)) __syncthreads();
        if (wave < 4 && !(skip & 4)) {
            const int tri = lane & 15, trg = (lane >> 4) & 1;
            const int troff = (tri >> 2) * 192 + (16 * trg + 4 * (tri & 3)) * 2;
#define TRFRAG(tile, row0, rowstep, col0) ({ const LAS unsigned char* a_ = (tile) + (row0) * 192 + (col0) * 2 + troff; \
                const s16x4_ lo_ = __builtin_amdgcn_ds_read_tr16_b64_v4i16((LAS s16x4_*)a_), hi_ = __builtin_amdgcn_ds_read_tr16_b64_v4i16((LAS s16x4_*)(a_ + (rowstep) * 192)); \
                (bf16x8){lo_[0], lo_[1], lo_[2], lo_[3], hi_[0], hi_[1], hi_[2], hi_[3]}; })
            f32x16 y;
#pragma unroll
            for (int i = 0; i < 16; ++i) y[i] = 0.f;
#pragma unroll
            for (int nb = 0; nb < 2; ++nb)
#pragma unroll
                for (int tt = 0; tt < 2; ++tt) { const LAS unsigned char* ap = cmR + (32 * qb + r) * SROW + (32 * nb + 16 * tt + 4 * hh) * 2;
                    const u32x2 a0 = *(const LAS u32x2*)ap, a1 = *(const LAS u32x2*)(ap + 16);
                    y = MFMA32(__builtin_bit_cast(bf16x8, (u32x4){a0.x, a0.y, a1.x, a1.y}), pack_acc(hacc[nb], tt), y); }
#pragma unroll
            for (int i = 0; i < 16; ++i) y[i] *= eac[32 * qb + (i & 3) + 8 * (i >> 2) + 4 * hh];
            const float aq = acum[32 * qb + r]; const int qg = 32 * qb + r;
            for (int sb = 0; sb <= qb; ++sb) {
                f32x16 cbt;
#pragma unroll
                for (int i = 0; i < 16; ++i) cbt[i] = 0.f;
#pragma unroll
                for (int ks = 0; ks < 4; ++ks) { const bf16x8 A = *(const LAS bf16x8*)(bmR + (32 * sb + r) * SROW + (16 * ks + 8 * hh) * 2), B = *(const LAS bf16x8*)(cmR + (32 * qb + r) * SROW + (16 * ks + 8 * hh) * 2); cbt = MFMA32(A, B, cbt); }
#pragma unroll
                for (int i = 0; i < 16; ++i) { const int sg = 32 * sb + (i & 3) + 8 * (i >> 2) + 4 * hh;
                    float wv = cbt[i] * exp_fast(fminf(aq - acum[sg], 0.f)) * dtv[sg]; wv = sg > qg ? 0.f : wv; wv = sg == qg ? wv + Dh : wv; cbt[i] = wv; }
#pragma unroll
                for (int tt = 0; tt < 2; ++tt) { const bf16x8 B = TRFRAG(xsR, 32 * sb + 16 * tt + 4 * hh, 8, 32 * pb); y = MFMA32(pack_acc(cbt, tt), B, y); }
            }
#pragma unroll
            for (int i = 0; i < 16; ++i) ybuf[(32 * qb + (i & 3) + 8 * (i >> 2) + 4 * hh) * 64 + 32 * pb + r] = y[i];
            const float dec = misc[0];
#pragma unroll
            for (int nb = 0; nb < 2; ++nb) {
#pragma unroll
                for (int i = 0; i < 16; ++i) hacc[nb][i] *= dec;
#pragma unroll
                for (int ks = 0; ks < 4; ++ks) { const bf16x8 A = TRFRAG(bwR, 16 * ks + 8 * hh, 4, 32 * nb), B = TRFRAG(xsR, 16 * ks + 8 * hh, 4, 32 * pb); hacc[nb] = MFMA32(A, B, hacc[nb]); }
            }
#undef TRFRAG
        } else if (wave == 4 && !(skip & 8)) {
            const int nsteps = (L - c * 64) < 64 ? (L - c * 64) : 64;
            for (int s0 = 0; s0 < nsteps; s0 += 8) {
                float av[8], uv[8];
#pragma unroll
                for (int q = 0; q < 8; ++q) { av[q] = aF[(s0 + q) * 64 + lane]; uv[q] = uF[(s0 + q) * 64 + lane]; }
#pragma unroll
                for (int q = 0; q < 8; ++q) { hstate = (s0 + q < nsteps) ? av[q] * hstate + uv[q] : hstate; uF[(s0 + q) * 64 + lane] = hstate; }
            }
        }
        if (!(skip & 256)) __syncthreads();
        if (!(skip & 64)) {
            const f32x4 y0 = *(const LAS f32x4*)(ybuf + t * 64 + cg * 8), y1 = *(const LAS f32x4*)(ybuf + t * 64 + cg * 8 + 4);
            const float o0 = y0[0] * bflo(zs.x), o1 = y0[1] * bfhi(zs.x), o2 = y0[2] * bflo(zs.y), o3 = y0[3] * bfhi(zs.y);
            const float o4 = y1[0] * bflo(zs.z), o5 = y1[1] * bfhi(zs.z), o6 = y1[2] * bflo(zs.w), o7 = y1[3] * bfhi(zs.w);
            float ss = (o0 * o0 + o1 * o1) + (o2 * o2 + o3 * o3) + (o4 * o4 + o5 * o5) + (o6 * o6 + o7 * o7);
            ss = row8_sum(ss);
            const f32x4 h0 = *(const LAS f32x4*)(uF + t * 64 + cg * 8), h1 = *(const LAS f32x4*)(uF + t * 64 + cg * 8 + 4);
            asm volatile("" :: "v"(o0), "v"(o7), "v"(ss), "v"(h0[0]), "v"(h1[3]));
            if (valid && !dry) { *(u32x4*)(Z + (size_t)(tok0 + tg) * DM + chx) = (u32x4){pk2(o0, o1), pk2(o2, o3), pk2(o4, o5), pk2(o6, o7)};
                if (cg == 0) SSQ[(size_t)(tok0 + tg) * 16 + head] = ss;
                *(u32x4*)(LY + (size_t)(tok0 + tg) * DM + ch0) = (u32x4){pk2(h0[0] * bflo(lyv.x), h0[1] * bfhi(lyv.x)), pk2(h0[2] * bflo(lyv.y), h0[3] * bfhi(lyv.y)),
                                                                          pk2(h1[0] * bflo(lyv.z), h1[1] * bfhi(lyv.z)), pk2(h1[2] * bflo(lyv.w), h1[3] * bfhi(lyv.w))}; }
        }
        if (skip & 512) {
#pragma unroll
            for (int k = 0; k < 4; ++k) asm volatile("" :: "v"(rw[k].x), "v"(rw[k].w), "v"(lrw[k].x), "v"(lrw[k].w));
            asm volatile("" :: "v"(bcv.x), "v"(ccv.x), "v"(zs.x), "v"(lyv.x), "v"(dtl)); }
        TAIL_LOAD(c + 1)
    }
#undef RAWROW
#undef SSD_LOAD
#undef LRU_LOAD
#undef TAIL_LOAD
    if (!dry && wave < 4 && qb == 0) {
        float* so = C.out + (smp ? O_SSSD : O_PSSD) + ((size_t)((l * NB + b) * 16 + head) * 64 + 32 * pb + r) * 64;
#pragma unroll
        for (int nb = 0; nb < 2; ++nb)
#pragma unroll
            for (int i4 = 0; i4 < 4; ++i4) *(f32x4*)(so + 32 * nb + 8 * i4 + 4 * hh) = (f32x4){hacc[nb][4 * i4], hacc[nb][4 * i4 + 1], hacc[nb][4 * i4 + 2], hacc[nb][4 * i4 + 3]};
    }
    if (wave == 4 && !dry) C.out[(smp ? O_SLRU : O_PLRU) + (size_t)(l * NB + b) * DM + j * 64 + lane] = hstate;
    __syncthreads();
}

__device__ __forceinline__ void phase_scan(const Ctx& C, int l, bool dry = false) {
    for (int it = C.bid; it < 384; it += C.G) scan_item_fused(C, l, it, dry);
}

__device__ __forceinline__ unsigned mono(float f) { const unsigned u = __float_as_uint(f); return (u & 0x80000000u) ? ~u : (u | 0x80000000u); }
__device__ __forceinline__ float unmono(unsigned k) { const unsigned u = (k & 0x80000000u) ? (k & 0x7fffffffu) : ~k; return __uint_as_float(u); }
template <int CTRL> __device__ __forceinline__ unsigned dpp_u(unsigned v) { return (unsigned)__builtin_amdgcn_update_dpp(0, (int)v, CTRL, 0xf, 0xf, true); }
__device__ __forceinline__ unsigned row_max_u(unsigned m) {
    m = max(m, dpp_u<0xB1>(m)); m = max(m, dpp_u<0x4E>(m)); m = max(m, dpp_u<0x141>(m)); m = max(m, dpp_u<0x140>(m)); return m;
}
__device__ __forceinline__ float row_max_f(float m) {
    m = fmaxf(m, __uint_as_float(dpp_u<0xB1>(__float_as_uint(m)))); m = fmaxf(m, __uint_as_float(dpp_u<0x4E>(__float_as_uint(m))));
    m = fmaxf(m, __uint_as_float(dpp_u<0x141>(__float_as_uint(m)))); m = fmaxf(m, __uint_as_float(dpp_u<0x140>(__float_as_uint(m)))); return m;
}
__device__ __forceinline__ float row_sum_f(float m) {
    m += __uint_as_float(dpp_u<0xB1>(__float_as_uint(m))); m += __uint_as_float(dpp_u<0x4E>(__float_as_uint(m)));
    m += __uint_as_float(dpp_u<0x141>(__float_as_uint(m))); m += __uint_as_float(dpp_u<0x140>(__float_as_uint(m))); return m;
}
#define CE_(a, b) { const unsigned hi_ = max(a, b), lo_ = min(a, b); a = hi_; b = lo_; }
#define KEY8(k, a, b) unsigned k##0 = (mono(a[0]) & ~127u) | (unsigned)(127 - (li * 8 + 0)), k##1 = (mono(a[1]) & ~127u) | (unsigned)(127 - (li * 8 + 1)), k##2 = (mono(a[2]) & ~127u) | (unsigned)(127 - (li * 8 + 2)), \
        k##3 = (mono(a[3]) & ~127u) | (unsigned)(127 - (li * 8 + 3)), k##4 = (mono(b[0]) & ~127u) | (unsigned)(127 - (li * 8 + 4)), k##5 = (mono(b[1]) & ~127u) | (unsigned)(127 - (li * 8 + 5)), \
        k##6 = (mono(b[2]) & ~127u) | (unsigned)(127 - (li * 8 + 6)), k##7 = (mono(b[3]) & ~127u) | (unsigned)(127 - (li * 8 + 7));
#define SORT8(k) CE_(k##0, k##1) CE_(k##2, k##3) CE_(k##4, k##5) CE_(k##6, k##7)  CE_(k##0, k##2) CE_(k##1, k##3) CE_(k##4, k##6) CE_(k##5, k##7)  CE_(k##1, k##2) CE_(k##5, k##6) \
        CE_(k##0, k##4) CE_(k##1, k##5) CE_(k##2, k##6) CE_(k##3, k##7)  CE_(k##2, k##4) CE_(k##3, k##5)  CE_(k##1, k##2) CE_(k##3, k##4) CE_(k##5, k##6)
#define POP8(k, m, c) k##0 = c ? k##1 : k##0; k##1 = c ? k##2 : k##1; k##2 = c ? k##3 : k##2; k##3 = c ? k##4 : k##3; k##4 = c ? k##5 : k##4; k##5 = c ? k##6 : k##5; k##6 = c ? k##7 : k##6; k##7 = c ? 0u : k##7;
__device__ __forceinline__ void top16_row2(const f32x4 a0, const f32x4 b0, const f32x4 a1, const f32x4 b1, int li, unsigned& r0, unsigned& r1) {
    KEY8(x, a0, b0) KEY8(y, a1, b1)
    SORT8(x) SORT8(y)
    unsigned rx = 0u, ry = 0u;
#pragma unroll
    for (int r = 0; r < 16; ++r) {
        const unsigned mx = row_max_u(x0), my = row_max_u(y0); const bool cx = (x0 == mx), cy = (y0 == my);
        POP8(x, mx, cx) POP8(y, my, cy)
        rx = (li == r) ? mx : rx; ry = (li == r) ? my : ry;
    }
    r0 = rx; r1 = ry;
}
#undef KEY8
#undef SORT8
#undef POP8
__device__ __forceinline__ void phase_topk(const Ctx& C) {
    const float* SC = WSP(float, WS_SC); int* EI = WSP(int, WS_EI); float* GW = WSP(float, WS_GW);
    const int lane = C.lane, li = lane & 15, rowi = lane >> 4;
    LAS float* sv = (LAS float*)(C.lds + 4096 + C.wave * 1024);
    LAS int* si = (LAS int*)(sv + 128);
    LAS unsigned char* tab = (LAS unsigned char*)C.lds;
    if (C.tid < 64) { int c = C.tid, i = 0; for (; i < 16; ++i) { const int cnt = 16 / (i + 1); if (c < cnt) break; c -= cnt; } tab[C.tid] = (unsigned char)(C.tid < 50 ? (i | (c << 4)) : 0); }
    __syncthreads();
    int ica[4], jca[4];
#pragma unroll
    for (int q = 0; q < 4; ++q) { const int tb = tab[4 * li + q]; ica[q] = tb & 15; jca[q] = tb >> 4; }
    const int gw = C.bid * NWAVES + C.wave, NGW = C.G * NWAVES;
    f32x4 na0, nb0, na1, nb1;
    { const float* base = SC + (size_t)min(gw, TT * 2 - 1) * 1024;
      na0 = *(const f32x4*)(base + lane * 8); nb0 = *(const f32x4*)(base + lane * 8 + 4); na1 = *(const f32x4*)(base + 512 + lane * 8); nb1 = *(const f32x4*)(base + 512 + lane * 8 + 4); }
    for (int g4 = gw; g4 < TT * 2; g4 += NGW) {
        const int row = g4 >> 1, hd0 = (g4 & 1) * 4;
        const f32x4 a0 = na0, b0 = nb0, a1 = na1, b1 = nb1;
        { const float* base = SC + (size_t)min(g4 + NGW, TT * 2 - 1) * 1024;
          na0 = *(const f32x4*)(base + lane * 8); nb0 = *(const f32x4*)(base + lane * 8 + 4); na1 = *(const f32x4*)(base + 512 + lane * 8); nb1 = *(const f32x4*)(base + 512 + lane * 8 + 4); }
        unsigned r0, r1; top16_row2(a0, b0, a1, b1, li, r0, r1);
        sv[lane] = unmono(r0 & ~127u); si[lane] = 127 - (int)(r0 & 127u); sv[64 + lane] = unmono(r1 & ~127u); si[64 + lane] = 127 - (int)(r1 & 127u);
        LDS_WAIT();
        const LAS float* v1 = sv + rowi * 32; const LAS float* v2 = v1 + 16;
        unsigned k[4];
#pragma unroll
        for (int q = 0; q < 4; ++q) { const int c = 4 * li + q; const float sum = v1[ica[q]] + v2[jca[q]]; k[q] = (c < 50) ? ((mono(sum) & ~63u) | (unsigned)(63 - c)) : 0u; }
        CE_(k[0], k[1]) CE_(k[2], k[3]) CE_(k[0], k[2]) CE_(k[1], k[3]) CE_(k[1], k[2])
        unsigned res = 0u;
#pragma unroll
        for (int r = 0; r < 16; ++r) {
            const unsigned m = row_max_u(k[0]); const bool c = (k[0] == m);
            k[0] = c ? k[1] : k[0]; k[1] = c ? k[2] : k[1]; k[2] = c ? k[3] : k[2]; k[3] = c ? 0u : k[3];
            res = (li == r) ? m : res;
        }
        const int csel = 63 - (int)(res & 63u); const int tb = tab[csel];
        const int e1 = (si + rowi * 32)[tb & 15], e2 = (si + rowi * 32 + 16)[tb >> 4];
        const float svv = unmono(res & ~63u);
        const float mx = row_max_f(svv), ex = __expf(svv - mx), den = row_sum_f(ex);
        const size_t o = (size_t)row * 128 + (hd0 + rowi) * 16 + li;
        EI[o] = e1 * 128 + e2; GW[o] = ex / den;
        LDS_WAIT();
    }
    __syncthreads();
}

template <int CTRL> __device__ __forceinline__ float dpp_f(float v) { return __int_as_float(__builtin_amdgcn_update_dpp(0, __float_as_int(v), CTRL, 0xf, 0xf, true)); }
__device__ __forceinline__ float swap16_f(float v, int lane) { auto r = __builtin_amdgcn_permlane16_swap(__float_as_uint(v), __float_as_uint(v), false, false); return __uint_as_float((lane & 16) ? r[0] : r[1]); }
constexpr int PEER_SLICES = 8;
#define PEER_LOAD_E(E, t_) { const u32x4* ep_ = (const u32x4*)(EI + (size_t)(t_) * 128 + r8 * 16); E[0] = ep_[0]; E[1] = ep_[1]; E[2] = ep_[2]; E[3] = ep_[3]; }
#define PEER_GATHER(U, E, base_, coff_) { _Pragma("unroll") for (int q_ = 0; q_ < 4; ++q_) { U[4 * q_] = *(const u32x4*)((base_) + (E[q_].x * 128u + (coff_))); U[4 * q_ + 1] = *(const u32x4*)((base_) + (E[q_].y * 128u + (coff_))); \
        U[4 * q_ + 2] = *(const u32x4*)((base_) + (E[q_].z * 128u + (coff_))); U[4 * q_ + 3] = *(const u32x4*)((base_) + (E[q_].w * 128u + (coff_))); } }
#define FP8LO(d) __builtin_amdgcn_cvt_pk_f32_fp8((int)(d), false)
#define FP8HI(d) __builtin_amdgcn_cvt_pk_f32_fp8((int)(d), true)
__device__ __forceinline__ void peer_u_reduce(const u32x4 (&U)[16], const u32x4 hq0, const u32x4 hq1, float* po, int c, bool store) {
    f32x2 h[8];
    h[0] = (f32x2){bflo(hq0.x), bfhi(hq0.x)}; h[1] = (f32x2){bflo(hq0.y), bfhi(hq0.y)}; h[2] = (f32x2){bflo(hq0.z), bfhi(hq0.z)}; h[3] = (f32x2){bflo(hq0.w), bfhi(hq0.w)};
    h[4] = (f32x2){bflo(hq1.x), bfhi(hq1.x)}; h[5] = (f32x2){bflo(hq1.y), bfhi(hq1.y)}; h[6] = (f32x2){bflo(hq1.z), bfhi(hq1.z)}; h[7] = (f32x2){bflo(hq1.w), bfhi(hq1.w)};
    float p[16];
#pragma unroll
    for (int i = 0; i < 16; ++i) {
        f32x2 s0 = FP8LO(U[i].x) * h[0], s1 = FP8HI(U[i].x) * h[1];
        s0 = __builtin_elementwise_fma(FP8LO(U[i].y), h[2], s0); s1 = __builtin_elementwise_fma(FP8HI(U[i].y), h[3], s1);
        s0 = __builtin_elementwise_fma(FP8LO(U[i].z), h[4], s0); s1 = __builtin_elementwise_fma(FP8HI(U[i].z), h[5], s1);
        s0 = __builtin_elementwise_fma(FP8LO(U[i].w), h[6], s0); s1 = __builtin_elementwise_fma(FP8HI(U[i].w), h[7], s1);
        s0 = s0 + s1; p[i] = s0.x + s0.y;
    }
#pragma unroll
    for (int bq = 0; bq < 2; ++bq) { float* q = p + 8 * bq;
        { const bool up = (c & 4) != 0;
#pragma unroll
          for (int j = 0; j < 4; ++j) { const float mine = up ? q[j + 4] : q[j], send = up ? q[j] : q[j + 4]; q[j] = mine + dpp_f<0x141>(send); } }
        { const bool up = (c & 2) != 0;
#pragma unroll
          for (int j = 0; j < 2; ++j) { const float mine = up ? q[j + 2] : q[j], send = up ? q[j] : q[j + 2]; q[j] = mine + dpp_f<0x4E>(send); } }
        { const bool up = (c & 1) != 0; const float mine = up ? q[1] : q[0], send = up ? q[0] : q[1]; q[0] = mine + dpp_f<0xB1>(send); } }
    if (store) { po[0] = p[0]; po[8] = p[8]; }
}
__device__ __forceinline__ void phase_peer_u(const Ctx& C) {
    const int lane = C.lane, r8 = lane >> 3, c = lane & 7;
    const bf16_t* H2 = WSP(bf16_t, WS_B0); const unsigned char* U8 = C.ws + WS_U8; const int* EI = WSP(int, WS_EI); float* PA = WSP(float, WS_SC);
    const int s = C.bid & 7, wg = (C.bid >> 3) * NWAVES + C.wave, nwg = (C.G >> 3) * NWAVES;
    const int n = (TT - wg + nwg - 1) / nwg;
    const unsigned char* ub = U8 + (size_t)s * NE * 128; const unsigned coff = (unsigned)c * 16u; const bf16_t* hb = H2 + s * 128 + c * 16;
    float* pab = PA + (size_t)s * 128 + r8 * 16 + c;
#define TOK(i_) (min(wg + (i_) * nwg, TT - 1))
#define LOAD_H(H0, H1, t_) { const u32x4* hp_ = (const u32x4*)(hb + (size_t)(t_) * DM); H0 = hp_[0]; H1 = hp_[1]; }
    u32x4 uA[16], uB[16], en[4], enn[4], hc0, hc1, hn0, hn1, hnn0, hnn1;
    PEER_LOAD_E(en, TOK(0)); LOAD_H(hc0, hc1, TOK(0));
    PEER_GATHER(uA, en, ub, coff);
    PEER_LOAD_E(en, TOK(1)); LOAD_H(hn0, hn1, TOK(1));
    for (int i = 0; i < n; i += 2) {
        PEER_GATHER(uB, en, ub, coff);
        PEER_LOAD_E(enn, TOK(i + 2)); LOAD_H(hnn0, hnn1, TOK(i + 2));
        peer_u_reduce(uA, hc0, hc1, pab + (size_t)TOK(i) * (PEER_SLICES * 128), c, true);
        hc0 = hn0; hc1 = hn1; hn0 = hnn0; hn1 = hnn1;
        PEER_GATHER(uA, enn, ub, coff);
        PEER_LOAD_E(en, TOK(i + 3)); LOAD_H(hnn0, hnn1, TOK(i + 3));
        peer_u_reduce(uB, hc0, hc1, pab + (size_t)TOK(i + 1) * (PEER_SLICES * 128), c, i + 1 < n);
        hc0 = hn0; hc1 = hn1; hn0 = hnn0; hn1 = hnn1;
    }
#undef LOAD_H
#undef TOK
}
__device__ __forceinline__ void phase_peer_act(const Ctx& C) {
    const float* PA = WSP(float, WS_SC); float* GW = WSP(float, WS_GW); const int* EI = WSP(int, WS_EI); const float* SU = WSP(float, WS_SU); const float* SV = WSP(float, WS_SV);
    const size_t n = (size_t)TT * 128, stride = (size_t)C.G * NTHREADS;
    for (size_t i = (size_t)C.bid * NTHREADS + C.tid; i < n; i += stride) {
        const size_t t = i >> 7; const int k = (int)(i & 127); const float* pp = PA + t * (PEER_SLICES * 128) + k;
        float a = 0.f;
#pragma unroll
        for (int s = 0; s < PEER_SLICES; ++s) a += pp[s * 128];
        const int e = EI[i];
        GW[i] = geluf_(a * SU[e]) * GW[i] * SV[e];
    }
}
#define PEER_LOAD_A(A, t_) { const f32x4* ap_ = (const f32x4*)(ACT + (size_t)(t_) * 128 + r8 * 16); A[0] = ap_[0]; A[1] = ap_[1]; A[2] = ap_[2]; A[3] = ap_[3]; }
#define PEER_GATHER8(U, E0, E1, base_, coff_) { U[0] = *(const u32x4*)((base_) + (E0.x * 128u + (coff_))); U[1] = *(const u32x4*)((base_) + (E0.y * 128u + (coff_))); U[2] = *(const u32x4*)((base_) + (E0.z * 128u + (coff_))); U[3] = *(const u32x4*)((base_) + (E0.w * 128u + (coff_))); \
        U[4] = *(const u32x4*)((base_) + (E1.x * 128u + (coff_))); U[5] = *(const u32x4*)((base_) + (E1.y * 128u + (coff_))); U[6] = *(const u32x4*)((base_) + (E1.z * 128u + (coff_))); U[7] = *(const u32x4*)((base_) + (E1.w * 128u + (coff_))); }
__device__ __forceinline__ void peer_v_acc8(f32x2 (&o)[8], const u32x4 (&V)[8], const f32x4 A0, const f32x4 A1) {
#pragma unroll
    for (int i = 0; i < 8; ++i) { const float a = i < 4 ? A0[i & 3] : A1[i & 3]; const f32x2 a2 = (f32x2){a, a};
        o[0] = __builtin_elementwise_fma(FP8LO(V[i].x), a2, o[0]); o[1] = __builtin_elementwise_fma(FP8HI(V[i].x), a2, o[1]);
        o[2] = __builtin_elementwise_fma(FP8LO(V[i].y), a2, o[2]); o[3] = __builtin_elementwise_fma(FP8HI(V[i].y), a2, o[3]);
        o[4] = __builtin_elementwise_fma(FP8LO(V[i].z), a2, o[4]); o[5] = __builtin_elementwise_fma(FP8HI(V[i].z), a2, o[5]);
        o[6] = __builtin_elementwise_fma(FP8LO(V[i].w), a2, o[6]); o[7] = __builtin_elementwise_fma(FP8HI(V[i].w), a2, o[7]); }
}
__device__ __forceinline__ f32x2 peer_v_scatter(const f32x2 (&o2)[8], int lane) {
    float o[16];
#pragma unroll
    for (int j = 0; j < 8; ++j) { o[2 * j] = o2[j].x; o[2 * j + 1] = o2[j].y; }
    { const bool up = (lane & 32) != 0;
#pragma unroll
      for (int j = 0; j < 8; ++j) { const float mine = up ? o[j + 8] : o[j], send = up ? o[j] : o[j + 8]; o[j] = mine + shfx<32>(send, lane); } }
    { const bool up = (lane & 16) != 0;
#pragma unroll
      for (int j = 0; j < 4; ++j) { const float mine = up ? o[j + 4] : o[j], send = up ? o[j] : o[j + 4]; o[j] = mine + swap16_f(send, lane); } }
    { const bool up = (lane & 8) != 0;
#pragma unroll
      for (int j = 0; j < 2; ++j) { const float mine = up ? o[j + 2] : o[j], send = up ? o[j] : o[j + 2]; o[j] = mine + dpp_f<0x128>(send); } }
    return (f32x2){o[0], o[1]};
}
__device__ __forceinline__ void phase_peer_v(const Ctx& C, int l, bool dry = false) {
    const int lane = C.lane, r8 = lane >> 3, c = lane & 7;
    const unsigned char* V8 = C.ws + WS_V8; const int* EI = WSP(int, WS_EI); const float* ACT = WSP(float, WS_GW); const float* MOD = WSP(float, WS_MOD);
    const int s = C.bid & 7, wg = (C.bid >> 3) * NWAVES + C.wave, nwg = (C.G >> 3) * NWAVES;
    const int n = (TT - wg + nwg - 1) / nwg;
    const int jcol = ((lane >> 5) & 1) * 8 + ((lane >> 4) & 1) * 4 + ((lane >> 3) & 1) * 2;
    const int col = s * 128 + c * 16 + jcol;
    const unsigned char* vb = V8 + (size_t)s * NE * 128; const unsigned coff = (unsigned)c * 16u;
    float* xb = C.out + col; const float* g2 = MOD + (size_t)l * NBT * 6144 + 5120 + col;
#define TOK(i_) (min(wg + (i_) * nwg, TT - 1))
    u32x4 vA[8], vB[8], ec[4], en[4]; f32x4 ac[4], an[4];
    PEER_LOAD_E(ec, TOK(0)); PEER_LOAD_A(ac, TOK(0));
    PEER_GATHER8(vA, ec[0], ec[1], vb, coff);
    PEER_LOAD_E(en, TOK(1)); PEER_LOAD_A(an, TOK(1));
    for (int i = 0; i < n; ++i) {
        const int t = TOK(i);
        PEER_GATHER8(vB, ec[2], ec[3], vb, coff);
        const f32x2 xv = *(const f32x2*)(xb + (size_t)t * DM), gv = *(const f32x2*)(g2 + (size_t)row_batch(t) * 6144);
        f32x2 o[8];
#pragma unroll
        for (int j = 0; j < 8; ++j) o[j] = (f32x2){0.f, 0.f};
        peer_v_acc8(o, vA, ac[0], ac[1]);
        PEER_GATHER8(vA, en[0], en[1], vb, coff);
        peer_v_acc8(o, vB, ac[2], ac[3]);
#pragma unroll
        for (int q = 0; q < 4; ++q) { ec[q] = en[q]; ac[q] = an[q]; }
        PEER_LOAD_E(en, TOK(i + 2)); PEER_LOAD_A(an, TOK(i + 2));
        const f32x2 ov = peer_v_scatter(o, lane);
        asm volatile("" :: "v"(ov.x), "v"(ov.y));
        if (!dry) *(f32x2*)(xb + (size_t)t * DM) = xv + gv * ov;
    }
#undef TOK
}
#undef PEER_GATHER8
#undef PEER_LOAD_E
#undef PEER_LOAD_A
#undef PEER_GATHER
__device__ __forceinline__ void phase_final_norm(const Ctx& C) {
    const int gw = C.bid * NWAVES + C.wave, NGW = C.G * NWAVES; const float* fw = as_global(C.P->in[IN_FNW]);
    for (int row = gw; row < TT; row += NGW) {
        f32x4* xr = (f32x4*)(C.out + (size_t)row * DM) + C.lane;
        f32x4 v[4]; float s = 0.f;
#pragma unroll
        for (int j = 0; j < 4; ++j) { v[j] = xr[64 * j]; s += (v[j][0] * v[j][0] + v[j][1] * v[j][1]) + (v[j][2] * v[j][2] + v[j][3] * v[j][3]); }
        const float rstd = rsqrtf(wave_sum(s) * (1.f / DM) + EPS);
#pragma unroll
        for (int j = 0; j < 4; ++j) xr[64 * j] = v[j] * rstd * *(const f32x4*)(fw + C.lane * 4 + 256 * j);
    }
}


#define XB_TMO      128
#define XB_XCNT(j)  (256  + 64 * (j))
#define XB_XSUB(j)  (1280 + 64 * (j))
#define XB_XGEN(j)  (2304 + 64 * (j))
#define XB_TOP      3328
#define XB_TOPGEN   3392
#define XCD_BAR_WORDS 3456
#define XB_SPIN_CAP (1u << 22)
__device__ __forceinline__ unsigned xb_ld(unsigned* p)              { return __hip_atomic_load(p, __ATOMIC_RELAXED, __HIP_MEMORY_SCOPE_AGENT); }
__device__ __forceinline__ unsigned xb_add(unsigned* p, unsigned v) { return __hip_atomic_fetch_add(p, v, __ATOMIC_RELAXED, __HIP_MEMORY_SCOPE_AGENT); }
__device__ __forceinline__ unsigned xb_xcc_id() { return (unsigned)__builtin_amdgcn_s_getreg((3 << 11) | 20) & 0xFu; }
#define XB_SPIN(cond, bar) do { unsigned _sp = 0; while (cond) { __builtin_amdgcn_s_sleep(1); \
    if ((++_sp & 255u) == 0u) { if (xb_ld(&(bar)[XB_TMO])) break; if (_sp > XB_SPIN_CAP) { atomicAdd(&(bar)[XB_TMO], 1u); break; } } } } while (0)
struct XcdBarrier { unsigned* bar; unsigned x; volatile LAS unsigned* st; };
__device__ __forceinline__ XcdBarrier xcd_barrier_post(unsigned* bar, volatile LAS unsigned* st) {
    XcdBarrier b; b.bar = bar; b.x = xb_xcc_id(); b.st = st;
    if (threadIdx.x == 0) (void)xb_add(&bar[XB_XCNT(b.x)], 1u);
    return b;
}
__device__ __forceinline__ void xcd_barrier_complete(unsigned* bar, unsigned x, unsigned& nloc, unsigned& nx) {
    const unsigned G = gridDim.x * gridDim.y * gridDim.z;
    unsigned sum, cnt, mine, sp = 0u;
    for (;;) {
        sum = 0u; cnt = 0u; mine = 0u;
#pragma unroll
        for (unsigned j = 0; j < 16; ++j) { const unsigned c = xb_ld(&bar[XB_XCNT(j)]); sum += c; cnt += (c > 0u) ? 1u : 0u; mine = (j == x) ? c : mine; }
        if (sum == G) break;
        __builtin_amdgcn_s_sleep(1);
        if ((++sp & 255u) == 0u) { if (xb_ld(&bar[XB_TMO])) break; if (sp > XB_SPIN_CAP) { atomicAdd(&bar[XB_TMO], 1u); break; } }
    }
    nloc = mine > 0u ? mine : 1u; nx = cnt > 0u ? cnt : 1u;
}
__device__ __forceinline__ void xcd_barrier(const XcdBarrier& b) {
    asm volatile("s_waitcnt vmcnt(0)" ::: "memory");
    __syncthreads();
    if (threadIdx.x == 0) {
        unsigned* bar = b.bar;
        __builtin_amdgcn_s_waitcnt(0);
        unsigned nloc = b.st[0], nx = b.st[1];
        if (nloc == 0u) { xcd_barrier_complete(bar, b.x, nloc, nx); b.st[0] = nloc; b.st[1] = nx; }
        const unsigned old = xb_add(&bar[XB_XSUB(b.x)], 1u);
        const unsigned gen = old / nloc;
        if (old + 1u == (gen + 1u) * nloc) {
            __builtin_amdgcn_fence(__ATOMIC_RELEASE, "agent");
            asm volatile("s_waitcnt vmcnt(0)" ::: "memory");
            const unsigned og = xb_add(&bar[XB_TOP], 1u);
            const unsigned tg = og / nx;
            if (og + 1u == (tg + 1u) * nx) xb_add(&bar[XB_TOPGEN], 1u);
            else XB_SPIN(xb_ld(&bar[XB_TOPGEN]) == tg, bar);
            __builtin_amdgcn_fence(__ATOMIC_ACQUIRE, "agent");
            xb_add(&bar[XB_XGEN(b.x)], 1u);
            asm volatile("s_waitcnt vmcnt(0)" ::: "memory");
        } else {
            XB_SPIN(xb_ld(&bar[XB_XGEN(b.x)]) == gen, bar);
            __builtin_amdgcn_fence(__ATOMIC_ACQUIRE, "agent");
            asm volatile("s_waitcnt vmcnt(0)" ::: "memory");
        }
    }
    __syncthreads();
}

__device__ __forceinline__ Ctx relaunder(const Ctx& C) {
    Ctx D = C; int t = C.tid; asm volatile("" : "+v"(t)); D.tid = t; D.lane = t & 63;
    unsigned char* w = C.ws; float* o = C.out; asm volatile("" : "+s"(w), "+s"(o)); D.ws = as_global(w); D.out = as_global(o); return D;
}
constexpr int NPL = 13, NPH = 2 + 2 * NPL;
__device__ __forceinline__ void run_phase(const Ctx& C0, int ph, bool dry) {
    if (ph == 0) { const Ctx C = relaunder(C0); phase_prep(C); return; }
    if (ph == NPH - 1) { const Ctx C = relaunder(C0); phase_final_norm(C); return; }
    const int l = (ph - 1) / NPL, k = (ph - 1) % NPL;
    switch (k) {
    case 0: { const Ctx C = relaunder(C0); phase_norm(C, l, 0); } break;
    case 1: { const Ctx C = relaunder(C0); CParams& P = *C.P; Epi1 E{WSP(bf16_t, WS_B1), WSP(bf16_t, WS_B2), WSP(bf16_t, WS_B3), WSP(bf16_t, WS_B4), WSP(float, WS_DT), as_global(P.in[IN_DTB]) + l * 16};
              gemm_run(C, WSP(bf16_t, WS_B0), WSP(bf16_t, WS_W1T) + (size_t)l * N1 * DM, nullptr, nullptr, N1, E); } break;
    case 2: { const Ctx C = relaunder(C0); phase_convbc(C, l); } break;
    case 3: { const Ctx C = relaunder(C0); phase_scan(C, l, dry); } break;
    case 4: { const Ctx C = relaunder(C0); Epi2 E{WSP(bf16_t, WS_GS), WSP(bf16_t, WS_GL)};
              gemm_run(C, WSP(bf16_t, WS_B0), WSP(bf16_t, WS_WGT) + (size_t)l * NG * DM, nullptr, nullptr, NG, E); } break;
    case 5: { const Ctx C = relaunder(C0); Epi3 E{WSP(bf16_t, WS_GS), WSP(bf16_t, WS_GL), WSP(float, WS_SSQ), WSP(bf16_t, WS_B0)};
              gemm_run(C, WSP(bf16_t, WS_B1), WSP(bf16_t, WS_WBS) + (size_t)l * DM * DM, WSP(bf16_t, WS_B4), WSP(bf16_t, WS_WBL) + (size_t)l * DM * DM, DM, E); } break;
    case 6: { const Ctx C = relaunder(C0); CParams& P = *C.P; Epi4 E{as_global(P.in[IN_XP]), as_global(P.in[IN_XS]), C.out, WSP(float, WS_MOD) + (size_t)l * NBT * 6144, l};
              gemm_run(C, WSP(bf16_t, WS_B0), WSP(bf16_t, WS_WO) + (size_t)l * DM * DM, nullptr, nullptr, DM, E); } break;
    case 7: { const Ctx C = relaunder(C0); phase_norm(C, l, 1); } break;
    case 8: { const Ctx C = relaunder(C0); Epi5 E{WSP(float, WS_SC)};
              gemm_run(C, WSP(bf16_t, WS_B0), WSP(bf16_t, WS_WC) + (size_t)l * 2048 * DM, nullptr, nullptr, 2048, E); } break;
    case 9: { const Ctx C = relaunder(C0); phase_topk(C); } break;
    case 10: { const Ctx C = relaunder(C0); phase_peer_u(C); } break;
    case 11: { const Ctx C = relaunder(C0); phase_peer_act(C); } break;
    case 12: { const Ctx C = relaunder(C0); phase_peer_v(C, l, dry); } break;
    }
}

__global__ void __launch_bounds__(NTHREADS, 2) fwd(Params P) {
    extern __shared__ __attribute__((aligned(16))) unsigned char lds_raw[];
    const int ph_lo = P.ph_lo, ph_hi = P.ph_hi;
    volatile LAS unsigned* bst = (volatile LAS unsigned*)((LAS unsigned char*)lds_raw + LDS_BYTES - 64);
    if (threadIdx.x == 0) { bst[0] = 0u; bst[1] = 0u; }
    __syncthreads();
    (void)xcd_barrier_post((unsigned*)(P.ws + WS_CTL), bst);
    for (int ph = ph_lo; ph < ph_hi; ++ph) {
        CParams* Pp = (CParams*)__builtin_amdgcn_kernarg_segment_ptr(); asm volatile("" : "+s"(Pp));
        Ctx C; C.P = Pp; C.lds = (LAS unsigned char*)lds_raw;
        int tid = threadIdx.x; asm volatile("" : "+v"(tid));
        unsigned char* ws = Pp->ws; float* out = Pp->out; asm volatile("" : "+s"(ws), "+s"(out));
        C.ws = ws; C.out = out;
        C.tid = tid; C.lane = tid & 63; C.wave = __builtin_amdgcn_readfirstlane(tid >> 6); C.bid = blockIdx.x; C.G = gridDim.x;
#ifdef PROBE_K
        { const bool hit = (PROBE_K == 100) ? ph == 0 : ((PROBE_K == 101) ? ph == NPH - 1 : (ph > 0 && ph < NPH - 1 && (ph - 1) % NPL == PROBE_K));
          if (hit) for (int rep = 0; rep < PROBE_N; ++rep) { run_phase(C, ph, true); __syncthreads(); } }
#endif
        run_phase(C, ph, false);
        if (ph + 1 < ph_hi) { if (ph == 0) cg::this_grid().sync();
            else { XcdBarrier xb; xb.bar = (unsigned*)(ws + WS_CTL); xb.x = xb_xcc_id(); xb.st = (volatile LAS unsigned*)((LAS unsigned char*)lds_raw + LDS_BYTES - 64); xcd_barrier(xb); } }
    }
}

extern "C" void kernel_launch(void* const* d_in, const int* in_sizes, int n_in, void* d_out, int out_size, void* d_ws, size_t ws_size, hipStream_t stream) {
    static int grid = 0;
    if (grid == 0) {
        if (n_in != N_IN || (size_t)out_size != O_END || ws_size < WS_END) { fprintf(stderr, "kernel_launch: unexpected shapes n_in %d out %d ws %zu (need %zu)\n", n_in, out_size, ws_size, (size_t)WS_END); grid = -1; return; }
        int dev = 0, cus = 0, per_cu = 0;
        hipGetDevice(&dev); hipDeviceGetAttribute(&cus, hipDeviceAttributeMultiprocessorCount, dev);
        hipFuncSetAttribute((const void*)fwd, hipFuncAttributeMaxDynamicSharedMemorySize, LDS_BYTES);
        hipOccupancyMaxActiveBlocksPerMultiprocessor(&per_cu, (const void*)fwd, NTHREADS, LDS_BYTES);
        if (per_cu < 1) { fprintf(stderr, "kernel_launch: occupancy query says %d blocks/CU\n", per_cu); per_cu = 1; }
        grid = cus;
        fprintf(stderr, "kernel_launch: cus %d per_cu %d grid %d ws %zu\n", cus, per_cu, grid, ws_size);
    }
    if (grid < 0) return;
    Params p{};
    for (int i = 0; i < N_IN; ++i) p.in[i] = (const float*)d_in[i];
    p.out = (float*)d_out; p.ws = (unsigned char*)d_ws;
    hipMemsetAsync((char*)d_ws + WS_CTL, 0, 65536, stream);
#if MEGA
    p.ph_lo = 0; p.ph_hi = NPH;
    void* args[] = {&p};
    hipError_t e = hipLaunchCooperativeKernel((const void*)fwd, dim3(grid), dim3(NTHREADS), args, LDS_BYTES, stream);
    if (e != hipSuccess) fprintf(stderr, "cooperative launch failed: %s\n", hipGetErrorString(e));
#else
    for (int ph = 0; ph < NPH; ++ph) { p.ph_lo = ph; p.ph_hi = ph + 1; hipLaunchKernelGGL(fwd, dim3(grid), dim3(NTHREADS), LDS_BYTES, stream, p); }
#endif
}
```

```cpp
#include <hip/hip_runtime.h>
#include <hip/hip_cooperative_groups.h>
#include <cstdio>
#include <cstdint>
namespace cg = cooperative_groups;

#ifndef MEGA
#define MEGA 1
#endif

#define LAS __attribute__((address_space(3)))
typedef unsigned short bf16_t;
typedef __bf16 bf16x2_t __attribute__((ext_vector_type(2)));
typedef short bf16x8 __attribute__((ext_vector_type(8)));
typedef float f32x4 __attribute__((ext_vector_type(4)));
typedef float f32x16 __attribute__((ext_vector_type(16)));
typedef unsigned u32x4 __attribute__((ext_vector_type(4)));
typedef unsigned u32x2 __attribute__((ext_vector_type(2)));

constexpr int DM = 1024;
constexpr int TP = 32768, TS = 128, TT = TP + TS, MT = 33024;
constexpr int NBT = 24;
constexpr int N1 = 4608;
constexpr int NG = 2048;
constexpr int NE = 16384;
constexpr int INC = 6416;
constexpr float EPS = 1e-6f;
constexpr int NWAVES = 8, NTHREADS = 512;
constexpr int LDS_BYTES = 150528;

enum { IN_XP = 0, IN_XS, IN_CP, IN_CS, IN_SSD, IN_SSDCONV, IN_LRU, IN_LRUCONV, IN_LN1, IN_LN2, IN_WMOD, IN_BMOD, IN_WIN, IN_SCW, IN_SCB, IN_DTB,
       IN_ALOG, IN_SSDD, IN_SNW, IN_LCW, IN_LCB, IN_WA, IN_BA, IN_WX, IN_BX, IN_LAM, IN_WBS, IN_WBL, IN_WO, IN_WQ, IN_K1, IN_K2, IN_U, IN_V, IN_FNW, N_IN };

constexpr size_t O_Y = 0, O_PSSD = 33685504, O_PSCONV = 35782656, O_PLRU = 35905536, O_PLCONV = 35938304,
                 O_SSSD = 36036608, O_SSCONV = 37085184, O_SLRU = 37146624, O_SLCONV = 37163008, O_END = 37212160;

constexpr size_t al256(size_t x) { return (x + 255) & ~(size_t)255; }
constexpr size_t WS_CTL = 0;
constexpr size_t WS_LRUW = 131072;
constexpr size_t WS_MOD = 1u << 20;
constexpr size_t WS_DT = al256(WS_MOD + (size_t)2 * NBT * 6144 * 4);
constexpr size_t WS_SSQ = al256(WS_DT + (size_t)MT * 16 * 4);
constexpr size_t WS_W1T = al256(WS_SSQ + (size_t)MT * 16 * 4);
constexpr size_t WS_WGT = al256(WS_W1T + (size_t)2 * N1 * DM * 2);
constexpr size_t WS_WBS = al256(WS_WGT + (size_t)2 * NG * DM * 2);
constexpr size_t WS_WBL = al256(WS_WBS + (size_t)2 * DM * DM * 2);
constexpr size_t WS_WO = al256(WS_WBL + (size_t)2 * DM * DM * 2);
constexpr size_t WS_WC = al256(WS_WO + (size_t)2 * DM * DM * 2);
constexpr size_t WS_U16 = al256(WS_WC + (size_t)2 * 2048 * DM * 2);
constexpr size_t WS_V16 = al256(WS_U16 + (size_t)NE * DM * 2);
constexpr size_t WS_EI = al256(WS_V16 + (size_t)NE * DM * 2);
constexpr size_t WS_GW = al256(WS_EI + (size_t)MT * 128 * 4);
constexpr size_t WS_B0 = al256(WS_GW + (size_t)MT * 128 * 4);
constexpr size_t WS_B1 = al256(WS_B0 + (size_t)MT * DM * 2);
constexpr size_t WS_B2 = al256(WS_B1 + (size_t)MT * DM * 2);
constexpr size_t WS_B3 = al256(WS_B2 + (size_t)MT * 1280 * 2);
constexpr size_t WS_B4 = al256(WS_B3 + (size_t)MT * DM * 2);
constexpr size_t WS_END = al256(WS_B4 + (size_t)MT * DM * 2);
constexpr size_t WS_GS = WS_B2, WS_GL = WS_B2 + (size_t)MT * DM * 2;
constexpr size_t WS_SC = WS_B1;
static_assert(WS_GL + (size_t)MT * DM * 2 <= WS_B4, "gate overlay");
static_assert(WS_SC + (size_t)MT * 2048 * 4 <= WS_END, "score overlay");
static_assert(WS_END <= (size_t)512 << 20, "d_ws budget");

struct Params {
    const float* in[N_IN];
    float* out;
    unsigned char* ws;
    int ph_lo, ph_hi;
};

__device__ __forceinline__ unsigned f2bf(float f) { return (unsigned)__builtin_bit_cast(unsigned short, (__bf16)f); }
__device__ __forceinline__ float bf2f(unsigned b) { return __uint_as_float(b << 16); }
__device__ __forceinline__ unsigned pk2(float lo, float hi) { typedef float f32x2_ __attribute__((ext_vector_type(2))); return __builtin_bit_cast(unsigned, __builtin_convertvector((f32x2_){lo, hi}, bf16x2_t)); }
__device__ __forceinline__ float bflo(unsigned w) { return __uint_as_float(w << 16); }
__device__ __forceinline__ float bfhi(unsigned w) { return __uint_as_float(w & 0xffff0000u); }
template <int M> __device__ __forceinline__ int shfx_i(int v, int lane) {
    if constexpr (M == 32) { auto r = __builtin_amdgcn_permlane32_swap((unsigned)v, (unsigned)v, false, false); return (int)((lane & 32) ? r[0] : r[1]); }
    else return __builtin_amdgcn_ds_swizzle(v, 0x1f | (M << 10));
}
template <int M> __device__ __forceinline__ float shfx(float v, int lane) { return __int_as_float(shfx_i<M>(__float_as_int(v), lane)); }
__device__ __forceinline__ float shfl_f(float v, int src) { return __int_as_float(__builtin_amdgcn_ds_bpermute(src << 2, __float_as_int(v))); }
__device__ __forceinline__ int shfl_i(int v, int src) { return __builtin_amdgcn_ds_bpermute(src << 2, v); }
template <int CTRL> __device__ __forceinline__ float dppf_(float v) { return __int_as_float(__builtin_amdgcn_update_dpp(0, __float_as_int(v), CTRL, 0xf, 0xf, true)); }
__device__ __forceinline__ float row8_sum(float v) { v += dppf_<0xB1>(v); v += dppf_<0x4E>(v); v += dppf_<0x141>(v); return v; }
__device__ __forceinline__ float wave_sum(float v) {
    v += dppf_<0xB1>(v); v += dppf_<0x4E>(v); v += dppf_<0x141>(v); v += dppf_<0x140>(v);
    { auto r = __builtin_amdgcn_permlane16_swap(__float_as_uint(v), __float_as_uint(v), false, false); v = __uint_as_float(r[0]) + __uint_as_float(r[1]); }
    { auto r = __builtin_amdgcn_permlane32_swap(__float_as_uint(v), __float_as_uint(v), false, false); v = __uint_as_float(r[0]) + __uint_as_float(r[1]); }
    return v;
}
__device__ __forceinline__ float exp_fast(float x) { return __builtin_amdgcn_exp2f(x * 1.4426950408889634f); }
__device__ __forceinline__ float sigmoidf_(float x) { return __builtin_amdgcn_rcpf(1.0f + exp_fast(-x)); }
__device__ __forceinline__ float siluf_(float x) { return x * __builtin_amdgcn_rcpf(1.0f + exp_fast(-x)); }
__device__ __forceinline__ float geluf_(float x) { const float u = 1.5957691216057308f * (x + 0.044715f * x * x * x); return x * __builtin_amdgcn_rcpf(1.0f + exp_fast(-u)); }
__device__ __forceinline__ float softplusf_(float x) { const float e = exp_fast(-fabsf(x));
    const float l = __builtin_amdgcn_logf(1.0f + e) * 0.6931471805599453f, s = e * (1.0f + e * (-0.5f + e * 0.33333333f)); return fmaxf(x, 0.f) + (e < 0.02f ? s : l); }
__device__ __forceinline__ int row_batch(int row) { return row < TP ? (row >> 11) : (row < TT ? 16 + ((row - TP) >> 4) : 23); }
__device__ __forceinline__ float dot2bf(unsigned a, unsigned b, float acc) { return __builtin_amdgcn_fdot2_f32_bf16(__builtin_bit_cast(bf16x2_t, a), __builtin_bit_cast(bf16x2_t, b), acc, false); }
__device__ __forceinline__ float rl(float v, int lane) { return __int_as_float(__builtin_amdgcn_readlane(__float_as_int(v), lane)); }
#define LDS_WAIT() asm volatile("s_waitcnt lgkmcnt(0)" ::: "memory")
#define MFMA32(a, b, c) __builtin_amdgcn_mfma_f32_32x32x16_bf16((a), (b), (c), 0, 0, 0)

typedef const __attribute__((address_space(4))) Params CParams;
template <class T> __device__ __forceinline__ T* as_global(T* p) { __attribute__((address_space(1))) T* g = (__attribute__((address_space(1))) T*)p; asm volatile("" : "+s"(g)); return (T*)g; }
struct Ctx {
    CParams* P; LAS unsigned char* lds; unsigned char* ws; float* out;
    int tid, lane, wave, bid, G;
};
#define WSP(T, off) (as_global((T*)(C.ws + (off))))

__device__ __forceinline__ void tr_item(const float* W, int ldw, int src_col0, int valid, const float* kscale, int k0, bf16_t* dst, LAS float* scr, int lane) {
    const int c4 = lane & 7, r0 = lane >> 3;
    f32x4 v[8];
#pragma unroll
    for (int i = 0; i < 8; ++i) { const int kk = r0 + 8 * i; v[i] = (4 * c4 < valid) ? *(const f32x4*)(W + (size_t)(k0 + kk) * ldw + src_col0 + 4 * c4) : (f32x4){0.f, 0.f, 0.f, 0.f}; }
#pragma unroll
    for (int i = 0; i < 8; ++i) { const int kk = r0 + 8 * i; const float ks = kscale ? kscale[k0 + kk] : 1.0f; LAS float* s = scr + kk * 33 + 4 * c4;
        s[0] = v[i][0] * ks; s[1] = v[i][1] * ks; s[2] = v[i][2] * ks; s[3] = v[i][3] * ks; }
    LDS_WAIT();
    const int c8 = lane & 7;
#pragma unroll
    for (int j = 0; j < 4; ++j) { const int n = (lane >> 3) + 8 * j; const LAS float* s = scr + (8 * c8) * 33 + n;
        u32x4 o; o.x = pk2(s[0 * 33], s[1 * 33]); o.y = pk2(s[2 * 33], s[3 * 33]); o.z = pk2(s[4 * 33], s[5 * 33]); o.w = pk2(s[6 * 33], s[7 * 33]);
        *(u32x4*)(dst + (size_t)n * DM + k0 + 8 * c8) = o; }
    LDS_WAIT();
}
typedef float f32x2 __attribute__((ext_vector_type(2)));
typedef short s16x4_ __attribute__((ext_vector_type(4)));
constexpr size_t WS_U8 = WS_U16, WS_SU = WS_U16 + ((size_t)16 << 20), WS_V8 = WS_V16, WS_SV = WS_V16 + ((size_t)16 << 20);
__device__ __forceinline__ float wave_max(float v) {
    v = fmaxf(v, shfx<1>(v, 0)); v = fmaxf(v, shfx<2>(v, 0)); v = fmaxf(v, shfx<4>(v, 0)); v = fmaxf(v, shfx<8>(v, 0)); v = fmaxf(v, shfx<16>(v, 0));
    auto r = __builtin_amdgcn_permlane32_swap(__float_as_uint(v), __float_as_uint(v), false, false);
    return fmaxf(__uint_as_float(r[0]), __uint_as_float(r[1]));
}
__device__ __forceinline__ void convert_row(const Ctx& C, int it, const f32x4 (&v)[4]) {
    const int lane = C.lane; const bool isv = it >= NE; const int e = isv ? it - NE : it;
    unsigned char* dst = C.ws + (isv ? WS_V8 : WS_U8); float* sc = (float*)(C.ws + (isv ? WS_SV : WS_SU));
    float m = 0.f;
#pragma unroll
    for (int j = 0; j < 4; ++j) m = fmaxf(m, fmaxf(fmaxf(fabsf(v[j][0]), fabsf(v[j][1])), fmaxf(fabsf(v[j][2]), fabsf(v[j][3]))));
    m = wave_max(m);
    const float scale = m > 0.f ? m * (1.0f / 440.0f) : 1.0f, inv = 1.0f / scale;
    if (lane == 0) sc[e] = scale;
#pragma unroll
    for (int j = 0; j < 4; ++j) { int w = __builtin_amdgcn_cvt_pk_fp8_f32(v[j][0] * inv, v[j][1] * inv, 0, false); w = __builtin_amdgcn_cvt_pk_fp8_f32(v[j][2] * inv, v[j][3] * inv, w, true);
        const int slice = 2 * j + (lane >> 5);
        *(int*)(dst + ((size_t)slice * NE + e) * 128 + (lane & 31) * 4) = w; }
}
__device__ __forceinline__ void phase_prep(const Ctx& C) {
    CParams& P = *C.P;
    {
        LAS float* Kh = (LAS float*)C.lds;
        LAS float* Wq = (LAS float*)(C.lds + 128 * 132 * 4);
        bf16_t* WcT = WSP(bf16_t, WS_WC);
        for (int it = C.bid; it < 512; it += C.G) {
            const int l = it >> 8, h = (it >> 5) & 7, half = (it >> 4) & 1, jb = it & 15;
            const float* ksrc = as_global(P.in[half ? IN_K2 : IN_K1]) + (size_t)l * 128 * 128;
            const float* wsrc = as_global(P.in[IN_WQ]) + (size_t)l * DM * 2048 + (size_t)(jb * 64) * 2048 + h * 256 + half * 128;
            __syncthreads();
            for (int i = C.tid; i < 128 * 32; i += NTHREADS) { const int r = i >> 5, c4 = i & 31; *(LAS f32x4*)(Kh + r * 132 + c4 * 4) = *(const f32x4*)(ksrc + r * 128 + c4 * 4); }
            for (int i = C.tid; i < 64 * 32; i += NTHREADS) { const int r = i >> 5, c4 = i & 31; *(LAS f32x4*)(Wq + r * 132 + c4 * 4) = *(const f32x4*)(wsrc + (size_t)r * 2048 + c4 * 4); }
            __syncthreads();
            const int tk = C.tid & 31, tj = C.tid >> 5;
            float acc[4][4];
#pragma unroll
            for (int a = 0; a < 4; ++a)
#pragma unroll
                for (int b = 0; b < 4; ++b) acc[a][b] = 0.f;
            for (int d4 = 0; d4 < 32; ++d4) {
                f32x4 kv[4], wv[4];
#pragma unroll
                for (int a = 0; a < 4; ++a) { kv[a] = *(LAS f32x4*)(Kh + (tk + 32 * a) * 132 + d4 * 4); wv[a] = *(LAS f32x4*)(Wq + (4 * tj + a) * 132 + d4 * 4); }
#pragma unroll
                for (int a = 0; a < 4; ++a)
#pragma unroll
                    for (int b = 0; b < 4; ++b) acc[a][b] += kv[a][0] * wv[b][0] + kv[a][1] * wv[b][1] + kv[a][2] * wv[b][2] + kv[a][3] * wv[b][3];
            }
            __syncthreads();
            LAS unsigned char* ot = (LAS unsigned char*)Kh;
#pragma unroll
            for (int a = 0; a < 4; ++a) *(LAS u32x2*)(ot + (tk + 32 * a) * 144 + 8 * tj) = (u32x2){pk2(acc[a][0], acc[a][1]), pk2(acc[a][2], acc[a][3])};
            __syncthreads();
            for (int i = C.tid; i < 1024; i += NTHREADS) { const int n = i >> 3, ck = i & 7;
                *(u32x4*)(WcT + ((size_t)l * 2048 + h * 256 + half * 128 + n) * DM + jb * 64 + ck * 8) = *(const LAS u32x4*)(ot + n * 144 + ck * 16); }
        }
        __syncthreads();
    }
    {
        LAS float* sc = (LAS float*)C.lds;
        LAS float* red = (LAS float*)(C.lds + 98304);
        for (int i = C.tid; i < NBT * DM; i += NTHREADS) { const int bb = i >> 10, k = i & 1023;
            const float cv = bb < 16 ? as_global(P.in[IN_CP])[bb * DM + k] : as_global(P.in[IN_CS])[(bb - 16) * DM + k]; sc[i] = siluf_(cv); }
        __syncthreads();
        float* MOD = WSP(float, WS_MOD);
        for (int it = C.bid; it < 192; it += C.G) {
            const int l = it / 96, cg_ = it % 96, j = cg_ * 64 + C.lane;
            const float* wm = as_global(P.in[IN_WMOD]) + (size_t)l * DM * 6144 + j;
            float acc[NBT];
#pragma unroll
            for (int bb = 0; bb < NBT; ++bb) acc[bb] = 0.f;
            const int k0 = C.wave * 128;
#pragma unroll 16
            for (int k = 0; k < 128; ++k) { const float w = wm[(size_t)(k0 + k) * 6144];
#pragma unroll
                for (int bb = 0; bb < NBT; ++bb) acc[bb] += sc[bb * DM + k0 + k] * w; }
#pragma unroll
            for (int bb = 0; bb < NBT; ++bb) red[(C.wave * NBT + bb) * 64 + C.lane] = acc[bb];
            __syncthreads();
            const float bm = as_global(P.in[IN_BMOD])[l * 6144 + j];
#pragma unroll
            for (int q = 0; q < 3; ++q) { const int bb = 3 * C.wave + q; float a = bm;
#pragma unroll
                for (int w8 = 0; w8 < 8; ++w8) a += red[(w8 * NBT + bb) * 64 + C.lane];
                MOD[((size_t)l * NBT + bb) * 6144 + j] = a; }
            __syncthreads();
        }
        __syncthreads();
    }
    {
        LAS float* scr = (LAS float*)(C.lds + C.wave * 16384);
        const int gw = C.bid * NWAVES + C.wave, NGW = C.G * NWAVES;
        constexpr int I_W1 = 144 * 16, I_WG = 64 * 16, I_SQ = 32 * 16, PER_L = I_W1 + I_WG + 3 * I_SQ;
        for (int it = gw; it < 2 * PER_L; it += NGW) {
            const int l = it / PER_L; int r = it % PER_L;
            if (r < I_W1) { const int nb = r >> 4, kb = r & 15, n0 = nb * 32; int src, valid;
                if (n0 < 2304) { src = n0; valid = 32; } else if (n0 < 4352) { src = n0 + 16; valid = 32; } else if (n0 == 4352) { src = 2304; valid = 16; } else { src = 0; valid = 0; }
                tr_item(as_global(P.in[IN_WIN]) + (size_t)l * DM * INC, INC, src, valid, nullptr, kb * 64, WSP(bf16_t, WS_W1T) + ((size_t)l * N1 + n0) * DM, scr, C.lane); continue; }
            r -= I_W1;
            if (r < I_WG) { const int nb = r >> 4, kb = r & 15, n0 = nb * 32;
                tr_item(as_global(P.in[IN_WIN]) + (size_t)l * DM * INC, INC, 4368 + n0, 32, nullptr, kb * 64, WSP(bf16_t, WS_WGT) + ((size_t)l * NG + n0) * DM, scr, C.lane); continue; }
            r -= I_WG;
            const int which = r / I_SQ; r %= I_SQ; const int nb = r >> 4, kb = r & 15, n0 = nb * 32;
            const float* src = as_global(P.in[which == 0 ? IN_WBS : (which == 1 ? IN_WBL : IN_WO)]) + (size_t)l * DM * DM;
            bf16_t* dst = WSP(bf16_t, which == 0 ? WS_WBS : (which == 1 ? WS_WBL : WS_WO)) + ((size_t)l * DM + n0) * DM;
            tr_item(src, DM, n0, 32, which == 0 ? as_global(P.in[IN_SNW]) + l * DM : nullptr, kb * 64, dst, scr, C.lane);
        }
    }
    {
        bf16_t* LW = (bf16_t*)(C.ws + WS_LRUW);
        const float* wap = as_global(P.in[IN_WA]); const float* wxp = as_global(P.in[IN_WX]);
        for (int i = C.bid * NTHREADS + C.tid; i < 2 * 16 * 2 * 4096; i += C.G * NTHREADS) {
            const int d = i & 63, e = (i >> 6) & 63, gate = (i >> 12) & 1, lj = i >> 13;
            LW[i] = (bf16_t)f2bf((gate ? wxp : wap)[(size_t)lj * 4096 + d * 64 + e]);
        }
    }
}

__device__ __forceinline__ void phase_norm(const Ctx& C, int l, int which) {
    CParams& P = *C.P;
    const int gw = C.bid * NWAVES + C.wave, NGW = C.G * NWAVES;
    bf16_t* H = WSP(bf16_t, WS_B0);
    const float* lw = as_global(P.in[which ? IN_LN2 : IN_LN1]) + l * DM;
    const float* MOD = WSP(float, WS_MOD);
    const float* xpp = as_global(P.in[IN_XP]); const float* xsp = as_global(P.in[IN_XS]);
#define NORM_SRC(row_) ((which == 0 && l == 0) ? ((row_) < TP ? xpp + (size_t)(row_) * DM : xsp + (size_t)((row_) - TP) * DM) : C.out + (size_t)(row_) * DM)
    const int c0 = 8 * C.lane;
    f32x4 lwv[4];
#pragma unroll
    for (int j = 0; j < 4; ++j) lwv[j] = *(const f32x4*)(lw + (j >> 1) * 512 + c0 + (j & 1) * 4);
    f32x4 nv[4];
    { const float* xr = NORM_SRC(min(gw, TT - 1)) + c0;
#pragma unroll
      for (int j = 0; j < 4; ++j) nv[j] = *(const f32x4*)(xr + (j >> 1) * 512 + (j & 1) * 4); }
    for (int row = gw; row < TT; row += NGW) {
        f32x4 v[4]; float s = 0.f;
#pragma unroll
        for (int j = 0; j < 4; ++j) { v[j] = nv[j]; s += (v[j][0] * v[j][0] + v[j][1] * v[j][1]) + (v[j][2] * v[j][2] + v[j][3] * v[j][3]); }
        { const float* xr = NORM_SRC(min(row + NGW, TT - 1)) + c0;
#pragma unroll
          for (int j = 0; j < 4; ++j) nv[j] = *(const f32x4*)(xr + (j >> 1) * 512 + (j & 1) * 4); }
        const float rstd = rsqrtf(wave_sum(s) * (1.f / DM) + EPS);
        const float* md = MOD + ((size_t)l * NBT + row_batch(row)) * 6144 + (which ? 3072 : 0) + c0;
        f32x4 y[4];
#pragma unroll
        for (int j = 0; j < 4; ++j) { const int co = (j >> 1) * 512 + (j & 1) * 4;
            const f32x4 sh = *(const f32x4*)(md + co), scv = *(const f32x4*)(md + 1024 + co);
            y[j] = (v[j] * rstd * lwv[j]) * (scv + 1.0f) + sh; }
        bf16_t* hp = H + (size_t)row * DM + c0;
        *(u32x4*)hp = (u32x4){pk2(y[0][0], y[0][1]), pk2(y[0][2], y[0][3]), pk2(y[1][0], y[1][1]), pk2(y[1][2], y[1][3])};
        *(u32x4*)(hp + 512) = (u32x4){pk2(y[2][0], y[2][1]), pk2(y[2][2], y[2][3]), pk2(y[3][0], y[3][1]), pk2(y[3][2], y[3][3])};
    }
#undef NORM_SRC
}

struct Epi1 {
    static constexpr bool TILE = false;
    __device__ __forceinline__ bool idem() const { return true; }
    static constexpr int NK = 5; static constexpr bool PERM = true;
    bf16_t *Z, *XBC, *LX, *LY; float* DT; const float* dtb;
    __device__ __forceinline__ int kind(int pn) const { return pn < 4 ? 0 : (pn < 9 ? 1 : (pn < 13 ? 2 : (pn < 17 ? 3 : 4))); }
    template <int KD> __device__ __forceinline__ void apply(int, int row, int col, f32x4 v) const {
        if constexpr (KD == 0) { *(u32x2*)(Z + (size_t)row * DM + col) = (u32x2){pk2(siluf_(v[0]), siluf_(v[1])), pk2(siluf_(v[2]), siluf_(v[3]))}; }
        else if constexpr (KD == 1) { *(u32x2*)(XBC + (size_t)row * 1280 + (col - 1024)) = (u32x2){pk2(v[0], v[1]), pk2(v[2], v[3])}; }
        else if constexpr (KD == 2) { *(u32x2*)(LX + (size_t)row * DM + (col - 2304)) = (u32x2){pk2(v[0], v[1]), pk2(v[2], v[3])}; }
        else if constexpr (KD == 3) { *(u32x2*)(LY + (size_t)row * DM + (col - 3328)) = (u32x2){pk2(geluf_(v[0]), geluf_(v[1])), pk2(geluf_(v[2]), geluf_(v[3]))}; }
        else { if (col < 4368) { const int c = col - 4352; const f32x4 b = *(const f32x4*)(dtb + c);
            *(f32x4*)(DT + (size_t)row * 16 + c) = (f32x4){softplusf_(v[0] + b[0]), softplusf_(v[1] + b[1]), softplusf_(v[2] + b[2]), softplusf_(v[3] + b[3])}; } }
    }
    template <int KD> static constexpr bool swap_kind() { return KD < 4; }
    template <int KD> __device__ __forceinline__ u32x4 pack8(f32x4 a, f32x4 b) const {
        if constexpr (KD == 0) return (u32x4){pk2(siluf_(a[0]), siluf_(a[1])), pk2(siluf_(a[2]), siluf_(a[3])), pk2(siluf_(b[0]), siluf_(b[1])), pk2(siluf_(b[2]), siluf_(b[3]))};
        else if constexpr (KD == 3) return (u32x4){pk2(geluf_(a[0]), geluf_(a[1])), pk2(geluf_(a[2]), geluf_(a[3])), pk2(geluf_(b[0]), geluf_(b[1])), pk2(geluf_(b[2]), geluf_(b[3]))};
        else return (u32x4){pk2(a[0], a[1]), pk2(a[2], a[3]), pk2(b[0], b[1]), pk2(b[2], b[3])};
    }
    template <int KD> __device__ __forceinline__ void store8(int row, int col, u32x4 v) const {
        if constexpr (KD == 0) *(u32x4*)(Z + (size_t)row * DM + col) = v;
        else if constexpr (KD == 1) *(u32x4*)(XBC + (size_t)row * 1280 + (col - 1024)) = v;
        else if constexpr (KD == 2) *(u32x4*)(LX + (size_t)row * DM + (col - 2304)) = v;
        else *(u32x4*)(LY + (size_t)row * DM + (col - 3328)) = v;
    }
    template <int KD> __device__ __forceinline__ void apply8(int w, int row, int col, f32x4 a, f32x4 b) const {
        if constexpr (KD == 0) { *(u32x4*)(Z + (size_t)row * DM + col) = (u32x4){pk2(siluf_(a[0]), siluf_(a[1])), pk2(siluf_(a[2]), siluf_(a[3])), pk2(siluf_(b[0]), siluf_(b[1])), pk2(siluf_(b[2]), siluf_(b[3]))}; }
        else if constexpr (KD == 1) { *(u32x4*)(XBC + (size_t)row * 1280 + (col - 1024)) = (u32x4){pk2(a[0], a[1]), pk2(a[2], a[3]), pk2(b[0], b[1]), pk2(b[2], b[3])}; }
        else if constexpr (KD == 2) { *(u32x4*)(LX + (size_t)row * DM + (col - 2304)) = (u32x4){pk2(a[0], a[1]), pk2(a[2], a[3]), pk2(b[0], b[1]), pk2(b[2], b[3])}; }
        else if constexpr (KD == 3) { *(u32x4*)(LY + (size_t)row * DM + (col - 3328)) = (u32x4){pk2(geluf_(a[0]), geluf_(a[1])), pk2(geluf_(a[2]), geluf_(a[3])), pk2(geluf_(b[0]), geluf_(b[1])), pk2(geluf_(b[2]), geluf_(b[3]))}; }
        else { apply<KD>(w, row, col, a); apply<KD>(w, row, col + 4, b); }
    }
};
struct Epi2 {
    static constexpr bool TILE = false;
    __device__ __forceinline__ bool idem() const { return true; }
    static constexpr int NK = 2; static constexpr bool PERM = true;
    bf16_t *GS, *GL;
    __device__ __forceinline__ int kind(int pn) const { return pn < 4 ? 0 : 1; }
    template <int KD> __device__ __forceinline__ void apply(int, int row, int col, f32x4 v) const {
        bf16_t* d = (KD == 0 ? GS + (size_t)row * DM + col : GL + (size_t)row * DM + (col - 1024));
        *(u32x2*)d = (u32x2){pk2(sigmoidf_(v[0]), sigmoidf_(v[1])), pk2(sigmoidf_(v[2]), sigmoidf_(v[3]))};
    }
    template <int KD> static constexpr bool swap_kind() { return true; }
    template <int KD> __device__ __forceinline__ u32x4 pack8(f32x4 a, f32x4 b) const {
        return (u32x4){pk2(sigmoidf_(a[0]), sigmoidf_(a[1])), pk2(sigmoidf_(a[2]), sigmoidf_(a[3])), pk2(sigmoidf_(b[0]), sigmoidf_(b[1])), pk2(sigmoidf_(b[2]), sigmoidf_(b[3]))}; }
    template <int KD> __device__ __forceinline__ void store8(int row, int col, u32x4 v) const { *(u32x4*)(KD == 0 ? GS + (size_t)row * DM + col : GL + (size_t)row * DM + (col - 1024)) = v; }
    template <int KD> __device__ __forceinline__ void apply8(int, int row, int col, f32x4 a, f32x4 b) const {
        bf16_t* d = (KD == 0 ? GS + (size_t)row * DM + col : GL + (size_t)row * DM + (col - 1024));
        *(u32x4*)d = (u32x4){pk2(sigmoidf_(a[0]), sigmoidf_(a[1])), pk2(sigmoidf_(a[2]), sigmoidf_(a[3])), pk2(sigmoidf_(b[0]), sigmoidf_(b[1])), pk2(sigmoidf_(b[2]), sigmoidf_(b[3]))};
    }
};
struct Epi3 {
    static constexpr bool TILE = false;
    __device__ __forceinline__ bool idem() const { return true; }
    static constexpr int NK = 1; static constexpr bool PERM = true;
    template <int KD> static constexpr bool swap_kind() { return false; }
    const bf16_t *GS, *GL; const float* SSQ; bf16_t* MG;
    __device__ __forceinline__ int kind(int) const { return 0; }
    __device__ __forceinline__ float rstd_of(int row) const { const f32x4* q = (const f32x4*)(SSQ + (size_t)row * 16); const f32x4 a = q[0] + q[1] + q[2] + q[3];
        return rsqrtf(((a[0] + a[1]) + (a[2] + a[3])) * (1.f / DM) + EPS); }
    template <int KD> __device__ __forceinline__ void apply(int w, int row, int col, f32x4 v) const {
        u32x2* m = (u32x2*)(MG + (size_t)row * DM + col);
        if (w == 0) { const float rstd = rstd_of(row);
            const u32x2 g = *(const u32x2*)(GS + (size_t)row * DM + col);
            *m = (u32x2){pk2(bflo(g.x) * rstd * v[0], bfhi(g.x) * rstd * v[1]), pk2(bflo(g.y) * rstd * v[2], bfhi(g.y) * rstd * v[3])};
        } else {
            const u32x2 g = *(const u32x2*)(GL + (size_t)row * DM + col); const u32x2 p = *m;
            *m = (u32x2){pk2(bflo(p.x) + bflo(g.x) * v[0], bfhi(p.x) + bfhi(g.x) * v[1]), pk2(bflo(p.y) + bflo(g.y) * v[2], bfhi(p.y) + bfhi(g.y) * v[3])};
        }
    }
    template <int KD> __device__ __forceinline__ void apply8(int w, int row, int col, f32x4 a, f32x4 b) const {
        u32x4* m = (u32x4*)(MG + (size_t)row * DM + col);
        if (w == 0) { const float rstd = rstd_of(row);
            const u32x4 g = *(const u32x4*)(GS + (size_t)row * DM + col);
            *m = (u32x4){pk2(bflo(g.x) * rstd * a[0], bfhi(g.x) * rstd * a[1]), pk2(bflo(g.y) * rstd * a[2], bfhi(g.y) * rstd * a[3]), pk2(bflo(g.z) * rstd * b[0], bfhi(g.z) * rstd * b[1]), pk2(bflo(g.w) * rstd * b[2], bfhi(g.w) * rstd * b[3])};
        } else {
            const u32x4 g = *(const u32x4*)(GL + (size_t)row * DM + col); const u32x4 p = *m;
            *m = (u32x4){pk2(bflo(p.x) + bflo(g.x) * a[0], bfhi(p.x) + bfhi(g.x) * a[1]), pk2(bflo(p.y) + bflo(g.y) * a[2], bfhi(p.y) + bfhi(g.y) * a[3]),
                         pk2(bflo(p.z) + bflo(g.z) * b[0], bfhi(p.z) + bfhi(g.z) * b[1]), pk2(bflo(p.w) + bflo(g.w) * b[2], bfhi(p.w) + bfhi(g.w) * b[3])};
        }
    }
};
struct Epi4 {
    static constexpr bool PERM = true;
    template <int KD> static constexpr bool swap_kind() { return false; }
    __device__ __forceinline__ bool idem() const { return layer == 0; }
    static constexpr int NK = 1;
    const float *xp, *xs; float* XR; const float* MODl; int layer;
    __device__ __forceinline__ int kind(int) const { return 0; }
    template <int KD> __device__ __forceinline__ void apply(int, int row, int col, f32x4 v) const {
        if (row >= TT) return;
        const float* src = layer == 0 ? (row < TP ? xp + (size_t)row * DM : xs + (size_t)(row - TP) * DM) : XR + (size_t)row * DM;
        const f32x4 x = *(const f32x4*)(src + col), g = *(const f32x4*)(MODl + (size_t)row_batch(row) * 6144 + 2048 + col);
        *(f32x4*)(XR + (size_t)row * DM + col) = x + g * v;
    }
    static constexpr bool TILE = true;
    __device__ __forceinline__ void tile(const f32x4 (&acc)[2][2][4][2], int pm, int pn, int wr, int wc, int fr, int fq) const {
        const int colb = pn * 256 + wc * 64 + 8 * fq; const float* gp = MODl + (size_t)(pm >> 3) * 6144 + 2048 + colb;
        const f32x4 g00 = *(const f32x4*)gp, g01 = *(const f32x4*)(gp + 4), g10 = *(const f32x4*)(gp + 32), g11 = *(const f32x4*)(gp + 36);
        const float* sb = (layer == 0 ? xp : XR) + colb; float* db = XR + colb;
#pragma unroll
        for (int ai = 0; ai < 2; ++ai)
#pragma unroll
            for (int m = 0; m < 4; ++m) { const size_t ro = (size_t)(pm * 256 + ai * 128 + wr * 64 + m * 16 + fr) * DM;
                const f32x4 x00 = *(const f32x4*)(sb + ro), x01 = *(const f32x4*)(sb + ro + 4), x10 = *(const f32x4*)(sb + ro + 32), x11 = *(const f32x4*)(sb + ro + 36);
                *(f32x4*)(db + ro) = x00 + g00 * acc[ai][0][m][0]; *(f32x4*)(db + ro + 4) = x01 + g01 * acc[ai][0][m][1];
                *(f32x4*)(db + ro + 32) = x10 + g10 * acc[ai][1][m][0]; *(f32x4*)(db + ro + 36) = x11 + g11 * acc[ai][1][m][1]; }
    }
    template <int KD> __device__ __forceinline__ void apply8(int, int row, int col, f32x4 a, f32x4 b) const {
        const float* src = (layer == 0 ? xp : XR) + (size_t)row * DM + col; const float* gp = MODl + (size_t)(row >> 11) * 6144 + 2048 + col;
        const f32x4 x0 = *(const f32x4*)src, x1 = *(const f32x4*)(src + 4), g0 = *(const f32x4*)gp, g1 = *(const f32x4*)(gp + 4);
        float* d = XR + (size_t)row * DM + col; *(f32x4*)d = x0 + g0 * a; *(f32x4*)(d + 4) = x1 + g1 * b;
    }
};
struct Epi5 {
    static constexpr bool TILE = false;
    static constexpr bool PERM = true;
    __device__ __forceinline__ bool idem() const { return true; }
    static constexpr int NK = 1;
    bf16_t* SC;
    __device__ __forceinline__ int kind(int) const { return 0; }
    template <int KD> __device__ __forceinline__ void apply(int, int row, int col, f32x4 v) const { *(u32x2*)(SC + (size_t)row * 2048 + col) = (u32x2){pk2(v[0], v[1]), pk2(v[2], v[3])}; }
    template <int KD> static constexpr bool swap_kind() { return true; }
    template <int KD> __device__ __forceinline__ u32x4 pack8(f32x4 a, f32x4 b) const { return (u32x4){pk2(a[0], a[1]), pk2(a[2], a[3]), pk2(b[0], b[1]), pk2(b[2], b[3])}; }
    template <int KD> __device__ __forceinline__ void store8(int row, int col, u32x4 v) const { *(u32x4*)(SC + (size_t)row * 2048 + col) = v; }
    template <int KD> __device__ __forceinline__ void apply8(int, int row, int col, f32x4 a, f32x4 b) const { *(u32x4*)(SC + (size_t)row * 2048 + col) = (u32x4){pk2(a[0], a[1]), pk2(a[2], a[3]), pk2(b[0], b[1]), pk2(b[2], b[3])}; }
};

namespace pg8 {
constexpr int BM = 256, BK = 64, HALF = 128, HTB = HALF * BK * 2, STAGE_BYTES = 8 * HTB, NXCD = 8, WGM = 8;
__host__ __device__ __forceinline__ int lds_byte(int r, int c) { const int st = (r >> 4) * 2 + (c >> 5), rr = r & 15, cc = c & 31, ob = rr * 64 + cc * 2; return st * 1024 + (ob ^ (((ob >> 9) & 1) << 5)); }
__host__ __device__ __forceinline__ void stage_rc(int b, int& R, int& C) { const int st = b / 1024, sb = b % 1024, swz = sb ^ (((sb >> 9) & 1) << 5); R = (st >> 1) * 16 + swz / 64; C = (st & 1) * 32 + (swz % 64) / 2; }
struct Unit { int pm, pn, w; };
struct Sched {
    int nM, nN, nW, nwg, G, c; const char *A0, *B0, *A1, *B1;
    __device__ __forceinline__ bool next(int i, Unit& u) const {
        const int ti = i / nW; u.w = i - ti * nW;
        const long L = (long)ti * G + c; if (L >= nwg) return false;
        int wgid = (int)L; { const int q = nwg / NXCD, r = nwg % NXCD, xcd = wgid % NXCD, off = wgid / NXCD; wgid = (xcd < r ? xcd * (q + 1) : r * (q + 1) + (xcd - r) * q) + off; }
        const int nig = WGM * nN, gid = wgid / nig, fm = gid * WGM, gsz = (nM - fm) < WGM ? (nM - fm) : WGM;
        u.pm = fm + ((wgid % nig) % gsz); u.pn = (wgid % nig) / gsz; return true;
    }
};
__host__ __device__ __forceinline__ int perm32(int rho) { const int n = rho >> 4, i = rho & 15; return 8 * (i >> 2) + 4 * n + (i & 3); }
template <int KD, class Epi>
__device__ __forceinline__ void epi_tile(const Epi& E, const f32x4 (&acc)[2][2][4][2], const Unit& u, int wr, int wc, int fr, int fq) {
    if constexpr (Epi::PERM && Epi::template swap_kind<KD>()) {
        const bool lo = fr < 8; const int colx = u.pn * BM + wc * 64 + (lo ? 0 : 32) + 8 * fq;
#pragma unroll
        for (int ai = 0; ai < 2; ++ai)
#pragma unroll
            for (int m = 0; m < 4; ++m) { const int rowb = u.pm * BM + ai * HALF + wr * 64 + m * 16 + (fr & 7);
                const u32x4 p0 = E.template pack8<KD>(acc[ai][0][m][0], acc[ai][0][m][1]), p1 = E.template pack8<KD>(acc[ai][1][m][0], acc[ai][1][m][1]);
                u32x4 rcv, sa, sb;
#pragma unroll
                for (int q = 0; q < 4; ++q) { const unsigned snd = lo ? p1[q] : p0[q]; rcv[q] = (unsigned)__builtin_amdgcn_update_dpp(0, (int)snd, 0x128, 0xf, 0xf, true);
                    sa[q] = lo ? p0[q] : rcv[q]; sb[q] = lo ? rcv[q] : p1[q]; }
                E.template store8<KD>(rowb, colx, sa); E.template store8<KD>(rowb + 8, colx, sb); }
    } else {
#pragma unroll
    for (int ai = 0; ai < 2; ++ai)
#pragma unroll
        for (int m = 0; m < 4; ++m) { const int row = u.pm * BM + ai * HALF + wr * 64 + m * 16 + fr;
#pragma unroll
            for (int bj = 0; bj < 2; ++bj) {
                if constexpr (Epi::PERM) E.template apply8<KD>(u.w, row, u.pn * BM + wc * 64 + bj * 32 + 8 * fq, acc[ai][bj][m][0], acc[ai][bj][m][1]);
                else {
#pragma unroll
                    for (int n = 0; n < 2; ++n) E.template apply<KD>(u.w, row, u.pn * BM + bj * HALF + wc * 32 + n * 16 + 4 * fq, acc[ai][bj][m][n]); } } }
    }
}
template <class Epi>
__device__ __forceinline__ void epi_apply(const Epi& E, const f32x4 (&acc)[2][2][4][2], const Unit& u, int wr, int wc, int fr, int fq) {
    if constexpr (Epi::TILE) E.tile(acc, u.pm, u.pn, wr, wc, fr, fq);
    else if constexpr (Epi::NK == 1) epi_tile<0>(E, acc, u, wr, wc, fr, fq);
    else { const int kd = E.kind(u.pn);
        if (kd == 0) epi_tile<0>(E, acc, u, wr, wc, fr, fq);
        else if (kd == 1) epi_tile<1>(E, acc, u, wr, wc, fr, fq);
        else if constexpr (Epi::NK > 2) { if (kd == 2) epi_tile<2>(E, acc, u, wr, wc, fr, fq); else if (kd == 3) epi_tile<3>(E, acc, u, wr, wc, fr, fq); else epi_tile<4>(E, acc, u, wr, wc, fr, fq); } }
}
template <class Epi, bool ALIGN_EPI = true, bool SP2 = true>
__device__ __forceinline__ void gemm_phase(LAS unsigned char* lds, int tid, int K, const Sched& S, const Epi& E, bool dry = false) {
    const int wid = __builtin_amdgcn_readfirstlane(tid >> 6), lane = tid & 63, wr = wid >> 2, wc = wid & 3, fr = lane & 15, fq = lane >> 4;
    const int nt = K / BK;
    unsigned voffA[2], voffB[2];
#pragma unroll
    for (int i = 0; i < 2; ++i) { int R, Cc; stage_rc(tid * 16 + i * 8192, R, Cc); const int Rb = Epi::PERM ? (64 * (R >> 5) + perm32(R & 31)) : R;
        voffA[i] = (unsigned)(R * K + Cc) * 2u; voffB[i] = (unsigned)(Rb * K + Cc) * 2u; }
    const size_t kstep = (size_t)(BK * 2);
    const size_t hstep = (size_t)HALF * K * 2;
    const size_t tstep = 2 * hstep;
    const size_t hstepB = Epi::PERM ? (size_t)32 * K * 2 : hstep;
    const unsigned ldsw = (unsigned)wid * 1024u;
    const int aoff = lds_byte(wr * 64 + fr, fq * 8), boff = lds_byte(wc * 32 + fr, fq * 8);
#define PG8_SA(b, h) (((b) * 2 + (h)) * HTB)
#define PG8_SB(b, h) ((4 + (b) * 2 + (h)) * HTB)
#define PG8_STAGE(bufoff, gbase, voff) do { _Pragma("unroll") for (int _i = 0; _i < 2; ++_i) \
        __builtin_amdgcn_global_load_lds((const unsigned*)((const char*)(gbase) + (voff)[_i]), (LAS unsigned*)(lds + (bufoff) + ldsw + _i * 8192), 16, 0, 0); } while (0)
#define PG8_LDA(dst, b, h) do { _Pragma("unroll") for (int m = 0; m < 4; ++m) _Pragma("unroll") for (int k = 0; k < 2; ++k) dst[m][k] = *(const LAS bf16x8*)(lds + PG8_SA(b, h) + aoff + m * 2048 + k * 1024); } while (0)
#define PG8_LDB(dst, b, h) do { _Pragma("unroll") for (int n = 0; n < 2; ++n) _Pragma("unroll") for (int k = 0; k < 2; ++k) dst[n][k] = *(const LAS bf16x8*)(lds + PG8_SB(b, h) + boff + n * 2048 + k * 1024); } while (0)
#define PG8_MMA(ai, bj, At, Bt) do { __builtin_amdgcn_s_setprio(1); _Pragma("unroll") for (int m = 0; m < 4; ++m) _Pragma("unroll") for (int n = 0; n < 2; ++n) _Pragma("unroll") for (int k = 0; k < 2; ++k) \
        acc[ai][bj][m][n] = __builtin_amdgcn_mfma_f32_16x16x32_bf16(Bt[n][k], At[m][k], acc[ai][bj][m][n], 0, 0, 0); __builtin_amdgcn_s_setprio(0); } while (0)
#define PG8_WAIT_V(n) asm volatile("s_waitcnt vmcnt(" #n ")" ::: "memory")
#define PG8_WAIT_L(n) asm volatile("s_waitcnt lgkmcnt(" #n ")" ::: "memory")
#define PG8_BAR __builtin_amdgcn_s_barrier()
#define PG8_SCHED __builtin_amdgcn_sched_barrier(0)
    Unit cur, nxt; int ui = 0;
    if (!S.next(0, cur)) return;
    f32x4 acc[2][2][4][2];
#pragma unroll
    for (int a = 0; a < 2; ++a)
#pragma unroll
        for (int b = 0; b < 2; ++b)
#pragma unroll
            for (int m = 0; m < 4; ++m)
#pragma unroll
                for (int n = 0; n < 2; ++n) acc[a][b][m][n] = (f32x4){0.f, 0.f, 0.f, 0.f};
    bf16x8 At[4][2], B0[2][2], B1[2][2];
    const char* cA = (cur.w ? S.A1 : S.A0) + (size_t)cur.pm * tstep; const char* cB = (cur.w ? S.B1 : S.B0) + (size_t)cur.pn * tstep;
    if constexpr (SP2) {
        PG8_STAGE(PG8_SB(0, 0), cB, voffB); PG8_STAGE(PG8_SB(0, 1), cB + hstepB, voffB); PG8_STAGE(PG8_SA(0, 0), cA, voffA); PG8_STAGE(PG8_SA(0, 1), cA + hstep, voffA);
        if (wr == 1) PG8_BAR;
        PG8_WAIT_V(2); PG8_BAR;
        PG8_STAGE(PG8_SB(1, 0), cB + kstep, voffB); PG8_STAGE(PG8_SA(1, 0), cA + kstep, voffA); PG8_STAGE(PG8_SB(1, 1), cB + hstepB + kstep, voffB);
        PG8_WAIT_V(6); PG8_BAR;
    } else {
        PG8_STAGE(PG8_SB(0, 0), cB, voffB); PG8_STAGE(PG8_SA(0, 0), cA, voffA); PG8_STAGE(PG8_SB(0, 1), cB + hstepB, voffB); PG8_STAGE(PG8_SA(0, 1), cA + hstep, voffA);
        if (wr == 1) PG8_BAR;
        PG8_WAIT_V(4); PG8_BAR;
        PG8_STAGE(PG8_SB(1, 0), cB + kstep, voffB); PG8_STAGE(PG8_SA(1, 0), cA + kstep, voffA); PG8_STAGE(PG8_SB(1, 1), cB + hstepB + kstep, voffB);
        PG8_WAIT_V(6); PG8_BAR;
    }
    for (;;) {
        const bool has_next = S.next(ui + 1, nxt);
        const char* nA = has_next ? (nxt.w ? S.A1 : S.A0) + (size_t)nxt.pm * tstep : cA; const char* nB = has_next ? (nxt.w ? S.B1 : S.B0) + (size_t)nxt.pn * tstep : cB;
        for (int t = 0; t < nt; t += 2) {
            const bool last = (t == nt - 2);
            const char* a1 = cA + (size_t)(t + 1) * kstep;
            const char* a2 = last ? nA : cA + (size_t)(t + 2) * kstep; const char* b2 = last ? nB : cB + (size_t)(t + 2) * kstep;
            const char* a3 = a2 + kstep; const char* b3 = b2 + kstep;
            if constexpr (SP2) {
            PG8_LDB(B0, 0, 0); PG8_LDB(B1, 0, 1); PG8_SCHED; PG8_LDA(At, 0, 0); PG8_STAGE(PG8_SA(1, 1), a1 + hstep, voffA);
            PG8_WAIT_V(8); PG8_WAIT_L(0); PG8_BAR; PG8_MMA(0, 0, At, B0); PG8_MMA(0, 1, At, B1); PG8_BAR; PG8_SCHED;
            PG8_LDA(At, 0, 1); PG8_STAGE(PG8_SB(0, 0), b2, voffB); PG8_STAGE(PG8_SB(0, 1), b2 + hstepB, voffB); PG8_STAGE(PG8_SA(0, 0), a2, voffA);
            PG8_WAIT_V(8); PG8_WAIT_L(0); PG8_BAR; PG8_MMA(1, 0, At, B0); PG8_MMA(1, 1, At, B1); PG8_BAR; PG8_SCHED;
            PG8_LDB(B0, 1, 0); PG8_LDB(B1, 1, 1); PG8_SCHED; PG8_LDA(At, 1, 0); PG8_STAGE(PG8_SA(0, 1), a2 + hstep, voffA);
            PG8_WAIT_V(8); PG8_WAIT_L(0); PG8_BAR; PG8_MMA(0, 0, At, B0); PG8_MMA(0, 1, At, B1); PG8_BAR; PG8_SCHED;
            PG8_LDA(At, 1, 1); PG8_STAGE(PG8_SB(1, 0), b3, voffB); PG8_STAGE(PG8_SB(1, 1), b3 + hstepB, voffB); PG8_STAGE(PG8_SA(1, 0), a3, voffA);
            PG8_WAIT_V(8); PG8_WAIT_L(0); PG8_BAR; PG8_MMA(1, 0, At, B0); PG8_MMA(1, 1, At, B1); PG8_BAR; PG8_SCHED;
            } else {
            PG8_LDB(B0, 0, 0); PG8_SCHED; PG8_LDA(At, 0, 0); PG8_STAGE(PG8_SA(1, 1), a1 + hstep, voffA);
            PG8_WAIT_L(8); PG8_BAR; PG8_WAIT_L(0); PG8_MMA(0, 0, At, B0); PG8_BAR; PG8_SCHED;
            PG8_LDB(B1, 0, 1); PG8_STAGE(PG8_SB(0, 0), b2, voffB);
            PG8_BAR; PG8_WAIT_L(0); PG8_MMA(0, 1, At, B1); PG8_BAR;
            PG8_LDA(At, 0, 1); PG8_STAGE(PG8_SA(0, 0), a2, voffA);
            PG8_BAR; PG8_WAIT_L(0); PG8_MMA(1, 0, At, B0); PG8_BAR; PG8_SCHED;
            PG8_STAGE(PG8_SB(0, 1), b2 + hstepB, voffB);
            PG8_WAIT_V(6); PG8_BAR; PG8_MMA(1, 1, At, B1); PG8_BAR;
            PG8_LDB(B0, 1, 0); PG8_SCHED; PG8_LDA(At, 1, 0); PG8_STAGE(PG8_SA(0, 1), a2 + hstep, voffA);
            PG8_WAIT_L(8); PG8_BAR; PG8_WAIT_L(0); PG8_MMA(0, 0, At, B0); PG8_BAR; PG8_SCHED;
            PG8_LDB(B1, 1, 1); PG8_STAGE(PG8_SB(1, 0), b3, voffB);
            PG8_BAR; PG8_WAIT_L(0); PG8_MMA(0, 1, At, B1); PG8_BAR;
            PG8_LDA(At, 1, 1); PG8_STAGE(PG8_SA(1, 0), a3, voffA);
            PG8_BAR; PG8_WAIT_L(0); PG8_MMA(1, 0, At, B0); PG8_BAR; PG8_SCHED;
            PG8_STAGE(PG8_SB(1, 1), b3 + hstepB, voffB);
            PG8_WAIT_V(6); PG8_BAR; PG8_MMA(1, 1, At, B1); PG8_BAR;
            }
        }
        if constexpr (ALIGN_EPI) { if (wr == 0) PG8_BAR; }
#ifdef PROBE_K
        if (dry) {
#pragma unroll
            for (int a = 0; a < 2; ++a)
#pragma unroll
                for (int b = 0; b < 2; ++b)
#pragma unroll
                    for (int m = 0; m < 4; ++m)
#pragma unroll
                        for (int n = 0; n < 2; ++n) asm volatile("" :: "v"(acc[a][b][m][n]));
        } else
#endif
        epi_apply(E, acc, cur, wr, wc, fr, fq);
        if (!has_next) break;
#pragma unroll
        for (int a = 0; a < 2; ++a)
#pragma unroll
            for (int b = 0; b < 2; ++b)
#pragma unroll
                for (int m = 0; m < 4; ++m)
#pragma unroll
                    for (int n = 0; n < 2; ++n) acc[a][b][m][n] = (f32x4){0.f, 0.f, 0.f, 0.f};
        cur = nxt; cA = nA; cB = nB; ++ui;
        if constexpr (ALIGN_EPI) { if (wr == 1) PG8_BAR; }
    }
    PG8_WAIT_V(0);
    if constexpr (!ALIGN_EPI) { if (wr == 0) PG8_BAR; }
    PG8_BAR;
#undef PG8_SA
#undef PG8_SB
#undef PG8_STAGE
#undef PG8_LDA
#undef PG8_LDB
#undef PG8_MMA
#undef PG8_WAIT_V
#undef PG8_WAIT_L
#undef PG8_BAR
#undef PG8_SCHED
}
}
template <int KD, class Epi>
__device__ __forceinline__ void sample_tile(const Ctx& C, const bf16_t* A0, const bf16_t* B0, const bf16_t* A1, const bf16_t* B1, int rb, int cb, const Epi& E) {
    const int fr = C.lane & 15, fq = C.lane >> 4;
    for (int w = 0; w < (A1 ? 2 : 1); ++w) {
        const bf16_t* ap = (w ? A1 : A0) + (size_t)(TP + 16 * rb + fr) * DM + 8 * fq; const bf16_t* bp = (w ? B1 : B0) + (size_t)(16 * cb + fr) * DM + 8 * fq;
        f32x4 acc = (f32x4){0.f, 0.f, 0.f, 0.f};
#pragma unroll 16
        for (int ks = 0; ks < DM / 32; ++ks) { const bf16x8 a = *(const bf16x8*)(ap + 32 * ks), b = *(const bf16x8*)(bp + 32 * ks); acc = __builtin_amdgcn_mfma_f32_16x16x32_bf16(b, a, acc, 0, 0, 0); }
        E.template apply<KD>(w, TP + 16 * rb + fr, 16 * cb + 4 * fq, acc);
    }
}
template <class Epi>
__device__ __forceinline__ void gemm_sample(const Ctx& C, const bf16_t* A0, const bf16_t* B0, const bf16_t* A1, const bf16_t* B1, int N, const Epi& E) {
    const int gw = C.bid * NWAVES + C.wave, NGW = C.G * NWAVES, ncb = N / 16;
    for (int it = gw; it < 8 * ncb; it += NGW) {
        const int cb = it >> 3, rb = it & 7; const int kd = E.kind(cb >> 4);
        if constexpr (Epi::NK == 1) sample_tile<0>(C, A0, B0, A1, B1, rb, cb, E);
        else { if (kd == 0) sample_tile<0>(C, A0, B0, A1, B1, rb, cb, E); else if (kd == 1) sample_tile<1>(C, A0, B0, A1, B1, rb, cb, E);
            else if constexpr (Epi::NK > 2) { if (kd == 2) sample_tile<2>(C, A0, B0, A1, B1, rb, cb, E); else if (kd == 3) sample_tile<3>(C, A0, B0, A1, B1, rb, cb, E); else sample_tile<4>(C, A0, B0, A1, B1, rb, cb, E); } }
    }
}
template <class Epi>
__device__ __forceinline__ void gemm_run(const Ctx& C, const bf16_t* A0, const bf16_t* B0, const bf16_t* A1, const bf16_t* B1, int N, const Epi& E, bool dry = false) {
#if defined(PROBE_DRYEPI) || defined(PROBE_DRYSAMPLE)
    if (!dry)
#endif
    gemm_sample(C, A0, B0, A1, B1, N, E);
    pg8::Sched S; S.nM = TP / 256; S.nN = N / 256; S.nW = A1 ? 2 : 1; S.nwg = S.nM * S.nN; S.G = C.G; S.c = C.bid;
    S.A0 = (const char*)A0; S.B0 = (const char*)B0; S.A1 = (const char*)A1; S.B1 = (const char*)B1;
#ifdef PROBE_DRYEPI
    pg8::gemm_phase<Epi>(C.lds, C.tid, DM, S, E, dry);
#else
    pg8::gemm_phase<Epi>(C.lds, C.tid, DM, S, E);
#endif
    __syncthreads();
}

__device__ __forceinline__ unsigned cvt_pk_bf16(float lo, float hi) { unsigned r; asm volatile("v_cvt_pk_bf16_f32 %0, %1, %2" : "=v"(r) : "v"(lo), "v"(hi)); return r; }
__device__ __forceinline__ bf16x8 pack_acc(const f32x16& a, int t) {
    u32x4 w;
    if (t == 0) { w.x = cvt_pk_bf16(a[0], a[1]); w.y = cvt_pk_bf16(a[2], a[3]); w.z = cvt_pk_bf16(a[4], a[5]); w.w = cvt_pk_bf16(a[6], a[7]); }
    else { w.x = cvt_pk_bf16(a[8], a[9]); w.y = cvt_pk_bf16(a[10], a[11]); w.z = cvt_pk_bf16(a[12], a[13]); w.w = cvt_pk_bf16(a[14], a[15]); }
    return __builtin_bit_cast(bf16x8, w);
}
__device__ __forceinline__ int sig_pos(int s) { return (s & ~15) | (((s >> 2) & 1) << 3) | (((s >> 3) & 1) << 2) | (s & 3); }
constexpr int SROW = 144;

template <int WSTR>
__device__ __forceinline__ void conv8(const u32x4 (&rw)[4], const LAS float* wl, float (&v)[8]) {
    f32x4 w[5][2];
#pragma unroll
    for (int k = 0; k < 5; ++k) { w[k][0] = *(const LAS f32x4*)(wl + k * WSTR); w[k][1] = *(const LAS f32x4*)(wl + k * WSTR + 4); }
#pragma unroll
    for (int e = 0; e < 8; ++e) { const int dw = e >> 1; const bool hi = e & 1;
        float x[4];
#pragma unroll
        for (int k = 0; k < 4; ++k) { const unsigned q = dw == 0 ? rw[k].x : (dw == 1 ? rw[k].y : (dw == 2 ? rw[k].z : rw[k].w)); x[k] = hi ? bfhi(q) : bflo(q); }
        v[e] = w[4][e >> 2][e & 3] + w[0][e >> 2][e & 3] * x[0] + w[1][e >> 2][e & 3] * x[1] + w[2][e >> 2][e & 3] * x[2] + w[3][e >> 2][e & 3] * x[3]; }
}
constexpr size_t WS_CBC = WS_EI;
__device__ __forceinline__ void phase_convbc(const Ctx& C, int l) {
    CParams& P = *C.P;
    const bf16_t* XBC = WSP(bf16_t, WS_B2); bf16_t* CBC = WSP(bf16_t, WS_CBC);
    const float* cw = as_global(P.in[IN_SCW]) + (size_t)l * 4 * 1280 + 1024; const float* cbp = as_global(P.in[IN_SCB]) + (size_t)l * 1280 + 1024;
    const float* cst = as_global(P.in[IN_SSDCONV]) + (size_t)l * 8 * 3 * 1280;
    const int items = TT * 32, stride = C.G * NTHREADS;
    for (int it = C.bid * NTHREADS + C.tid; it < items; it += stride) {
        const int tok = it >> 5, cg = it & 31, ch = cg * 8;
        const bool smp = tok >= TP; const int b = smp ? (tok - TP) >> 4 : tok >> 11, t = smp ? (tok - TP) & 15 : tok & 2047, L = smp ? 16 : 2048, NB = smp ? 8 : 16;
        u32x4 rw[4];
#pragma unroll
        for (int k = 0; k < 4; ++k) { const int tr = t - 3 + k;
            if (tr >= 0) rw[k] = *(const u32x4*)(XBC + (size_t)(tok - t + tr) * 1280 + 1024 + ch);
            else if (smp) { const float* s0 = cst + ((size_t)b * 3 + (tr + 3)) * 1280 + 1024 + ch; const f32x4 a0 = *(const f32x4*)s0, a1 = *(const f32x4*)(s0 + 4);
                rw[k] = (u32x4){pk2(a0[0], a0[1]), pk2(a0[2], a0[3]), pk2(a1[0], a1[1]), pk2(a1[2], a1[3])}; }
            else rw[k] = (u32x4){0u, 0u, 0u, 0u}; }
        f32x4 w[5][2];
#pragma unroll
        for (int k = 0; k < 4; ++k) { w[k][0] = *(const f32x4*)(cw + k * 1280 + ch); w[k][1] = *(const f32x4*)(cw + k * 1280 + ch + 4); }
        w[4][0] = *(const f32x4*)(cbp + ch); w[4][1] = *(const f32x4*)(cbp + ch + 4);
        float v[8];
#pragma unroll
        for (int e = 0; e < 8; ++e) { const int dw = e >> 1; const bool hi = e & 1; float x[4];
#pragma unroll
            for (int k = 0; k < 4; ++k) { const unsigned q = dw == 0 ? rw[k].x : (dw == 1 ? rw[k].y : (dw == 2 ? rw[k].z : rw[k].w)); x[k] = hi ? bfhi(q) : bflo(q); }
            v[e] = siluf_(w[4][e >> 2][e & 3] + w[0][e >> 2][e & 3] * x[0] + w[1][e >> 2][e & 3] * x[1] + w[2][e >> 2][e & 3] * x[2] + w[3][e >> 2][e & 3] * x[3]); }
        *(u32x4*)(CBC + (size_t)tok * 256 + ch) = (u32x4){pk2(v[0], v[1]), pk2(v[2], v[3]), pk2(v[4], v[5]), pk2(v[6], v[7])};
        if (t >= L - 3) { float* co = C.out + (smp ? O_SSCONV : O_PSCONV) + ((size_t)(l * NB + b) * 3 + (t - (L - 3))) * 1280 + 1024 + ch; const u32x4 q = rw[3];
            *(f32x4*)co = (f32x4){bflo(q.x), bfhi(q.x), bflo(q.y), bfhi(q.y)}; *(f32x4*)(co + 4) = (f32x4){bflo(q.z), bfhi(q.z), bflo(q.w), bfhi(q.w)}; }
    }
}

#ifndef SCAN_SKIP
#define SCAN_SKIP 0
#endif
__device__ __forceinline__ void scan_item_fused(const Ctx& C, int l, int idx, bool dry) {
    const int skip = dry ? SCAN_SKIP : 0;
    CParams& P = *C.P; const int tid = C.tid, lane = C.lane, wave = C.wave;
    const bool smp = idx >= 256; const int ii = smp ? idx - 256 : idx; const int b = ii >> 4, head = ii & 15, g = head >> 3, j = head;
    const int tok0 = smp ? TP + b * 16 : b * 2048, L = smp ? 16 : 2048, NB = smp ? 8 : 16, nchunk = smp ? 1 : 32;
    const bf16_t* XBC = WSP(bf16_t, WS_B2); const bf16_t* CBC = WSP(bf16_t, WS_CBC); bf16_t* Z = WSP(bf16_t, WS_B1); const float* DT = WSP(float, WS_DT); float* SSQ = WSP(float, WS_SSQ);
    const float a_h = -__expf(as_global(P.in[IN_ALOG])[l * 16 + head]), Dh = as_global(P.in[IN_SSDD])[l * 16 + head];
    LAS unsigned char* bmR = C.lds; LAS unsigned char* cmR = C.lds + 9216; LAS unsigned char* xsR = C.lds + 18432; LAS unsigned char* bwR = C.lds + 30720;
    LAS float* ybuf = (LAS float*)(C.lds + 43008);
    LAS float* acum = (LAS float*)(C.lds + 59392); LAS float* dtv = acum + 64; LAS float* eac = acum + 128; LAS float* wsc = acum + 192; LAS float* misc = acum + 256; LAS float* cwl = acum + 320;
    const int t = tid >> 3, cg = tid & 7;
    const int chx = head * 64 + cg * 8, chb = 1024 + g * 64 + cg * 8, chc = 1152 + g * 64 + cg * 8;
    const float* scw = as_global(P.in[IN_SCW]) + (size_t)l * 4 * 1280; const float* scb = as_global(P.in[IN_SCB]) + (size_t)l * 1280;
    const float* scst = smp ? as_global(P.in[IN_SSDCONV]) + (size_t)(l * 8 + b) * 3 * 1280 : nullptr;
    const int qb = (wave >> 1) & 1, pb = wave & 1, r = lane & 31, hh = lane >> 5;
    f32x16 hacc[2];
#pragma unroll
    for (int nb = 0; nb < 2; ++nb)
#pragma unroll
        for (int i = 0; i < 16; ++i) hacc[nb][i] = 0.f;
    if (smp && wave < 4) {
        const float* hs = as_global(P.in[IN_SSD]) + ((size_t)((l * 8 + b) * 16 + head) * 64 + 32 * pb + r) * 64;
#pragma unroll
        for (int nb = 0; nb < 2; ++nb)
#pragma unroll
            for (int i4 = 0; i4 < 4; ++i4) { const f32x4 v = *(const f32x4*)(hs + 32 * nb + 8 * i4 + 4 * hh); hacc[nb][4 * i4] = v[0]; hacc[nb][4 * i4 + 1] = v[1]; hacc[nb][4 * i4 + 2] = v[2]; hacc[nb][4 * i4 + 3] = v[3]; }
    }
    const bf16_t* LX = WSP(bf16_t, WS_B3); bf16_t* LY = WSP(bf16_t, WS_B4);
    LAS unsigned char* LB = C.lds + 65536;
    LAS unsigned char* xcB = LB; LAS unsigned char* waT = LB + 9216; LAS unsigned char* wxT = LB + 18432;
    LAS float* xcF = (LAS float*)(LB + 27648); LAS float* aF = (LAS float*)(LB + 44032); LAS float* uF = (LAS float*)(LB + 60416); LAS float* lcwl = (LAS float*)(LB + 76800);
    const int ch0 = j * 64 + cg * 8;
    const float* lcw = as_global(P.in[IN_LCW]) + (size_t)l * 4 * DM; const float* lcb = as_global(P.in[IN_LCB]) + (size_t)l * DM;
    const float* lcst = smp ? as_global(P.in[IN_LRUCONV]) + (size_t)(l * 8 + b) * 3 * DM : nullptr;
    const int tb = qb, eb = pb, ech = j * 64 + 32 * eb + r;
    const float ba = as_global(P.in[IN_BA])[l * DM + ech], bxx = as_global(P.in[IN_BX])[l * DM + ech], sp8 = -8.0f * softplusf_(-as_global(P.in[IN_LAM])[l * DM + ech]);
    float hstate = (smp && wave == 4) ? as_global(P.in[IN_LRU])[(size_t)(l * 8 + b) * DM + j * 64 + lane] : 0.f;
    __syncthreads();
    for (int i = tid; i < 5 * 192; i += NTHREADS) { const int k = i / 192, cc = i % 192; const int ch = cc < 64 ? head * 64 + cc : (cc < 128 ? 1024 + g * 64 + (cc - 64) : 1152 + g * 64 + (cc - 128));
        cwl[i] = k < 4 ? scw[k * 1280 + ch] : scb[ch]; }
    { const u32x4* lw = (const u32x4*)(WSP(bf16_t, WS_LRUW) + (size_t)(l * 16 + j) * 8192);
      for (int i = tid; i < 1024; i += NTHREADS) { const int gate = i >> 9, e = (i >> 3) & 63, ck = i & 7; *(LAS u32x4*)((gate ? wxT : waT) + e * SROW + ck * 16) = lw[i]; } }
    for (int i = tid; i < 5 * 64; i += NTHREADS) { const int k = i >> 6, cc = i & 63; lcwl[i] = k < 4 ? lcw[k * DM + j * 64 + cc] : lcb[j * 64 + cc]; }
    u32x4 rw[4], bcv, ccv, lrw[4], zs, lyv; float dtl = 0.f;
#define RAWROW(dst, base, ld, ch, cstp, tr) { if ((tr) >= 0) dst = ((tr) < L) ? *(const u32x4*)((base) + (size_t)(tok0 + (tr)) * (ld) + (ch)) : (u32x4){0u, 0u, 0u, 0u}; \
        else if (smp) { const float* s0_ = (cstp) + (size_t)((tr) + 3) * (ld) + (ch); const f32x4 a0_ = *(const f32x4*)s0_, a1_ = *(const f32x4*)(s0_ + 4); \
            dst = (u32x4){pk2(a0_[0], a0_[1]), pk2(a0_[2], a0_[3]), pk2(a1_[0], a1_[1]), pk2(a1_[2], a1_[3])}; } else dst = (u32x4){0u, 0u, 0u, 0u}; }
#define SSD_LOAD(c_) { const int tg_ = (c_) * 64 + t; _Pragma("unroll") for (int k = 0; k < 4; ++k) { RAWROW(rw[k], XBC, 1280, chx, scst, tg_ - 3 + k) } \
        const bool v_ = tg_ < L; bcv = v_ ? *(const u32x4*)(CBC + (size_t)(tok0 + tg_) * 256 + g * 64 + cg * 8) : (u32x4){0u, 0u, 0u, 0u}; ccv = v_ ? *(const u32x4*)(CBC + (size_t)(tok0 + tg_) * 256 + 128 + g * 64 + cg * 8) : (u32x4){0u, 0u, 0u, 0u}; \
        }
#define LRU_LOAD(c_) { const int tg_ = (c_) * 64 + t; _Pragma("unroll") for (int k = 0; k < 4; ++k) { RAWROW(lrw[k], LX, DM, ch0, lcst, tg_ - 3 + k) } }
#define TAIL_LOAD(c_) { const int tg_ = (c_) * 64 + t; const bool v_ = tg_ < L; zs = v_ ? *(const u32x4*)(Z + (size_t)(tok0 + tg_) * DM + chx) : (u32x4){0u, 0u, 0u, 0u}; lyv = v_ ? *(const u32x4*)(LY + (size_t)(tok0 + tg_) * DM + ch0) : (u32x4){0u, 0u, 0u, 0u}; }
    SSD_LOAD(0) LRU_LOAD(0) TAIL_LOAD(0)
    if (wave == 0) dtl = (lane < L) ? DT[(size_t)(tok0 + lane) * 16 + head] : 0.f;
    __syncthreads();
    for (int c = 0; c < nchunk; ++c) {
        int lt_ = tid; asm volatile("" : "+v"(lt_));
        const int t = lt_ >> 3, cg = lt_ & 7, lane = lt_ & 63, r = lane & 31, hh = lane >> 5;
        const int chx = head * 64 + cg * 8, chb = 1024 + g * 64 + cg * 8, chc = 1152 + g * 64 + cg * 8, ch0 = j * 64 + cg * 8;
        const int tg = c * 64 + t; const bool valid = tg < L;
        if (wave == 0 && !(skip & 128)) {
            float cs = dtl * a_h;
            { float o = shfl_f(cs, lane - 1); if (lane >= 1) cs += o; o = shfl_f(cs, lane - 2); if (lane >= 2) cs += o; o = shfl_f(cs, lane - 4); if (lane >= 4) cs += o;
              o = shfl_f(cs, lane - 8); if (lane >= 8) cs += o; o = shfl_f(cs, lane - 16); if (lane >= 16) cs += o; o = shfl_f(cs, lane - 32); if (lane >= 32) cs += o; }
            const float tot = shfl_f(cs, 63);
            acum[lane] = cs; dtv[lane] = dtl; eac[lane] = __expf(cs); wsc[lane] = __expf(tot - cs) * dtl; if (lane == 0) misc[0] = __expf(tot);
        }
        if (!(skip & 32)) {
            float v[8]; conv8<64>(lrw, lcwl + cg * 8, v);
            *(LAS u32x4*)(xcB + t * SROW + cg * 16) = (u32x4){pk2(v[0], v[1]), pk2(v[2], v[3]), pk2(v[4], v[5]), pk2(v[6], v[7])};
            *(LAS f32x4*)(xcF + t * 64 + cg * 8) = (f32x4){v[0], v[1], v[2], v[3]}; *(LAS f32x4*)(xcF + t * 64 + cg * 8 + 4) = (f32x4){v[4], v[5], v[6], v[7]};
            if (!dry && valid && tg >= L - 3) { float* co = C.out + (smp ? O_SLCONV : O_PLCONV) + ((size_t)(l * NB + b) * 3 + (tg - (L - 3))) * DM + ch0; const u32x4 q = lrw[3];
                *(f32x4*)co = (f32x4){bflo(q.x), bfhi(q.x), bflo(q.y), bfhi(q.y)}; *(f32x4*)(co + 4) = (f32x4){bflo(q.z), bfhi(q.z), bflo(q.w), bfhi(q.w)}; }
        }
        LRU_LOAD(c + 1)
        if (!(skip & 256)) __syncthreads();
        if (!(skip & 16)) {
            const float wsl = wsc[t];
            { float v[8]; conv8<192>(rw, cwl + cg * 8, v);
#pragma unroll
              for (int e = 0; e < 8; ++e) v[e] = valid ? siluf_(v[e]) : 0.f;
              if (!(skip & 1)) *(LAS u32x4*)(xsR + t * 192 + cg * 16) = (u32x4){pk2(v[0], v[1]), pk2(v[2], v[3]), pk2(v[4], v[5]), pk2(v[6], v[7])}; }
            *(LAS u32x4*)(bmR + t * SROW + cg * 16) = bcv;
            *(LAS u32x4*)(cmR + t * SROW + cg * 16) = ccv;
            if (!(skip & 1)) *(LAS u32x4*)(bwR + t * 192 + cg * 16) = (u32x4){pk2(bflo(bcv.x) * wsl, bfhi(bcv.x) * wsl), pk2(bflo(bcv.y) * wsl, bfhi(bcv.y) * wsl), pk2(bflo(bcv.z) * wsl, bfhi(bcv.z) * wsl), pk2(bflo(bcv.w) * wsl, bfhi(bcv.w) * wsl)};
            if (!dry && valid && tg >= L - 3) { float* co = C.out + (smp ? O_SSCONV : O_PSCONV) + ((size_t)(l * NB + b) * 3 + (tg - (L - 3))) * 1280 + chx; const u32x4 q = rw[3];
                *(f32x4*)co = (f32x4){bflo(q.x), bfhi(q.x), bflo(q.y), bfhi(q.y)}; *(f32x4*)(co + 4) = (f32x4){bflo(q.z), bfhi(q.z), bflo(q.w), bfhi(q.w)}; }
        }
        asm volatile("" ::: "memory");
        SSD_LOAD(c + 1)
        if (wave == 0) { const int tq_ = (c + 1) * 64 + lane; dtl = (tq_ < L) ? DT[(size_t)(tok0 + tq_) * 16 + head] : 0.f; }
        if (wave >= 4 && !(skip & 2)) {
            f32x16 ra, ia;
#pragma unroll
            for (int i = 0; i < 16; ++i) { ra[i] = 0.f; ia[i] = 0.f; }
#pragma unroll
            for (int ks = 0; ks < 4; ++ks) { const bf16x8 A = *(const LAS bf16x8*)(xcB + (32 * tb + r) * SROW + (16 * ks + 8 * hh) * 2);
                const bf16x8 Ba = *(const LAS bf16x8*)(waT + (32 * eb + r) * SROW + (16 * ks + 8 * hh) * 2), Bx = *(const LAS bf16x8*)(wxT + (32 * eb + r) * SROW + (16 * ks + 8 * hh) * 2);
                ra = MFMA32(A, Ba, ra); ia = MFMA32(A, Bx, ia); }
#pragma unroll
            for (int i = 0; i < 16; ++i) { const int tt = 32 * tb + (i & 3) + 8 * (i >> 2) + 4 * hh, e = 32 * eb + r;
                const float rg = sigmoidf_(ra[i] + ba), ig = sigmoidf_(ia[i] + bxx), log_a = rg * sp8, av = exp_fast(log_a);
                const float u = __builtin_amdgcn_sqrtf(fmaxf(1.0f - av * av, 0.f)) * (ig * xcF[tt * 64 + e]);
                aF[tt * 64 + e] = av; uF[tt * 64 + e] = u; }
        }
        if (!(skip & 256)) __syncthreads();
        if (wave < 4 && !(skip & 4)) {
            const int tri = lane & 15, trg = (lane >> 4) & 1;
            const int troff = (tri >> 2) * 192 + (16 * trg + 4 * (tri & 3)) * 2;
#define TRFRAG(tile, row0, rowstep, col0) ({ const LAS unsigned char* a_ = (tile) + (row0) * 192 + (col0) * 2 + troff; \
                const s16x4_ lo_ = __builtin_amdgcn_ds_read_tr16_b64_v4i16((LAS s16x4_*)a_), hi_ = __builtin_amdgcn_ds_read_tr16_b64_v4i16((LAS s16x4_*)(a_ + (rowstep) * 192)); \
                (bf16x8){lo_[0], lo_[1], lo_[2], lo_[3], hi_[0], hi_[1], hi_[2], hi_[3]}; })
            f32x16 y;
#pragma unroll
            for (int i = 0; i < 16; ++i) y[i] = 0.f;
#pragma unroll
            for (int nb = 0; nb < 2; ++nb)
#pragma unroll
                for (int tt = 0; tt < 2; ++tt) { const LAS unsigned char* ap = cmR + (32 * qb + r) * SROW + (32 * nb + 16 * tt + 4 * hh) * 2;
                    const u32x2 a0 = *(const LAS u32x2*)ap, a1 = *(const LAS u32x2*)(ap + 16);
                    y = MFMA32(__builtin_bit_cast(bf16x8, (u32x4){a0.x, a0.y, a1.x, a1.y}), pack_acc(hacc[nb], tt), y); }
#pragma unroll
            for (int i = 0; i < 16; ++i) y[i] *= eac[32 * qb + (i & 3) + 8 * (i >> 2) + 4 * hh];
            const float aq = acum[32 * qb + r]; const int qg = 32 * qb + r;
            for (int sb = 0; sb <= qb; ++sb) {
                f32x16 cbt;
#pragma unroll
                for (int i = 0; i < 16; ++i) cbt[i] = 0.f;
#pragma unroll
                for (int ks = 0; ks < 4; ++ks) { const bf16x8 A = *(const LAS bf16x8*)(bmR + (32 * sb + r) * SROW + (16 * ks + 8 * hh) * 2), B = *(const LAS bf16x8*)(cmR + (32 * qb + r) * SROW + (16 * ks + 8 * hh) * 2); cbt = MFMA32(A, B, cbt); }
#pragma unroll
                for (int i = 0; i < 16; ++i) { const int sg = 32 * sb + (i & 3) + 8 * (i >> 2) + 4 * hh;
                    float wv = cbt[i] * exp_fast(fminf(aq - acum[sg], 0.f)) * dtv[sg]; wv = sg > qg ? 0.f : wv; wv = sg == qg ? wv + Dh : wv; cbt[i] = wv; }
#pragma unroll
                for (int tt = 0; tt < 2; ++tt) { const bf16x8 B = TRFRAG(xsR, 32 * sb + 16 * tt + 4 * hh, 8, 32 * pb); y = MFMA32(pack_acc(cbt, tt), B, y); }
            }
#pragma unroll
            for (int i = 0; i < 16; ++i) ybuf[(32 * qb + (i & 3) + 8 * (i >> 2) + 4 * hh) * 64 + 32 * pb + r] = y[i];
            const float dec = misc[0];
#pragma unroll
            for (int nb = 0; nb < 2; ++nb) {
#pragma unroll
                for (int i = 0; i < 16; ++i) hacc[nb][i] *= dec;
#pragma unroll
                for (int ks = 0; ks < 4; ++ks) { const bf16x8 A = TRFRAG(bwR, 16 * ks + 8 * hh, 4, 32 * nb), B = TRFRAG(xsR, 16 * ks + 8 * hh, 4, 32 * pb); hacc[nb] = MFMA32(A, B, hacc[nb]); }
            }
#undef TRFRAG
        } else if (wave == 4 && !(skip & 8)) {
            const int nsteps = (L - c * 64) < 64 ? (L - c * 64) : 64;
            for (int s0 = 0; s0 < nsteps; s0 += 8) {
                float av[8], uv[8];
#pragma unroll
                for (int q = 0; q < 8; ++q) { av[q] = aF[(s0 + q) * 64 + lane]; uv[q] = uF[(s0 + q) * 64 + lane]; }
#pragma unroll
                for (int q = 0; q < 8; ++q) { hstate = (s0 + q < nsteps) ? av[q] * hstate + uv[q] : hstate; uF[(s0 + q) * 64 + lane] = hstate; }
            }
        }
        if (!(skip & 256)) __syncthreads();
        if (!(skip & 64)) {
            const f32x4 y0 = *(const LAS f32x4*)(ybuf + t * 64 + cg * 8), y1 = *(const LAS f32x4*)(ybuf + t * 64 + cg * 8 + 4);
            const float o0 = y0[0] * bflo(zs.x), o1 = y0[1] * bfhi(zs.x), o2 = y0[2] * bflo(zs.y), o3 = y0[3] * bfhi(zs.y);
            const float o4 = y1[0] * bflo(zs.z), o5 = y1[1] * bfhi(zs.z), o6 = y1[2] * bflo(zs.w), o7 = y1[3] * bfhi(zs.w);
            float ss = (o0 * o0 + o1 * o1) + (o2 * o2 + o3 * o3) + (o4 * o4 + o5 * o5) + (o6 * o6 + o7 * o7);
            ss = row8_sum(ss);
            const f32x4 h0 = *(const LAS f32x4*)(uF + t * 64 + cg * 8), h1 = *(const LAS f32x4*)(uF + t * 64 + cg * 8 + 4);
            asm volatile("" :: "v"(o0), "v"(o7), "v"(ss), "v"(h0[0]), "v"(h1[3]));
            if (valid && !dry) { *(u32x4*)(Z + (size_t)(tok0 + tg) * DM + chx) = (u32x4){pk2(o0, o1), pk2(o2, o3), pk2(o4, o5), pk2(o6, o7)};
                if (cg == 0) SSQ[(size_t)(tok0 + tg) * 16 + head] = ss;
                *(u32x4*)(LY + (size_t)(tok0 + tg) * DM + ch0) = (u32x4){pk2(h0[0] * bflo(lyv.x), h0[1] * bfhi(lyv.x)), pk2(h0[2] * bflo(lyv.y), h0[3] * bfhi(lyv.y)),
                                                                          pk2(h1[0] * bflo(lyv.z), h1[1] * bfhi(lyv.z)), pk2(h1[2] * bflo(lyv.w), h1[3] * bfhi(lyv.w))}; }
        }
        if (skip & 512) {
#pragma unroll
            for (int k = 0; k < 4; ++k) asm volatile("" :: "v"(rw[k].x), "v"(rw[k].w), "v"(lrw[k].x), "v"(lrw[k].w));
            asm volatile("" :: "v"(bcv.x), "v"(ccv.x), "v"(zs.x), "v"(lyv.x), "v"(dtl)); }
        TAIL_LOAD(c + 1)
    }
#undef RAWROW
#undef SSD_LOAD
#undef LRU_LOAD
#undef TAIL_LOAD
    if (!dry && wave < 4 && qb == 0) {
        float* so = C.out + (smp ? O_SSSD : O_PSSD) + ((size_t)((l * NB + b) * 16 + head) * 64 + 32 * pb + r) * 64;
#pragma unroll
        for (int nb = 0; nb < 2; ++nb)
#pragma unroll
            for (int i4 = 0; i4 < 4; ++i4) *(f32x4*)(so + 32 * nb + 8 * i4 + 4 * hh) = (f32x4){hacc[nb][4 * i4], hacc[nb][4 * i4 + 1], hacc[nb][4 * i4 + 2], hacc[nb][4 * i4 + 3]};
    }
    if (wave == 4 && !dry) C.out[(smp ? O_SLRU : O_PLRU) + (size_t)(l * NB + b) * DM + j * 64 + lane] = hstate;
    __syncthreads();
}

__device__ __forceinline__ void phase_scan(const Ctx& C, int l, bool dry = false) {
    for (int it = C.bid; it < 384; it += C.G) scan_item_fused(C, l, it, dry);
}

__device__ __forceinline__ unsigned mono(float f) { const unsigned u = __float_as_uint(f); return (u & 0x80000000u) ? ~u : (u | 0x80000000u); }
__device__ __forceinline__ float unmono(unsigned k) { const unsigned u = (k & 0x80000000u) ? (k & 0x7fffffffu) : ~k; return __uint_as_float(u); }
template <int CTRL> __device__ __forceinline__ unsigned dpp_u(unsigned v) { return (unsigned)__builtin_amdgcn_update_dpp(0, (int)v, CTRL, 0xf, 0xf, true); }
__device__ __forceinline__ unsigned row_max_u(unsigned m) {
    m = max(m, dpp_u<0xB1>(m)); m = max(m, dpp_u<0x4E>(m)); m = max(m, dpp_u<0x141>(m)); m = max(m, dpp_u<0x140>(m)); return m;
}
__device__ __forceinline__ float row_max_f(float m) {
    m = fmaxf(m, __uint_as_float(dpp_u<0xB1>(__float_as_uint(m)))); m = fmaxf(m, __uint_as_float(dpp_u<0x4E>(__float_as_uint(m))));
    m = fmaxf(m, __uint_as_float(dpp_u<0x141>(__float_as_uint(m)))); m = fmaxf(m, __uint_as_float(dpp_u<0x140>(__float_as_uint(m)))); return m;
}
__device__ __forceinline__ float row_sum_f(float m) {
    m += __uint_as_float(dpp_u<0xB1>(__float_as_uint(m))); m += __uint_as_float(dpp_u<0x4E>(__float_as_uint(m)));
    m += __uint_as_float(dpp_u<0x141>(__float_as_uint(m))); m += __uint_as_float(dpp_u<0x140>(__float_as_uint(m))); return m;
}
#define CE_(a, b) { const unsigned hi_ = max(a, b), lo_ = min(a, b); a = hi_; b = lo_; }
#define KEY8(k, a, b) unsigned k##0 = (mono(a[0]) & ~127u) | (unsigned)(127 - (li * 8 + 0)), k##1 = (mono(a[1]) & ~127u) | (unsigned)(127 - (li * 8 + 1)), k##2 = (mono(a[2]) & ~127u) | (unsigned)(127 - (li * 8 + 2)), \
        k##3 = (mono(a[3]) & ~127u) | (unsigned)(127 - (li * 8 + 3)), k##4 = (mono(b[0]) & ~127u) | (unsigned)(127 - (li * 8 + 4)), k##5 = (mono(b[1]) & ~127u) | (unsigned)(127 - (li * 8 + 5)), \
        k##6 = (mono(b[2]) & ~127u) | (unsigned)(127 - (li * 8 + 6)), k##7 = (mono(b[3]) & ~127u) | (unsigned)(127 - (li * 8 + 7));
#define SORT8(k) CE_(k##0, k##1) CE_(k##2, k##3) CE_(k##4, k##5) CE_(k##6, k##7)  CE_(k##0, k##2) CE_(k##1, k##3) CE_(k##4, k##6) CE_(k##5, k##7)  CE_(k##1, k##2) CE_(k##5, k##6) \
        CE_(k##0, k##4) CE_(k##1, k##5) CE_(k##2, k##6) CE_(k##3, k##7)  CE_(k##2, k##4) CE_(k##3, k##5)  CE_(k##1, k##2) CE_(k##3, k##4) CE_(k##5, k##6)
#define POP8(k, m, c) k##0 = c ? k##1 : k##0; k##1 = c ? k##2 : k##1; k##2 = c ? k##3 : k##2; k##3 = c ? k##4 : k##3; k##4 = c ? k##5 : k##4; k##5 = c ? k##6 : k##5; k##6 = c ? k##7 : k##6; k##7 = c ? 0u : k##7;
__device__ __forceinline__ void top16_row2(const f32x4 a0, const f32x4 b0, const f32x4 a1, const f32x4 b1, int li, unsigned& r0, unsigned& r1) {
    KEY8(x, a0, b0) KEY8(y, a1, b1)
    SORT8(x) SORT8(y)
    unsigned rx = 0u, ry = 0u;
#pragma unroll
    for (int r = 0; r < 16; ++r) {
        const unsigned mx = row_max_u(x0), my = row_max_u(y0); const bool cx = (x0 == mx), cy = (y0 == my);
        POP8(x, mx, cx) POP8(y, my, cy)
        rx = (li == r) ? mx : rx; ry = (li == r) ? my : ry;
    }
    r0 = rx; r1 = ry;
}
#undef KEY8
#undef SORT8
#undef POP8
__device__ __forceinline__ void phase_topk(const Ctx& C, int l) {
    const bf16_t* SC = WSP(bf16_t, WS_SC); unsigned short* EI = WSP(unsigned short, WS_EI); float* GW = WSP(float, WS_GW);
    const int lane = C.lane, li = lane & 15, rowi = lane >> 4;
    LAS float* sv = (LAS float*)(C.lds + 4096 + C.wave * 1024);
    LAS int* si = (LAS int*)(sv + 128);
    LAS unsigned char* tab = (LAS unsigned char*)C.lds;
    if (C.tid < 64) { int c = C.tid, i = 0; for (; i < 16; ++i) { const int cnt = 16 / (i + 1); if (c < cnt) break; c -= cnt; } tab[C.tid] = (unsigned char)(C.tid < 50 ? (i | (c << 4)) : 0); }
    __syncthreads();
    int ica[4], jca[4];
#pragma unroll
    for (int q = 0; q < 4; ++q) { const int tb = tab[4 * li + q]; ica[q] = tb & 15; jca[q] = tb >> 4; }
    const int gw = C.bid * NWAVES + C.wave, NGW = C.G * NWAVES;
    u32x4 nw0, nw1;
    { const bf16_t* base = SC + (size_t)min(gw, TT * 2 - 1) * 1024;
      nw0 = *(const u32x4*)(base + lane * 8); nw1 = *(const u32x4*)(base + 512 + lane * 8); }
    const float* up = as_global(C.P->in[IN_U]) + (size_t)l * NE * DM; const float* vp = as_global(C.P->in[IN_V]) + (size_t)l * NE * DM;
#define TROW(it_) (((it_) >= NE ? vp + (size_t)((it_) - NE) * DM : up + (size_t)(it_) * DM) + lane * 4)
    int tit = gw; f32x4 tv[4];
    { const float* s0 = TROW(min(tit, 2 * NE - 1));
#pragma unroll
      for (int j = 0; j < 4; ++j) tv[j] = *(const f32x4*)(s0 + 256 * j); }
    int nit = 0;
    for (int g4 = gw; g4 < TT * 2; g4 += NGW, ++nit) {
        if (!(nit & 1) && tit < 2 * NE) { convert_row(C, tit, tv); tit += NGW;
            const float* s0 = TROW(min(tit, 2 * NE - 1));
#pragma unroll
            for (int j = 0; j < 4; ++j) tv[j] = *(const f32x4*)(s0 + 256 * j); }
        const int row = g4 >> 1, hd0 = (g4 & 1) * 4;
        const f32x4 a0 = (f32x4){bflo(nw0.x), bfhi(nw0.x), bflo(nw0.y), bfhi(nw0.y)}, b0 = (f32x4){bflo(nw0.z), bfhi(nw0.z), bflo(nw0.w), bfhi(nw0.w)};
        const f32x4 a1 = (f32x4){bflo(nw1.x), bfhi(nw1.x), bflo(nw1.y), bfhi(nw1.y)}, b1 = (f32x4){bflo(nw1.z), bfhi(nw1.z), bflo(nw1.w), bfhi(nw1.w)};
        { const bf16_t* base = SC + (size_t)min(g4 + NGW, TT * 2 - 1) * 1024;
          nw0 = *(const u32x4*)(base + lane * 8); nw1 = *(const u32x4*)(base + 512 + lane * 8); }
        unsigned r0, r1; top16_row2(a0, b0, a1, b1, li, r0, r1);
        sv[lane] = unmono(r0 & ~127u); si[lane] = 127 - (int)(r0 & 127u); sv[64 + lane] = unmono(r1 & ~127u); si[64 + lane] = 127 - (int)(r1 & 127u);
        LDS_WAIT();
        const LAS float* v1 = sv + rowi * 32; const LAS float* v2 = v1 + 16;
        unsigned k[4];
#pragma unroll
        for (int q = 0; q < 4; ++q) { const int c = 4 * li + q; const float sum = v1[ica[q]] + v2[jca[q]]; k[q] = (c < 50) ? ((mono(sum) & ~63u) | (unsigned)(63 - c)) : 0u; }
        CE_(k[0], k[1]) CE_(k[2], k[3]) CE_(k[0], k[2]) CE_(k[1], k[3]) CE_(k[1], k[2])
        unsigned res = 0u;
#pragma unroll
        for (int r = 0; r < 16; ++r) {
            const unsigned m = row_max_u(k[0]); const bool c = (k[0] == m);
            k[0] = c ? k[1] : k[0]; k[1] = c ? k[2] : k[1]; k[2] = c ? k[3] : k[2]; k[3] = c ? 0u : k[3];
            res = (li == r) ? m : res;
        }
        const int csel = 63 - (int)(res & 63u); const int tb = tab[csel];
        const int e1 = (si + rowi * 32)[tb & 15], e2 = (si + rowi * 32 + 16)[tb >> 4];
        const float svv = unmono(res & ~63u);
        const float mx = row_max_f(svv), ex = __expf(svv - mx), den = row_sum_f(ex);
        const size_t o = (size_t)row * 128 + (hd0 + rowi) * 16 + li;
        EI[o] = (unsigned short)(e1 * 128 + e2); GW[o] = ex / den;
        LDS_WAIT();
    }
    for (; tit < 2 * NE; ) { convert_row(C, tit, tv); tit += NGW;
        const float* s0 = TROW(min(tit, 2 * NE - 1));
#pragma unroll
        for (int j = 0; j < 4; ++j) tv[j] = *(const f32x4*)(s0 + 256 * j); }
#undef TROW
    __syncthreads();
}

template <int CTRL> __device__ __forceinline__ float dpp_f(float v) { return __int_as_float(__builtin_amdgcn_update_dpp(0, __float_as_int(v), CTRL, 0xf, 0xf, true)); }
__device__ __forceinline__ float swap16_f(float v, int lane) { auto r = __builtin_amdgcn_permlane16_swap(__float_as_uint(v), __float_as_uint(v), false, false); return __uint_as_float((lane & 16) ? r[0] : r[1]); }
constexpr int PEER_SLICES = 8;
#define PEER_LOAD_E(E, t_) { const u32x4* ep_ = (const u32x4*)(EI + (size_t)(t_) * 128 + r8 * 16); E[0] = ep_[0]; E[1] = ep_[1]; }
#define EID(E, i_) (((i_) & 1) ? (E[(i_) >> 3][((i_) >> 1) & 3] >> 16) : (E[(i_) >> 3][((i_) >> 1) & 3] & 0xffffu))
#define PEER_GATHER(U, E, base_, coff_) { _Pragma("unroll") for (int i_ = 0; i_ < 16; ++i_) U[i_] = *(const u32x4*)((base_) + (EID(E, i_) * 128u + (coff_))); }
#define FP8LO(d) __builtin_amdgcn_cvt_pk_f32_fp8((int)(d), false)
#define FP8HI(d) __builtin_amdgcn_cvt_pk_f32_fp8((int)(d), true)
__device__ __forceinline__ float peer_u_reduce8(const u32x4 (&U)[8], const u32x4 hq0, const u32x4 hq1, int c) {
    f32x2 h[8];
    h[0] = (f32x2){bflo(hq0.x), bfhi(hq0.x)}; h[1] = (f32x2){bflo(hq0.y), bfhi(hq0.y)}; h[2] = (f32x2){bflo(hq0.z), bfhi(hq0.z)}; h[3] = (f32x2){bflo(hq0.w), bfhi(hq0.w)};
    h[4] = (f32x2){bflo(hq1.x), bfhi(hq1.x)}; h[5] = (f32x2){bflo(hq1.y), bfhi(hq1.y)}; h[6] = (f32x2){bflo(hq1.z), bfhi(hq1.z)}; h[7] = (f32x2){bflo(hq1.w), bfhi(hq1.w)};
    float q[8];
#pragma unroll
    for (int i = 0; i < 8; ++i) {
        f32x2 s0 = FP8LO(U[i].x) * h[0], s1 = FP8HI(U[i].x) * h[1];
        s0 = __builtin_elementwise_fma(FP8LO(U[i].y), h[2], s0); s1 = __builtin_elementwise_fma(FP8HI(U[i].y), h[3], s1);
        s0 = __builtin_elementwise_fma(FP8LO(U[i].z), h[4], s0); s1 = __builtin_elementwise_fma(FP8HI(U[i].z), h[5], s1);
        s0 = __builtin_elementwise_fma(FP8LO(U[i].w), h[6], s0); s1 = __builtin_elementwise_fma(FP8HI(U[i].w), h[7], s1);
        s0 = s0 + s1; q[i] = s0.x + s0.y;
    }
    { const bool up = (c & 4) != 0;
#pragma unroll
      for (int j = 0; j < 4; ++j) { const float mine = up ? q[j + 4] : q[j], send = up ? q[j] : q[j + 4]; q[j] = mine + dpp_f<0x141>(send); } }
    { const bool up = (c & 2) != 0;
#pragma unroll
      for (int j = 0; j < 2; ++j) { const float mine = up ? q[j + 2] : q[j], send = up ? q[j] : q[j + 2]; q[j] = mine + dpp_f<0x4E>(send); } }
    { const bool up = (c & 1) != 0; const float mine = up ? q[1] : q[0], send = up ? q[0] : q[1]; q[0] = mine + dpp_f<0xB1>(send); }
    return q[0];
}
#define PEER_GATHER8(U, EW, base_, coff_) { _Pragma("unroll") for (int i_ = 0; i_ < 8; ++i_) { const unsigned w_ = EW[i_ >> 1]; U[i_] = *(const u32x4*)((base_) + (((i_ & 1) ? (w_ >> 16) : (w_ & 0xffffu)) * 128u + (coff_))); } }
__device__ __forceinline__ void phase_peer_u(const Ctx& C) {
    const int lane = C.lane, r8 = lane >> 3, c = lane & 7;
    const bf16_t* H2 = WSP(bf16_t, WS_B0); const unsigned char* U8 = C.ws + WS_U8; const unsigned short* EI = WSP(unsigned short, WS_EI); unsigned* PA = WSP(unsigned, WS_SC);
    const int s = C.bid & 7, wg = (C.bid >> 3) * NWAVES + C.wave, nwg = (C.G >> 3) * NWAVES;
    const int n = (TT - wg + nwg - 1) / nwg;
    const unsigned char* ub = U8 + (size_t)s * NE * 128; const unsigned coff = (unsigned)c * 16u; const bf16_t* hb = H2 + s * 128 + c * 16;
    unsigned* pab = PA + (size_t)s * 64 + lane;
#define TOK(i_) (min(wg + (i_) * nwg, TT - 1))
#define LOAD_H(H0, H1, t_) { const u32x4* hp_ = (const u32x4*)(hb + (size_t)(t_) * DM); H0 = hp_[0]; H1 = hp_[1]; }
    u32x4 uA[8], uB[8], ec[2], en[2], hc0, hc1, hn0, hn1;
    PEER_LOAD_E(ec, TOK(0)); LOAD_H(hc0, hc1, TOK(0));
    PEER_GATHER8(uA, ec[0], ub, coff);
    PEER_LOAD_E(en, TOK(1)); LOAD_H(hn0, hn1, TOK(1));
    for (int i = 0; i < n; ++i) {
        PEER_GATHER8(uB, ec[1], ub, coff);
        const float r0 = peer_u_reduce8(uA, hc0, hc1, c);
        PEER_GATHER8(uA, en[0], ub, coff);
        const float r1 = peer_u_reduce8(uB, hc0, hc1, c);
        pab[(size_t)TOK(i) * (PEER_SLICES * 64)] = pk2(r0, r1);
        ec[0] = en[0]; ec[1] = en[1]; hc0 = hn0; hc1 = hn1;
        PEER_LOAD_E(en, TOK(i + 2)); LOAD_H(hn0, hn1, TOK(i + 2));
    }
#undef LOAD_H
#undef TOK
}
constexpr size_t WS_ACT16 = WS_U16 + ((size_t)17 << 20);
__device__ __forceinline__ void phase_peer_act(const Ctx& C) {
    const unsigned* PA = WSP(unsigned, WS_SC); const float* GW = WSP(float, WS_GW); bf16_t* ACT = WSP(bf16_t, WS_ACT16);
    const unsigned short* EI = WSP(unsigned short, WS_EI); const float* SU = WSP(float, WS_SU); const float* SV = WSP(float, WS_SV);
    const int n4 = TT * 32, stride = C.G * NTHREADS;
#define ACT_LOAD(X, i4_) { const size_t t_ = (size_t)((i4_) >> 5); const int k_ = ((i4_) & 31) * 4; const unsigned* pp_ = PA + t_ * (PEER_SLICES * 64) + (k_ >> 4) * 8 + (k_ & 7); \
        _Pragma("unroll") for (int s_ = 0; s_ < PEER_SLICES; ++s_) X##w[s_] = *(const u32x4*)(pp_ + s_ * 64); \
        X##e = *(const u32x2*)(EI + (size_t)(i4_) * 4); X##g = *(const f32x4*)(GW + (size_t)(i4_) * 4); }
#define ACT_SCALES(X) { const u32x4 e_ = (u32x4){X##e.x & 0xffffu, X##e.x >> 16, X##e.y & 0xffffu, X##e.y >> 16}; \
        X##su = (f32x4){SU[e_.x], SU[e_.y], SU[e_.z], SU[e_.w]}; X##sv = (f32x4){SV[e_.x], SV[e_.y], SV[e_.z], SV[e_.w]}; }
#define ACT_STORE(X, i4_) { const bool hi_ = (((((i4_) & 31) * 4) >> 3) & 1) != 0; f32x4 a_ = (f32x4){0.f, 0.f, 0.f, 0.f}; \
        _Pragma("unroll") for (int s_ = 0; s_ < PEER_SLICES; ++s_) { const u32x4 w_ = X##w[s_]; \
            a_ += hi_ ? (f32x4){bfhi(w_.x), bfhi(w_.y), bfhi(w_.z), bfhi(w_.w)} : (f32x4){bflo(w_.x), bflo(w_.y), bflo(w_.z), bflo(w_.w)}; } \
        *(u32x2*)(ACT + (size_t)(i4_) * 4) = (u32x2){pk2(geluf_(a_[0] * X##su[0]) * X##g[0] * X##sv[0], geluf_(a_[1] * X##su[1]) * X##g[1] * X##sv[1]), \
                                                     pk2(geluf_(a_[2] * X##su[2]) * X##g[2] * X##sv[2], geluf_(a_[3] * X##su[3]) * X##g[3] * X##sv[3])}; }
    u32x4 Pw[8], Qw[8]; u32x2 Pe, Qe; f32x4 Pg, Qg, Psu, Psv, Qsu, Qsv;
    int i4 = C.bid * NTHREADS + C.tid;
    for (; i4 + stride < n4; i4 += 2 * stride) {
        ACT_LOAD(P, i4) ACT_LOAD(Q, i4 + stride)
        ACT_SCALES(P) ACT_SCALES(Q)
        ACT_STORE(P, i4) ACT_STORE(Q, i4 + stride)
    }
    if (i4 < n4) { ACT_LOAD(P, i4) ACT_SCALES(P) ACT_STORE(P, i4) }
#undef ACT_LOAD
#undef ACT_SCALES
#undef ACT_STORE
}
#define PEER_LOAD_A(A, t_) { const u32x4* ap_ = (const u32x4*)(ACT + (size_t)(t_) * 128 + r8 * 16); A[0] = ap_[0]; A[1] = ap_[1]; }
__device__ __forceinline__ void peer_v_acc8(f32x2 (&o)[8], const u32x4 (&V)[8], const u32x4 AW) {
#pragma unroll
    for (int i = 0; i < 8; ++i) { const unsigned w = AW[i >> 1]; const float a = (i & 1) ? bfhi(w) : bflo(w); const f32x2 a2 = (f32x2){a, a};
        o[0] = __builtin_elementwise_fma(FP8LO(V[i].x), a2, o[0]); o[1] = __builtin_elementwise_fma(FP8HI(V[i].x), a2, o[1]);
        o[2] = __builtin_elementwise_fma(FP8LO(V[i].y), a2, o[2]); o[3] = __builtin_elementwise_fma(FP8HI(V[i].y), a2, o[3]);
        o[4] = __builtin_elementwise_fma(FP8LO(V[i].z), a2, o[4]); o[5] = __builtin_elementwise_fma(FP8HI(V[i].z), a2, o[5]);
        o[6] = __builtin_elementwise_fma(FP8LO(V[i].w), a2, o[6]); o[7] = __builtin_elementwise_fma(FP8HI(V[i].w), a2, o[7]); }
}
__device__ __forceinline__ f32x2 peer_v_scatter(const f32x2 (&o2)[8], int lane) {
    float o[16];
#pragma unroll
    for (int j = 0; j < 8; ++j) { o[2 * j] = o2[j].x; o[2 * j + 1] = o2[j].y; }
    { const bool up = (lane & 32) != 0;
#pragma unroll
      for (int j = 0; j < 8; ++j) { const float mine = up ? o[j + 8] : o[j], send = up ? o[j] : o[j + 8]; o[j] = mine + shfx<32>(send, lane); } }
    { const bool up = (lane & 16) != 0;
#pragma unroll
      for (int j = 0; j < 4; ++j) { const float mine = up ? o[j + 4] : o[j], send = up ? o[j] : o[j + 4]; o[j] = mine + swap16_f(send, lane); } }
    { const bool up = (lane & 8) != 0;
#pragma unroll
      for (int j = 0; j < 2; ++j) { const float mine = up ? o[j + 2] : o[j], send = up ? o[j] : o[j + 2]; o[j] = mine + dpp_f<0x128>(send); } }
    return (f32x2){o[0], o[1]};
}
__device__ __forceinline__ void phase_peer_v(const Ctx& C, int l, bool dry = false) {
    const int lane = C.lane, r8 = lane >> 3, c = lane & 7;
    const unsigned char* V8 = C.ws + WS_V8; const unsigned short* EI = WSP(unsigned short, WS_EI); const bf16_t* ACT = WSP(bf16_t, WS_ACT16); const float* MOD = WSP(float, WS_MOD);
    const int s = C.bid & 7, wg = (C.bid >> 3) * NWAVES + C.wave, nwg = (C.G >> 3) * NWAVES;
    const int n = (TT - wg + nwg - 1) / nwg;
    const int jcol = ((lane >> 5) & 1) * 8 + ((lane >> 4) & 1) * 4 + ((lane >> 3) & 1) * 2;
    const int col = s * 128 + c * 16 + jcol;
    const unsigned char* vb = V8 + (size_t)s * NE * 128; const unsigned coff = (unsigned)c * 16u;
    float* xb = C.out + col; const float* g2 = MOD + (size_t)l * NBT * 6144 + 5120 + col;
#define TOK(i_) (min(wg + (i_) * nwg, TT - 1))
    u32x4 vA[8], vB[8], ec[2], en[2], ac[2], an[2];
    PEER_LOAD_E(ec, TOK(0)); PEER_LOAD_A(ac, TOK(0));
    PEER_GATHER8(vA, ec[0], vb, coff);
    PEER_LOAD_E(en, TOK(1)); PEER_LOAD_A(an, TOK(1));
    for (int i = 0; i < n; ++i) {
        const int t = TOK(i);
        PEER_GATHER8(vB, ec[1], vb, coff);
        const f32x2 xv = *(const f32x2*)(xb + (size_t)t * DM), gv = *(const f32x2*)(g2 + (size_t)row_batch(t) * 6144);
        f32x2 o[8];
#pragma unroll
        for (int j = 0; j < 8; ++j) o[j] = (f32x2){0.f, 0.f};
        peer_v_acc8(o, vA, ac[0]);
        __builtin_amdgcn_sched_barrier(0);
        PEER_GATHER8(vA, en[0], vb, coff);
        peer_v_acc8(o, vB, ac[1]);
        __builtin_amdgcn_sched_barrier(0);
        ac[0] = an[0]; ac[1] = an[1]; ec[0] = en[0]; ec[1] = en[1];
        PEER_LOAD_E(en, TOK(i + 2)); PEER_LOAD_A(an, TOK(i + 2));
        const f32x2 ov = peer_v_scatter(o, lane);
        asm volatile("" :: "v"(ov.x), "v"(ov.y));
        if (!dry) *(f32x2*)(xb + (size_t)t * DM) = xv + gv * ov;
    }
#undef TOK
}
#undef PEER_GATHER8
#undef PEER_LOAD_E
#undef EID
#undef PEER_LOAD_A
#undef PEER_GATHER
__device__ __forceinline__ void phase_final_norm(const Ctx& C) {
    const int gw = C.bid * NWAVES + C.wave, NGW = C.G * NWAVES; const float* fw = as_global(C.P->in[IN_FNW]);
    for (int row = gw; row < TT; row += NGW) {
        f32x4* xr = (f32x4*)(C.out + (size_t)row * DM) + C.lane;
        f32x4 v[4]; float s = 0.f;
#pragma unroll
        for (int j = 0; j < 4; ++j) { v[j] = xr[64 * j]; s += (v[j][0] * v[j][0] + v[j][1] * v[j][1]) + (v[j][2] * v[j][2] + v[j][3] * v[j][3]); }
        const float rstd = rsqrtf(wave_sum(s) * (1.f / DM) + EPS);
#pragma unroll
        for (int j = 0; j < 4; ++j) xr[64 * j] = v[j] * rstd * *(const f32x4*)(fw + C.lane * 4 + 256 * j);
    }
}


#define XB_TMO      128
#define XB_XCNT(j)  (256  + 64 * (j))
#define XB_XSUB(j)  (1280 + 64 * (j))
#define XB_XGEN(j)  (2304 + 64 * (j))
#define XB_TOP      3328
#define XB_TOPGEN   3392
#define XCD_BAR_WORDS 3456
#define XB_SPIN_CAP (1u << 22)
__device__ __forceinline__ unsigned xb_ld(unsigned* p)              { return __hip_atomic_load(p, __ATOMIC_RELAXED, __HIP_MEMORY_SCOPE_AGENT); }
__device__ __forceinline__ unsigned xb_add(unsigned* p, unsigned v) { return __hip_atomic_fetch_add(p, v, __ATOMIC_RELAXED, __HIP_MEMORY_SCOPE_AGENT); }
__device__ __forceinline__ unsigned xb_xcc_id() { return (unsigned)__builtin_amdgcn_s_getreg((3 << 11) | 20) & 0xFu; }
#define XB_SPIN(cond, bar) do { unsigned _sp = 0; while (cond) { __builtin_amdgcn_s_sleep(1); \
    if ((++_sp & 255u) == 0u) { if (xb_ld(&(bar)[XB_TMO])) break; if (_sp > XB_SPIN_CAP) { atomicAdd(&(bar)[XB_TMO], 1u); break; } } } } while (0)
struct XcdBarrier { unsigned* bar; unsigned x; volatile LAS unsigned* st; };
__device__ __forceinline__ XcdBarrier xcd_barrier_post(unsigned* bar, volatile LAS unsigned* st) {
    XcdBarrier b; b.bar = bar; b.x = xb_xcc_id(); b.st = st;
    if (threadIdx.x == 0) (void)xb_add(&bar[XB_XCNT(b.x)], 1u);
    return b;
}
__device__ __forceinline__ void xcd_barrier_complete(unsigned* bar, unsigned x, unsigned& nloc, unsigned& nx) {
    const unsigned G = gridDim.x * gridDim.y * gridDim.z;
    unsigned sum, cnt, mine, sp = 0u;
    for (;;) {
        sum = 0u; cnt = 0u; mine = 0u;
#pragma unroll
        for (unsigned j = 0; j < 16; ++j) { const unsigned c = xb_ld(&bar[XB_XCNT(j)]); sum += c; cnt += (c > 0u) ? 1u : 0u; mine = (j == x) ? c : mine; }
        if (sum == G) break;
        __builtin_amdgcn_s_sleep(1);
        if ((++sp & 255u) == 0u) { if (xb_ld(&bar[XB_TMO])) break; if (sp > XB_SPIN_CAP) { atomicAdd(&bar[XB_TMO], 1u); break; } }
    }
    nloc = mine > 0u ? mine : 1u; nx = cnt > 0u ? cnt : 1u;
}
__device__ __forceinline__ void xcd_barrier(const XcdBarrier& b) {
    asm volatile("s_waitcnt vmcnt(0)" ::: "memory");
    __syncthreads();
    if (threadIdx.x == 0) {
        unsigned* bar = b.bar;
        __builtin_amdgcn_s_waitcnt(0);
        unsigned nloc = b.st[0], nx = b.st[1];
        if (nloc == 0u) { xcd_barrier_complete(bar, b.x, nloc, nx); b.st[0] = nloc; b.st[1] = nx; }
        const unsigned old = xb_add(&bar[XB_XSUB(b.x)], 1u);
        const unsigned gen = old / nloc;
        if (old + 1u == (gen + 1u) * nloc) {
            __builtin_amdgcn_fence(__ATOMIC_RELEASE, "agent");
            asm volatile("s_waitcnt vmcnt(0)" ::: "memory");
            const unsigned og = xb_add(&bar[XB_TOP], 1u);
            const unsigned tg = og / nx;
            if (og + 1u == (tg + 1u) * nx) xb_add(&bar[XB_TOPGEN], 1u);
            else XB_SPIN(xb_ld(&bar[XB_TOPGEN]) == tg, bar);
            __builtin_amdgcn_fence(__ATOMIC_ACQUIRE, "agent");
            xb_add(&bar[XB_XGEN(b.x)], 1u);
            asm volatile("s_waitcnt vmcnt(0)" ::: "memory");
        } else {
            XB_SPIN(xb_ld(&bar[XB_XGEN(b.x)]) == gen, bar);
            __builtin_amdgcn_fence(__ATOMIC_ACQUIRE, "agent");
            asm volatile("s_waitcnt vmcnt(0)" ::: "memory");
        }
    }
    __syncthreads();
}

__device__ __forceinline__ Ctx relaunder(const Ctx& C) {
    Ctx D = C; int t = C.tid; asm volatile("" : "+v"(t)); D.tid = t; D.lane = t & 63;
    unsigned char* w = C.ws; float* o = C.out; asm volatile("" : "+s"(w), "+s"(o)); D.ws = as_global(w); D.out = as_global(o); return D;
}
constexpr int NPL = 13, NPH = 2 + 2 * NPL;
__device__ __forceinline__ void run_phase(const Ctx& C0, int ph, bool dry) {
    if (ph == 0) { const Ctx C = relaunder(C0); phase_prep(C); return; }
    if (ph == NPH - 1) { const Ctx C = relaunder(C0); phase_final_norm(C); return; }
    const int l = (ph - 1) / NPL, k = (ph - 1) % NPL;
    switch (k) {
    case 0: { const Ctx C = relaunder(C0); phase_norm(C, l, 0); } break;
    case 1: { const Ctx C = relaunder(C0); CParams& P = *C.P;
#ifdef STAGGER_US
              { const unsigned long long t0 = __builtin_amdgcn_s_memrealtime(); const unsigned long long d = (unsigned long long)((C.bid >> 3) & 3) * (STAGGER_US * 100);
                while (__builtin_amdgcn_s_memrealtime() - t0 < d) __builtin_amdgcn_s_sleep(4); }
#endif
              Epi1 E{WSP(bf16_t, WS_B1), WSP(bf16_t, WS_B2), WSP(bf16_t, WS_B3), WSP(bf16_t, WS_B4), WSP(float, WS_DT), as_global(P.in[IN_DTB]) + l * 16};
              gemm_run(C, WSP(bf16_t, WS_B0), WSP(bf16_t, WS_W1T) + (size_t)l * N1 * DM, nullptr, nullptr, N1, E, dry); } break;
    case 2: { const Ctx C = relaunder(C0); phase_convbc(C, l); } break;
    case 3: { const Ctx C = relaunder(C0); phase_scan(C, l, dry); } break;
    case 4: { const Ctx C = relaunder(C0); Epi2 E{WSP(bf16_t, WS_GS), WSP(bf16_t, WS_GL)};
              gemm_run(C, WSP(bf16_t, WS_B0), WSP(bf16_t, WS_WGT) + (size_t)l * NG * DM, nullptr, nullptr, NG, E, dry); } break;
    case 5: { const Ctx C = relaunder(C0); Epi3 E{WSP(bf16_t, WS_GS), WSP(bf16_t, WS_GL), WSP(float, WS_SSQ), WSP(bf16_t, WS_B0)};
              gemm_run(C, WSP(bf16_t, WS_B1), WSP(bf16_t, WS_WBS) + (size_t)l * DM * DM, WSP(bf16_t, WS_B4), WSP(bf16_t, WS_WBL) + (size_t)l * DM * DM, DM, E, dry); } break;
    case 6: { const Ctx C = relaunder(C0); CParams& P = *C.P; Epi4 E{as_global(P.in[IN_XP]), as_global(P.in[IN_XS]), C.out, WSP(float, WS_MOD) + (size_t)l * NBT * 6144, l};
              gemm_run(C, WSP(bf16_t, WS_B0), WSP(bf16_t, WS_WO) + (size_t)l * DM * DM, nullptr, nullptr, DM, E, dry); } break;
    case 7: { const Ctx C = relaunder(C0); phase_norm(C, l, 1); } break;
    case 8: { const Ctx C = relaunder(C0); Epi5 E{WSP(bf16_t, WS_SC)};
              gemm_run(C, WSP(bf16_t, WS_B0), WSP(bf16_t, WS_WC) + (size_t)l * 2048 * DM, nullptr, nullptr, 2048, E, dry); } break;
    case 9: { const Ctx C = relaunder(C0); phase_topk(C, l); } break;
    case 10: { const Ctx C = relaunder(C0); phase_peer_u(C); } break;
    case 11: { const Ctx C = relaunder(C0); phase_peer_act(C); } break;
    case 12: { const Ctx C = relaunder(C0); phase_peer_v(C, l, dry); } break;
    }
}

__global__ void __launch_bounds__(NTHREADS, 2) fwd(Params P) {
    extern __shared__ __attribute__((aligned(16))) unsigned char lds_raw[];
    const int ph_lo = P.ph_lo, ph_hi = P.ph_hi;
    volatile LAS unsigned* bst = (volatile LAS unsigned*)((LAS unsigned char*)lds_raw + LDS_BYTES - 64);
    if (threadIdx.x == 0) { bst[0] = 0u; bst[1] = 0u; }
    __syncthreads();
    (void)xcd_barrier_post((unsigned*)(P.ws + WS_CTL), bst);
#ifdef PROBE_T
    unsigned long long tm_acc = 0;
#endif
    for (int ph = ph_lo; ph < ph_hi; ++ph) {
        CParams* Pp = (CParams*)__builtin_amdgcn_kernarg_segment_ptr(); asm volatile("" : "+s"(Pp));
        Ctx C; C.P = Pp; C.lds = (LAS unsigned char*)lds_raw;
        int tid = threadIdx.x; asm volatile("" : "+v"(tid));
        unsigned char* ws = Pp->ws; float* out = Pp->out; asm volatile("" : "+s"(ws), "+s"(out));
        C.ws = ws; C.out = out;
        C.tid = tid; C.lane = tid & 63; C.wave = __builtin_amdgcn_readfirstlane(tid >> 6); C.bid = blockIdx.x; C.G = gridDim.x;
#ifdef PROBE_K
        { const bool hit = (PROBE_K == 100) ? ph == 0 : ((PROBE_K == 101) ? ph == NPH - 1 : (ph > 0 && ph < NPH - 1 && (ph - 1) % NPL == PROBE_K));
          if (hit) for (int rep = 0; rep < PROBE_N; ++rep) { run_phase(C, ph, true); __syncthreads(); } }
#endif
#ifdef PROBE_T
        const bool tm_hit = (PROBE_T == 100) ? ph == 0 : ((PROBE_T == 101) ? ph == NPH - 1 : (ph > 0 && ph < NPH - 1 && (ph - 1) % NPL == PROBE_T));
        const unsigned long long tm_t0 = __builtin_amdgcn_s_memrealtime();
#endif
        run_phase(C, ph, false);
        if (ph + 1 < ph_hi) { if (ph == 0) cg::this_grid().sync();
            else { XcdBarrier xb; xb.bar = (unsigned*)(ws + WS_CTL); xb.x = xb_xcc_id(); xb.st = (volatile LAS unsigned*)((LAS unsigned char*)lds_raw + LDS_BYTES - 64); xcd_barrier(xb); } }
#ifdef PROBE_T
        if (tm_hit) tm_acc += __builtin_amdgcn_s_memrealtime() - tm_t0;
#endif
    }
#ifdef PROBE_T
    if (blockIdx.x == 0 && threadIdx.x == 0) { const unsigned long long t0 = __builtin_amdgcn_s_memrealtime(); while (__builtin_amdgcn_s_memrealtime() - t0 < 4 * tm_acc) __builtin_amdgcn_s_sleep(8); }
#endif
}

extern "C" void kernel_launch(void* const* d_in, const int* in_sizes, int n_in, void* d_out, int out_size, void* d_ws, size_t ws_size, hipStream_t stream) {
    static int grid = 0;
    if (grid == 0) {
        if (n_in != N_IN || (size_t)out_size != O_END || ws_size < WS_END) { fprintf(stderr, "kernel_launch: unexpected shapes n_in %d out %d ws %zu (need %zu)\n", n_in, out_size, ws_size, (size_t)WS_END); grid = -1; return; }
        int dev = 0, cus = 0, per_cu = 0;
        hipGetDevice(&dev); hipDeviceGetAttribute(&cus, hipDeviceAttributeMultiprocessorCount, dev);
        hipFuncSetAttribute((const void*)fwd, hipFuncAttributeMaxDynamicSharedMemorySize, LDS_BYTES);
        hipOccupancyMaxActiveBlocksPerMultiprocessor(&per_cu, (const void*)fwd, NTHREADS, LDS_BYTES);
        if (per_cu < 1) { fprintf(stderr, "kernel_launch: occupancy query says %d blocks/CU\n", per_cu); per_cu = 1; }
        grid = cus;
        fprintf(stderr, "kernel_launch: cus %d per_cu %d grid %d ws %zu\n", cus, per_cu, grid, ws_size);
    }
    if (grid < 0) return;
    Params p{};
    for (int i = 0; i < N_IN; ++i) p.in[i] = (const float*)d_in[i];
    p.out = (float*)d_out; p.ws = (unsigned char*)d_ws;
    hipMemsetAsync((char*)d_ws + WS_CTL, 0, 65536, stream);
#if MEGA
    p.ph_lo = 0; p.ph_hi = NPH;
    void* args[] = {&p};
    hipError_t e = hipLaunchCooperativeKernel((const void*)fwd, dim3(grid), dim3(NTHREADS), args, LDS_BYTES, stream);
    if (e != hipSuccess) fprintf(stderr, "cooperative launch failed: %s\n", hipGetErrorString(e));
#else
    for (int ph = 0; ph < NPH; ++ph) { p.ph_lo = ph; p.ph_hi = ph + 1; hipLaunchKernelGGL(fwd, dim3(grid), dim3(NTHREADS), LDS_BYTES, stream, p); }
#endif
}
```

```cpp
#include <hip/hip_runtime.h>
#include <hip/hip_cooperative_groups.h>
#include <cstdio>
#include <cstdint>
namespace cg = cooperative_groups;

#ifndef MEGA
#define MEGA 1
#endif

#define LAS __attribute__((address_space(3)))
typedef unsigned short bf16_t;
typedef __bf16 bf16x2_t __attribute__((ext_vector_type(2)));
typedef short bf16x8 __attribute__((ext_vector_type(8)));
typedef float f32x4 __attribute__((ext_vector_type(4)));
typedef float f32x16 __attribute__((ext_vector_type(16)));
typedef unsigned u32x4 __attribute__((ext_vector_type(4)));
typedef unsigned u32x2 __attribute__((ext_vector_type(2)));

constexpr int DM = 1024;
constexpr int TP = 32768, TS = 128, TT = TP + TS, MT = 33024;
constexpr int NBT = 24;
constexpr int N1 = 4608;
constexpr int NG = 2048;
constexpr int NE = 16384;
constexpr int INC = 6416;
constexpr float EPS = 1e-6f;
constexpr int NWAVES = 8, NTHREADS = 512;
constexpr int LDS_BYTES = 150528;

enum { IN_XP = 0, IN_XS, IN_CP, IN_CS, IN_SSD, IN_SSDCONV, IN_LRU, IN_LRUCONV, IN_LN1, IN_LN2, IN_WMOD, IN_BMOD, IN_WIN, IN_SCW, IN_SCB, IN_DTB,
       IN_ALOG, IN_SSDD, IN_SNW, IN_LCW, IN_LCB, IN_WA, IN_BA, IN_WX, IN_BX, IN_LAM, IN_WBS, IN_WBL, IN_WO, IN_WQ, IN_K1, IN_K2, IN_U, IN_V, IN_FNW, N_IN };

constexpr size_t O_Y = 0, O_PSSD = 33685504, O_PSCONV = 35782656, O_PLRU = 35905536, O_PLCONV = 35938304,
                 O_SSSD = 36036608, O_SSCONV = 37085184, O_SLRU = 37146624, O_SLCONV = 37163008, O_END = 37212160;

constexpr size_t al256(size_t x) { return (x + 255) & ~(size_t)255; }
constexpr size_t WS_CTL = 0;
constexpr size_t WS_LRUW = 131072;
constexpr size_t WS_MOD = 1u << 20;
constexpr size_t WS_DT = al256(WS_MOD + (size_t)2 * NBT * 6144 * 4);
constexpr size_t WS_SSQ = al256(WS_DT + (size_t)MT * 16 * 4);
constexpr size_t WS_W1T = al256(WS_SSQ + (size_t)MT * 16 * 4);
constexpr size_t WS_WGT = al256(WS_W1T + (size_t)2 * N1 * DM * 2);
constexpr size_t WS_WBS = al256(WS_WGT + (size_t)2 * NG * DM * 2);
constexpr size_t WS_WBL = al256(WS_WBS + (size_t)2 * DM * DM * 2);
constexpr size_t WS_WO = al256(WS_WBL + (size_t)2 * DM * DM * 2);
constexpr size_t WS_WC = al256(WS_WO + (size_t)2 * DM * DM * 2);
constexpr size_t WS_U16 = al256(WS_WC + (size_t)2 * 2048 * DM * 2);
constexpr size_t WS_V16 = al256(WS_U16 + (size_t)NE * DM * 2);
constexpr size_t WS_EI = al256(WS_V16 + (size_t)NE * DM * 2);
constexpr size_t WS_GW = al256(WS_EI + (size_t)MT * 128 * 4);
constexpr size_t WS_B0 = al256(WS_GW + (size_t)MT * 128 * 4);
constexpr size_t WS_B1 = al256(WS_B0 + (size_t)MT * DM * 2);
constexpr size_t WS_B2 = al256(WS_B1 + (size_t)MT * DM * 2);
constexpr size_t WS_B3 = al256(WS_B2 + (size_t)MT * 1280 * 2);
constexpr size_t WS_B4 = al256(WS_B3 + (size_t)MT * DM * 2);
constexpr size_t WS_SINK = al256(WS_B4 + (size_t)MT * DM * 2);
constexpr size_t WS_END = al256(WS_SINK + 32768);
constexpr size_t WS_GS = WS_B2, WS_GL = WS_B2 + (size_t)MT * DM * 2;
constexpr size_t WS_SC = WS_B1;
static_assert(WS_GL + (size_t)MT * DM * 2 <= WS_B4, "gate overlay");
static_assert(WS_SC + (size_t)MT * 2048 * 4 <= WS_SINK, "score overlay");
static_assert(WS_END <= (size_t)512 << 20, "d_ws budget");

struct Params {
    const float* in[N_IN];
    float* out;
    unsigned char* ws;
    int ph_lo, ph_hi;
};

__device__ __forceinline__ unsigned f2bf(float f) { return (unsigned)__builtin_bit_cast(unsigned short, (__bf16)f); }
__device__ __forceinline__ float bf2f(unsigned b) { return __uint_as_float(b << 16); }
__device__ __forceinline__ unsigned pk2(float lo, float hi) { typedef float f32x2_ __attribute__((ext_vector_type(2))); return __builtin_bit_cast(unsigned, __builtin_convertvector((f32x2_){lo, hi}, bf16x2_t)); }
__device__ __forceinline__ float bflo(unsigned w) { return __uint_as_float(w << 16); }
__device__ __forceinline__ float bfhi(unsigned w) { return __uint_as_float(w & 0xffff0000u); }
template <int M> __device__ __forceinline__ int shfx_i(int v, int lane) {
    if constexpr (M == 32) { auto r = __builtin_amdgcn_permlane32_swap((unsigned)v, (unsigned)v, false, false); return (int)((lane & 32) ? r[0] : r[1]); }
    else return __builtin_amdgcn_ds_swizzle(v, 0x1f | (M << 10));
}
template <int M> __device__ __forceinline__ float shfx(float v, int lane) { return __int_as_float(shfx_i<M>(__float_as_int(v), lane)); }
__device__ __forceinline__ float shfl_f(float v, int src) { return __int_as_float(__builtin_amdgcn_ds_bpermute(src << 2, __float_as_int(v))); }
__device__ __forceinline__ int shfl_i(int v, int src) { return __builtin_amdgcn_ds_bpermute(src << 2, v); }
template <int CTRL> __device__ __forceinline__ float dppf_(float v) { return __int_as_float(__builtin_amdgcn_update_dpp(0, __float_as_int(v), CTRL, 0xf, 0xf, true)); }
__device__ __forceinline__ float row8_sum(float v) { v += dppf_<0xB1>(v); v += dppf_<0x4E>(v); v += dppf_<0x141>(v); return v; }
__device__ __forceinline__ float wave_sum(float v) {
    v += dppf_<0xB1>(v); v += dppf_<0x4E>(v); v += dppf_<0x141>(v); v += dppf_<0x140>(v);
    { auto r = __builtin_amdgcn_permlane16_swap(__float_as_uint(v), __float_as_uint(v), false, false); v = __uint_as_float(r[0]) + __uint_as_float(r[1]); }
    { auto r = __builtin_amdgcn_permlane32_swap(__float_as_uint(v), __float_as_uint(v), false, false); v = __uint_as_float(r[0]) + __uint_as_float(r[1]); }
    return v;
}
__device__ __forceinline__ float exp_fast(float x) { return __builtin_amdgcn_exp2f(x * 1.4426950408889634f); }
__device__ __forceinline__ float sigmoidf_(float x) { return __builtin_amdgcn_rcpf(1.0f + exp_fast(-x)); }
__device__ __forceinline__ float siluf_(float x) { return x * __builtin_amdgcn_rcpf(1.0f + exp_fast(-x)); }
__device__ __forceinline__ float geluf_(float x) { const float u = 1.5957691216057308f * (x + 0.044715f * x * x * x); return x * __builtin_amdgcn_rcpf(1.0f + exp_fast(-u)); }
__device__ __forceinline__ float softplusf_(float x) { const float e = exp_fast(-fabsf(x));
    const float l = __builtin_amdgcn_logf(1.0f + e) * 0.6931471805599453f, s = e * (1.0f + e * (-0.5f + e * 0.33333333f)); return fmaxf(x, 0.f) + (e < 0.02f ? s : l); }
__device__ __forceinline__ int row_batch(int row) { return row < TP ? (row >> 11) : (row < TT ? 16 + ((row - TP) >> 4) : 23); }
__device__ __forceinline__ float dot2bf(unsigned a, unsigned b, float acc) { return __builtin_amdgcn_fdot2_f32_bf16(__builtin_bit_cast(bf16x2_t, a), __builtin_bit_cast(bf16x2_t, b), acc, false); }
__device__ __forceinline__ float rl(float v, int lane) { return __int_as_float(__builtin_amdgcn_readlane(__float_as_int(v), lane)); }
#define LDS_WAIT() asm volatile("s_waitcnt lgkmcnt(0)" ::: "memory")
#define MFMA32(a, b, c) __builtin_amdgcn_mfma_f32_32x32x16_bf16((a), (b), (c), 0, 0, 0)

typedef const __attribute__((address_space(4))) Params CParams;
template <class T> __device__ __forceinline__ T* as_global(T* p) { __attribute__((address_space(1))) T* g = (__attribute__((address_space(1))) T*)p; asm volatile("" : "+s"(g)); return (T*)g; }
struct Ctx {
    CParams* P; LAS unsigned char* lds; unsigned char* ws; float* out;
    int tid, lane, wave, bid, G;
};
#define WSP(T, off) (as_global((T*)(C.ws + (off))))

__device__ __forceinline__ void tr_item(const float* W, int ldw, int src_col0, int valid, const float* kscale, int k0, bf16_t* dst, LAS float* scr, int lane) {
    const int c4 = lane & 7, r0 = lane >> 3;
    f32x4 v[8];
#pragma unroll
    for (int i = 0; i < 8; ++i) { const int kk = r0 + 8 * i; v[i] = (4 * c4 < valid) ? *(const f32x4*)(W + (size_t)(k0 + kk) * ldw + src_col0 + 4 * c4) : (f32x4){0.f, 0.f, 0.f, 0.f}; }
#pragma unroll
    for (int i = 0; i < 8; ++i) { const int kk = r0 + 8 * i; const float ks = kscale ? kscale[k0 + kk] : 1.0f; LAS float* s = scr + kk * 33 + 4 * c4;
        s[0] = v[i][0] * ks; s[1] = v[i][1] * ks; s[2] = v[i][2] * ks; s[3] = v[i][3] * ks; }
    LDS_WAIT();
    const int c8 = lane & 7;
#pragma unroll
    for (int j = 0; j < 4; ++j) { const int n = (lane >> 3) + 8 * j; const LAS float* s = scr + (8 * c8) * 33 + n;
        u32x4 o; o.x = pk2(s[0 * 33], s[1 * 33]); o.y = pk2(s[2 * 33], s[3 * 33]); o.z = pk2(s[4 * 33], s[5 * 33]); o.w = pk2(s[6 * 33], s[7 * 33]);
        *(u32x4*)(dst + (size_t)n * DM + k0 + 8 * c8) = o; }
    LDS_WAIT();
}
typedef float f32x2 __attribute__((ext_vector_type(2)));
typedef short s16x4_ __attribute__((ext_vector_type(4)));
constexpr size_t WS_U8 = WS_U16, WS_SU = WS_U16 + ((size_t)16 << 20), WS_V8 = WS_V16, WS_SV = WS_V16 + ((size_t)16 << 20);
__device__ __forceinline__ float wave_max(float v) {
    v = fmaxf(v, shfx<1>(v, 0)); v = fmaxf(v, shfx<2>(v, 0)); v = fmaxf(v, shfx<4>(v, 0)); v = fmaxf(v, shfx<8>(v, 0)); v = fmaxf(v, shfx<16>(v, 0));
    auto r = __builtin_amdgcn_permlane32_swap(__float_as_uint(v), __float_as_uint(v), false, false);
    return fmaxf(__uint_as_float(r[0]), __uint_as_float(r[1]));
}
__device__ __forceinline__ void convert_row(const Ctx& C, int it, const f32x4 (&v)[4]) {
    const int lane = C.lane; const bool isv = it >= NE; const int e = isv ? it - NE : it;
    unsigned char* dst = C.ws + (isv ? WS_V8 : WS_U8); float* sc = (float*)(C.ws + (isv ? WS_SV : WS_SU));
    float m = 0.f;
#pragma unroll
    for (int j = 0; j < 4; ++j) m = fmaxf(m, fmaxf(fmaxf(fabsf(v[j][0]), fabsf(v[j][1])), fmaxf(fabsf(v[j][2]), fabsf(v[j][3]))));
    m = wave_max(m);
    const float scale = m > 0.f ? m * (1.0f / 440.0f) : 1.0f, inv = 1.0f / scale;
    if (lane == 0) sc[e] = scale;
#pragma unroll
    for (int j = 0; j < 4; ++j) { int w = __builtin_amdgcn_cvt_pk_fp8_f32(v[j][0] * inv, v[j][1] * inv, 0, false); w = __builtin_amdgcn_cvt_pk_fp8_f32(v[j][2] * inv, v[j][3] * inv, w, true);
        const int slice = 2 * j + (lane >> 5);
        *(int*)(dst + ((size_t)slice * NE + e) * 128 + (lane & 31) * 4) = w; }
}
__device__ __forceinline__ void phase_prep(const Ctx& C) {
    CParams& P = *C.P;
    {
        LAS float* Kh = (LAS float*)C.lds;
        LAS float* Wq = (LAS float*)(C.lds + 128 * 132 * 4);
        bf16_t* WcT = WSP(bf16_t, WS_WC);
        for (int it = C.bid; it < 512; it += C.G) {
            const int l = it >> 8, h = (it >> 5) & 7, half = (it >> 4) & 1, jb = it & 15;
            const float* ksrc = as_global(P.in[half ? IN_K2 : IN_K1]) + (size_t)l * 128 * 128;
            const float* wsrc = as_global(P.in[IN_WQ]) + (size_t)l * DM * 2048 + (size_t)(jb * 64) * 2048 + h * 256 + half * 128;
            __syncthreads();
            for (int i = C.tid; i < 128 * 32; i += NTHREADS) { const int r = i >> 5, c4 = i & 31; *(LAS f32x4*)(Kh + r * 132 + c4 * 4) = *(const f32x4*)(ksrc + r * 128 + c4 * 4); }
            for (int i = C.tid; i < 64 * 32; i += NTHREADS) { const int r = i >> 5, c4 = i & 31; *(LAS f32x4*)(Wq + r * 132 + c4 * 4) = *(const f32x4*)(wsrc + (size_t)r * 2048 + c4 * 4); }
            __syncthreads();
            const int tk = C.tid & 31, tj = C.tid >> 5;
            float acc[4][4];
#pragma unroll
            for (int a = 0; a < 4; ++a)
#pragma unroll
                for (int b = 0; b < 4; ++b) acc[a][b] = 0.f;
            for (int d4 = 0; d4 < 32; ++d4) {
                f32x4 kv[4], wv[4];
#pragma unroll
                for (int a = 0; a < 4; ++a) { kv[a] = *(LAS f32x4*)(Kh + (tk + 32 * a) * 132 + d4 * 4); wv[a] = *(LAS f32x4*)(Wq + (4 * tj + a) * 132 + d4 * 4); }
#pragma unroll
                for (int a = 0; a < 4; ++a)
#pragma unroll
                    for (int b = 0; b < 4; ++b) acc[a][b] += kv[a][0] * wv[b][0] + kv[a][1] * wv[b][1] + kv[a][2] * wv[b][2] + kv[a][3] * wv[b][3];
            }
            __syncthreads();
            LAS unsigned char* ot = (LAS unsigned char*)Kh;
#pragma unroll
            for (int a = 0; a < 4; ++a) *(LAS u32x2*)(ot + (tk + 32 * a) * 144 + 8 * tj) = (u32x2){pk2(acc[a][0], acc[a][1]), pk2(acc[a][2], acc[a][3])};
            __syncthreads();
            for (int i = C.tid; i < 1024; i += NTHREADS) { const int n = i >> 3, ck = i & 7;
                *(u32x4*)(WcT + ((size_t)l * 2048 + h * 256 + half * 128 + n) * DM + jb * 64 + ck * 8) = *(const LAS u32x4*)(ot + n * 144 + ck * 16); }
        }
        __syncthreads();
    }
    {
        LAS float* sc = (LAS float*)C.lds;
        LAS float* red = (LAS float*)(C.lds + 98304);
        for (int i = C.tid; i < NBT * DM; i += NTHREADS) { const int bb = i >> 10, k = i & 1023;
            const float cv = bb < 16 ? as_global(P.in[IN_CP])[bb * DM + k] : as_global(P.in[IN_CS])[(bb - 16) * DM + k]; sc[i] = siluf_(cv); }
        __syncthreads();
        float* MOD = WSP(float, WS_MOD);
        for (int it = C.bid; it < 192; it += C.G) {
            const int l = it / 96, cg_ = it % 96, j = cg_ * 64 + C.lane;
            const float* wm = as_global(P.in[IN_WMOD]) + (size_t)l * DM * 6144 + j;
            float acc[NBT];
#pragma unroll
            for (int bb = 0; bb < NBT; ++bb) acc[bb] = 0.f;
            const int k0 = C.wave * 128;
#pragma unroll 16
            for (int k = 0; k < 128; ++k) { const float w = wm[(size_t)(k0 + k) * 6144];
#pragma unroll
                for (int bb = 0; bb < NBT; ++bb) acc[bb] += sc[bb * DM + k0 + k] * w; }
#pragma unroll
            for (int bb = 0; bb < NBT; ++bb) red[(C.wave * NBT + bb) * 64 + C.lane] = acc[bb];
            __syncthreads();
            const float bm = as_global(P.in[IN_BMOD])[l * 6144 + j];
#pragma unroll
            for (int q = 0; q < 3; ++q) { const int bb = 3 * C.wave + q; float a = bm;
#pragma unroll
                for (int w8 = 0; w8 < 8; ++w8) a += red[(w8 * NBT + bb) * 64 + C.lane];
                MOD[((size_t)l * NBT + bb) * 6144 + j] = a; }
            __syncthreads();
        }
        __syncthreads();
    }
    {
        LAS float* scr = (LAS float*)(C.lds + C.wave * 16384);
        const int gw = C.bid * NWAVES + C.wave, NGW = C.G * NWAVES;
        constexpr int I_W1 = 144 * 16, I_WG = 64 * 16, I_SQ = 32 * 16, PER_L = I_W1 + I_WG + 3 * I_SQ;
        for (int it = gw; it < 2 * PER_L; it += NGW) {
            const int l = it / PER_L; int r = it % PER_L;
            if (r < I_W1) { const int nb = r >> 4, kb = r & 15, n0 = nb * 32; int src, valid;
                if (n0 < 2304) { src = n0; valid = 32; } else if (n0 < 4352) { src = n0 + 16; valid = 32; } else if (n0 == 4352) { src = 2304; valid = 16; } else { src = 0; valid = 0; }
                tr_item(as_global(P.in[IN_WIN]) + (size_t)l * DM * INC, INC, src, valid, nullptr, kb * 64, WSP(bf16_t, WS_W1T) + ((size_t)l * N1 + n0) * DM, scr, C.lane); continue; }
            r -= I_W1;
            if (r < I_WG) { const int nb = r >> 4, kb = r & 15, n0 = nb * 32;
                tr_item(as_global(P.in[IN_WIN]) + (size_t)l * DM * INC, INC, 4368 + n0, 32, nullptr, kb * 64, WSP(bf16_t, WS_WGT) + ((size_t)l * NG + n0) * DM, scr, C.lane); continue; }
            r -= I_WG;
            const int which = r / I_SQ; r %= I_SQ; const int nb = r >> 4, kb = r & 15, n0 = nb * 32;
            const float* src = as_global(P.in[which == 0 ? IN_WBS : (which == 1 ? IN_WBL : IN_WO)]) + (size_t)l * DM * DM;
            bf16_t* dst = WSP(bf16_t, which == 0 ? WS_WBS : (which == 1 ? WS_WBL : WS_WO)) + ((size_t)l * DM + n0) * DM;
            tr_item(src, DM, n0, 32, which == 0 ? as_global(P.in[IN_SNW]) + l * DM : nullptr, kb * 64, dst, scr, C.lane);
        }
    }
    {
        bf16_t* LW = (bf16_t*)(C.ws + WS_LRUW);
        const float* wap = as_global(P.in[IN_WA]); const float* wxp = as_global(P.in[IN_WX]);
        for (int i = C.bid * NTHREADS + C.tid; i < 2 * 16 * 2 * 4096; i += C.G * NTHREADS) {
            const int d = i & 63, e = (i >> 6) & 63, gate = (i >> 12) & 1, lj = i >> 13;
            LW[i] = (bf16_t)f2bf((gate ? wxp : wap)[(size_t)lj * 4096 + d * 64 + e]);
        }
    }
}

__device__ __forceinline__ void phase_norm(const Ctx& C, int l, int which) {
    CParams& P = *C.P;
    const int gw = C.bid * NWAVES + C.wave, NGW = C.G * NWAVES;
    bf16_t* H = WSP(bf16_t, WS_B0);
    const float* lw = as_global(P.in[which ? IN_LN2 : IN_LN1]) + l * DM;
    const float* MOD = WSP(float, WS_MOD);
    const float* xpp = as_global(P.in[IN_XP]); const float* xsp = as_global(P.in[IN_XS]);
#define NORM_SRC(row_) ((which == 0 && l == 0) ? ((row_) < TP ? xpp + (size_t)(row_) * DM : xsp + (size_t)((row_) - TP) * DM) : C.out + (size_t)(row_) * DM)
    const int c0 = 8 * C.lane;
    f32x4 lwv[4];
#pragma unroll
    for (int j = 0; j < 4; ++j) lwv[j] = *(const f32x4*)(lw + (j >> 1) * 512 + c0 + (j & 1) * 4);
    f32x4 nv[4];
    { const float* xr = NORM_SRC(min(gw, TT - 1)) + c0;
#pragma unroll
      for (int j = 0; j < 4; ++j) nv[j] = *(const f32x4*)(xr + (j >> 1) * 512 + (j & 1) * 4); }
    for (int row = gw; row < TT; row += NGW) {
        f32x4 v[4]; float s = 0.f;
#pragma unroll
        for (int j = 0; j < 4; ++j) { v[j] = nv[j]; s += (v[j][0] * v[j][0] + v[j][1] * v[j][1]) + (v[j][2] * v[j][2] + v[j][3] * v[j][3]); }
        { const float* xr = NORM_SRC(min(row + NGW, TT - 1)) + c0;
#pragma unroll
          for (int j = 0; j < 4; ++j) nv[j] = *(const f32x4*)(xr + (j >> 1) * 512 + (j & 1) * 4); }
        const float rstd = rsqrtf(wave_sum(s) * (1.f / DM) + EPS);
        const float* md = MOD + ((size_t)l * NBT + row_batch(row)) * 6144 + (which ? 3072 : 0) + c0;
        f32x4 y[4];
#pragma unroll
        for (int j = 0; j < 4; ++j) { const int co = (j >> 1) * 512 + (j & 1) * 4;
            const f32x4 sh = *(const f32x4*)(md + co), scv = *(const f32x4*)(md + 1024 + co);
            y[j] = (v[j] * rstd * lwv[j]) * (scv + 1.0f) + sh; }
        bf16_t* hp = H + (size_t)row * DM + c0;
        *(u32x4*)hp = (u32x4){pk2(y[0][0], y[0][1]), pk2(y[0][2], y[0][3]), pk2(y[1][0], y[1][1]), pk2(y[1][2], y[1][3])};
        *(u32x4*)(hp + 512) = (u32x4){pk2(y[2][0], y[2][1]), pk2(y[2][2], y[2][3]), pk2(y[3][0], y[3][1]), pk2(y[3][2], y[3][3])};
    }
#undef NORM_SRC
}

struct Epi1 {
    static constexpr bool TILE = false;
    __device__ __forceinline__ bool idem() const { return true; }
    static constexpr int NK = 5; static constexpr bool PERM = true;
    bf16_t *Z, *XBC, *LX, *LY; float* DT; const float* dtb;
    __device__ __forceinline__ int kind(int pn) const { return pn < 4 ? 0 : (pn < 9 ? 1 : (pn < 13 ? 2 : (pn < 17 ? 3 : 4))); }
    template <int KD> __device__ __forceinline__ void apply(int, int row, int col, f32x4 v) const {
        if constexpr (KD == 0) { *(u32x2*)(Z + (size_t)row * DM + col) = (u32x2){pk2(siluf_(v[0]), siluf_(v[1])), pk2(siluf_(v[2]), siluf_(v[3]))}; }
        else if constexpr (KD == 1) { *(u32x2*)(XBC + (size_t)row * 1280 + (col - 1024)) = (u32x2){pk2(v[0], v[1]), pk2(v[2], v[3])}; }
        else if constexpr (KD == 2) { *(u32x2*)(LX + (size_t)row * DM + (col - 2304)) = (u32x2){pk2(v[0], v[1]), pk2(v[2], v[3])}; }
        else if constexpr (KD == 3) { *(u32x2*)(LY + (size_t)row * DM + (col - 3328)) = (u32x2){pk2(geluf_(v[0]), geluf_(v[1])), pk2(geluf_(v[2]), geluf_(v[3]))}; }
        else { if (col < 4368) { const int c = col - 4352; const f32x4 b = *(const f32x4*)(dtb + c);
            *(f32x4*)(DT + (size_t)row * 16 + c) = (f32x4){softplusf_(v[0] + b[0]), softplusf_(v[1] + b[1]), softplusf_(v[2] + b[2]), softplusf_(v[3] + b[3])}; } }
    }
    template <int KD> static constexpr bool swap_kind() { return KD < 4; }
    template <int KD> __device__ __forceinline__ u32x4 pack8(f32x4 a, f32x4 b) const {
        if constexpr (KD == 0) return (u32x4){pk2(siluf_(a[0]), siluf_(a[1])), pk2(siluf_(a[2]), siluf_(a[3])), pk2(siluf_(b[0]), siluf_(b[1])), pk2(siluf_(b[2]), siluf_(b[3]))};
        else if constexpr (KD == 3) return (u32x4){pk2(geluf_(a[0]), geluf_(a[1])), pk2(geluf_(a[2]), geluf_(a[3])), pk2(geluf_(b[0]), geluf_(b[1])), pk2(geluf_(b[2]), geluf_(b[3]))};
        else return (u32x4){pk2(a[0], a[1]), pk2(a[2], a[3]), pk2(b[0], b[1]), pk2(b[2], b[3])};
    }
    template <int KD> __device__ __forceinline__ void store8(int row, int col, u32x4 v) const {
        if constexpr (KD == 0) *(u32x4*)(Z + (size_t)row * DM + col) = v;
        else if constexpr (KD == 1) *(u32x4*)(XBC + (size_t)row * 1280 + (col - 1024)) = v;
        else if constexpr (KD == 2) *(u32x4*)(LX + (size_t)row * DM + (col - 2304)) = v;
        else *(u32x4*)(LY + (size_t)row * DM + (col - 3328)) = v;
    }
    template <int KD> __device__ __forceinline__ void apply8(int w, int row, int col, f32x4 a, f32x4 b) const {
        if constexpr (KD == 0) { *(u32x4*)(Z + (size_t)row * DM + col) = (u32x4){pk2(siluf_(a[0]), siluf_(a[1])), pk2(siluf_(a[2]), siluf_(a[3])), pk2(siluf_(b[0]), siluf_(b[1])), pk2(siluf_(b[2]), siluf_(b[3]))}; }
        else if constexpr (KD == 1) { *(u32x4*)(XBC + (size_t)row * 1280 + (col - 1024)) = (u32x4){pk2(a[0], a[1]), pk2(a[2], a[3]), pk2(b[0], b[1]), pk2(b[2], b[3])}; }
        else if constexpr (KD == 2) { *(u32x4*)(LX + (size_t)row * DM + (col - 2304)) = (u32x4){pk2(a[0], a[1]), pk2(a[2], a[3]), pk2(b[0], b[1]), pk2(b[2], b[3])}; }
        else if constexpr (KD == 3) { *(u32x4*)(LY + (size_t)row * DM + (col - 3328)) = (u32x4){pk2(geluf_(a[0]), geluf_(a[1])), pk2(geluf_(a[2]), geluf_(a[3])), pk2(geluf_(b[0]), geluf_(b[1])), pk2(geluf_(b[2]), geluf_(b[3]))}; }
        else { apply<KD>(w, row, col, a); apply<KD>(w, row, col + 4, b); }
    }
};
struct Epi2 {
    static constexpr bool TILE = false;
    __device__ __forceinline__ bool idem() const { return true; }
    static constexpr int NK = 2; static constexpr bool PERM = true;
    bf16_t *GS, *GL;
    __device__ __forceinline__ int kind(int pn) const { return pn < 4 ? 0 : 1; }
    template <int KD> __device__ __forceinline__ void apply(int, int row, int col, f32x4 v) const {
        bf16_t* d = (KD == 0 ? GS + (size_t)row * DM + col : GL + (size_t)row * DM + (col - 1024));
        *(u32x2*)d = (u32x2){pk2(sigmoidf_(v[0]), sigmoidf_(v[1])), pk2(sigmoidf_(v[2]), sigmoidf_(v[3]))};
    }
    template <int KD> static constexpr bool swap_kind() { return true; }
    template <int KD> __device__ __forceinline__ u32x4 pack8(f32x4 a, f32x4 b) const {
        return (u32x4){pk2(sigmoidf_(a[0]), sigmoidf_(a[1])), pk2(sigmoidf_(a[2]), sigmoidf_(a[3])), pk2(sigmoidf_(b[0]), sigmoidf_(b[1])), pk2(sigmoidf_(b[2]), sigmoidf_(b[3]))}; }
    template <int KD> __device__ __forceinline__ void store8(int row, int col, u32x4 v) const { *(u32x4*)(KD == 0 ? GS + (size_t)row * DM + col : GL + (size_t)row * DM + (col - 1024)) = v; }
    template <int KD> __device__ __forceinline__ void apply8(int, int row, int col, f32x4 a, f32x4 b) const {
        bf16_t* d = (KD == 0 ? GS + (size_t)row * DM + col : GL + (size_t)row * DM + (col - 1024));
        *(u32x4*)d = (u32x4){pk2(sigmoidf_(a[0]), sigmoidf_(a[1])), pk2(sigmoidf_(a[2]), sigmoidf_(a[3])), pk2(sigmoidf_(b[0]), sigmoidf_(b[1])), pk2(sigmoidf_(b[2]), sigmoidf_(b[3]))};
    }
};
struct Epi3 {
    static constexpr bool TILE = false;
    __device__ __forceinline__ bool idem() const { return true; }
    static constexpr int NK = 1; static constexpr bool PERM = true;
    template <int KD> static constexpr bool swap_kind() { return false; }
    const bf16_t *GS, *GL; const float* SSQ; bf16_t* MG;
    __device__ __forceinline__ int kind(int) const { return 0; }
    __device__ __forceinline__ float rstd_of(int row) const { const f32x4* q = (const f32x4*)(SSQ + (size_t)row * 16); const f32x4 a = q[0] + q[1] + q[2] + q[3];
        return rsqrtf(((a[0] + a[1]) + (a[2] + a[3])) * (1.f / DM) + EPS); }
    template <int KD> __device__ __forceinline__ void apply(int w, int row, int col, f32x4 v) const {
        u32x2* m = (u32x2*)(MG + (size_t)row * DM + col);
        if (w == 0) { const float rstd = rstd_of(row);
            const u32x2 g = *(const u32x2*)(GS + (size_t)row * DM + col);
            *m = (u32x2){pk2(bflo(g.x) * rstd * v[0], bfhi(g.x) * rstd * v[1]), pk2(bflo(g.y) * rstd * v[2], bfhi(g.y) * rstd * v[3])};
        } else {
            const u32x2 g = *(const u32x2*)(GL + (size_t)row * DM + col); const u32x2 p = *m;
            *m = (u32x2){pk2(bflo(p.x) + bflo(g.x) * v[0], bfhi(p.x) + bfhi(g.x) * v[1]), pk2(bflo(p.y) + bflo(g.y) * v[2], bfhi(p.y) + bfhi(g.y) * v[3])};
        }
    }
    template <int KD> __device__ __forceinline__ void apply8(int w, int row, int col, f32x4 a, f32x4 b) const {
        u32x4* m = (u32x4*)(MG + (size_t)row * DM + col);
        if (w == 0) { const float rstd = rstd_of(row);
            const u32x4 g = *(const u32x4*)(GS + (size_t)row * DM + col);
            *m = (u32x4){pk2(bflo(g.x) * rstd * a[0], bfhi(g.x) * rstd * a[1]), pk2(bflo(g.y) * rstd * a[2], bfhi(g.y) * rstd * a[3]), pk2(bflo(g.z) * rstd * b[0], bfhi(g.z) * rstd * b[1]), pk2(bflo(g.w) * rstd * b[2], bfhi(g.w) * rstd * b[3])};
        } else {
            const u32x4 g = *(const u32x4*)(GL + (size_t)row * DM + col); const u32x4 p = *m;
            *m = (u32x4){pk2(bflo(p.x) + bflo(g.x) * a[0], bfhi(p.x) + bfhi(g.x) * a[1]), pk2(bflo(p.y) + bflo(g.y) * a[2], bfhi(p.y) + bfhi(g.y) * a[3]),
                         pk2(bflo(p.z) + bflo(g.z) * b[0], bfhi(p.z) + bfhi(g.z) * b[1]), pk2(bflo(p.w) + bflo(g.w) * b[2], bfhi(p.w) + bfhi(g.w) * b[3])};
        }
    }
};
struct Epi4 {
    static constexpr bool PERM = true;
    template <int KD> static constexpr bool swap_kind() { return false; }
    __device__ __forceinline__ bool idem() const { return layer == 0; }
    static constexpr int NK = 1;
    const float *xp, *xs; float* XR; const float* MODl; int layer;
    __device__ __forceinline__ int kind(int) const { return 0; }
    template <int KD> __device__ __forceinline__ void apply(int, int row, int col, f32x4 v) const {
        if (row >= TT) return;
        const float* src = layer == 0 ? (row < TP ? xp + (size_t)row * DM : xs + (size_t)(row - TP) * DM) : XR + (size_t)row * DM;
        const f32x4 x = *(const f32x4*)(src + col), g = *(const f32x4*)(MODl + (size_t)row_batch(row) * 6144 + 2048 + col);
        *(f32x4*)(XR + (size_t)row * DM + col) = x + g * v;
    }
    static constexpr bool TILE = true;
    __device__ __forceinline__ void tile(const f32x4 (&acc)[2][2][4][2], int pm, int pn, int wr, int wc, int fr, int fq) const {
        const int colb = pn * 256 + wc * 64 + 8 * fq; const float* gp = MODl + (size_t)(pm >> 3) * 6144 + 2048 + colb;
        const f32x4 g00 = *(const f32x4*)gp, g01 = *(const f32x4*)(gp + 4), g10 = *(const f32x4*)(gp + 32), g11 = *(const f32x4*)(gp + 36);
        const float* sb = (layer == 0 ? xp : XR) + colb; float* db = XR + colb;
#pragma unroll
        for (int ai = 0; ai < 2; ++ai)
#pragma unroll
            for (int m = 0; m < 4; ++m) { const size_t ro = (size_t)(pm * 256 + ai * 128 + wr * 64 + m * 16 + fr) * DM;
                const f32x4 x00 = *(const f32x4*)(sb + ro), x01 = *(const f32x4*)(sb + ro + 4), x10 = *(const f32x4*)(sb + ro + 32), x11 = *(const f32x4*)(sb + ro + 36);
                *(f32x4*)(db + ro) = x00 + g00 * acc[ai][0][m][0]; *(f32x4*)(db + ro + 4) = x01 + g01 * acc[ai][0][m][1];
                *(f32x4*)(db + ro + 32) = x10 + g10 * acc[ai][1][m][0]; *(f32x4*)(db + ro + 36) = x11 + g11 * acc[ai][1][m][1]; }
    }
    template <int KD> __device__ __forceinline__ void apply8(int, int row, int col, f32x4 a, f32x4 b) const {
        const float* src = (layer == 0 ? xp : XR) + (size_t)row * DM + col; const float* gp = MODl + (size_t)(row >> 11) * 6144 + 2048 + col;
        const f32x4 x0 = *(const f32x4*)src, x1 = *(const f32x4*)(src + 4), g0 = *(const f32x4*)gp, g1 = *(const f32x4*)(gp + 4);
        float* d = XR + (size_t)row * DM + col; *(f32x4*)d = x0 + g0 * a; *(f32x4*)(d + 4) = x1 + g1 * b;
    }
};
struct Epi5 {
    static constexpr bool TILE = false;
    static constexpr bool PERM = true;
    __device__ __forceinline__ bool idem() const { return true; }
    static constexpr int NK = 1;
    bf16_t* SC;
    __device__ __forceinline__ int kind(int) const { return 0; }
    template <int KD> __device__ __forceinline__ void apply(int, int row, int col, f32x4 v) const { *(u32x2*)(SC + (size_t)row * 2048 + col) = (u32x2){pk2(v[0], v[1]), pk2(v[2], v[3])}; }
    template <int KD> static constexpr bool swap_kind() { return true; }
    template <int KD> __device__ __forceinline__ u32x4 pack8(f32x4 a, f32x4 b) const { return (u32x4){pk2(a[0], a[1]), pk2(a[2], a[3]), pk2(b[0], b[1]), pk2(b[2], b[3])}; }
    template <int KD> __device__ __forceinline__ void store8(int row, int col, u32x4 v) const { *(u32x4*)(SC + (size_t)row * 2048 + col) = v; }
    template <int KD> __device__ __forceinline__ void apply8(int, int row, int col, f32x4 a, f32x4 b) const { *(u32x4*)(SC + (size_t)row * 2048 + col) = (u32x4){pk2(a[0], a[1]), pk2(a[2], a[3]), pk2(b[0], b[1]), pk2(b[2], b[3])}; }
};

namespace pg8 {
constexpr int BM = 256, BK = 64, HALF = 128, HTB = HALF * BK * 2, STAGE_BYTES = 8 * HTB, NXCD = 8, WGM = 8;
__host__ __device__ __forceinline__ int lds_byte(int r, int c) { const int st = (r >> 4) * 2 + (c >> 5), rr = r & 15, cc = c & 31, ob = rr * 64 + cc * 2; return st * 1024 + (ob ^ (((ob >> 9) & 1) << 5)); }
__host__ __device__ __forceinline__ void stage_rc(int b, int& R, int& C) { const int st = b / 1024, sb = b % 1024, swz = sb ^ (((sb >> 9) & 1) << 5); R = (st >> 1) * 16 + swz / 64; C = (st & 1) * 32 + (swz % 64) / 2; }
struct Unit { int pm, pn, w; };
struct Sched {
    int nM, nN, nW, nwg, G, c; const char *A0, *B0, *A1, *B1;
    __device__ __forceinline__ bool next(int i, Unit& u) const {
        const int ti = i / nW; u.w = i - ti * nW;
        const long L = (long)ti * G + c; if (L >= nwg) return false;
        int wgid = (int)L; { const int q = nwg / NXCD, r = nwg % NXCD, xcd = wgid % NXCD, off = wgid / NXCD; wgid = (xcd < r ? xcd * (q + 1) : r * (q + 1) + (xcd - r) * q) + off; }
        const int nig = WGM * nN, gid = wgid / nig, fm = gid * WGM, gsz = (nM - fm) < WGM ? (nM - fm) : WGM;
        u.pm = fm + ((wgid % nig) % gsz); u.pn = (wgid % nig) / gsz; return true;
    }
};
__host__ __device__ __forceinline__ int perm32(int rho) { const int n = rho >> 4, i = rho & 15; return 8 * (i >> 2) + 4 * n + (i & 3); }
template <int KD, class Epi>
__device__ __forceinline__ void epi_tile(const Epi& E, const f32x4 (&acc)[2][2][4][2], const Unit& u, int wr, int wc, int fr, int fq) {
    if constexpr (Epi::PERM && Epi::template swap_kind<KD>()) {
        const bool lo = fr < 8; const int colx = u.pn * BM + wc * 64 + (lo ? 0 : 32) + 8 * fq;
#pragma unroll
        for (int ai = 0; ai < 2; ++ai)
#pragma unroll
            for (int m = 0; m < 4; ++m) { const int rowb = u.pm * BM + ai * HALF + wr * 64 + m * 16 + (fr & 7);
                const u32x4 p0 = E.template pack8<KD>(acc[ai][0][m][0], acc[ai][0][m][1]), p1 = E.template pack8<KD>(acc[ai][1][m][0], acc[ai][1][m][1]);
                u32x4 rcv, sa, sb;
#pragma unroll
                for (int q = 0; q < 4; ++q) { const unsigned snd = lo ? p1[q] : p0[q]; rcv[q] = (unsigned)__builtin_amdgcn_update_dpp(0, (int)snd, 0x128, 0xf, 0xf, true);
                    sa[q] = lo ? p0[q] : rcv[q]; sb[q] = lo ? rcv[q] : p1[q]; }
                E.template store8<KD>(rowb, colx, sa); E.template store8<KD>(rowb + 8, colx, sb); }
    } else {
#pragma unroll
    for (int ai = 0; ai < 2; ++ai)
#pragma unroll
        for (int m = 0; m < 4; ++m) { const int row = u.pm * BM + ai * HALF + wr * 64 + m * 16 + fr;
#pragma unroll
            for (int bj = 0; bj < 2; ++bj) {
                if constexpr (Epi::PERM) E.template apply8<KD>(u.w, row, u.pn * BM + wc * 64 + bj * 32 + 8 * fq, acc[ai][bj][m][0], acc[ai][bj][m][1]);
                else {
#pragma unroll
                    for (int n = 0; n < 2; ++n) E.template apply<KD>(u.w, row, u.pn * BM + bj * HALF + wc * 32 + n * 16 + 4 * fq, acc[ai][bj][m][n]); } } }
    }
}
template <class Epi>
__device__ __forceinline__ void epi_apply(const Epi& E, const f32x4 (&acc)[2][2][4][2], const Unit& u, int wr, int wc, int fr, int fq) {
    if constexpr (Epi::TILE) E.tile(acc, u.pm, u.pn, wr, wc, fr, fq);
    else if constexpr (Epi::NK == 1) epi_tile<0>(E, acc, u, wr, wc, fr, fq);
    else { const int kd = E.kind(u.pn);
        if (kd == 0) epi_tile<0>(E, acc, u, wr, wc, fr, fq);
        else if (kd == 1) epi_tile<1>(E, acc, u, wr, wc, fr, fq);
        else if constexpr (Epi::NK > 2) { if (kd == 2) epi_tile<2>(E, acc, u, wr, wc, fr, fq); else if (kd == 3) epi_tile<3>(E, acc, u, wr, wc, fr, fq); else epi_tile<4>(E, acc, u, wr, wc, fr, fq); } }
}
template <class Epi, bool ALIGN_EPI = true, bool SP2 = true>
__device__ __forceinline__ void gemm_phase(LAS unsigned char* lds, int tid, int K, const Sched& S, const Epi& E, bool dry = false) {
    const int wid = __builtin_amdgcn_readfirstlane(tid >> 6), lane = tid & 63, wr = wid >> 2, wc = wid & 3, fr = lane & 15, fq = lane >> 4;
    const int nt = K / BK;
    unsigned voffA[2], voffB[2];
#pragma unroll
    for (int i = 0; i < 2; ++i) { int R, Cc; stage_rc(tid * 16 + i * 8192, R, Cc); const int Rb = Epi::PERM ? (64 * (R >> 5) + perm32(R & 31)) : R;
        voffA[i] = (unsigned)(R * K + Cc) * 2u; voffB[i] = (unsigned)(Rb * K + Cc) * 2u; }
    const size_t kstep = (size_t)(BK * 2);
    const size_t hstep = (size_t)HALF * K * 2;
    const size_t tstep = 2 * hstep;
    const size_t hstepB = Epi::PERM ? (size_t)32 * K * 2 : hstep;
    const unsigned ldsw = (unsigned)wid * 1024u;
    const int aoff = lds_byte(wr * 64 + fr, fq * 8), boff = lds_byte(wc * 32 + fr, fq * 8);
#define PG8_SA(b, h) (((b) * 2 + (h)) * HTB)
#define PG8_SB(b, h) ((4 + (b) * 2 + (h)) * HTB)
#define PG8_STAGE(bufoff, gbase, voff) do { _Pragma("unroll") for (int _i = 0; _i < 2; ++_i) \
        __builtin_amdgcn_global_load_lds((const unsigned*)((const char*)(gbase) + (voff)[_i]), (LAS unsigned*)(lds + (bufoff) + ldsw + _i * 8192), 16, 0, 0); } while (0)
#define PG8_LDA(dst, b, h) do { _Pragma("unroll") for (int m = 0; m < 4; ++m) _Pragma("unroll") for (int k = 0; k < 2; ++k) dst[m][k] = *(const LAS bf16x8*)(lds + PG8_SA(b, h) + aoff + m * 2048 + k * 1024); } while (0)
#define PG8_LDB(dst, b, h) do { _Pragma("unroll") for (int n = 0; n < 2; ++n) _Pragma("unroll") for (int k = 0; k < 2; ++k) dst[n][k] = *(const LAS bf16x8*)(lds + PG8_SB(b, h) + boff + n * 2048 + k * 1024); } while (0)
#define PG8_MMA(ai, bj, At, Bt) do { __builtin_amdgcn_s_setprio(1); _Pragma("unroll") for (int m = 0; m < 4; ++m) _Pragma("unroll") for (int n = 0; n < 2; ++n) _Pragma("unroll") for (int k = 0; k < 2; ++k) \
        acc[ai][bj][m][n] = __builtin_amdgcn_mfma_f32_16x16x32_bf16(Bt[n][k], At[m][k], acc[ai][bj][m][n], 0, 0, 0); __builtin_amdgcn_s_setprio(0); } while (0)
#define PG8_WAIT_V(n) asm volatile("s_waitcnt vmcnt(" #n ")" ::: "memory")
#define PG8_WAIT_L(n) asm volatile("s_waitcnt lgkmcnt(" #n ")" ::: "memory")
#define PG8_BAR __builtin_amdgcn_s_barrier()
#define PG8_SCHED __builtin_amdgcn_sched_barrier(0)
    Unit cur, nxt; int ui = 0;
    if (!S.next(0, cur)) return;
    f32x4 acc[2][2][4][2];
#pragma unroll
    for (int a = 0; a < 2; ++a)
#pragma unroll
        for (int b = 0; b < 2; ++b)
#pragma unroll
            for (int m = 0; m < 4; ++m)
#pragma unroll
                for (int n = 0; n < 2; ++n) acc[a][b][m][n] = (f32x4){0.f, 0.f, 0.f, 0.f};
    bf16x8 At[4][2], B0[2][2], B1[2][2];
    const char* cA = (cur.w ? S.A1 : S.A0) + (size_t)cur.pm * tstep; const char* cB = (cur.w ? S.B1 : S.B0) + (size_t)cur.pn * tstep;
    if constexpr (SP2) {
        PG8_STAGE(PG8_SB(0, 0), cB, voffB); PG8_STAGE(PG8_SB(0, 1), cB + hstepB, voffB); PG8_STAGE(PG8_SA(0, 0), cA, voffA); PG8_STAGE(PG8_SA(0, 1), cA + hstep, voffA);
        if (wr == 1) PG8_BAR;
        PG8_WAIT_V(2); PG8_BAR;
        PG8_STAGE(PG8_SB(1, 0), cB + kstep, voffB); PG8_STAGE(PG8_SA(1, 0), cA + kstep, voffA); PG8_STAGE(PG8_SB(1, 1), cB + hstepB + kstep, voffB);
        PG8_WAIT_V(6); PG8_BAR;
    } else {
        PG8_STAGE(PG8_SB(0, 0), cB, voffB); PG8_STAGE(PG8_SA(0, 0), cA, voffA); PG8_STAGE(PG8_SB(0, 1), cB + hstepB, voffB); PG8_STAGE(PG8_SA(0, 1), cA + hstep, voffA);
        if (wr == 1) PG8_BAR;
        PG8_WAIT_V(4); PG8_BAR;
        PG8_STAGE(PG8_SB(1, 0), cB + kstep, voffB); PG8_STAGE(PG8_SA(1, 0), cA + kstep, voffA); PG8_STAGE(PG8_SB(1, 1), cB + hstepB + kstep, voffB);
        PG8_WAIT_V(6); PG8_BAR;
    }
    for (;;) {
        const bool has_next = S.next(ui + 1, nxt);
        const char* nA = has_next ? (nxt.w ? S.A1 : S.A0) + (size_t)nxt.pm * tstep : cA; const char* nB = has_next ? (nxt.w ? S.B1 : S.B0) + (size_t)nxt.pn * tstep : cB;
        for (int t = 0; t < nt; t += 2) {
            const bool last = (t == nt - 2);
            const char* a1 = cA + (size_t)(t + 1) * kstep;
            const char* a2 = last ? nA : cA + (size_t)(t + 2) * kstep; const char* b2 = last ? nB : cB + (size_t)(t + 2) * kstep;
            const char* a3 = a2 + kstep; const char* b3 = b2 + kstep;
            if constexpr (SP2) {
            PG8_LDB(B0, 0, 0); PG8_LDB(B1, 0, 1); PG8_SCHED; PG8_LDA(At, 0, 0); PG8_STAGE(PG8_SA(1, 1), a1 + hstep, voffA);
            PG8_WAIT_V(8); PG8_WAIT_L(0); PG8_BAR; PG8_MMA(0, 0, At, B0); PG8_MMA(0, 1, At, B1); PG8_BAR; PG8_SCHED;
            PG8_LDA(At, 0, 1); PG8_STAGE(PG8_SB(0, 0), b2, voffB); PG8_STAGE(PG8_SB(0, 1), b2 + hstepB, voffB); PG8_STAGE(PG8_SA(0, 0), a2, voffA);
            PG8_WAIT_V(8); PG8_WAIT_L(0); PG8_BAR; PG8_MMA(1, 0, At, B0); PG8_MMA(1, 1, At, B1); PG8_BAR; PG8_SCHED;
            PG8_LDB(B0, 1, 0); PG8_LDB(B1, 1, 1); PG8_SCHED; PG8_LDA(At, 1, 0); PG8_STAGE(PG8_SA(0, 1), a2 + hstep, voffA);
            PG8_WAIT_V(8); PG8_WAIT_L(0); PG8_BAR; PG8_MMA(0, 0, At, B0); PG8_MMA(0, 1, At, B1); PG8_BAR; PG8_SCHED;
            PG8_LDA(At, 1, 1); PG8_STAGE(PG8_SB(1, 0), b3, voffB); PG8_STAGE(PG8_SB(1, 1), b3 + hstepB, voffB); PG8_STAGE(PG8_SA(1, 0), a3, voffA);
            PG8_WAIT_V(8); PG8_WAIT_L(0); PG8_BAR; PG8_MMA(1, 0, At, B0); PG8_MMA(1, 1, At, B1); PG8_BAR; PG8_SCHED;
            } else {
            PG8_LDB(B0, 0, 0); PG8_SCHED; PG8_LDA(At, 0, 0); PG8_STAGE(PG8_SA(1, 1), a1 + hstep, voffA);
            PG8_WAIT_L(8); PG8_BAR; PG8_WAIT_L(0); PG8_MMA(0, 0, At, B0); PG8_BAR; PG8_SCHED;
            PG8_LDB(B1, 0, 1); PG8_STAGE(PG8_SB(0, 0), b2, voffB);
            PG8_BAR; PG8_WAIT_L(0); PG8_MMA(0, 1, At, B1); PG8_BAR;
            PG8_LDA(At, 0, 1); PG8_STAGE(PG8_SA(0, 0), a2, voffA);
            PG8_BAR; PG8_WAIT_L(0); PG8_MMA(1, 0, At, B0); PG8_BAR; PG8_SCHED;
            PG8_STAGE(PG8_SB(0, 1), b2 + hstepB, voffB);
            PG8_WAIT_V(6); PG8_BAR; PG8_MMA(1, 1, At, B1); PG8_BAR;
            PG8_LDB(B0, 1, 0); PG8_SCHED; PG8_LDA(At, 1, 0); PG8_STAGE(PG8_SA(0, 1), a2 + hstep, voffA);
            PG8_WAIT_L(8); PG8_BAR; PG8_WAIT_L(0); PG8_MMA(0, 0, At, B0); PG8_BAR; PG8_SCHED;
            PG8_LDB(B1, 1, 1); PG8_STAGE(PG8_SB(1, 0), b3, voffB);
            PG8_BAR; PG8_WAIT_L(0); PG8_MMA(0, 1, At, B1); PG8_BAR;
            PG8_LDA(At, 1, 1); PG8_STAGE(PG8_SA(1, 0), a3, voffA);
            PG8_BAR; PG8_WAIT_L(0); PG8_MMA(1, 0, At, B0); PG8_BAR; PG8_SCHED;
            PG8_STAGE(PG8_SB(1, 1), b3 + hstepB, voffB);
            PG8_WAIT_V(6); PG8_BAR; PG8_MMA(1, 1, At, B1); PG8_BAR;
            }
        }
        if constexpr (ALIGN_EPI) { if (wr == 0) PG8_BAR; }
#ifdef PROBE_K
        if (dry) {
#pragma unroll
            for (int a = 0; a < 2; ++a)
#pragma unroll
                for (int b = 0; b < 2; ++b)
#pragma unroll
                    for (int m = 0; m < 4; ++m)
#pragma unroll
                        for (int n = 0; n < 2; ++n) asm volatile("" :: "v"(acc[a][b][m][n]));
        } else
#endif
        epi_apply(E, acc, cur, wr, wc, fr, fq);
        if (!has_next) break;
#pragma unroll
        for (int a = 0; a < 2; ++a)
#pragma unroll
            for (int b = 0; b < 2; ++b)
#pragma unroll
                for (int m = 0; m < 4; ++m)
#pragma unroll
                    for (int n = 0; n < 2; ++n) acc[a][b][m][n] = (f32x4){0.f, 0.f, 0.f, 0.f};
        cur = nxt; cA = nA; cB = nB; ++ui;
        if constexpr (ALIGN_EPI) { if (wr == 1) PG8_BAR; }
    }
    PG8_WAIT_V(0);
    if constexpr (!ALIGN_EPI) { if (wr == 0) PG8_BAR; }
    PG8_BAR;
#undef PG8_SA
#undef PG8_SB
#undef PG8_STAGE
#undef PG8_LDA
#undef PG8_LDB
#undef PG8_MMA
#undef PG8_WAIT_V
#undef PG8_WAIT_L
#undef PG8_BAR
#undef PG8_SCHED
}
}
template <int KD, class Epi>
__device__ __forceinline__ void sample_tile(const Ctx& C, const bf16_t* A0, const bf16_t* B0, const bf16_t* A1, const bf16_t* B1, int rb, int cb, const Epi& E) {
    const int fr = C.lane & 15, fq = C.lane >> 4;
    for (int w = 0; w < (A1 ? 2 : 1); ++w) {
        const bf16_t* ap = (w ? A1 : A0) + (size_t)(TP + 16 * rb + fr) * DM + 8 * fq; const bf16_t* bp = (w ? B1 : B0) + (size_t)(16 * cb + fr) * DM + 8 * fq;
        f32x4 acc = (f32x4){0.f, 0.f, 0.f, 0.f};
#pragma unroll 16
        for (int ks = 0; ks < DM / 32; ++ks) { const bf16x8 a = *(const bf16x8*)(ap + 32 * ks), b = *(const bf16x8*)(bp + 32 * ks); acc = __builtin_amdgcn_mfma_f32_16x16x32_bf16(b, a, acc, 0, 0, 0); }
        E.template apply<KD>(w, TP + 16 * rb + fr, 16 * cb + 4 * fq, acc);
    }
}
template <class Epi>
__device__ __forceinline__ void gemm_sample(const Ctx& C, const bf16_t* A0, const bf16_t* B0, const bf16_t* A1, const bf16_t* B1, int N, const Epi& E) {
    const int gw = C.bid * NWAVES + C.wave, NGW = C.G * NWAVES, ncb = N / 16;
    for (int it = gw; it < 8 * ncb; it += NGW) {
        const int cb = it >> 3, rb = it & 7; const int kd = E.kind(cb >> 4);
        if constexpr (Epi::NK == 1) sample_tile<0>(C, A0, B0, A1, B1, rb, cb, E);
        else { if (kd == 0) sample_tile<0>(C, A0, B0, A1, B1, rb, cb, E); else if (kd == 1) sample_tile<1>(C, A0, B0, A1, B1, rb, cb, E);
            else if constexpr (Epi::NK > 2) { if (kd == 2) sample_tile<2>(C, A0, B0, A1, B1, rb, cb, E); else if (kd == 3) sample_tile<3>(C, A0, B0, A1, B1, rb, cb, E); else sample_tile<4>(C, A0, B0, A1, B1, rb, cb, E); } }
    }
}
template <class Epi>
__device__ __forceinline__ void gemm_run(const Ctx& C, const bf16_t* A0, const bf16_t* B0, const bf16_t* A1, const bf16_t* B1, int N, const Epi& E, bool dry = false) {
#if defined(PROBE_DRYEPI) || defined(PROBE_DRYSAMPLE)
    if (!dry)
#endif
    gemm_sample(C, A0, B0, A1, B1, N, E);
    pg8::Sched S; S.nM = TP / 256; S.nN = N / 256; S.nW = A1 ? 2 : 1; S.nwg = S.nM * S.nN; S.G = C.G; S.c = C.bid;
    S.A0 = (const char*)A0; S.B0 = (const char*)B0; S.A1 = (const char*)A1; S.B1 = (const char*)B1;
#ifdef PROBE_DRYEPI
    pg8::gemm_phase<Epi>(C.lds, C.tid, DM, S, E, dry);
#else
    pg8::gemm_phase<Epi>(C.lds, C.tid, DM, S, E);
#endif
    __syncthreads();
}

__device__ __forceinline__ unsigned cvt_pk_bf16(float lo, float hi) { unsigned r; asm volatile("v_cvt_pk_bf16_f32 %0, %1, %2" : "=v"(r) : "v"(lo), "v"(hi)); return r; }
__device__ __forceinline__ bf16x8 pack_acc(const f32x16& a, int t) {
    u32x4 w;
    if (t == 0) { w.x = cvt_pk_bf16(a[0], a[1]); w.y = cvt_pk_bf16(a[2], a[3]); w.z = cvt_pk_bf16(a[4], a[5]); w.w = cvt_pk_bf16(a[6], a[7]); }
    else { w.x = cvt_pk_bf16(a[8], a[9]); w.y = cvt_pk_bf16(a[10], a[11]); w.z = cvt_pk_bf16(a[12], a[13]); w.w = cvt_pk_bf16(a[14], a[15]); }
    return __builtin_bit_cast(bf16x8, w);
}
__device__ __forceinline__ int sig_pos(int s) { return (s & ~15) | (((s >> 2) & 1) << 3) | (((s >> 3) & 1) << 2) | (s & 3); }
constexpr int SROW = 144;

template <int WSTR>
__device__ __forceinline__ void conv8(const u32x4 (&rw)[4], const LAS float* wl, float (&v)[8]) {
    f32x4 w[5][2];
#pragma unroll
    for (int k = 0; k < 5; ++k) { w[k][0] = *(const LAS f32x4*)(wl + k * WSTR); w[k][1] = *(const LAS f32x4*)(wl + k * WSTR + 4); }
#pragma unroll
    for (int e = 0; e < 8; ++e) { const int dw = e >> 1; const bool hi = e & 1;
        float x[4];
#pragma unroll
        for (int k = 0; k < 4; ++k) { const unsigned q = dw == 0 ? rw[k].x : (dw == 1 ? rw[k].y : (dw == 2 ? rw[k].z : rw[k].w)); x[k] = hi ? bfhi(q) : bflo(q); }
        v[e] = w[4][e >> 2][e & 3] + w[0][e >> 2][e & 3] * x[0] + w[1][e >> 2][e & 3] * x[1] + w[2][e >> 2][e & 3] * x[2] + w[3][e >> 2][e & 3] * x[3]; }
}
constexpr size_t WS_CBC = WS_EI;
__device__ __forceinline__ void phase_convbc(const Ctx& C, int l) {
    CParams& P = *C.P;
    const bf16_t* XBC = WSP(bf16_t, WS_B2); bf16_t* CBC = WSP(bf16_t, WS_CBC);
    const float* cw = as_global(P.in[IN_SCW]) + (size_t)l * 4 * 1280 + 1024; const float* cbp = as_global(P.in[IN_SCB]) + (size_t)l * 1280 + 1024;
    const float* cst = as_global(P.in[IN_SSDCONV]) + (size_t)l * 8 * 3 * 1280;
    const int items = TT * 32, stride = C.G * NTHREADS;
    for (int it = C.bid * NTHREADS + C.tid; it < items; it += stride) {
        const int tok = it >> 5, cg = it & 31, ch = cg * 8;
        const bool smp = tok >= TP; const int b = smp ? (tok - TP) >> 4 : tok >> 11, t = smp ? (tok - TP) & 15 : tok & 2047, L = smp ? 16 : 2048, NB = smp ? 8 : 16;
        u32x4 rw[4];
#pragma unroll
        for (int k = 0; k < 4; ++k) { const int tr = t - 3 + k;
            if (tr >= 0) rw[k] = *(const u32x4*)(XBC + (size_t)(tok - t + tr) * 1280 + 1024 + ch);
            else if (smp) { const float* s0 = cst + ((size_t)b * 3 + (tr + 3)) * 1280 + 1024 + ch; const f32x4 a0 = *(const f32x4*)s0, a1 = *(const f32x4*)(s0 + 4);
                rw[k] = (u32x4){pk2(a0[0], a0[1]), pk2(a0[2], a0[3]), pk2(a1[0], a1[1]), pk2(a1[2], a1[3])}; }
            else rw[k] = (u32x4){0u, 0u, 0u, 0u}; }
        f32x4 w[5][2];
#pragma unroll
        for (int k = 0; k < 4; ++k) { w[k][0] = *(const f32x4*)(cw + k * 1280 + ch); w[k][1] = *(const f32x4*)(cw + k * 1280 + ch + 4); }
        w[4][0] = *(const f32x4*)(cbp + ch); w[4][1] = *(const f32x4*)(cbp + ch + 4);
        float v[8];
#pragma unroll
        for (int e = 0; e < 8; ++e) { const int dw = e >> 1; const bool hi = e & 1; float x[4];
#pragma unroll
            for (int k = 0; k < 4; ++k) { const unsigned q = dw == 0 ? rw[k].x : (dw == 1 ? rw[k].y : (dw == 2 ? rw[k].z : rw[k].w)); x[k] = hi ? bfhi(q) : bflo(q); }
            v[e] = siluf_(w[4][e >> 2][e & 3] + w[0][e >> 2][e & 3] * x[0] + w[1][e >> 2][e & 3] * x[1] + w[2][e >> 2][e & 3] * x[2] + w[3][e >> 2][e & 3] * x[3]); }
        *(u32x4*)(CBC + (size_t)tok * 256 + ch) = (u32x4){pk2(v[0], v[1]), pk2(v[2], v[3]), pk2(v[4], v[5]), pk2(v[6], v[7])};
        if (t >= L - 3) { float* co = C.out + (smp ? O_SSCONV : O_PSCONV) + ((size_t)(l * NB + b) * 3 + (t - (L - 3))) * 1280 + 1024 + ch; const u32x4 q = rw[3];
            *(f32x4*)co = (f32x4){bflo(q.x), bfhi(q.x), bflo(q.y), bfhi(q.y)}; *(f32x4*)(co + 4) = (f32x4){bflo(q.z), bfhi(q.z), bflo(q.w), bfhi(q.w)}; }
    }
}

#ifndef SCAN_SKIP
#define SCAN_SKIP 0
#endif
__device__ __forceinline__ void scan_item_fused(const Ctx& C, int l, int idx, bool dry) {
    const int skip = dry ? SCAN_SKIP : 0;
    CParams& P = *C.P; const int tid = C.tid, lane = C.lane, wave = C.wave;
    const bool smp = idx >= 256; const int ii = smp ? idx - 256 : idx; const int b = ii >> 4, head = ii & 15, g = head >> 3, j = head;
    const int tok0 = smp ? TP + b * 16 : b * 2048, L = smp ? 16 : 2048, NB = smp ? 8 : 16, nchunk = smp ? 1 : 32;
    const bf16_t* XBC = WSP(bf16_t, WS_B2); const bf16_t* CBC = WSP(bf16_t, WS_CBC); bf16_t* Z = WSP(bf16_t, WS_B1); const float* DT = WSP(float, WS_DT); float* SSQ = WSP(float, WS_SSQ);
    const float a_h = -__expf(as_global(P.in[IN_ALOG])[l * 16 + head]), Dh = as_global(P.in[IN_SSDD])[l * 16 + head];
    LAS unsigned char* bmR = C.lds; LAS unsigned char* cmR = C.lds + 9216; LAS unsigned char* xsR = C.lds + 18432; LAS unsigned char* bwR = C.lds + 30720;
    LAS float* ybuf = (LAS float*)(C.lds + 43008);
    LAS float* acum = (LAS float*)(C.lds + 59392); LAS float* dtv = acum + 64; LAS float* eac = acum + 128; LAS float* wsc = acum + 192; LAS float* misc = acum + 256; LAS float* cwl = acum + 320;
    const int t = tid >> 3, cg = tid & 7;
    const int chx = head * 64 + cg * 8, chb = 1024 + g * 64 + cg * 8, chc = 1152 + g * 64 + cg * 8;
    const float* scw = as_global(P.in[IN_SCW]) + (size_t)l * 4 * 1280; const float* scb = as_global(P.in[IN_SCB]) + (size_t)l * 1280;
    const float* scst = smp ? as_global(P.in[IN_SSDCONV]) + (size_t)(l * 8 + b) * 3 * 1280 : nullptr;
    const int qb = (wave >> 1) & 1, pb = wave & 1, r = lane & 31, hh = lane >> 5;
    f32x16 hacc[2];
#pragma unroll
    for (int nb = 0; nb < 2; ++nb)
#pragma unroll
        for (int i = 0; i < 16; ++i) hacc[nb][i] = 0.f;
    if (smp && wave < 4) {
        const float* hs = as_global(P.in[IN_SSD]) + ((size_t)((l * 8 + b) * 16 + head) * 64 + 32 * pb + r) * 64;
#pragma unroll
        for (int nb = 0; nb < 2; ++nb)
#pragma unroll
            for (int i4 = 0; i4 < 4; ++i4) { const f32x4 v = *(const f32x4*)(hs + 32 * nb + 8 * i4 + 4 * hh); hacc[nb][4 * i4] = v[0]; hacc[nb][4 * i4 + 1] = v[1]; hacc[nb][4 * i4 + 2] = v[2]; hacc[nb][4 * i4 + 3] = v[3]; }
    }
    const bf16_t* LX = WSP(bf16_t, WS_B3); bf16_t* LY = WSP(bf16_t, WS_B4);
    LAS unsigned char* LB = C.lds + 65536;
    LAS unsigned char* xcB = LB; LAS unsigned char* waT = LB + 9216; LAS unsigned char* wxT = LB + 18432;
    LAS float* xcF = (LAS float*)(LB + 27648); LAS float* aF = (LAS float*)(LB + 44032); LAS float* uF = (LAS float*)(LB + 60416); LAS float* lcwl = (LAS float*)(LB + 76800);
    const int ch0 = j * 64 + cg * 8;
    const float* lcw = as_global(P.in[IN_LCW]) + (size_t)l * 4 * DM; const float* lcb = as_global(P.in[IN_LCB]) + (size_t)l * DM;
    const float* lcst = smp ? as_global(P.in[IN_LRUCONV]) + (size_t)(l * 8 + b) * 3 * DM : nullptr;
    const int tb = qb, eb = pb, ech = j * 64 + 32 * eb + r;
    const float ba = as_global(P.in[IN_BA])[l * DM + ech], bxx = as_global(P.in[IN_BX])[l * DM + ech], sp8 = -8.0f * softplusf_(-as_global(P.in[IN_LAM])[l * DM + ech]);
    float hstate = (smp && wave == 4) ? as_global(P.in[IN_LRU])[(size_t)(l * 8 + b) * DM + j * 64 + lane] : 0.f;
    __syncthreads();
    for (int i = tid; i < 5 * 192; i += NTHREADS) { const int k = i / 192, cc = i % 192; const int ch = cc < 64 ? head * 64 + cc : (cc < 128 ? 1024 + g * 64 + (cc - 64) : 1152 + g * 64 + (cc - 128));
        cwl[i] = k < 4 ? scw[k * 1280 + ch] : scb[ch]; }
    { const u32x4* lw = (const u32x4*)(WSP(bf16_t, WS_LRUW) + (size_t)(l * 16 + j) * 8192);
      for (int i = tid; i < 1024; i += NTHREADS) { const int gate = i >> 9, e = (i >> 3) & 63, ck = i & 7; *(LAS u32x4*)((gate ? wxT : waT) + e * SROW + ck * 16) = lw[i]; } }
    for (int i = tid; i < 5 * 64; i += NTHREADS) { const int k = i >> 6, cc = i & 63; lcwl[i] = k < 4 ? lcw[k * DM + j * 64 + cc] : lcb[j * 64 + cc]; }
    u32x4 rw[4], bcv, ccv, lrw[4], zs, lyv; float dtl = 0.f;
#define RAWROW(dst, base, ld, ch, cstp, tr) { if ((tr) >= 0) dst = ((tr) < L) ? *(const u32x4*)((base) + (size_t)(tok0 + (tr)) * (ld) + (ch)) : (u32x4){0u, 0u, 0u, 0u}; \
        else if (smp) { const float* s0_ = (cstp) + (size_t)((tr) + 3) * (ld) + (ch); const f32x4 a0_ = *(const f32x4*)s0_, a1_ = *(const f32x4*)(s0_ + 4); \
            dst = (u32x4){pk2(a0_[0], a0_[1]), pk2(a0_[2], a0_[3]), pk2(a1_[0], a1_[1]), pk2(a1_[2], a1_[3])}; } else dst = (u32x4){0u, 0u, 0u, 0u}; }
#define SSD_LOAD(c_) { const int tg_ = (c_) * 64 + t; _Pragma("unroll") for (int k = 0; k < 4; ++k) { RAWROW(rw[k], XBC, 1280, chx, scst, tg_ - 3 + k) } \
        const bool v_ = tg_ < L; bcv = v_ ? *(const u32x4*)(CBC + (size_t)(tok0 + tg_) * 256 + g * 64 + cg * 8) : (u32x4){0u, 0u, 0u, 0u}; ccv = v_ ? *(const u32x4*)(CBC + (size_t)(tok0 + tg_) * 256 + 128 + g * 64 + cg * 8) : (u32x4){0u, 0u, 0u, 0u}; \
        }
#define LRU_LOAD(c_) { const int tg_ = (c_) * 64 + t; _Pragma("unroll") for (int k = 0; k < 4; ++k) { RAWROW(lrw[k], LX, DM, ch0, lcst, tg_ - 3 + k) } }
#define TAIL_LOAD(c_) { const int tg_ = (c_) * 64 + t; const bool v_ = tg_ < L; zs = v_ ? *(const u32x4*)(Z + (size_t)(tok0 + tg_) * DM + chx) : (u32x4){0u, 0u, 0u, 0u}; lyv = v_ ? *(const u32x4*)(LY + (size_t)(tok0 + tg_) * DM + ch0) : (u32x4){0u, 0u, 0u, 0u}; }
    SSD_LOAD(0) LRU_LOAD(0) TAIL_LOAD(0)
#define RAWROW_N(dst, base, ld, ch, tr) { const int trc_ = min((tr), L - 1); const u32x4 v__ = *(const u32x4*)((base) + (size_t)(tok0 + trc_) * (ld) + (ch)); dst = ((tr) < L) ? v__ : (u32x4){0u, 0u, 0u, 0u}; }
#define SSD_LOAD_N(c_) { const int tg_ = (c_) * 64 + t; _Pragma("unroll") for (int k = 0; k < 4; ++k) { RAWROW_N(rw[k], XBC, 1280, chx, tg_ - 3 + k) } \
        const bool v_ = tg_ < L; const size_t ro_ = (size_t)(tok0 + min(tg_, L - 1)) * 256 + g * 64 + cg * 8; const u32x4 b__ = *(const u32x4*)(CBC + ro_), c__ = *(const u32x4*)(CBC + ro_ + 128); \
        bcv = v_ ? b__ : (u32x4){0u, 0u, 0u, 0u}; ccv = v_ ? c__ : (u32x4){0u, 0u, 0u, 0u}; }
#define LRU_LOAD_N(c_) { const int tg_ = (c_) * 64 + t; _Pragma("unroll") for (int k = 0; k < 4; ++k) { RAWROW_N(lrw[k], LX, DM, ch0, tg_ - 3 + k) } }
#define TAIL_LOAD_N(c_) { const int tg_ = (c_) * 64 + t; const bool v_ = tg_ < L; const size_t ro_ = (size_t)(tok0 + min(tg_, L - 1)) * DM; const u32x4 z__ = *(const u32x4*)(Z + ro_ + chx), y__ = *(const u32x4*)(LY + ro_ + ch0); \
        zs = v_ ? z__ : (u32x4){0u, 0u, 0u, 0u}; lyv = v_ ? y__ : (u32x4){0u, 0u, 0u, 0u}; }
    { const float d_ = DT[(size_t)(tok0 + min(lane, L - 1)) * 16 + head]; dtl = (lane < L) ? d_ : 0.f; }
    __syncthreads();
    for (int c = 0; c < nchunk; ++c) {
        int lt_ = tid; asm volatile("" : "+v"(lt_));
        const int t = lt_ >> 3, cg = lt_ & 7, lane = lt_ & 63, r = lane & 31, hh = lane >> 5;
        const int chx = head * 64 + cg * 8, chb = 1024 + g * 64 + cg * 8, chc = 1152 + g * 64 + cg * 8, ch0 = j * 64 + cg * 8;
        const int tg = c * 64 + t; const bool valid = tg < L;
        if (wave == 0 && !(skip & 128)) {
            float cs = dtl * a_h;
            { float o = shfl_f(cs, lane - 1); if (lane >= 1) cs += o; o = shfl_f(cs, lane - 2); if (lane >= 2) cs += o; o = shfl_f(cs, lane - 4); if (lane >= 4) cs += o;
              o = shfl_f(cs, lane - 8); if (lane >= 8) cs += o; o = shfl_f(cs, lane - 16); if (lane >= 16) cs += o; o = shfl_f(cs, lane - 32); if (lane >= 32) cs += o; }
            const float tot = shfl_f(cs, 63);
            acum[lane] = cs; dtv[lane] = dtl; eac[lane] = __expf(cs); wsc[lane] = __expf(tot - cs) * dtl; if (lane == 0) misc[0] = __expf(tot);
        }
        if (!(skip & 32)) {
            float v[8]; conv8<64>(lrw, lcwl + cg * 8, v);
            *(LAS u32x4*)(xcB + t * SROW + cg * 16) = (u32x4){pk2(v[0], v[1]), pk2(v[2], v[3]), pk2(v[4], v[5]), pk2(v[6], v[7])};
            *(LAS f32x4*)(xcF + t * 64 + cg * 8) = (f32x4){v[0], v[1], v[2], v[3]}; *(LAS f32x4*)(xcF + t * 64 + cg * 8 + 4) = (f32x4){v[4], v[5], v[6], v[7]};
        }
        LRU_LOAD_N(c + 1)
        if (!(skip & 256)) __syncthreads();
        if (!(skip & 16)) {
            const float wsl = wsc[t];
            { float v[8]; conv8<192>(rw, cwl + cg * 8, v);
#pragma unroll
              for (int e = 0; e < 8; ++e) v[e] = valid ? siluf_(v[e]) : 0.f;
              if (!(skip & 1)) *(LAS u32x4*)(xsR + t * 192 + cg * 16) = (u32x4){pk2(v[0], v[1]), pk2(v[2], v[3]), pk2(v[4], v[5]), pk2(v[6], v[7])}; }
            *(LAS u32x4*)(bmR + t * SROW + cg * 16) = bcv;
            *(LAS u32x4*)(cmR + t * SROW + cg * 16) = ccv;
            if (!(skip & 1)) *(LAS u32x4*)(bwR + t * 192 + cg * 16) = (u32x4){pk2(bflo(bcv.x) * wsl, bfhi(bcv.x) * wsl), pk2(bflo(bcv.y) * wsl, bfhi(bcv.y) * wsl), pk2(bflo(bcv.z) * wsl, bfhi(bcv.z) * wsl), pk2(bflo(bcv.w) * wsl, bfhi(bcv.w) * wsl)};
        }
        asm volatile("" ::: "memory");
        SSD_LOAD_N(c + 1)
        { const int tq_ = (c + 1) * 64 + lane; const float d_ = DT[(size_t)(tok0 + min(tq_, L - 1)) * 16 + head]; dtl = (tq_ < L) ? d_ : 0.f; }
        if (wave >= 4 && !(skip & 2)) {
            f32x16 ra, ia;
#pragma unroll
            for (int i = 0; i < 16; ++i) { ra[i] = 0.f; ia[i] = 0.f; }
#pragma unroll
            for (int ks = 0; ks < 4; ++ks) { const bf16x8 A = *(const LAS bf16x8*)(xcB + (32 * tb + r) * SROW + (16 * ks + 8 * hh) * 2);
                const bf16x8 Ba = *(const LAS bf16x8*)(waT + (32 * eb + r) * SROW + (16 * ks + 8 * hh) * 2), Bx = *(const LAS bf16x8*)(wxT + (32 * eb + r) * SROW + (16 * ks + 8 * hh) * 2);
                ra = MFMA32(A, Ba, ra); ia = MFMA32(A, Bx, ia); }
#pragma unroll
            for (int i = 0; i < 16; ++i) { const int tt = 32 * tb + (i & 3) + 8 * (i >> 2) + 4 * hh, e = 32 * eb + r;
                const float rg = sigmoidf_(ra[i] + ba), ig = sigmoidf_(ia[i] + bxx), log_a = rg * sp8, av = exp_fast(log_a);
                const float u = __builtin_amdgcn_sqrtf(fmaxf(1.0f - av * av, 0.f)) * (ig * xcF[tt * 64 + e]);
                aF[tt * 64 + e] = av; uF[tt * 64 + e] = u; }
        }
        if (!(skip & 256)) __syncthreads();
        if (wave < 4 && !(skip & 4)) {
            const int tri = lane & 15, trg = (lane >> 4) & 1;
            const int troff = (tri >> 2) * 192 + (16 * trg + 4 * (tri & 3)) * 2;
#define TRFRAG(tile, row0, rowstep, col0) ({ const LAS unsigned char* a_ = (tile) + (row0) * 192 + (col0) * 2 + troff; \
                const s16x4_ lo_ = __builtin_amdgcn_ds_read_tr16_b64_v4i16((LAS s16x4_*)a_), hi_ = __builtin_amdgcn_ds_read_tr16_b64_v4i16((LAS s16x4_*)(a_ + (rowstep) * 192)); \
                (bf16x8){lo_[0], lo_[1], lo_[2], lo_[3], hi_[0], hi_[1], hi_[2], hi_[3]}; })
            f32x16 y;
#pragma unroll
            for (int i = 0; i < 16; ++i) y[i] = 0.f;
#pragma unroll
            for (int nb = 0; nb < 2; ++nb)
#pragma unroll
                for (int tt = 0; tt < 2; ++tt) { const LAS unsigned char* ap = cmR + (32 * qb + r) * SROW + (32 * nb + 16 * tt + 4 * hh) * 2;
                    const u32x2 a0 = *(const LAS u32x2*)ap, a1 = *(const LAS u32x2*)(ap + 16);
                    y = MFMA32(__builtin_bit_cast(bf16x8, (u32x4){a0.x, a0.y, a1.x, a1.y}), pack_acc(hacc[nb], tt), y); }
#pragma unroll
            for (int i = 0; i < 16; ++i) y[i] *= eac[32 * qb + (i & 3) + 8 * (i >> 2) + 4 * hh];
            const float aq = acum[32 * qb + r]; const int qg = 32 * qb + r;
            for (int sb = 0; sb <= qb; ++sb) {
                f32x16 cbt;
#pragma unroll
                for (int i = 0; i < 16; ++i) cbt[i] = 0.f;
#pragma unroll
                for (int ks = 0; ks < 4; ++ks) { const bf16x8 A = *(const LAS bf16x8*)(bmR + (32 * sb + r) * SROW + (16 * ks + 8 * hh) * 2), B = *(const LAS bf16x8*)(cmR + (32 * qb + r) * SROW + (16 * ks + 8 * hh) * 2); cbt = MFMA32(A, B, cbt); }
#pragma unroll
                for (int i = 0; i < 16; ++i) { const int sg = 32 * sb + (i & 3) + 8 * (i >> 2) + 4 * hh;
                    float wv = cbt[i] * exp_fast(fminf(aq - acum[sg], 0.f)) * dtv[sg]; wv = sg > qg ? 0.f : wv; wv = sg == qg ? wv + Dh : wv; cbt[i] = wv; }
#pragma unroll
                for (int tt = 0; tt < 2; ++tt) { const bf16x8 B = TRFRAG(xsR, 32 * sb + 16 * tt + 4 * hh, 8, 32 * pb); y = MFMA32(pack_acc(cbt, tt), B, y); }
            }
#pragma unroll
            for (int i = 0; i < 16; ++i) ybuf[(32 * qb + (i & 3) + 8 * (i >> 2) + 4 * hh) * 64 + 32 * pb + r] = y[i];
            const float dec = misc[0];
#pragma unroll
            for (int nb = 0; nb < 2; ++nb) {
#pragma unroll
                for (int i = 0; i < 16; ++i) hacc[nb][i] *= dec;
#pragma unroll
                for (int ks = 0; ks < 4; ++ks) { const bf16x8 A = TRFRAG(bwR, 16 * ks + 8 * hh, 4, 32 * nb), B = TRFRAG(xsR, 16 * ks + 8 * hh, 4, 32 * pb); hacc[nb] = MFMA32(A, B, hacc[nb]); }
            }
#undef TRFRAG
        } else if (wave == 4 && !(skip & 8)) {
            const int nsteps = (L - c * 64) < 64 ? (L - c * 64) : 64;
            for (int s0 = 0; s0 < nsteps; s0 += 8) {
                float av[8], uv[8];
#pragma unroll
                for (int q = 0; q < 8; ++q) { av[q] = aF[(s0 + q) * 64 + lane]; uv[q] = uF[(s0 + q) * 64 + lane]; }
#pragma unroll
                for (int q = 0; q < 8; ++q) { hstate = (s0 + q < nsteps) ? av[q] * hstate + uv[q] : hstate; uF[(s0 + q) * 64 + lane] = hstate; }
            }
        }
        if (!(skip & 256)) __syncthreads();
        if (!(skip & 64)) {
            const f32x4 y0 = *(const LAS f32x4*)(ybuf + t * 64 + cg * 8), y1 = *(const LAS f32x4*)(ybuf + t * 64 + cg * 8 + 4);
            const float o0 = y0[0] * bflo(zs.x), o1 = y0[1] * bfhi(zs.x), o2 = y0[2] * bflo(zs.y), o3 = y0[3] * bfhi(zs.y);
            const float o4 = y1[0] * bflo(zs.z), o5 = y1[1] * bfhi(zs.z), o6 = y1[2] * bflo(zs.w), o7 = y1[3] * bfhi(zs.w);
            float ss = (o0 * o0 + o1 * o1) + (o2 * o2 + o3 * o3) + (o4 * o4 + o5 * o5) + (o6 * o6 + o7 * o7);
            ss = row8_sum(ss);
            const f32x4 h0 = *(const LAS f32x4*)(uF + t * 64 + cg * 8), h1 = *(const LAS f32x4*)(uF + t * 64 + cg * 8 + 4);
            asm volatile("" :: "v"(o0), "v"(o7), "v"(ss), "v"(h0[0]), "v"(h1[3]));
            const bool st = valid && !dry; const size_t ro = (size_t)(tok0 + (st ? tg : 0)) * DM; unsigned char* sink = C.ws + WS_SINK + lt_ * 16;
            u32x4* zp = st ? (u32x4*)(Z + ro + chx) : (u32x4*)sink; u32x4* lp = st ? (u32x4*)(LY + ro + ch0) : (u32x4*)(sink + 8192);
            float* sp = (st && cg == 0) ? SSQ + (size_t)(tok0 + tg) * 16 + head : (float*)(sink + 16384);
            *zp = (u32x4){pk2(o0, o1), pk2(o2, o3), pk2(o4, o5), pk2(o6, o7)};
            *sp = ss;
            *lp = (u32x4){pk2(h0[0] * bflo(lyv.x), h0[1] * bfhi(lyv.x)), pk2(h0[2] * bflo(lyv.y), h0[3] * bfhi(lyv.y)), pk2(h1[0] * bflo(lyv.z), h1[1] * bfhi(lyv.z)), pk2(h1[2] * bflo(lyv.w), h1[3] * bfhi(lyv.w))};
        }
        if (skip & 512) {
#pragma unroll
            for (int k = 0; k < 4; ++k) asm volatile("" :: "v"(rw[k].x), "v"(rw[k].w), "v"(lrw[k].x), "v"(lrw[k].w));
            asm volatile("" :: "v"(bcv.x), "v"(ccv.x), "v"(zs.x), "v"(lyv.x), "v"(dtl)); }
        TAIL_LOAD_N(c + 1)
    }
#undef RAWROW
#undef SSD_LOAD
#undef LRU_LOAD
#undef TAIL_LOAD
#undef RAWROW_N
#undef SSD_LOAD_N
#undef LRU_LOAD_N
#undef TAIL_LOAD_N
    if (!dry && tid < 24) { const int rr = tid >> 3, cq = tid & 7; const size_t tokr = (size_t)(tok0 + L - 3 + rr);
        { const u32x4 q = *(const u32x4*)(LX + tokr * DM + j * 64 + cq * 8); float* co = C.out + (smp ? O_SLCONV : O_PLCONV) + ((size_t)(l * NB + b) * 3 + rr) * DM + j * 64 + cq * 8;
          *(f32x4*)co = (f32x4){bflo(q.x), bfhi(q.x), bflo(q.y), bfhi(q.y)}; *(f32x4*)(co + 4) = (f32x4){bflo(q.z), bfhi(q.z), bflo(q.w), bfhi(q.w)}; }
        { const u32x4 q = *(const u32x4*)(XBC + tokr * 1280 + head * 64 + cq * 8); float* co = C.out + (smp ? O_SSCONV : O_PSCONV) + ((size_t)(l * NB + b) * 3 + rr) * 1280 + head * 64 + cq * 8;
          *(f32x4*)co = (f32x4){bflo(q.x), bfhi(q.x), bflo(q.y), bfhi(q.y)}; *(f32x4*)(co + 4) = (f32x4){bflo(q.z), bfhi(q.z), bflo(q.w), bfhi(q.w)}; } }
    if (!dry && wave < 4 && qb == 0) {
        float* so = C.out + (smp ? O_SSSD : O_PSSD) + ((size_t)((l * NB + b) * 16 + head) * 64 + 32 * pb + r) * 64;
#pragma unroll
        for (int nb = 0; nb < 2; ++nb)
#pragma unroll
            for (int i4 = 0; i4 < 4; ++i4) *(f32x4*)(so + 32 * nb + 8 * i4 + 4 * hh) = (f32x4){hacc[nb][4 * i4], hacc[nb][4 * i4 + 1], hacc[nb][4 * i4 + 2], hacc[nb][4 * i4 + 3]};
    }
    if (wave == 4 && !dry) C.out[(smp ? O_SLRU : O_PLRU) + (size_t)(l * NB + b) * DM + j * 64 + lane] = hstate;
    __syncthreads();
}

__device__ __forceinline__ void phase_scan(const Ctx& C, int l, bool dry = false) {
    for (int it = C.bid; it < 384; it += C.G) scan_item_fused(C, l, it, dry);
}

__device__ __forceinline__ unsigned mono(float f) { const unsigned u = __float_as_uint(f); return (u & 0x80000000u) ? ~u : (u | 0x80000000u); }
__device__ __forceinline__ float unmono(unsigned k) { const unsigned u = (k & 0x80000000u) ? (k & 0x7fffffffu) : ~k; return __uint_as_float(u); }
template <int CTRL> __device__ __forceinline__ unsigned dpp_u(unsigned v) { return (unsigned)__builtin_amdgcn_update_dpp(0, (int)v, CTRL, 0xf, 0xf, true); }
__device__ __forceinline__ unsigned row_max_u(unsigned m) {
    m = max(m, dpp_u<0xB1>(m)); m = max(m, dpp_u<0x4E>(m)); m = max(m, dpp_u<0x141>(m)); m = max(m, dpp_u<0x140>(m)); return m;
}
__device__ __forceinline__ float row_max_f(float m) {
    m = fmaxf(m, __uint_as_float(dpp_u<0xB1>(__float_as_uint(m)))); m = fmaxf(m, __uint_as_float(dpp_u<0x4E>(__float_as_uint(m))));
    m = fmaxf(m, __uint_as_float(dpp_u<0x141>(__float_as_uint(m)))); m = fmaxf(m, __uint_as_float(dpp_u<0x140>(__float_as_uint(m)))); return m;
}
__device__ __forceinline__ float row_sum_f(float m) {
    m += __uint_as_float(dpp_u<0xB1>(__float_as_uint(m))); m += __uint_as_float(dpp_u<0x4E>(__float_as_uint(m)));
    m += __uint_as_float(dpp_u<0x141>(__float_as_uint(m))); m += __uint_as_float(dpp_u<0x140>(__float_as_uint(m))); return m;
}
#define CE_(a, b) { const unsigned hi_ = max(a, b), lo_ = min(a, b); a = hi_; b = lo_; }
#define KEY8(k, a, b) unsigned k##0 = (mono(a[0]) & ~127u) | (unsigned)(127 - (li * 8 + 0)), k##1 = (mono(a[1]) & ~127u) | (unsigned)(127 - (li * 8 + 1)), k##2 = (mono(a[2]) & ~127u) | (unsigned)(127 - (li * 8 + 2)), \
        k##3 = (mono(a[3]) & ~127u) | (unsigned)(127 - (li * 8 + 3)), k##4 = (mono(b[0]) & ~127u) | (unsigned)(127 - (li * 8 + 4)), k##5 = (mono(b[1]) & ~127u) | (unsigned)(127 - (li * 8 + 5)), \
        k##6 = (mono(b[2]) & ~127u) | (unsigned)(127 - (li * 8 + 6)), k##7 = (mono(b[3]) & ~127u) | (unsigned)(127 - (li * 8 + 7));
#define SORT8(k) CE_(k##0, k##1) CE_(k##2, k##3) CE_(k##4, k##5) CE_(k##6, k##7)  CE_(k##0, k##2) CE_(k##1, k##3) CE_(k##4, k##6) CE_(k##5, k##7)  CE_(k##1, k##2) CE_(k##5, k##6) \
        CE_(k##0, k##4) CE_(k##1, k##5) CE_(k##2, k##6) CE_(k##3, k##7)  CE_(k##2, k##4) CE_(k##3, k##5)  CE_(k##1, k##2) CE_(k##3, k##4) CE_(k##5, k##6)
#define POP8(k, m, c) k##0 = c ? k##1 : k##0; k##1 = c ? k##2 : k##1; k##2 = c ? k##3 : k##2; k##3 = c ? k##4 : k##3; k##4 = c ? k##5 : k##4; k##5 = c ? k##6 : k##5; k##6 = c ? k##7 : k##6; k##7 = c ? 0u : k##7;
__device__ __forceinline__ void top16_row2(const f32x4 a0, const f32x4 b0, const f32x4 a1, const f32x4 b1, int li, unsigned& r0, unsigned& r1) {
    KEY8(x, a0, b0) KEY8(y, a1, b1)
    SORT8(x) SORT8(y)
    unsigned rx = 0u, ry = 0u;
#pragma unroll
    for (int r = 0; r < 16; ++r) {
        const unsigned mx = row_max_u(x0), my = row_max_u(y0); const bool cx = (x0 == mx), cy = (y0 == my);
        POP8(x, mx, cx) POP8(y, my, cy)
        rx = (li == r) ? mx : rx; ry = (li == r) ? my : ry;
    }
    r0 = rx; r1 = ry;
}
#undef KEY8
#undef SORT8
#undef POP8
__device__ __forceinline__ void phase_topk(const Ctx& C, int l) {
    const bf16_t* SC = WSP(bf16_t, WS_SC); unsigned short* EI = WSP(unsigned short, WS_EI); float* GW = WSP(float, WS_GW);
    const int lane = C.lane, li = lane & 15, rowi = lane >> 4;
    LAS float* sv = (LAS float*)(C.lds + 4096 + C.wave * 1024);
    LAS int* si = (LAS int*)(sv + 128);
    LAS unsigned char* tab = (LAS unsigned char*)C.lds;
    if (C.tid < 64) { int c = C.tid, i = 0; for (; i < 16; ++i) { const int cnt = 16 / (i + 1); if (c < cnt) break; c -= cnt; } tab[C.tid] = (unsigned char)(C.tid < 50 ? (i | (c << 4)) : 0); }
    __syncthreads();
    int ica[4], jca[4];
#pragma unroll
    for (int q = 0; q < 4; ++q) { const int tb = tab[4 * li + q]; ica[q] = tb & 15; jca[q] = tb >> 4; }
    const int gw = C.bid * NWAVES + C.wave, NGW = C.G * NWAVES;
    u32x4 nw0, nw1;
    { const bf16_t* base = SC + (size_t)min(gw, TT * 2 - 1) * 1024;
      nw0 = *(const u32x4*)(base + lane * 8); nw1 = *(const u32x4*)(base + 512 + lane * 8); }
    const float* up = as_global(C.P->in[IN_U]) + (size_t)l * NE * DM; const float* vp = as_global(C.P->in[IN_V]) + (size_t)l * NE * DM;
#define TROW(it_) (((it_) >= NE ? vp + (size_t)((it_) - NE) * DM : up + (size_t)(it_) * DM) + lane * 4)
    int tit = gw; f32x4 tv[4];
    { const float* s0 = TROW(min(tit, 2 * NE - 1));
#pragma unroll
      for (int j = 0; j < 4; ++j) tv[j] = *(const f32x4*)(s0 + 256 * j); }
    int nit = 0;
    for (int g4 = gw; g4 < TT * 2; g4 += NGW, ++nit) {
        if (!(nit & 1) && tit < 2 * NE) { convert_row(C, tit, tv); tit += NGW;
            const float* s0 = TROW(min(tit, 2 * NE - 1));
#pragma unroll
            for (int j = 0; j < 4; ++j) tv[j] = *(const f32x4*)(s0 + 256 * j); }
        const int row = g4 >> 1, hd0 = (g4 & 1) * 4;
        const f32x4 a0 = (f32x4){bflo(nw0.x), bfhi(nw0.x), bflo(nw0.y), bfhi(nw0.y)}, b0 = (f32x4){bflo(nw0.z), bfhi(nw0.z), bflo(nw0.w), bfhi(nw0.w)};
        const f32x4 a1 = (f32x4){bflo(nw1.x), bfhi(nw1.x), bflo(nw1.y), bfhi(nw1.y)}, b1 = (f32x4){bflo(nw1.z), bfhi(nw1.z), bflo(nw1.w), bfhi(nw1.w)};
        { const bf16_t* base = SC + (size_t)min(g4 + NGW, TT * 2 - 1) * 1024;
          nw0 = *(const u32x4*)(base + lane * 8); nw1 = *(const u32x4*)(base + 512 + lane * 8); }
        unsigned r0, r1; top16_row2(a0, b0, a1, b1, li, r0, r1);
        sv[lane] = unmono(r0 & ~127u); si[lane] = 127 - (int)(r0 & 127u); sv[64 + lane] = unmono(r1 & ~127u); si[64 + lane] = 127 - (int)(r1 & 127u);
        LDS_WAIT();
        const LAS float* v1 = sv + rowi * 32; const LAS float* v2 = v1 + 16;
        unsigned k[4];
#pragma unroll
        for (int q = 0; q < 4; ++q) { const int c = 4 * li + q; const float sum = v1[ica[q]] + v2[jca[q]]; k[q] = (c < 50) ? ((mono(sum) & ~63u) | (unsigned)(63 - c)) : 0u; }
        CE_(k[0], k[1]) CE_(k[2], k[3]) CE_(k[0], k[2]) CE_(k[1], k[3]) CE_(k[1], k[2])
        unsigned res = 0u;
#pragma unroll
        for (int r = 0; r < 16; ++r) {
            const unsigned m = row_max_u(k[0]); const bool c = (k[0] == m);
            k[0] = c ? k[1] : k[0]; k[1] = c ? k[2] : k[1]; k[2] = c ? k[3] : k[2]; k[3] = c ? 0u : k[3];
            res = (li == r) ? m : res;
        }
        const int csel = 63 - (int)(res & 63u); const int tb = tab[csel];
        const int e1 = (si + rowi * 32)[tb & 15], e2 = (si + rowi * 32 + 16)[tb >> 4];
        const float svv = unmono(res & ~63u);
        const float mx = row_max_f(svv), ex = __expf(svv - mx), den = row_sum_f(ex);
        const size_t o = (size_t)row * 128 + (hd0 + rowi) * 16 + li;
        EI[o] = (unsigned short)(e1 * 128 + e2); GW[o] = ex / den;
        LDS_WAIT();
    }
    for (; tit < 2 * NE; ) { convert_row(C, tit, tv); tit += NGW;
        const float* s0 = TROW(min(tit, 2 * NE - 1));
#pragma unroll
        for (int j = 0; j < 4; ++j) tv[j] = *(const f32x4*)(s0 + 256 * j); }
#undef TROW
    __syncthreads();
}

template <int CTRL> __device__ __forceinline__ float dpp_f(float v) { return __int_as_float(__builtin_amdgcn_update_dpp(0, __float_as_int(v), CTRL, 0xf, 0xf, true)); }
__device__ __forceinline__ float swap16_f(float v, int lane) { auto r = __builtin_amdgcn_permlane16_swap(__float_as_uint(v), __float_as_uint(v), false, false); return __uint_as_float((lane & 16) ? r[0] : r[1]); }
constexpr int PEER_SLICES = 8;
#define PEER_LOAD_E(E, t_) { const u32x4* ep_ = (const u32x4*)(EI + (size_t)(t_) * 128 + r8 * 16); E[0] = ep_[0]; E[1] = ep_[1]; }
#define EID(E, i_) (((i_) & 1) ? (E[(i_) >> 3][((i_) >> 1) & 3] >> 16) : (E[(i_) >> 3][((i_) >> 1) & 3] & 0xffffu))
#define PEER_GATHER(U, E, base_, coff_) { _Pragma("unroll") for (int i_ = 0; i_ < 16; ++i_) U[i_] = *(const u32x4*)((base_) + (EID(E, i_) * 128u + (coff_))); }
#define FP8LO(d) __builtin_amdgcn_cvt_pk_f32_fp8((int)(d), false)
#define FP8HI(d) __builtin_amdgcn_cvt_pk_f32_fp8((int)(d), true)
__device__ __forceinline__ float peer_u_reduce8(const u32x4 (&U)[8], const u32x4 hq0, const u32x4 hq1, int c) {
    f32x2 h[8];
    h[0] = (f32x2){bflo(hq0.x), bfhi(hq0.x)}; h[1] = (f32x2){bflo(hq0.y), bfhi(hq0.y)}; h[2] = (f32x2){bflo(hq0.z), bfhi(hq0.z)}; h[3] = (f32x2){bflo(hq0.w), bfhi(hq0.w)};
    h[4] = (f32x2){bflo(hq1.x), bfhi(hq1.x)}; h[5] = (f32x2){bflo(hq1.y), bfhi(hq1.y)}; h[6] = (f32x2){bflo(hq1.z), bfhi(hq1.z)}; h[7] = (f32x2){bflo(hq1.w), bfhi(hq1.w)};
    float q[8];
#pragma unroll
    for (int i = 0; i < 8; ++i) {
        f32x2 s0 = FP8LO(U[i].x) * h[0], s1 = FP8HI(U[i].x) * h[1];
        s0 = __builtin_elementwise_fma(FP8LO(U[i].y), h[2], s0); s1 = __builtin_elementwise_fma(FP8HI(U[i].y), h[3], s1);
        s0 = __builtin_elementwise_fma(FP8LO(U[i].z), h[4], s0); s1 = __builtin_elementwise_fma(FP8HI(U[i].z), h[5], s1);
        s0 = __builtin_elementwise_fma(FP8LO(U[i].w), h[6], s0); s1 = __builtin_elementwise_fma(FP8HI(U[i].w), h[7], s1);
        s0 = s0 + s1; q[i] = s0.x + s0.y;
    }
    { const bool up = (c & 4) != 0;
#pragma unroll
      for (int j = 0; j < 4; ++j) { const float mine = up ? q[j + 4] : q[j], send = up ? q[j] : q[j + 4]; q[j] = mine + dpp_f<0x141>(send); } }
    { const bool up = (c & 2) != 0;
#pragma unroll
      for (int j = 0; j < 2; ++j) { const float mine = up ? q[j + 2] : q[j], send = up ? q[j] : q[j + 2]; q[j] = mine + dpp_f<0x4E>(send); } }
    { const bool up = (c & 1) != 0; const float mine = up ? q[1] : q[0], send = up ? q[0] : q[1]; q[0] = mine + dpp_f<0xB1>(send); }
    return q[0];
}
#define PEER_GATHER8(U, EW, base_, coff_) { _Pragma("unroll") for (int i_ = 0; i_ < 8; ++i_) { const unsigned w_ = EW[i_ >> 1]; U[i_] = *(const u32x4*)((base_) + (((i_ & 1) ? (w_ >> 16) : (w_ & 0xffffu)) * 128u + (coff_))); } }
__device__ __forceinline__ void phase_peer_u(const Ctx& C) {
    const int lane = C.lane, r8 = lane >> 3, c = lane & 7;
    const bf16_t* H2 = WSP(bf16_t, WS_B0); const unsigned char* U8 = C.ws + WS_U8; const unsigned short* EI = WSP(unsigned short, WS_EI); unsigned* PA = WSP(unsigned, WS_SC);
    const int s = C.bid & 7, wg = (C.bid >> 3) * NWAVES + C.wave, nwg = (C.G >> 3) * NWAVES;
    const int n = (TT - wg + nwg - 1) / nwg;
    const unsigned char* ub = U8 + (size_t)s * NE * 128; const unsigned coff = (unsigned)c * 16u; const bf16_t* hb = H2 + s * 128 + c * 16;
    unsigned* pab = PA + (size_t)s * 64 + lane;
#define TOK(i_) (min(wg + (i_) * nwg, TT - 1))
#define LOAD_H(H0, H1, t_) { const u32x4* hp_ = (const u32x4*)(hb + (size_t)(t_) * DM); H0 = hp_[0]; H1 = hp_[1]; }
    u32x4 uA[8], uB[8], ec[2], en[2], hc0, hc1, hn0, hn1;
    PEER_LOAD_E(ec, TOK(0)); LOAD_H(hc0, hc1, TOK(0));
    PEER_GATHER8(uA, ec[0], ub, coff);
    PEER_LOAD_E(en, TOK(1)); LOAD_H(hn0, hn1, TOK(1));
    for (int i = 0; i < n; ++i) {
        PEER_GATHER8(uB, ec[1], ub, coff);
        const float r0 = peer_u_reduce8(uA, hc0, hc1, c);
        PEER_GATHER8(uA, en[0], ub, coff);
        const float r1 = peer_u_reduce8(uB, hc0, hc1, c);
        pab[(size_t)TOK(i) * (PEER_SLICES * 64)] = pk2(r0, r1);
        ec[0] = en[0]; ec[1] = en[1]; hc0 = hn0; hc1 = hn1;
        PEER_LOAD_E(en, TOK(i + 2)); LOAD_H(hn0, hn1, TOK(i + 2));
    }
#undef LOAD_H
#undef TOK
}
constexpr size_t WS_ACT16 = WS_U16 + ((size_t)17 << 20);
__device__ __forceinline__ void phase_peer_act(const Ctx& C) {
    const unsigned* PA = WSP(unsigned, WS_SC); const float* GW = WSP(float, WS_GW); bf16_t* ACT = WSP(bf16_t, WS_ACT16);
    const unsigned short* EI = WSP(unsigned short, WS_EI); const float* SU = WSP(float, WS_SU); const float* SV = WSP(float, WS_SV);
    const int n4 = TT * 32, stride = C.G * NTHREADS;
    for (int i4 = C.bid * NTHREADS + C.tid; i4 < n4; i4 += stride) {
        const size_t t = (size_t)(i4 >> 5); const int k = (i4 & 31) * 4; const bool hi = ((k >> 3) & 1) != 0;
        const unsigned* pp = PA + t * (PEER_SLICES * 64) + (k >> 4) * 8 + (k & 7);
        f32x4 a = (f32x4){0.f, 0.f, 0.f, 0.f};
#pragma unroll
        for (int s = 0; s < PEER_SLICES; ++s) { const u32x4 w = *(const u32x4*)(pp + s * 64);
            a += hi ? (f32x4){bfhi(w.x), bfhi(w.y), bfhi(w.z), bfhi(w.w)} : (f32x4){bflo(w.x), bflo(w.y), bflo(w.z), bflo(w.w)}; }
        const u32x2 ew = *(const u32x2*)(EI + (size_t)i4 * 4); const u32x4 e = (u32x4){ew.x & 0xffffu, ew.x >> 16, ew.y & 0xffffu, ew.y >> 16}; const f32x4 g = *(const f32x4*)(GW + (size_t)i4 * 4);
        const f32x4 su = (f32x4){SU[e.x], SU[e.y], SU[e.z], SU[e.w]}, sv = (f32x4){SV[e.x], SV[e.y], SV[e.z], SV[e.w]};
        *(u32x2*)(ACT + (size_t)i4 * 4) = (u32x2){pk2(geluf_(a[0] * su[0]) * g[0] * sv[0], geluf_(a[1] * su[1]) * g[1] * sv[1]), pk2(geluf_(a[2] * su[2]) * g[2] * sv[2], geluf_(a[3] * su[3]) * g[3] * sv[3])};
    }
}
#define PEER_LOAD_A(A, t_) { const u32x4* ap_ = (const u32x4*)(ACT + (size_t)(t_) * 128 + r8 * 16); A[0] = ap_[0]; A[1] = ap_[1]; }
__device__ __forceinline__ void peer_v_acc8(f32x2 (&o)[8], const u32x4 (&V)[8], const u32x4 AW) {
#pragma unroll
    for (int i = 0; i < 8; ++i) { const unsigned w = AW[i >> 1]; const float a = (i & 1) ? bfhi(w) : bflo(w); const f32x2 a2 = (f32x2){a, a};
        o[0] = __builtin_elementwise_fma(FP8LO(V[i].x), a2, o[0]); o[1] = __builtin_elementwise_fma(FP8HI(V[i].x), a2, o[1]);
        o[2] = __builtin_elementwise_fma(FP8LO(V[i].y), a2, o[2]); o[3] = __builtin_elementwise_fma(FP8HI(V[i].y), a2, o[3]);
        o[4] = __builtin_elementwise_fma(FP8LO(V[i].z), a2, o[4]); o[5] = __builtin_elementwise_fma(FP8HI(V[i].z), a2, o[5]);
        o[6] = __builtin_elementwise_fma(FP8LO(V[i].w), a2, o[6]); o[7] = __builtin_elementwise_fma(FP8HI(V[i].w), a2, o[7]); }
}
__device__ __forceinline__ f32x2 peer_v_scatter(const f32x2 (&o2)[8], int lane) {
    float o[16];
#pragma unroll
    for (int j = 0; j < 8; ++j) { o[2 * j] = o2[j].x; o[2 * j + 1] = o2[j].y; }
    { const bool up = (lane & 32) != 0;
#pragma unroll
      for (int j = 0; j < 8; ++j) { const float mine = up ? o[j + 8] : o[j], send = up ? o[j] : o[j + 8]; o[j] = mine + shfx<32>(send, lane); } }
    { const bool up = (lane & 16) != 0;
#pragma unroll
      for (int j = 0; j < 4; ++j) { const float mine = up ? o[j + 4] : o[j], send = up ? o[j] : o[j + 4]; o[j] = mine + swap16_f(send, lane); } }
    { const bool up = (lane & 8) != 0;
#pragma unroll
      for (int j = 0; j < 2; ++j) { const float mine = up ? o[j + 2] : o[j], send = up ? o[j] : o[j + 2]; o[j] = mine + dpp_f<0x128>(send); } }
    return (f32x2){o[0], o[1]};
}
__device__ __forceinline__ void phase_peer_v(const Ctx& C, int l, bool dry = false) {
    const int lane = C.lane, r8 = lane >> 3, c = lane & 7;
    const unsigned char* V8 = C.ws + WS_V8; const unsigned short* EI = WSP(unsigned short, WS_EI); const bf16_t* ACT = WSP(bf16_t, WS_ACT16); const float* MOD = WSP(float, WS_MOD);
    const int s = C.bid & 7, wg = (C.bid >> 3) * NWAVES + C.wave, nwg = (C.G >> 3) * NWAVES;
    const int n = (TT - wg + nwg - 1) / nwg;
    const int jcol = ((lane >> 5) & 1) * 8 + ((lane >> 4) & 1) * 4 + ((lane >> 3) & 1) * 2;
    const int col = s * 128 + c * 16 + jcol;
    const unsigned char* vb = V8 + (size_t)s * NE * 128; const unsigned coff = (unsigned)c * 16u;
    float* xb = C.out + col; const float* g2 = MOD + (size_t)l * NBT * 6144 + 5120 + col;
#define TOK(i_) (min(wg + (i_) * nwg, TT - 1))
    u32x4 vA[8], vB[8], ec[2], en[2], ac[2], an[2];
    PEER_LOAD_E(ec, TOK(0)); PEER_LOAD_A(ac, TOK(0));
    PEER_GATHER8(vA, ec[0], vb, coff);
    PEER_LOAD_E(en, TOK(1)); PEER_LOAD_A(an, TOK(1));
    for (int i = 0; i < n; ++i) {
        const int t = TOK(i);
        PEER_GATHER8(vB, ec[1], vb, coff);
        const f32x2 xv = *(const f32x2*)(xb + (size_t)t * DM), gv = *(const f32x2*)(g2 + (size_t)row_batch(t) * 6144);
        f32x2 o[8];
#pragma unroll
        for (int j = 0; j < 8; ++j) o[j] = (f32x2){0.f, 0.f};
        peer_v_acc8(o, vA, ac[0]);
        __builtin_amdgcn_sched_barrier(0);
        PEER_GATHER8(vA, en[0], vb, coff);
        peer_v_acc8(o, vB, ac[1]);
        __builtin_amdgcn_sched_barrier(0);
        ac[0] = an[0]; ac[1] = an[1]; ec[0] = en[0]; ec[1] = en[1];
        PEER_LOAD_E(en, TOK(i + 2)); PEER_LOAD_A(an, TOK(i + 2));
        const f32x2 ov = peer_v_scatter(o, lane);
        asm volatile("" :: "v"(ov.x), "v"(ov.y));
        if (!dry) *(f32x2*)(xb + (size_t)t * DM) = xv + gv * ov;
    }
#undef TOK
}
#undef PEER_GATHER8
#undef PEER_LOAD_E
#undef EID
#undef PEER_LOAD_A
#undef PEER_GATHER
__device__ __forceinline__ void phase_final_norm(const Ctx& C) {
    const int gw = C.bid * NWAVES + C.wave, NGW = C.G * NWAVES; const float* fw = as_global(C.P->in[IN_FNW]);
    for (int row = gw; row < TT; row += NGW) {
        f32x4* xr = (f32x4*)(C.out + (size_t)row * DM) + C.lane;
        f32x4 v[4]; float s = 0.f;
#pragma unroll
        for (int j = 0; j < 4; ++j) { v[j] = xr[64 * j]; s += (v[j][0] * v[j][0] + v[j][1] * v[j][1]) + (v[j][2] * v[j][2] + v[j][3] * v[j][3]); }
        const float rstd = rsqrtf(wave_sum(s) * (1.f / DM) + EPS);
#pragma unroll
        for (int j = 0; j < 4; ++j) xr[64 * j] = v[j] * rstd * *(const f32x4*)(fw + C.lane * 4 + 256 * j);
    }
}


#define XB_TMO      128
#define XB_XCNT(j)  (256  + 64 * (j))
#define XB_XSUB(j)  (1280 + 64 * (j))
#define XB_XGEN(j)  (2304 + 64 * (j))
#define XB_TOP      3328
#define XB_TOPGEN   3392
#define XCD_BAR_WORDS 3456
#define XB_SPIN_CAP (1u << 22)
__device__ __forceinline__ unsigned xb_ld(unsigned* p)              { return __hip_atomic_load(p, __ATOMIC_RELAXED, __HIP_MEMORY_SCOPE_AGENT); }
__device__ __forceinline__ unsigned xb_add(unsigned* p, unsigned v) { return __hip_atomic_fetch_add(p, v, __ATOMIC_RELAXED, __HIP_MEMORY_SCOPE_AGENT); }
__device__ __forceinline__ unsigned xb_xcc_id() { return (unsigned)__builtin_amdgcn_s_getreg((3 << 11) | 20) & 0xFu; }
#define XB_SPIN(cond, bar) do { unsigned _sp = 0; while (cond) { __builtin_amdgcn_s_sleep(1); \
    if ((++_sp & 255u) == 0u) { if (xb_ld(&(bar)[XB_TMO])) break; if (_sp > XB_SPIN_CAP) { atomicAdd(&(bar)[XB_TMO], 1u); break; } } } } while (0)
struct XcdBarrier { unsigned* bar; unsigned x; volatile LAS unsigned* st; };
__device__ __forceinline__ XcdBarrier xcd_barrier_post(unsigned* bar, volatile LAS unsigned* st) {
    XcdBarrier b; b.bar = bar; b.x = xb_xcc_id(); b.st = st;
    if (threadIdx.x == 0) (void)xb_add(&bar[XB_XCNT(b.x)], 1u);
    return b;
}
__device__ __forceinline__ void xcd_barrier_complete(unsigned* bar, unsigned x, unsigned& nloc, unsigned& nx) {
    const unsigned G = gridDim.x * gridDim.y * gridDim.z;
    unsigned sum, cnt, mine, sp = 0u;
    for (;;) {
        sum = 0u; cnt = 0u; mine = 0u;
#pragma unroll
        for (unsigned j = 0; j < 16; ++j) { const unsigned c = xb_ld(&bar[XB_XCNT(j)]); sum += c; cnt += (c > 0u) ? 1u : 0u; mine = (j == x) ? c : mine; }
        if (sum == G) break;
        __builtin_amdgcn_s_sleep(1);
        if ((++sp & 255u) == 0u) { if (xb_ld(&bar[XB_TMO])) break; if (sp > XB_SPIN_CAP) { atomicAdd(&bar[XB_TMO], 1u); break; } }
    }
    nloc = mine > 0u ? mine : 1u; nx = cnt > 0u ? cnt : 1u;
}
__device__ __forceinline__ void xcd_barrier(const XcdBarrier& b) {
    asm volatile("s_waitcnt vmcnt(0)" ::: "memory");
    __syncthreads();
    if (threadIdx.x == 0) {
        unsigned* bar = b.bar;
        __builtin_amdgcn_s_waitcnt(0);
        unsigned nloc = b.st[0], nx = b.st[1];
        if (nloc == 0u) { xcd_barrier_complete(bar, b.x, nloc, nx); b.st[0] = nloc; b.st[1] = nx; }
        const unsigned old = xb_add(&bar[XB_XSUB(b.x)], 1u);
        const unsigned gen = old / nloc;
        if (old + 1u == (gen + 1u) * nloc) {
            __builtin_amdgcn_fence(__ATOMIC_RELEASE, "agent");
            asm volatile("s_waitcnt vmcnt(0)" ::: "memory");
            const unsigned og = xb_add(&bar[XB_TOP], 1u);
            const unsigned tg = og / nx;
            if (og + 1u == (tg + 1u) * nx) xb_add(&bar[XB_TOPGEN], 1u);
            else XB_SPIN(xb_ld(&bar[XB_TOPGEN]) == tg, bar);
            __builtin_amdgcn_fence(__ATOMIC_ACQUIRE, "agent");
            xb_add(&bar[XB_XGEN(b.x)], 1u);
            asm volatile("s_waitcnt vmcnt(0)" ::: "memory");
        } else {
            XB_SPIN(xb_ld(&bar[XB_XGEN(b.x)]) == gen, bar);
            __builtin_amdgcn_fence(__ATOMIC_ACQUIRE, "agent");
            asm volatile("s_waitcnt vmcnt(0)" ::: "memory");
        }
    }
    __syncthreads();
}

__device__ __forceinline__ Ctx relaunder(const Ctx& C) {
    Ctx D = C; int t = C.tid; asm volatile("" : "+v"(t)); D.tid = t; D.lane = t & 63;
    unsigned char* w = C.ws; float* o = C.out; asm volatile("" : "+s"(w), "+s"(o)); D.ws = as_global(w); D.out = as_global(o); return D;
}
constexpr int NPL = 13, NPH = 2 + 2 * NPL;
__device__ __forceinline__ void run_phase(const Ctx& C0, int ph, bool dry) {
    if (ph == 0) { const Ctx C = relaunder(C0); phase_prep(C); return; }
    if (ph == NPH - 1) { const Ctx C = relaunder(C0); phase_final_norm(C); return; }
    const int l = (ph - 1) / NPL, k = (ph - 1) % NPL;
    switch (k) {
    case 0: { const Ctx C = relaunder(C0); phase_norm(C, l, 0); } break;
    case 1: { const Ctx C = relaunder(C0); CParams& P = *C.P;
#ifdef STAGGER_US
              { const unsigned long long t0 = __builtin_amdgcn_s_memrealtime(); const unsigned long long d = (unsigned long long)((C.bid >> 3) & 3) * (STAGGER_US * 100);
                while (__builtin_amdgcn_s_memrealtime() - t0 < d) __builtin_amdgcn_s_sleep(4); }
#endif
              Epi1 E{WSP(bf16_t, WS_B1), WSP(bf16_t, WS_B2), WSP(bf16_t, WS_B3), WSP(bf16_t, WS_B4), WSP(float, WS_DT), as_global(P.in[IN_DTB]) + l * 16};
              gemm_run(C, WSP(bf16_t, WS_B0), WSP(bf16_t, WS_W1T) + (size_t)l * N1 * DM, nullptr, nullptr, N1, E, dry); } break;
    case 2: { const Ctx C = relaunder(C0); phase_convbc(C, l); } break;
    case 3: { const Ctx C = relaunder(C0); phase_scan(C, l, dry); } break;
    case 4: { const Ctx C = relaunder(C0); Epi2 E{WSP(bf16_t, WS_GS), WSP(bf16_t, WS_GL)};
              gemm_run(C, WSP(bf16_t, WS_B0), WSP(bf16_t, WS_WGT) + (size_t)l * NG * DM, nullptr, nullptr, NG, E, dry); } break;
    case 5: { const Ctx C = relaunder(C0); Epi3 E{WSP(bf16_t, WS_GS), WSP(bf16_t, WS_GL), WSP(float, WS_SSQ), WSP(bf16_t, WS_B0)};
              gemm_run(C, WSP(bf16_t, WS_B1), WSP(bf16_t, WS_WBS) + (size_t)l * DM * DM, WSP(bf16_t, WS_B4), WSP(bf16_t, WS_WBL) + (size_t)l * DM * DM, DM, E, dry); } break;
    case 6: { const Ctx C = relaunder(C0); CParams& P = *C.P; Epi4 E{as_global(P.in[IN_XP]), as_global(P.in[IN_XS]), C.out, WSP(float, WS_MOD) + (size_t)l * NBT * 6144, l};
              gemm_run(C, WSP(bf16_t, WS_B0), WSP(bf16_t, WS_WO) + (size_t)l * DM * DM, nullptr, nullptr, DM, E, dry); } break;
    case 7: { const Ctx C = relaunder(C0); phase_norm(C, l, 1); } break;
    case 8: { const Ctx C = relaunder(C0); Epi5 E{WSP(bf16_t, WS_SC)};
              gemm_run(C, WSP(bf16_t, WS_B0), WSP(bf16_t, WS_WC) + (size_t)l * 2048 * DM, nullptr, nullptr, 2048, E, dry); } break;
    case 9: { const Ctx C = relaunder(C0); phase_topk(C, l); } break;
    case 10: { const Ctx C = relaunder(C0); phase_peer_u(C); } break;
    case 11: { const Ctx C = relaunder(C0); phase_peer_act(C); } break;
    case 12: { const Ctx C = relaunder(C0); phase_peer_v(C, l, dry); } break;
    }
}

__global__ void __launch_bounds__(NTHREADS, 2) fwd(Params P) {
    extern __shared__ __attribute__((aligned(16))) unsigned char lds_raw[];
    const int ph_lo = P.ph_lo, ph_hi = P.ph_hi;
    volatile LAS unsigned* bst = (volatile LAS unsigned*)((LAS unsigned char*)lds_raw + LDS_BYTES - 64);
    if (threadIdx.x == 0) { bst[0] = 0u; bst[1] = 0u; }
    __syncthreads();
    (void)xcd_barrier_post((unsigned*)(P.ws + WS_CTL), bst);
#ifdef PROBE_T
    unsigned long long tm_acc = 0;
#endif
    for (int ph = ph_lo; ph < ph_hi; ++ph) {
        CParams* Pp = (CParams*)__builtin_amdgcn_kernarg_segment_ptr(); asm volatile("" : "+s"(Pp));
        Ctx C; C.P = Pp; C.lds = (LAS unsigned char*)lds_raw;
        int tid = threadIdx.x; asm volatile("" : "+v"(tid));
        unsigned char* ws = Pp->ws; float* out = Pp->out; asm volatile("" : "+s"(ws), "+s"(out));
        C.ws = ws; C.out = out;
        C.tid = tid; C.lane = tid & 63; C.wave = __builtin_amdgcn_readfirstlane(tid >> 6); C.bid = blockIdx.x; C.G = gridDim.x;
#ifdef PROBE_K
        { const bool hit = (PROBE_K == 100) ? ph == 0 : ((PROBE_K == 101) ? ph == NPH - 1 : (ph > 0 && ph < NPH - 1 && (ph - 1) % NPL == PROBE_K));
          if (hit) for (int rep = 0; rep < PROBE_N; ++rep) { run_phase(C, ph, true); __syncthreads(); } }
#endif
#ifdef PROBE_T
        const bool tm_hit = (PROBE_T == 100) ? ph == 0 : ((PROBE_T == 101) ? ph == NPH - 1 : (ph > 0 && ph < NPH - 1 && (ph - 1) % NPL == PROBE_T));
        const unsigned long long tm_t0 = __builtin_amdgcn_s_memrealtime();
#endif
        run_phase(C, ph, false);
        if (ph + 1 < ph_hi) { if (ph == 0) cg::this_grid().sync();
            else { XcdBarrier xb; xb.bar = (unsigned*)(ws + WS_CTL); xb.x = xb_xcc_id(); xb.st = (volatile LAS unsigned*)((LAS unsigned char*)lds_raw + LDS_BYTES - 64); xcd_barrier(xb); } }
#ifdef PROBE_T
        if (tm_hit) tm_acc += __builtin_amdgcn_s_memrealtime() - tm_t0;
#endif
    }
#ifdef PROBE_T
    if (blockIdx.x == 0 && threadIdx.x == 0) { const unsigned long long t0 = __builtin_amdgcn_s_memrealtime(); while (__builtin_amdgcn_s_memrealtime() - t0 < 4 * tm_acc) __builtin_amdgcn_s_sleep(8); }
#endif
}

extern "C" void kernel_launch(void* const* d_in, const int* in_sizes, int n_in, void* d_out, int out_size, void* d_ws, size_t ws_size, hipStream_t stream) {
    static int grid = 0;
    if (grid == 0) {
        if (n_in != N_IN || (size_t)out_size != O_END || ws_size < WS_END) { fprintf(stderr, "kernel_launch: unexpected shapes n_in %d out %d ws %zu (need %zu)\n", n_in, out_size, ws_size, (size_t)WS_END); grid = -1; return; }
        int dev = 0, cus = 0, per_cu = 0;
        hipGetDevice(&dev); hipDeviceGetAttribute(&cus, hipDeviceAttributeMultiprocessorCount, dev);
        hipFuncSetAttribute((const void*)fwd, hipFuncAttributeMaxDynamicSharedMemorySize, LDS_BYTES);
        hipOccupancyMaxActiveBlocksPerMultiprocessor(&per_cu, (const void*)fwd, NTHREADS, LDS_BYTES);
        if (per_cu < 1) { fprintf(stderr, "kernel_launch: occupancy query says %d blocks/CU\n", per_cu); per_cu = 1; }
        grid = cus;
        fprintf(stderr, "kernel_launch: cus %d per_cu %d grid %d ws %zu\n", cus, per_cu, grid, ws_size);
    }
    if (grid < 0) return;
    Params p{};
    for (int i = 0; i < N_IN; ++i) p.in[i] = (const float*)d_in[i];
    p.out = (float*)d_out; p.ws = (unsigned char*)d_ws;
    hipMemsetAsync((char*)d_ws + WS_CTL, 0, 65536, stream);
#if MEGA
    p.ph_lo = 0; p.ph_hi = NPH;
    void* args[] = {&p};
    hipError_t e = hipLaunchCooperativeKernel((const void*)fwd, dim3(grid), dim3(NTHREADS), args, LDS_BYTES, stream);
    if (e != hipSuccess) fprintf(stderr, "cooperative launch failed: %s\n", hipGetErrorString(e));
#else
    for (int ph = 0; ph < NPH; ++ph) { p.ph_lo = ph; p.ph_hi = ph + 1; hipLaunchKernelGGL(fwd, dim3(grid), dim3(NTHREADS), LDS_BYTES, stream, p); }
#endif
}
```

```cpp
#include <hip/hip_runtime.h>
#include <hip/hip_cooperative_groups.h>
#include <cstdio>
#include <cstdint>
namespace cg = cooperative_groups;

#ifndef MEGA
#define MEGA 1
#endif

#define LAS __attribute__((address_space(3)))
typedef unsigned short bf16_t;
typedef __bf16 bf16x2_t __attribute__((ext_vector_type(2)));
typedef short bf16x8 __attribute__((ext_vector_type(8)));
typedef float f32x4 __attribute__((ext_vector_type(4)));
typedef float f32x16 __attribute__((ext_vector_type(16)));
typedef unsigned u32x4 __attribute__((ext_vector_type(4)));
typedef unsigned u32x2 __attribute__((ext_vector_type(2)));

constexpr int DM = 1024;
constexpr int TP = 32768, TS = 128, TT = TP + TS, MT = 33024;
constexpr int NBT = 24;
constexpr int N1 = 4608;
constexpr int NG = 2048;
constexpr int NE = 16384;
constexpr int INC = 6416;
constexpr float EPS = 1e-6f;
constexpr int NWAVES = 8, NTHREADS = 512;
constexpr int LDS_BYTES = 150528;

enum { IN_XP = 0, IN_XS, IN_CP, IN_CS, IN_SSD, IN_SSDCONV, IN_LRU, IN_LRUCONV, IN_LN1, IN_LN2, IN_WMOD, IN_BMOD, IN_WIN, IN_SCW, IN_SCB, IN_DTB,
       IN_ALOG, IN_SSDD, IN_SNW, IN_LCW, IN_LCB, IN_WA, IN_BA, IN_WX, IN_BX, IN_LAM, IN_WBS, IN_WBL, IN_WO, IN_WQ, IN_K1, IN_K2, IN_U, IN_V, IN_FNW, N_IN };

constexpr size_t O_Y = 0, O_PSSD = 33685504, O_PSCONV = 35782656, O_PLRU = 35905536, O_PLCONV = 35938304,
                 O_SSSD = 36036608, O_SSCONV = 37085184, O_SLRU = 37146624, O_SLCONV = 37163008, O_END = 37212160;

constexpr size_t al256(size_t x) { return (x + 255) & ~(size_t)255; }
constexpr size_t WS_CTL = 0;
constexpr size_t WS_LRUW = 131072;
constexpr size_t WS_MOD = 1u << 20;
constexpr size_t WS_DT = al256(WS_MOD + (size_t)2 * NBT * 6144 * 4);
constexpr size_t WS_SSQ = al256(WS_DT + (size_t)MT * 16 * 4);
constexpr size_t WS_W1T = al256(WS_SSQ + (size_t)MT * 16 * 4);
constexpr size_t WS_WGT = al256(WS_W1T + (size_t)2 * N1 * DM * 2);
constexpr size_t WS_WBS = al256(WS_WGT + (size_t)2 * NG * DM * 2);
constexpr size_t WS_WBL = al256(WS_WBS + (size_t)2 * DM * DM * 2);
constexpr size_t WS_WO = al256(WS_WBL + (size_t)2 * DM * DM * 2);
constexpr size_t WS_WC = al256(WS_WO + (size_t)2 * DM * DM * 2);
constexpr size_t WS_U16 = al256(WS_WC + (size_t)2 * 2048 * DM * 2);
constexpr size_t WS_V16 = al256(WS_U16 + (size_t)NE * DM * 2);
constexpr size_t WS_EI = al256(WS_V16 + (size_t)NE * DM * 2);
constexpr size_t WS_GW = al256(WS_EI + (size_t)MT * 128 * 4);
constexpr size_t WS_B0 = al256(WS_GW + (size_t)MT * 128 * 4);
constexpr size_t WS_B1 = al256(WS_B0 + (size_t)MT * DM * 2);
constexpr size_t WS_B2 = al256(WS_B1 + (size_t)MT * DM * 2);
constexpr size_t WS_B3 = al256(WS_B2 + (size_t)MT * 1280 * 2);
constexpr size_t WS_B4 = al256(WS_B3 + (size_t)MT * DM * 2);
constexpr size_t WS_SINK = al256(WS_B4 + (size_t)MT * DM * 2);
constexpr size_t WS_END = al256(WS_SINK + 32768);
constexpr size_t WS_GS = WS_B2, WS_GL = WS_B2 + (size_t)MT * DM * 2;
constexpr size_t WS_SC = WS_B1;
static_assert(WS_GL + (size_t)MT * DM * 2 <= WS_B4, "gate overlay");
static_assert(WS_SC + (size_t)MT * 2048 * 4 <= WS_SINK, "score overlay");
static_assert(WS_END <= (size_t)512 << 20, "d_ws budget");

struct Params {
    const float* in[N_IN];
    float* out;
    unsigned char* ws;
    int ph_lo, ph_hi;
};

__device__ __forceinline__ unsigned f2bf(float f) { return (unsigned)__builtin_bit_cast(unsigned short, (__bf16)f); }
__device__ __forceinline__ float bf2f(unsigned b) { return __uint_as_float(b << 16); }
__device__ __forceinline__ unsigned pk2(float lo, float hi) { typedef float f32x2_ __attribute__((ext_vector_type(2))); return __builtin_bit_cast(unsigned, __builtin_convertvector((f32x2_){lo, hi}, bf16x2_t)); }
__device__ __forceinline__ float bflo(unsigned w) { return __uint_as_float(w << 16); }
__device__ __forceinline__ float bfhi(unsigned w) { return __uint_as_float(w & 0xffff0000u); }
template <int M> __device__ __forceinline__ int shfx_i(int v, int lane) {
    if constexpr (M == 32) { auto r = __builtin_amdgcn_permlane32_swap((unsigned)v, (unsigned)v, false, false); return (int)((lane & 32) ? r[0] : r[1]); }
    else return __builtin_amdgcn_ds_swizzle(v, 0x1f | (M << 10));
}
template <int M> __device__ __forceinline__ float shfx(float v, int lane) { return __int_as_float(shfx_i<M>(__float_as_int(v), lane)); }
__device__ __forceinline__ float shfl_f(float v, int src) { return __int_as_float(__builtin_amdgcn_ds_bpermute(src << 2, __float_as_int(v))); }
__device__ __forceinline__ int shfl_i(int v, int src) { return __builtin_amdgcn_ds_bpermute(src << 2, v); }
template <int CTRL> __device__ __forceinline__ float dppf_(float v) { return __int_as_float(__builtin_amdgcn_update_dpp(0, __float_as_int(v), CTRL, 0xf, 0xf, true)); }
__device__ __forceinline__ float row8_sum(float v) { v += dppf_<0xB1>(v); v += dppf_<0x4E>(v); v += dppf_<0x141>(v); return v; }
__device__ __forceinline__ float wave_sum(float v) {
    v += dppf_<0xB1>(v); v += dppf_<0x4E>(v); v += dppf_<0x141>(v); v += dppf_<0x140>(v);
    { auto r = __builtin_amdgcn_permlane16_swap(__float_as_uint(v), __float_as_uint(v), false, false); v = __uint_as_float(r[0]) + __uint_as_float(r[1]); }
    { auto r = __builtin_amdgcn_permlane32_swap(__float_as_uint(v), __float_as_uint(v), false, false); v = __uint_as_float(r[0]) + __uint_as_float(r[1]); }
    return v;
}
__device__ __forceinline__ float exp_fast(float x) { return __builtin_amdgcn_exp2f(x * 1.4426950408889634f); }
__device__ __forceinline__ float sigmoidf_(float x) { return __builtin_amdgcn_rcpf(1.0f + exp_fast(-x)); }
__device__ __forceinline__ float siluf_(float x) { return x * __builtin_amdgcn_rcpf(1.0f + exp_fast(-x)); }
__device__ __forceinline__ float geluf_(float x) { const float u = 1.5957691216057308f * (x + 0.044715f * x * x * x); return x * __builtin_amdgcn_rcpf(1.0f + exp_fast(-u)); }
__device__ __forceinline__ float softplusf_(float x) { const float e = exp_fast(-fabsf(x));
    const float l = __builtin_amdgcn_logf(1.0f + e) * 0.6931471805599453f, s = e * (1.0f + e * (-0.5f + e * 0.33333333f)); return fmaxf(x, 0.f) + (e < 0.02f ? s : l); }
__device__ __forceinline__ int row_batch(int row) { return row < TP ? (row >> 11) : (row < TT ? 16 + ((row - TP) >> 4) : 23); }
__device__ __forceinline__ float dot2bf(unsigned a, unsigned b, float acc) { return __builtin_amdgcn_fdot2_f32_bf16(__builtin_bit_cast(bf16x2_t, a), __builtin_bit_cast(bf16x2_t, b), acc, false); }
__device__ __forceinline__ float rl(float v, int lane) { return __int_as_float(__builtin_amdgcn_readlane(__float_as_int(v), lane)); }
#define LDS_WAIT() asm volatile("s_waitcnt lgkmcnt(0)" ::: "memory")
#define MFMA32(a, b, c) __builtin_amdgcn_mfma_f32_32x32x16_bf16((a), (b), (c), 0, 0, 0)

typedef const __attribute__((address_space(4))) Params CParams;
template <class T> __device__ __forceinline__ T* as_global(T* p) { __attribute__((address_space(1))) T* g = (__attribute__((address_space(1))) T*)p; asm volatile("" : "+s"(g)); return (T*)g; }
struct Ctx {
    CParams* P; LAS unsigned char* lds; unsigned char* ws; float* out;
    int tid, lane, wave, bid, G;
};
#define WSP(T, off) (as_global((T*)(C.ws + (off))))

__device__ __forceinline__ void tr_item(const float* W, int ldw, int src_col0, int valid, const float* kscale, int k0, bf16_t* dst, LAS float* scr, int lane) {
    const int c4 = lane & 7, r0 = lane >> 3;
    f32x4 v[8];
#pragma unroll
    for (int i = 0; i < 8; ++i) { const int kk = r0 + 8 * i; v[i] = (4 * c4 < valid) ? *(const f32x4*)(W + (size_t)(k0 + kk) * ldw + src_col0 + 4 * c4) : (f32x4){0.f, 0.f, 0.f, 0.f}; }
#pragma unroll
    for (int i = 0; i < 8; ++i) { const int kk = r0 + 8 * i; const float ks = kscale ? kscale[k0 + kk] : 1.0f; LAS float* s = scr + kk * 33 + 4 * c4;
        s[0] = v[i][0] * ks; s[1] = v[i][1] * ks; s[2] = v[i][2] * ks; s[3] = v[i][3] * ks; }
    LDS_WAIT();
    const int c8 = lane & 7;
#pragma unroll
    for (int j = 0; j < 4; ++j) { const int n = (lane >> 3) + 8 * j; const LAS float* s = scr + (8 * c8) * 33 + n;
        u32x4 o; o.x = pk2(s[0 * 33], s[1 * 33]); o.y = pk2(s[2 * 33], s[3 * 33]); o.z = pk2(s[4 * 33], s[5 * 33]); o.w = pk2(s[6 * 33], s[7 * 33]);
        *(u32x4*)(dst + (size_t)n * DM + k0 + 8 * c8) = o; }
    LDS_WAIT();
}
typedef float f32x2 __attribute__((ext_vector_type(2)));
typedef short s16x4_ __attribute__((ext_vector_type(4)));
constexpr size_t WS_U8 = WS_U16, WS_SU = WS_U16 + ((size_t)16 << 20), WS_V8 = WS_V16, WS_SV = WS_V16 + ((size_t)16 << 20);
__device__ __forceinline__ float wave_max(float v) {
    v = fmaxf(v, shfx<1>(v, 0)); v = fmaxf(v, shfx<2>(v, 0)); v = fmaxf(v, shfx<4>(v, 0)); v = fmaxf(v, shfx<8>(v, 0)); v = fmaxf(v, shfx<16>(v, 0));
    auto r = __builtin_amdgcn_permlane32_swap(__float_as_uint(v), __float_as_uint(v), false, false);
    return fmaxf(__uint_as_float(r[0]), __uint_as_float(r[1]));
}
__device__ __forceinline__ void convert_row(const Ctx& C, int it, const f32x4 (&v)[4]) {
    const int lane = C.lane; const bool isv = it >= NE; const int e = isv ? it - NE : it;
    unsigned char* dst = C.ws + (isv ? WS_V8 : WS_U8); float* sc = (float*)(C.ws + (isv ? WS_SV : WS_SU));
    float m = 0.f;
#pragma unroll
    for (int j = 0; j < 4; ++j) m = fmaxf(m, fmaxf(fmaxf(fabsf(v[j][0]), fabsf(v[j][1])), fmaxf(fabsf(v[j][2]), fabsf(v[j][3]))));
    m = wave_max(m);
    const float scale = m > 0.f ? m * (1.0f / 440.0f) : 1.0f, inv = 1.0f / scale;
    if (lane == 0) sc[e] = scale;
#pragma unroll
    for (int j = 0; j < 4; ++j) { int w = __builtin_amdgcn_cvt_pk_fp8_f32(v[j][0] * inv, v[j][1] * inv, 0, false); w = __builtin_amdgcn_cvt_pk_fp8_f32(v[j][2] * inv, v[j][3] * inv, w, true);
        const int slice = 2 * j + (lane >> 5);
        *(int*)(dst + ((size_t)slice * NE + e) * 128 + (lane & 31) * 4) = w; }
}
__device__ __forceinline__ void phase_prep(const Ctx& C) {
    CParams& P = *C.P;
#ifdef PROBE_PREP
    unsigned long long pp_t0 = __builtin_amdgcn_s_memrealtime(); int pp_sec = 0;
#define PP_MARK() { __syncthreads(); const unsigned long long t1_ = __builtin_amdgcn_s_memrealtime(); if (pp_sec == PROBE_PREP && C.tid == 0) *(volatile LAS unsigned long long*)(C.lds + LDS_BYTES - 32) = t1_ - pp_t0; pp_t0 = t1_; ++pp_sec; }
#else
#define PP_MARK()
#endif
    {
        LAS float* Kh = (LAS float*)C.lds;
        LAS float* Wq = (LAS float*)(C.lds + 128 * 132 * 4);
        bf16_t* WcT = WSP(bf16_t, WS_WC);
        for (int it = C.bid; it < 512; it += C.G) {
            const int l = it >> 8, h = (it >> 5) & 7, half = (it >> 4) & 1, jb = it & 15;
            const float* ksrc = as_global(P.in[half ? IN_K2 : IN_K1]) + (size_t)l * 128 * 128;
            const float* wsrc = as_global(P.in[IN_WQ]) + (size_t)l * DM * 2048 + (size_t)(jb * 64) * 2048 + h * 256 + half * 128;
            __syncthreads();
            for (int i = C.tid; i < 128 * 32; i += NTHREADS) { const int r = i >> 5, c4 = i & 31; *(LAS f32x4*)(Kh + r * 132 + c4 * 4) = *(const f32x4*)(ksrc + r * 128 + c4 * 4); }
            for (int i = C.tid; i < 64 * 32; i += NTHREADS) { const int r = i >> 5, c4 = i & 31; *(LAS f32x4*)(Wq + r * 132 + c4 * 4) = *(const f32x4*)(wsrc + (size_t)r * 2048 + c4 * 4); }
            __syncthreads();
            const int l31 = C.lane & 31, kk = C.lane >> 5, nb = C.wave >> 1, jw = C.wave & 1;
            const LAS float* ap = Kh + (32 * nb + l31) * 132 + kk; const LAS float* bp = Wq + (32 * jw + l31) * 132 + kk;
            f32x16 acc;
#pragma unroll
            for (int i = 0; i < 16; ++i) acc[i] = 0.f;
#pragma unroll 16
            for (int s2 = 0; s2 < 64; ++s2) acc = __builtin_amdgcn_mfma_f32_32x32x2f32(ap[2 * s2], bp[2 * s2], acc, 0, 0, 0);
            __syncthreads();
            LAS unsigned char* ot = (LAS unsigned char*)Kh;
#pragma unroll
            for (int r = 0; r < 16; ++r) *(LAS bf16_t*)(ot + (32 * nb + (r & 3) + 8 * (r >> 2) + 4 * kk) * 144 + (32 * jw + l31) * 2) = (bf16_t)f2bf(acc[r]);
            __syncthreads();
            for (int i = C.tid; i < 1024; i += NTHREADS) { const int n = i >> 3, ck = i & 7;
                *(u32x4*)(WcT + ((size_t)l * 2048 + h * 256 + half * 128 + n) * DM + jb * 64 + ck * 8) = *(const LAS u32x4*)(ot + n * 144 + ck * 16); }
        }
        __syncthreads();
    }
    PP_MARK()
    {
        constexpr int SCS = 1025;
        LAS float* sc = (LAS float*)C.lds;
        LAS float* red = (LAS float*)(C.lds + 98816);
        if (C.bid < 192) {
            const float* cpp = as_global(P.in[IN_CP]); const float* csp = as_global(P.in[IN_CS]);
            f32x4 cv[12];
#pragma unroll
            for (int q = 0; q < 12; ++q) { const int i4 = C.tid + q * NTHREADS, bb = i4 >> 8, k4 = i4 & 255; const float* s0 = (bb < 16 ? cpp + bb * DM : csp + (bb - 16) * DM) + 4 * k4; cv[q] = *(const f32x4*)s0; }
#pragma unroll
            for (int q = 0; q < 12; ++q) { const int i4 = C.tid + q * NTHREADS, bb = i4 >> 8, k4 = i4 & 255; LAS float* d = sc + bb * SCS + 4 * k4;
                d[0] = siluf_(cv[q][0]); d[1] = siluf_(cv[q][1]); d[2] = siluf_(cv[q][2]); d[3] = siluf_(cv[q][3]); }
        }
        __syncthreads();
        float* MOD = WSP(float, WS_MOD);
        for (int it = C.bid; it < 192; it += C.G) {
            const int l = it / 96, cg_ = it % 96, j = cg_ * 64 + C.lane;
            const int l31 = C.lane & 31, kk = C.lane >> 5, k0 = C.wave * 128;
            const float* wm = as_global(P.in[IN_WMOD]) + (size_t)l * DM * 6144 + (size_t)(k0 + kk) * 6144 + cg_ * 64 + l31;
            const LAS float* sp = sc + (l31 < NBT ? l31 : 0) * SCS + k0 + kk;
            f32x16 a0, a1;
#pragma unroll
            for (int i = 0; i < 16; ++i) { a0[i] = 0.f; a1[i] = 0.f; }
#pragma unroll 16
            for (int s2 = 0; s2 < 64; ++s2) { const float av = sp[2 * s2]; const float b0 = wm[(size_t)(2 * s2) * 6144], b1 = wm[(size_t)(2 * s2) * 6144 + 32];
                a0 = __builtin_amdgcn_mfma_f32_32x32x2f32(av, b0, a0, 0, 0, 0); a1 = __builtin_amdgcn_mfma_f32_32x32x2f32(av, b1, a1, 0, 0, 0); }
#pragma unroll
            for (int r = 0; r < 12; ++r) { const int bb = (r & 3) + 8 * (r >> 2) + 4 * kk;
                red[(C.wave * NBT + bb) * 64 + l31] = a0[r]; red[(C.wave * NBT + bb) * 64 + 32 + l31] = a1[r]; }
            __syncthreads();
            const float bm = as_global(P.in[IN_BMOD])[l * 6144 + j];
#pragma unroll
            for (int q = 0; q < 3; ++q) { const int bb = 3 * C.wave + q; float a = bm;
#pragma unroll
                for (int w8 = 0; w8 < 8; ++w8) a += red[(w8 * NBT + bb) * 64 + C.lane];
                MOD[((size_t)l * NBT + bb) * 6144 + j] = a; }
            __syncthreads();
        }
        __syncthreads();
    }
    PP_MARK()
    {
        LAS float* scr = (LAS float*)(C.lds + C.wave * 16384);
        const int gw = C.bid * NWAVES + C.wave, NGW = C.G * NWAVES;
        constexpr int I_W1 = 144 * 16, I_WG = 64 * 16, I_SQ = 32 * 16, PER_L = I_W1 + I_WG + 3 * I_SQ;
        for (int it = gw; it < 2 * PER_L; it += NGW) {
            const int l = it / PER_L; int r = it % PER_L;
            if (r < I_W1) { const int nb = r >> 4, kb = r & 15, n0 = nb * 32; int src, valid;
                if (n0 < 2304) { src = n0; valid = 32; } else if (n0 < 4352) { src = n0 + 16; valid = 32; } else if (n0 == 4352) { src = 2304; valid = 16; } else { src = 0; valid = 0; }
                tr_item(as_global(P.in[IN_WIN]) + (size_t)l * DM * INC, INC, src, valid, nullptr, kb * 64, WSP(bf16_t, WS_W1T) + ((size_t)l * N1 + n0) * DM, scr, C.lane); continue; }
            r -= I_W1;
            if (r < I_WG) { const int nb = r >> 4, kb = r & 15, n0 = nb * 32;
                tr_item(as_global(P.in[IN_WIN]) + (size_t)l * DM * INC, INC, 4368 + n0, 32, nullptr, kb * 64, WSP(bf16_t, WS_WGT) + ((size_t)l * NG + n0) * DM, scr, C.lane); continue; }
            r -= I_WG;
            const int which = r / I_SQ; r %= I_SQ; const int nb = r >> 4, kb = r & 15, n0 = nb * 32;
            const float* src = as_global(P.in[which == 0 ? IN_WBS : (which == 1 ? IN_WBL : IN_WO)]) + (size_t)l * DM * DM;
            bf16_t* dst = WSP(bf16_t, which == 0 ? WS_WBS : (which == 1 ? WS_WBL : WS_WO)) + ((size_t)l * DM + n0) * DM;
            tr_item(src, DM, n0, 32, which == 0 ? as_global(P.in[IN_SNW]) + l * DM : nullptr, kb * 64, dst, scr, C.lane);
        }
    }
    PP_MARK()
    {
        bf16_t* LW = (bf16_t*)(C.ws + WS_LRUW);
        const float* wap = as_global(P.in[IN_WA]); const float* wxp = as_global(P.in[IN_WX]);
        for (int i = C.bid * NTHREADS + C.tid; i < 2 * 16 * 2 * 4096; i += C.G * NTHREADS) {
            const int d = i & 63, e = (i >> 6) & 63, gate = (i >> 12) & 1, lj = i >> 13;
            LW[i] = (bf16_t)f2bf((gate ? wxp : wap)[(size_t)lj * 4096 + d * 64 + e]);
        }
    }
    PP_MARK()
#undef PP_MARK
}

__device__ __forceinline__ void phase_norm(const Ctx& C, int l, int which) {
    CParams& P = *C.P;
    const int gw = C.bid * NWAVES + C.wave, NGW = C.G * NWAVES;
    bf16_t* H = WSP(bf16_t, WS_B0);
    const float* lw = as_global(P.in[which ? IN_LN2 : IN_LN1]) + l * DM;
    const float* MOD = WSP(float, WS_MOD);
    const float* xpp = as_global(P.in[IN_XP]); const float* xsp = as_global(P.in[IN_XS]);
#define NORM_SRC(row_) ((which == 0 && l == 0) ? ((row_) < TP ? xpp + (size_t)(row_) * DM : xsp + (size_t)((row_) - TP) * DM) : C.out + (size_t)(row_) * DM)
    const int c0 = 8 * C.lane;
    f32x4 lwv[4];
#pragma unroll
    for (int j = 0; j < 4; ++j) lwv[j] = *(const f32x4*)(lw + (j >> 1) * 512 + c0 + (j & 1) * 4);
    f32x4 nv[4];
    { const float* xr = NORM_SRC(min(gw, TT - 1)) + c0;
#pragma unroll
      for (int j = 0; j < 4; ++j) nv[j] = *(const f32x4*)(xr + (j >> 1) * 512 + (j & 1) * 4); }
    for (int row = gw; row < TT; row += NGW) {
        f32x4 v[4]; float s = 0.f;
#pragma unroll
        for (int j = 0; j < 4; ++j) { v[j] = nv[j]; s += (v[j][0] * v[j][0] + v[j][1] * v[j][1]) + (v[j][2] * v[j][2] + v[j][3] * v[j][3]); }
        { const float* xr = NORM_SRC(min(row + NGW, TT - 1)) + c0;
#pragma unroll
          for (int j = 0; j < 4; ++j) nv[j] = *(const f32x4*)(xr + (j >> 1) * 512 + (j & 1) * 4); }
        const float rstd = rsqrtf(wave_sum(s) * (1.f / DM) + EPS);
        const float* md = MOD + ((size_t)l * NBT + row_batch(row)) * 6144 + (which ? 3072 : 0) + c0;
        f32x4 y[4];
#pragma unroll
        for (int j = 0; j < 4; ++j) { const int co = (j >> 1) * 512 + (j & 1) * 4;
            const f32x4 sh = *(const f32x4*)(md + co), scv = *(const f32x4*)(md + 1024 + co);
            y[j] = (v[j] * rstd * lwv[j]) * (scv + 1.0f) + sh; }
        bf16_t* hp = H + (size_t)row * DM + c0;
        *(u32x4*)hp = (u32x4){pk2(y[0][0], y[0][1]), pk2(y[0][2], y[0][3]), pk2(y[1][0], y[1][1]), pk2(y[1][2], y[1][3])};
        *(u32x4*)(hp + 512) = (u32x4){pk2(y[2][0], y[2][1]), pk2(y[2][2], y[2][3]), pk2(y[3][0], y[3][1]), pk2(y[3][2], y[3][3])};
    }
#undef NORM_SRC
}

struct Epi1 {
    static constexpr bool MIDSCALE = false;
    static constexpr bool TILEW = false;
    static constexpr bool TILE = false;
    __device__ __forceinline__ bool idem() const { return true; }
    static constexpr int NK = 5; static constexpr bool PERM = true;
    bf16_t *Z, *XBC, *LX, *LY; float* DT; const float* dtb;
    __device__ __forceinline__ int kind(int pn) const { return pn < 4 ? 0 : (pn < 9 ? 1 : (pn < 13 ? 2 : (pn < 17 ? 3 : 4))); }
    template <int KD> __device__ __forceinline__ void apply(int, int row, int col, f32x4 v) const {
        if constexpr (KD == 0) { *(u32x2*)(Z + (size_t)row * DM + col) = (u32x2){pk2(siluf_(v[0]), siluf_(v[1])), pk2(siluf_(v[2]), siluf_(v[3]))}; }
        else if constexpr (KD == 1) { *(u32x2*)(XBC + (size_t)row * 1280 + (col - 1024)) = (u32x2){pk2(v[0], v[1]), pk2(v[2], v[3])}; }
        else if constexpr (KD == 2) { *(u32x2*)(LX + (size_t)row * DM + (col - 2304)) = (u32x2){pk2(v[0], v[1]), pk2(v[2], v[3])}; }
        else if constexpr (KD == 3) { *(u32x2*)(LY + (size_t)row * DM + (col - 3328)) = (u32x2){pk2(geluf_(v[0]), geluf_(v[1])), pk2(geluf_(v[2]), geluf_(v[3]))}; }
        else { if (col < 4368) { const int c = col - 4352; const f32x4 b = *(const f32x4*)(dtb + c);
            *(f32x4*)(DT + (size_t)row * 16 + c) = (f32x4){softplusf_(v[0] + b[0]), softplusf_(v[1] + b[1]), softplusf_(v[2] + b[2]), softplusf_(v[3] + b[3])}; } }
    }
    __device__ __forceinline__ void tile_dt(const f32x4 (&acc)[2][2][4][2], int pm, int wr, int wc, int fr, int fq) const {
        if (wc != 0 || fq >= 2) return;
        const int c = 8 * fq; const f32x4 b0 = *(const f32x4*)(dtb + c), b1 = *(const f32x4*)(dtb + c + 4);
#pragma unroll
        for (int ai = 0; ai < 2; ++ai)
#pragma unroll
            for (int m = 0; m < 4; ++m) { float* d = DT + (size_t)(pm * 256 + ai * 128 + wr * 64 + m * 16 + fr) * 16 + c; const f32x4 v0 = acc[ai][0][m][0] + b0, v1 = acc[ai][0][m][1] + b1;
                *(f32x4*)d = (f32x4){softplusf_(v0[0]), softplusf_(v0[1]), softplusf_(v0[2]), softplusf_(v0[3])}; *(f32x4*)(d + 4) = (f32x4){softplusf_(v1[0]), softplusf_(v1[1]), softplusf_(v1[2]), softplusf_(v1[3])}; }
    }
    template <int KD> static constexpr bool swap_kind() { return KD < 4; }
    template <int KD> __device__ __forceinline__ u32x4 pack8(f32x4 a, f32x4 b) const {
        if constexpr (KD == 0) return (u32x4){pk2(siluf_(a[0]), siluf_(a[1])), pk2(siluf_(a[2]), siluf_(a[3])), pk2(siluf_(b[0]), siluf_(b[1])), pk2(siluf_(b[2]), siluf_(b[3]))};
        else if constexpr (KD == 3) return (u32x4){pk2(geluf_(a[0]), geluf_(a[1])), pk2(geluf_(a[2]), geluf_(a[3])), pk2(geluf_(b[0]), geluf_(b[1])), pk2(geluf_(b[2]), geluf_(b[3]))};
        else return (u32x4){pk2(a[0], a[1]), pk2(a[2], a[3]), pk2(b[0], b[1]), pk2(b[2], b[3])};
    }
    template <int KD> __device__ __forceinline__ void store8(int row, int col, u32x4 v) const {
        if constexpr (KD == 0) __builtin_nontemporal_store(v, (u32x4*)(Z + (size_t)row * DM + col));
        else if constexpr (KD == 1) __builtin_nontemporal_store(v, (u32x4*)(XBC + (size_t)row * 1280 + (col - 1024)));
        else if constexpr (KD == 2) __builtin_nontemporal_store(v, (u32x4*)(LX + (size_t)row * DM + (col - 2304)));
        else __builtin_nontemporal_store(v, (u32x4*)(LY + (size_t)row * DM + (col - 3328)));
    }
    template <int KD> __device__ __forceinline__ void apply8(int w, int row, int col, f32x4 a, f32x4 b) const {
        if constexpr (KD == 0) { *(u32x4*)(Z + (size_t)row * DM + col) = (u32x4){pk2(siluf_(a[0]), siluf_(a[1])), pk2(siluf_(a[2]), siluf_(a[3])), pk2(siluf_(b[0]), siluf_(b[1])), pk2(siluf_(b[2]), siluf_(b[3]))}; }
        else if constexpr (KD == 1) { *(u32x4*)(XBC + (size_t)row * 1280 + (col - 1024)) = (u32x4){pk2(a[0], a[1]), pk2(a[2], a[3]), pk2(b[0], b[1]), pk2(b[2], b[3])}; }
        else if constexpr (KD == 2) { *(u32x4*)(LX + (size_t)row * DM + (col - 2304)) = (u32x4){pk2(a[0], a[1]), pk2(a[2], a[3]), pk2(b[0], b[1]), pk2(b[2], b[3])}; }
        else if constexpr (KD == 3) { *(u32x4*)(LY + (size_t)row * DM + (col - 3328)) = (u32x4){pk2(geluf_(a[0]), geluf_(a[1])), pk2(geluf_(a[2]), geluf_(a[3])), pk2(geluf_(b[0]), geluf_(b[1])), pk2(geluf_(b[2]), geluf_(b[3]))}; }
        else { apply<KD>(w, row, col, a); apply<KD>(w, row, col + 4, b); }
    }
};
struct Epi2 {
    static constexpr bool MIDSCALE = false;
    static constexpr bool TILEW = false;
    static constexpr bool TILE = false;
    __device__ __forceinline__ bool idem() const { return true; }
    static constexpr int NK = 2; static constexpr bool PERM = true;
    bf16_t *GS, *GL;
    __device__ __forceinline__ int kind(int pn) const { return pn < 4 ? 0 : 1; }
    template <int KD> __device__ __forceinline__ void apply(int, int row, int col, f32x4 v) const {
        bf16_t* d = (KD == 0 ? GS + (size_t)row * DM + col : GL + (size_t)row * DM + (col - 1024));
        *(u32x2*)d = (u32x2){pk2(sigmoidf_(v[0]), sigmoidf_(v[1])), pk2(sigmoidf_(v[2]), sigmoidf_(v[3]))};
    }
    template <int KD> static constexpr bool swap_kind() { return true; }
    template <int KD> __device__ __forceinline__ u32x4 pack8(f32x4 a, f32x4 b) const {
        return (u32x4){pk2(sigmoidf_(a[0]), sigmoidf_(a[1])), pk2(sigmoidf_(a[2]), sigmoidf_(a[3])), pk2(sigmoidf_(b[0]), sigmoidf_(b[1])), pk2(sigmoidf_(b[2]), sigmoidf_(b[3]))}; }
    template <int KD> __device__ __forceinline__ void store8(int row, int col, u32x4 v) const { __builtin_nontemporal_store(v, (u32x4*)(KD == 0 ? GS + (size_t)row * DM + col : GL + (size_t)row * DM + (col - 1024))); }
    template <int KD> __device__ __forceinline__ void apply8(int, int row, int col, f32x4 a, f32x4 b) const {
        bf16_t* d = (KD == 0 ? GS + (size_t)row * DM + col : GL + (size_t)row * DM + (col - 1024));
        *(u32x4*)d = (u32x4){pk2(sigmoidf_(a[0]), sigmoidf_(a[1])), pk2(sigmoidf_(a[2]), sigmoidf_(a[3])), pk2(sigmoidf_(b[0]), sigmoidf_(b[1])), pk2(sigmoidf_(b[2]), sigmoidf_(b[3]))};
    }
};
struct Epi3 {
    static constexpr bool TILE = false;
    __device__ __forceinline__ bool idem() const { return true; }
    static constexpr int NK = 1; static constexpr bool PERM = true;
    template <int KD> static constexpr bool swap_kind() { return false; }
    const bf16_t *GS, *GL; const float* SSQ; bf16_t* MG;
    __device__ __forceinline__ int kind(int) const { return 0; }
    __device__ __forceinline__ float rstd_of(int row) const { const f32x4* q = (const f32x4*)(SSQ + (size_t)row * 16); const f32x4 a = q[0] + q[1] + q[2] + q[3];
        return rsqrtf(((a[0] + a[1]) + (a[2] + a[3])) * (1.f / DM) + EPS); }
    static constexpr bool TILEW = true, MIDSCALE = true;
    static constexpr float GL_FLOOR = 1e-20f;
    __device__ __forceinline__ void mid(f32x4 (&acc)[2][2][4][2], int pm, int pn, int wr, int wc, int fr, int fq) const {
        const int colb = pn * 256 + wc * 64 + 8 * fq;
#pragma unroll
        for (int ai = 0; ai < 2; ++ai) {
            const int r0 = pm * 256 + ai * 128 + wr * 64 + fr;
            float rs[4];
            { f32x4 q[4][4];
#pragma unroll
              for (int m = 0; m < 4; ++m) { const f32x4* sp = (const f32x4*)(SSQ + (size_t)(r0 + 16 * m) * 16); q[m][0] = sp[0]; q[m][1] = sp[1]; q[m][2] = sp[2]; q[m][3] = sp[3]; }
#pragma unroll
              for (int m = 0; m < 4; ++m) { const f32x4 a = q[m][0] + q[m][1] + q[m][2] + q[m][3]; rs[m] = rsqrtf(((a[0] + a[1]) + (a[2] + a[3])) * (1.f / DM) + EPS); } }
            u32x4 g[4][2], h[4][2];
#pragma unroll
            for (int m = 0; m < 4; ++m) { const size_t ro = (size_t)(r0 + 16 * m) * DM + colb; g[m][0] = *(const u32x4*)(GS + ro); g[m][1] = *(const u32x4*)(GS + ro + 32);
                h[m][0] = *(const u32x4*)(GL + ro); h[m][1] = *(const u32x4*)(GL + ro + 32); }
#pragma unroll
            for (int m = 0; m < 4; ++m)
#pragma unroll
                for (int bj = 0; bj < 2; ++bj) { const u32x4 q = g[m][bj], o = h[m][bj]; const float r = rs[m];
#define SC_(gw_, lw_) ((gw_) * r * __builtin_amdgcn_rcpf(fmaxf((lw_), GL_FLOOR)))
                    acc[ai][bj][m][0] *= (f32x4){SC_(bflo(q.x), bflo(o.x)), SC_(bfhi(q.x), bfhi(o.x)), SC_(bflo(q.y), bflo(o.y)), SC_(bfhi(q.y), bfhi(o.y))};
                    acc[ai][bj][m][1] *= (f32x4){SC_(bflo(q.z), bflo(o.z)), SC_(bfhi(q.z), bfhi(o.z)), SC_(bflo(q.w), bflo(o.w)), SC_(bfhi(q.w), bfhi(o.w))};
#undef SC_
                }
        }
    }
    __device__ __forceinline__ void tilew(const f32x4 (&acc)[2][2][4][2], int pm, int pn, int w, int wr, int wc, int fr, int fq) const {
        const int colb = pn * 256 + wc * 64 + 8 * fq;
#pragma unroll
        for (int ai = 0; ai < 2; ++ai) {
            const int r0 = pm * 256 + ai * 128 + wr * 64 + fr;
            u32x4 h[4][2];
#pragma unroll
            for (int m = 0; m < 4; ++m) { const size_t ro = (size_t)(r0 + 16 * m) * DM + colb; h[m][0] = *(const u32x4*)(GL + ro); h[m][1] = *(const u32x4*)(GL + ro + 32); }
            asm volatile("" ::: "memory");
#pragma unroll
            for (int m = 0; m < 4; ++m)
#pragma unroll
                for (int bj = 0; bj < 2; ++bj) { const u32x4 o = h[m][bj]; const f32x4 a = acc[ai][bj][m][0], b = acc[ai][bj][m][1];
#define GF_(x_) fmaxf((x_), GL_FLOOR)
                    *(u32x4*)(MG + (size_t)(r0 + 16 * m) * DM + colb + 32 * bj) = (u32x4){pk2(GF_(bflo(o.x)) * a[0], GF_(bfhi(o.x)) * a[1]), pk2(GF_(bflo(o.y)) * a[2], GF_(bfhi(o.y)) * a[3]),
                                                                                          pk2(GF_(bflo(o.z)) * b[0], GF_(bfhi(o.z)) * b[1]), pk2(GF_(bflo(o.w)) * b[2], GF_(bfhi(o.w)) * b[3])};
#undef GF_
                }
            asm volatile("" ::: "memory");
        }
    }
    template <int KD> __device__ __forceinline__ void apply(int w, int row, int col, f32x4 v) const {
        u32x2* m = (u32x2*)(MG + (size_t)row * DM + col);
        if (w == 0) { const float rstd = rstd_of(row);
            const u32x2 g = *(const u32x2*)(GS + (size_t)row * DM + col);
            *m = (u32x2){pk2(bflo(g.x) * rstd * v[0], bfhi(g.x) * rstd * v[1]), pk2(bflo(g.y) * rstd * v[2], bfhi(g.y) * rstd * v[3])};
        } else {
            const u32x2 g = *(const u32x2*)(GL + (size_t)row * DM + col); const u32x2 p = *m;
            *m = (u32x2){pk2(bflo(p.x) + bflo(g.x) * v[0], bfhi(p.x) + bfhi(g.x) * v[1]), pk2(bflo(p.y) + bflo(g.y) * v[2], bfhi(p.y) + bfhi(g.y) * v[3])};
        }
    }
    template <int KD> __device__ __forceinline__ void apply8(int w, int row, int col, f32x4 a, f32x4 b) const {
        u32x4* m = (u32x4*)(MG + (size_t)row * DM + col);
        if (w == 0) { const float rstd = rstd_of(row);
            const u32x4 g = *(const u32x4*)(GS + (size_t)row * DM + col);
            *m = (u32x4){pk2(bflo(g.x) * rstd * a[0], bfhi(g.x) * rstd * a[1]), pk2(bflo(g.y) * rstd * a[2], bfhi(g.y) * rstd * a[3]), pk2(bflo(g.z) * rstd * b[0], bfhi(g.z) * rstd * b[1]), pk2(bflo(g.w) * rstd * b[2], bfhi(g.w) * rstd * b[3])};
        } else {
            const u32x4 g = *(const u32x4*)(GL + (size_t)row * DM + col); const u32x4 p = *m;
            *m = (u32x4){pk2(bflo(p.x) + bflo(g.x) * a[0], bfhi(p.x) + bfhi(g.x) * a[1]), pk2(bflo(p.y) + bflo(g.y) * a[2], bfhi(p.y) + bfhi(g.y) * a[3]),
                         pk2(bflo(p.z) + bflo(g.z) * b[0], bfhi(p.z) + bfhi(g.z) * b[1]), pk2(bflo(p.w) + bflo(g.w) * b[2], bfhi(p.w) + bfhi(g.w) * b[3])};
        }
    }
};
struct Epi4 {
    static constexpr bool MIDSCALE = false;
    static constexpr bool TILEW = false;
    static constexpr bool PERM = true;
    template <int KD> static constexpr bool swap_kind() { return false; }
    __device__ __forceinline__ bool idem() const { return layer == 0; }
    static constexpr int NK = 1;
    const float *xp, *xs; float* XR; const float* MODl; int layer;
    __device__ __forceinline__ int kind(int) const { return 0; }
    template <int KD> __device__ __forceinline__ void apply(int, int row, int col, f32x4 v) const {
        if (row >= TT) return;
        const float* src = layer == 0 ? (row < TP ? xp + (size_t)row * DM : xs + (size_t)(row - TP) * DM) : XR + (size_t)row * DM;
        const f32x4 x = *(const f32x4*)(src + col), g = *(const f32x4*)(MODl + (size_t)row_batch(row) * 6144 + 2048 + col);
        *(f32x4*)(XR + (size_t)row * DM + col) = x + g * v;
    }
    static constexpr bool TILE = true;
    __device__ __forceinline__ void tile(const f32x4 (&acc)[2][2][4][2], int pm, int pn, int wr, int wc, int fr, int fq) const {
        const int colb = pn * 256 + wc * 64 + 8 * fq; const float* gp = MODl + (size_t)(pm >> 3) * 6144 + 2048 + colb;
        const f32x4 g00 = *(const f32x4*)gp, g01 = *(const f32x4*)(gp + 4), g10 = *(const f32x4*)(gp + 32), g11 = *(const f32x4*)(gp + 36);
        const float* sb = (layer == 0 ? xp : XR) + colb; float* db = XR + colb;
#pragma unroll
        for (int ai = 0; ai < 2; ++ai) {
            f32x4 x[4][4];
#pragma unroll
            for (int m = 0; m < 4; ++m) { const size_t ro = (size_t)(pm * 256 + ai * 128 + wr * 64 + m * 16 + fr) * DM;
                x[m][0] = *(const f32x4*)(sb + ro); x[m][1] = *(const f32x4*)(sb + ro + 4); x[m][2] = *(const f32x4*)(sb + ro + 32); x[m][3] = *(const f32x4*)(sb + ro + 36); }
            asm volatile("" ::: "memory");
#pragma unroll
            for (int m = 0; m < 4; ++m) { const size_t ro = (size_t)(pm * 256 + ai * 128 + wr * 64 + m * 16 + fr) * DM;
                *(f32x4*)(db + ro) = x[m][0] + g00 * acc[ai][0][m][0]; *(f32x4*)(db + ro + 4) = x[m][1] + g01 * acc[ai][0][m][1];
                *(f32x4*)(db + ro + 32) = x[m][2] + g10 * acc[ai][1][m][0]; *(f32x4*)(db + ro + 36) = x[m][3] + g11 * acc[ai][1][m][1]; }
            asm volatile("" ::: "memory");
        }
    }
    template <int KD> __device__ __forceinline__ void apply8(int, int row, int col, f32x4 a, f32x4 b) const {
        const float* src = (layer == 0 ? xp : XR) + (size_t)row * DM + col; const float* gp = MODl + (size_t)(row >> 11) * 6144 + 2048 + col;
        const f32x4 x0 = *(const f32x4*)src, x1 = *(const f32x4*)(src + 4), g0 = *(const f32x4*)gp, g1 = *(const f32x4*)(gp + 4);
        float* d = XR + (size_t)row * DM + col; *(f32x4*)d = x0 + g0 * a; *(f32x4*)(d + 4) = x1 + g1 * b;
    }
};
struct Epi5 {
    static constexpr bool MIDSCALE = false;
    static constexpr bool TILEW = false;
    static constexpr bool TILE = false;
    static constexpr bool PERM = true;
    __device__ __forceinline__ bool idem() const { return true; }
    static constexpr int NK = 1;
    bf16_t* SC;
    __device__ __forceinline__ int kind(int) const { return 0; }
    template <int KD> __device__ __forceinline__ void apply(int, int row, int col, f32x4 v) const { *(u32x2*)(SC + (size_t)row * 2048 + col) = (u32x2){pk2(v[0], v[1]), pk2(v[2], v[3])}; }
    template <int KD> static constexpr bool swap_kind() { return true; }
    template <int KD> __device__ __forceinline__ u32x4 pack8(f32x4 a, f32x4 b) const { return (u32x4){pk2(a[0], a[1]), pk2(a[2], a[3]), pk2(b[0], b[1]), pk2(b[2], b[3])}; }
    template <int KD> __device__ __forceinline__ void store8(int row, int col, u32x4 v) const { __builtin_nontemporal_store(v, (u32x4*)(SC + (size_t)row * 2048 + col)); }
    template <int KD> __device__ __forceinline__ void apply8(int, int row, int col, f32x4 a, f32x4 b) const { *(u32x4*)(SC + (size_t)row * 2048 + col) = (u32x4){pk2(a[0], a[1]), pk2(a[2], a[3]), pk2(b[0], b[1]), pk2(b[2], b[3])}; }
};

namespace pg8 {
constexpr int BM = 256, BK = 64, HALF = 128, HTB = HALF * BK * 2, STAGE_BYTES = 8 * HTB, NXCD = 8, WGM = 8;
__host__ __device__ __forceinline__ int lds_byte(int r, int c) { const int st = (r >> 4) * 2 + (c >> 5), rr = r & 15, cc = c & 31, ob = rr * 64 + cc * 2; return st * 1024 + (ob ^ (((ob >> 9) & 1) << 5)); }
__host__ __device__ __forceinline__ void stage_rc(int b, int& R, int& C) { const int st = b / 1024, sb = b % 1024, swz = sb ^ (((sb >> 9) & 1) << 5); R = (st >> 1) * 16 + swz / 64; C = (st & 1) * 32 + (swz % 64) / 2; }
struct Unit { int pm, pn, w; };
struct Sched {
    int nM, nN, nW, nwg, G, c; const char *A0, *B0, *A1, *B1;
    __device__ __forceinline__ bool next(int i, Unit& u) const {
        const int ti = i / nW; u.w = i - ti * nW;
        const long L = (long)ti * G + c; if (L >= nwg) return false;
        int wgid = (int)L; { const int q = nwg / NXCD, r = nwg % NXCD, xcd = wgid % NXCD, off = wgid / NXCD; wgid = (xcd < r ? xcd * (q + 1) : r * (q + 1) + (xcd - r) * q) + off; }
        const int nig = WGM * nN, gid = wgid / nig, fm = gid * WGM, gsz = (nM - fm) < WGM ? (nM - fm) : WGM;
        u.pm = fm + ((wgid % nig) % gsz); u.pn = (wgid % nig) / gsz; return true;
    }
};
__host__ __device__ __forceinline__ int perm32(int rho) { const int n = rho >> 4, i = rho & 15; return 8 * (i >> 2) + 4 * n + (i & 3); }
template <int KD, class Epi>
__device__ __forceinline__ void epi_tile(const Epi& E, const f32x4 (&acc)[2][2][4][2], const Unit& u, int wr, int wc, int fr, int fq) {
    if constexpr (Epi::PERM && Epi::template swap_kind<KD>()) {
        const bool lo = fr < 8; const int colx = u.pn * BM + wc * 64 + (lo ? 0 : 32) + 8 * fq;
#pragma unroll
        for (int ai = 0; ai < 2; ++ai)
#pragma unroll
            for (int m = 0; m < 4; ++m) { const int rowb = u.pm * BM + ai * HALF + wr * 64 + m * 16 + (fr & 7);
                const u32x4 p0 = E.template pack8<KD>(acc[ai][0][m][0], acc[ai][0][m][1]), p1 = E.template pack8<KD>(acc[ai][1][m][0], acc[ai][1][m][1]);
                u32x4 rcv, sa, sb;
#pragma unroll
                for (int q = 0; q < 4; ++q) { const unsigned snd = lo ? p1[q] : p0[q]; rcv[q] = (unsigned)__builtin_amdgcn_update_dpp(0, (int)snd, 0x128, 0xf, 0xf, true);
                    sa[q] = lo ? p0[q] : rcv[q]; sb[q] = lo ? rcv[q] : p1[q]; }
                E.template store8<KD>(rowb, colx, sa); E.template store8<KD>(rowb + 8, colx, sb); }
    } else {
#pragma unroll
    for (int ai = 0; ai < 2; ++ai)
#pragma unroll
        for (int m = 0; m < 4; ++m) { const int row = u.pm * BM + ai * HALF + wr * 64 + m * 16 + fr;
#pragma unroll
            for (int bj = 0; bj < 2; ++bj) {
                if constexpr (Epi::PERM) E.template apply8<KD>(u.w, row, u.pn * BM + wc * 64 + bj * 32 + 8 * fq, acc[ai][bj][m][0], acc[ai][bj][m][1]);
                else {
#pragma unroll
                    for (int n = 0; n < 2; ++n) E.template apply<KD>(u.w, row, u.pn * BM + bj * HALF + wc * 32 + n * 16 + 4 * fq, acc[ai][bj][m][n]); } } }
    }
}
template <class Epi>
__device__ __forceinline__ void epi_apply(const Epi& E, const f32x4 (&acc)[2][2][4][2], const Unit& u, int wr, int wc, int fr, int fq) {
    if constexpr (Epi::TILEW) E.tilew(acc, u.pm, u.pn, u.w, wr, wc, fr, fq);
    else if constexpr (Epi::TILE) E.tile(acc, u.pm, u.pn, wr, wc, fr, fq);
    else if constexpr (Epi::NK == 1) epi_tile<0>(E, acc, u, wr, wc, fr, fq);
    else { const int kd = E.kind(u.pn);
        if (kd == 0) epi_tile<0>(E, acc, u, wr, wc, fr, fq);
        else if (kd == 1) epi_tile<1>(E, acc, u, wr, wc, fr, fq);
        else if constexpr (Epi::NK > 2) { if (kd == 2) epi_tile<2>(E, acc, u, wr, wc, fr, fq); else if (kd == 3) epi_tile<3>(E, acc, u, wr, wc, fr, fq); else E.tile_dt(acc, u.pm, wr, wc, fr, fq); } }
}
template <class Epi, bool ALIGN_EPI = true, bool SP2 = true>
__device__ __forceinline__ void gemm_phase(LAS unsigned char* lds, int tid, int K, const Sched& S, const Epi& E, bool dry = false) {
    const int wid = __builtin_amdgcn_readfirstlane(tid >> 6), lane = tid & 63, wr = wid >> 2, wc = wid & 3, fr = lane & 15, fq = lane >> 4;
    const int nt = K / BK;
    unsigned voffA[2], voffB[2];
#pragma unroll
    for (int i = 0; i < 2; ++i) { int R, Cc; stage_rc(tid * 16 + i * 8192, R, Cc); const int Rb = Epi::PERM ? (64 * (R >> 5) + perm32(R & 31)) : R;
        voffA[i] = (unsigned)(R * K + Cc) * 2u; voffB[i] = (unsigned)(Rb * K + Cc) * 2u; }
    const size_t kstep = (size_t)(BK * 2);
    const size_t hstep = (size_t)HALF * K * 2;
    const size_t tstep = 2 * hstep;
    const size_t hstepB = Epi::PERM ? (size_t)32 * K * 2 : hstep;
    const unsigned ldsw = (unsigned)wid * 1024u;
    const int aoff = lds_byte(wr * 64 + fr, fq * 8), boff = lds_byte(wc * 32 + fr, fq * 8);
#define PG8_SA(b, h) (((b) * 2 + (h)) * HTB)
#define PG8_SB(b, h) ((4 + (b) * 2 + (h)) * HTB)
#define PG8_STAGE(bufoff, gbase, voff) do { _Pragma("unroll") for (int _i = 0; _i < 2; ++_i) \
        __builtin_amdgcn_global_load_lds((const unsigned*)((const char*)(gbase) + (voff)[_i]), (LAS unsigned*)(lds + (bufoff) + ldsw + _i * 8192), 16, 0, 0); } while (0)
#define PG8_LDA(dst, b, h) do { _Pragma("unroll") for (int m = 0; m < 4; ++m) _Pragma("unroll") for (int k = 0; k < 2; ++k) dst[m][k] = *(const LAS bf16x8*)(lds + PG8_SA(b, h) + aoff + m * 2048 + k * 1024); } while (0)
#define PG8_LDB(dst, b, h) do { _Pragma("unroll") for (int n = 0; n < 2; ++n) _Pragma("unroll") for (int k = 0; k < 2; ++k) dst[n][k] = *(const LAS bf16x8*)(lds + PG8_SB(b, h) + boff + n * 2048 + k * 1024); } while (0)
#define PG8_MMA(ai, bj, At, Bt) do { __builtin_amdgcn_s_setprio(1); _Pragma("unroll") for (int m = 0; m < 4; ++m) _Pragma("unroll") for (int n = 0; n < 2; ++n) _Pragma("unroll") for (int k = 0; k < 2; ++k) \
        acc[ai][bj][m][n] = __builtin_amdgcn_mfma_f32_16x16x32_bf16(Bt[n][k], At[m][k], acc[ai][bj][m][n], 0, 0, 0); __builtin_amdgcn_s_setprio(0); } while (0)
#define PG8_WAIT_V(n) asm volatile("s_waitcnt vmcnt(" #n ")" ::: "memory")
#define PG8_WAIT_L(n) asm volatile("s_waitcnt lgkmcnt(" #n ")" ::: "memory")
#define PG8_BAR __builtin_amdgcn_s_barrier()
#define PG8_SCHED __builtin_amdgcn_sched_barrier(0)
    Unit cur, nxt; int ui = 0; bool keep_acc = false;
    if (!S.next(0, cur)) return;
    f32x4 acc[2][2][4][2];
#pragma unroll
    for (int a = 0; a < 2; ++a)
#pragma unroll
        for (int b = 0; b < 2; ++b)
#pragma unroll
            for (int m = 0; m < 4; ++m)
#pragma unroll
                for (int n = 0; n < 2; ++n) acc[a][b][m][n] = (f32x4){0.f, 0.f, 0.f, 0.f};
    bf16x8 At[4][2], B0[2][2], B1[2][2];
    const char* cA = (cur.w ? S.A1 : S.A0) + (size_t)cur.pm * tstep; const char* cB = (cur.w ? S.B1 : S.B0) + (size_t)cur.pn * tstep;
    if constexpr (SP2) {
        PG8_STAGE(PG8_SB(0, 0), cB, voffB); PG8_STAGE(PG8_SB(0, 1), cB + hstepB, voffB); PG8_STAGE(PG8_SA(0, 0), cA, voffA); PG8_STAGE(PG8_SA(0, 1), cA + hstep, voffA);
        if (wr == 1) PG8_BAR;
        PG8_WAIT_V(2); PG8_BAR;
        PG8_STAGE(PG8_SB(1, 0), cB + kstep, voffB); PG8_STAGE(PG8_SA(1, 0), cA + kstep, voffA); PG8_STAGE(PG8_SB(1, 1), cB + hstepB + kstep, voffB);
        PG8_WAIT_V(6); PG8_BAR;
    } else {
        PG8_STAGE(PG8_SB(0, 0), cB, voffB); PG8_STAGE(PG8_SA(0, 0), cA, voffA); PG8_STAGE(PG8_SB(0, 1), cB + hstepB, voffB); PG8_STAGE(PG8_SA(0, 1), cA + hstep, voffA);
        if (wr == 1) PG8_BAR;
        PG8_WAIT_V(4); PG8_BAR;
        PG8_STAGE(PG8_SB(1, 0), cB + kstep, voffB); PG8_STAGE(PG8_SA(1, 0), cA + kstep, voffA); PG8_STAGE(PG8_SB(1, 1), cB + hstepB + kstep, voffB);
        PG8_WAIT_V(6); PG8_BAR;
    }
    for (;;) {
        const bool has_next = S.next(ui + 1, nxt);
        const char* nA = has_next ? (nxt.w ? S.A1 : S.A0) + (size_t)nxt.pm * tstep : cA; const char* nB = has_next ? (nxt.w ? S.B1 : S.B0) + (size_t)nxt.pn * tstep : cB;
        for (int t = 0; t < nt; t += 2) {
            const bool last = (t == nt - 2);
            const char* a1 = cA + (size_t)(t + 1) * kstep;
            const char* a2 = last ? nA : cA + (size_t)(t + 2) * kstep; const char* b2 = last ? nB : cB + (size_t)(t + 2) * kstep;
            const char* a3 = a2 + kstep; const char* b3 = b2 + kstep;
            if constexpr (SP2) {
            PG8_LDB(B0, 0, 0); PG8_LDB(B1, 0, 1); PG8_SCHED; PG8_LDA(At, 0, 0); PG8_STAGE(PG8_SA(1, 1), a1 + hstep, voffA);
            PG8_WAIT_V(8); PG8_WAIT_L(0); PG8_BAR; PG8_MMA(0, 0, At, B0); PG8_MMA(0, 1, At, B1); PG8_BAR; PG8_SCHED;
            PG8_LDA(At, 0, 1); PG8_STAGE(PG8_SB(0, 0), b2, voffB); PG8_STAGE(PG8_SB(0, 1), b2 + hstepB, voffB); PG8_STAGE(PG8_SA(0, 0), a2, voffA);
            PG8_WAIT_V(8); PG8_WAIT_L(0); PG8_BAR; PG8_MMA(1, 0, At, B0); PG8_MMA(1, 1, At, B1); PG8_BAR; PG8_SCHED;
            PG8_LDB(B0, 1, 0); PG8_LDB(B1, 1, 1); PG8_SCHED; PG8_LDA(At, 1, 0); PG8_STAGE(PG8_SA(0, 1), a2 + hstep, voffA);
            PG8_WAIT_V(8); PG8_WAIT_L(0); PG8_BAR; PG8_MMA(0, 0, At, B0); PG8_MMA(0, 1, At, B1); PG8_BAR; PG8_SCHED;
            PG8_LDA(At, 1, 1); PG8_STAGE(PG8_SB(1, 0), b3, voffB); PG8_STAGE(PG8_SB(1, 1), b3 + hstepB, voffB); PG8_STAGE(PG8_SA(1, 0), a3, voffA);
            PG8_WAIT_V(8); PG8_WAIT_L(0); PG8_BAR; PG8_MMA(1, 0, At, B0); PG8_MMA(1, 1, At, B1); PG8_BAR; PG8_SCHED;
            } else {
            PG8_LDB(B0, 0, 0); PG8_SCHED; PG8_LDA(At, 0, 0); PG8_STAGE(PG8_SA(1, 1), a1 + hstep, voffA);
            PG8_WAIT_L(8); PG8_BAR; PG8_WAIT_L(0); PG8_MMA(0, 0, At, B0); PG8_BAR; PG8_SCHED;
            PG8_LDB(B1, 0, 1); PG8_STAGE(PG8_SB(0, 0), b2, voffB);
            PG8_BAR; PG8_WAIT_L(0); PG8_MMA(0, 1, At, B1); PG8_BAR;
            PG8_LDA(At, 0, 1); PG8_STAGE(PG8_SA(0, 0), a2, voffA);
            PG8_BAR; PG8_WAIT_L(0); PG8_MMA(1, 0, At, B0); PG8_BAR; PG8_SCHED;
            PG8_STAGE(PG8_SB(0, 1), b2 + hstepB, voffB);
            PG8_WAIT_V(6); PG8_BAR; PG8_MMA(1, 1, At, B1); PG8_BAR;
            PG8_LDB(B0, 1, 0); PG8_SCHED; PG8_LDA(At, 1, 0); PG8_STAGE(PG8_SA(0, 1), a2 + hstep, voffA);
            PG8_WAIT_L(8); PG8_BAR; PG8_WAIT_L(0); PG8_MMA(0, 0, At, B0); PG8_BAR; PG8_SCHED;
            PG8_LDB(B1, 1, 1); PG8_STAGE(PG8_SB(1, 0), b3, voffB);
            PG8_BAR; PG8_WAIT_L(0); PG8_MMA(0, 1, At, B1); PG8_BAR;
            PG8_LDA(At, 1, 1); PG8_STAGE(PG8_SA(1, 0), a3, voffA);
            PG8_BAR; PG8_WAIT_L(0); PG8_MMA(1, 0, At, B0); PG8_BAR; PG8_SCHED;
            PG8_STAGE(PG8_SB(1, 1), b3 + hstepB, voffB);
            PG8_WAIT_V(6); PG8_BAR; PG8_MMA(1, 1, At, B1); PG8_BAR;
            }
        }
        if constexpr (ALIGN_EPI) { if (wr == 0) PG8_BAR; }
#ifdef PROBE_K
        if (dry) {
#pragma unroll
            for (int a = 0; a < 2; ++a)
#pragma unroll
                for (int b = 0; b < 2; ++b)
#pragma unroll
                    for (int m = 0; m < 4; ++m)
#pragma unroll
                        for (int n = 0; n < 2; ++n) asm volatile("" :: "v"(acc[a][b][m][n]));
        } else
#endif
        { bool keep_ = false;
          if constexpr (Epi::MIDSCALE) { if (cur.w == 0 && has_next) { E.mid(acc, cur.pm, cur.pn, wr, wc, fr, fq); keep_ = true; } }
          if (!keep_) epi_apply(E, acc, cur, wr, wc, fr, fq);
          keep_acc = keep_; }
        if (!has_next) break;
        if (!keep_acc) {
#pragma unroll
        for (int a = 0; a < 2; ++a)
#pragma unroll
            for (int b = 0; b < 2; ++b)
#pragma unroll
                for (int m = 0; m < 4; ++m)
#pragma unroll
                    for (int n = 0; n < 2; ++n) acc[a][b][m][n] = (f32x4){0.f, 0.f, 0.f, 0.f};
        }
        cur = nxt; cA = nA; cB = nB; ++ui;
        if constexpr (ALIGN_EPI) { if (wr == 1) PG8_BAR; }
    }
    PG8_WAIT_V(0);
    if constexpr (!ALIGN_EPI) { if (wr == 0) PG8_BAR; }
    PG8_BAR;
#undef PG8_SA
#undef PG8_SB
#undef PG8_STAGE
#undef PG8_LDA
#undef PG8_LDB
#undef PG8_MMA
#undef PG8_WAIT_V
#undef PG8_WAIT_L
#undef PG8_BAR
#undef PG8_SCHED
}
}
template <int KD, class Epi>
__device__ __forceinline__ void sample_tile(const Ctx& C, const bf16_t* A0, const bf16_t* B0, const bf16_t* A1, const bf16_t* B1, int rb, int cb, const Epi& E) {
    const int fr = C.lane & 15, fq = C.lane >> 4;
    for (int w = 0; w < (A1 ? 2 : 1); ++w) {
        const bf16_t* ap = (w ? A1 : A0) + (size_t)(TP + 16 * rb + fr) * DM + 8 * fq; const bf16_t* bp = (w ? B1 : B0) + (size_t)(16 * cb + fr) * DM + 8 * fq;
        f32x4 acc = (f32x4){0.f, 0.f, 0.f, 0.f};
#pragma unroll 1
        for (int kb = 0; kb < DM / 256; ++kb) {
            bf16x8 av[8], bv[8];
#pragma unroll
            for (int j = 0; j < 8; ++j) { av[j] = *(const bf16x8*)(ap + 256 * kb + 32 * j); bv[j] = *(const bf16x8*)(bp + 256 * kb + 32 * j); }
            __builtin_amdgcn_sched_barrier(0);
#pragma unroll
            for (int j = 0; j < 8; ++j) acc = __builtin_amdgcn_mfma_f32_16x16x32_bf16(bv[j], av[j], acc, 0, 0, 0);
            __builtin_amdgcn_sched_barrier(0);
        }
        E.template apply<KD>(w, TP + 16 * rb + fr, 16 * cb + 4 * fq, acc);
    }
}
template <class Epi>
__device__ __forceinline__ void gemm_sample(const Ctx& C, const bf16_t* A0, const bf16_t* B0, const bf16_t* A1, const bf16_t* B1, int N, const Epi& E) {
    const int gw = C.bid * NWAVES + C.wave, NGW = C.G * NWAVES, ncb = N / 16, T = 8 * ncb, tpb = T >> 8;
    const bool even = (C.G == 256) && (T == tpb * 256) && (tpb == 2 || tpb == 4 || tpb == 9);
    const int step = even ? NWAVES : NGW, lim = even ? tpb : T;
    for (int it = even ? C.wave : gw; it < lim; it += step) {
        int rb, cb;
        if (even) { const int b = C.bid;
            if (tpb == 2) { rb = b & 7; cb = (b >> 3) * 2 + it; }
            else if (tpb == 4) { rb = (b & 3) * 2 + (it & 1); cb = (b >> 2) * 2 + (it >> 1); }
            else { const int g_ = it < 8 ? b : 256 + (b >> 3), w_ = it < 8 ? it : (b & 7); rb = (g_ & 3) * 2 + (w_ & 1); cb = (g_ >> 2) * 4 + (w_ >> 1); }
        } else { const int g_ = it >> 3, w_ = it & 7; rb = (g_ & 3) * 2 + (w_ & 1); cb = (g_ >> 2) * 4 + (w_ >> 1); }
        const int kd = E.kind(cb >> 4);
        if constexpr (Epi::NK == 1) sample_tile<0>(C, A0, B0, A1, B1, rb, cb, E);
        else { if (kd == 0) sample_tile<0>(C, A0, B0, A1, B1, rb, cb, E); else if (kd == 1) sample_tile<1>(C, A0, B0, A1, B1, rb, cb, E);
            else if constexpr (Epi::NK > 2) { if (kd == 2) sample_tile<2>(C, A0, B0, A1, B1, rb, cb, E); else if (kd == 3) sample_tile<3>(C, A0, B0, A1, B1, rb, cb, E); else sample_tile<4>(C, A0, B0, A1, B1, rb, cb, E); } }
    }
}
template <class Epi>
__device__ __forceinline__ void gemm_run(const Ctx& C, const bf16_t* A0, const bf16_t* B0, const bf16_t* A1, const bf16_t* B1, int N, const Epi& E, bool dry = false) {
#if defined(PROBE_DRYEPI) || defined(PROBE_DRYSAMPLE)
    if (!dry)
#endif
    gemm_sample(C, A0, B0, A1, B1, N, E);
    pg8::Sched S; S.nM = TP / 256; S.nN = N / 256; S.nW = A1 ? 2 : 1; S.nwg = S.nM * S.nN; S.G = C.G; S.c = C.bid;
    S.A0 = (const char*)A0; S.B0 = (const char*)B0; S.A1 = (const char*)A1; S.B1 = (const char*)B1;
#ifdef PROBE_DRYEPI
    pg8::gemm_phase<Epi>(C.lds, C.tid, DM, S, E, dry);
#else
    pg8::gemm_phase<Epi>(C.lds, C.tid, DM, S, E);
#endif
    __syncthreads();
}

__device__ __forceinline__ unsigned cvt_pk_bf16(float lo, float hi) { unsigned r; asm volatile("v_cvt_pk_bf16_f32 %0, %1, %2" : "=v"(r) : "v"(lo), "v"(hi)); return r; }
__device__ __forceinline__ bf16x8 pack_acc(const f32x16& a, int t) {
    u32x4 w;
    if (t == 0) { w.x = cvt_pk_bf16(a[0], a[1]); w.y = cvt_pk_bf16(a[2], a[3]); w.z = cvt_pk_bf16(a[4], a[5]); w.w = cvt_pk_bf16(a[6], a[7]); }
    else { w.x = cvt_pk_bf16(a[8], a[9]); w.y = cvt_pk_bf16(a[10], a[11]); w.z = cvt_pk_bf16(a[12], a[13]); w.w = cvt_pk_bf16(a[14], a[15]); }
    return __builtin_bit_cast(bf16x8, w);
}
__device__ __forceinline__ int sig_pos(int s) { return (s & ~15) | (((s >> 2) & 1) << 3) | (((s >> 3) & 1) << 2) | (s & 3); }
constexpr int SROW = 144;

template <int WSTR>
__device__ __forceinline__ void conv8(const u32x4 (&rw)[4], const LAS float* wl, float (&v)[8]) {
    f32x4 w[5][2];
#pragma unroll
    for (int k = 0; k < 5; ++k) { w[k][0] = *(const LAS f32x4*)(wl + k * WSTR); w[k][1] = *(const LAS f32x4*)(wl + k * WSTR + 4); }
#pragma unroll
    for (int e = 0; e < 8; ++e) { const int dw = e >> 1; const bool hi = e & 1;
        float x[4];
#pragma unroll
        for (int k = 0; k < 4; ++k) { const unsigned q = dw == 0 ? rw[k].x : (dw == 1 ? rw[k].y : (dw == 2 ? rw[k].z : rw[k].w)); x[k] = hi ? bfhi(q) : bflo(q); }
        v[e] = w[4][e >> 2][e & 3] + w[0][e >> 2][e & 3] * x[0] + w[1][e >> 2][e & 3] * x[1] + w[2][e >> 2][e & 3] * x[2] + w[3][e >> 2][e & 3] * x[3]; }
}
constexpr size_t WS_CBC = WS_EI;
__device__ __forceinline__ void phase_convbc(const Ctx& C, int l) {
    CParams& P = *C.P;
    const bf16_t* XBC = WSP(bf16_t, WS_B2); bf16_t* CBC = WSP(bf16_t, WS_CBC);
    const float* cw = as_global(P.in[IN_SCW]) + (size_t)l * 4 * 1280 + 1024; const float* cbp = as_global(P.in[IN_SCB]) + (size_t)l * 1280 + 1024;
    const float* cst = as_global(P.in[IN_SSDCONV]) + (size_t)l * 8 * 3 * 1280;
    const int items = TT * 32, stride = C.G * NTHREADS;
    for (int it = C.bid * NTHREADS + C.tid; it < items; it += stride) {
        const int tok = it >> 5, cg = it & 31, ch = cg * 8;
        const bool smp = tok >= TP; const int b = smp ? (tok - TP) >> 4 : tok >> 11, t = smp ? (tok - TP) & 15 : tok & 2047, L = smp ? 16 : 2048, NB = smp ? 8 : 16;
        u32x4 rw[4];
#pragma unroll
        for (int k = 0; k < 4; ++k) { const int tr = t - 3 + k;
            if (tr >= 0) rw[k] = *(const u32x4*)(XBC + (size_t)(tok - t + tr) * 1280 + 1024 + ch);
            else if (smp) { const float* s0 = cst + ((size_t)b * 3 + (tr + 3)) * 1280 + 1024 + ch; const f32x4 a0 = *(const f32x4*)s0, a1 = *(const f32x4*)(s0 + 4);
                rw[k] = (u32x4){pk2(a0[0], a0[1]), pk2(a0[2], a0[3]), pk2(a1[0], a1[1]), pk2(a1[2], a1[3])}; }
            else rw[k] = (u32x4){0u, 0u, 0u, 0u}; }
        f32x4 w[5][2];
#pragma unroll
        for (int k = 0; k < 4; ++k) { w[k][0] = *(const f32x4*)(cw + k * 1280 + ch); w[k][1] = *(const f32x4*)(cw + k * 1280 + ch + 4); }
        w[4][0] = *(const f32x4*)(cbp + ch); w[4][1] = *(const f32x4*)(cbp + ch + 4);
        float v[8];
#pragma unroll
        for (int e = 0; e < 8; ++e) { const int dw = e >> 1; const bool hi = e & 1; float x[4];
#pragma unroll
            for (int k = 0; k < 4; ++k) { const unsigned q = dw == 0 ? rw[k].x : (dw == 1 ? rw[k].y : (dw == 2 ? rw[k].z : rw[k].w)); x[k] = hi ? bfhi(q) : bflo(q); }
            v[e] = siluf_(w[4][e >> 2][e & 3] + w[0][e >> 2][e & 3] * x[0] + w[1][e >> 2][e & 3] * x[1] + w[2][e >> 2][e & 3] * x[2] + w[3][e >> 2][e & 3] * x[3]); }
        *(u32x4*)(CBC + (size_t)tok * 256 + ch) = (u32x4){pk2(v[0], v[1]), pk2(v[2], v[3]), pk2(v[4], v[5]), pk2(v[6], v[7])};
        if (t >= L - 3) { float* co = C.out + (smp ? O_SSCONV : O_PSCONV) + ((size_t)(l * NB + b) * 3 + (t - (L - 3))) * 1280 + 1024 + ch; const u32x4 q = rw[3];
            *(f32x4*)co = (f32x4){bflo(q.x), bfhi(q.x), bflo(q.y), bfhi(q.y)}; *(f32x4*)(co + 4) = (f32x4){bflo(q.z), bfhi(q.z), bflo(q.w), bfhi(q.w)}; }
    }
}

#ifndef SCAN_SKIP
#define SCAN_SKIP 0
#endif
__device__ __forceinline__ void scan_item_fused(const Ctx& C, int l, int idx, bool dry) {
    const int skip = dry ? SCAN_SKIP : 0;
    CParams& P = *C.P; const int tid = C.tid, lane = C.lane, wave = C.wave;
    const bool smp = idx >= 256; const int ii = smp ? idx - 256 : idx; const int b = ii >> 4, head = ii & 15, g = head >> 3, j = head;
    const int tok0 = smp ? TP + b * 16 : b * 2048, L = smp ? 16 : 2048, NB = smp ? 8 : 16, nchunk = smp ? 1 : 32;
    const bf16_t* XBC = WSP(bf16_t, WS_B2); const bf16_t* CBC = WSP(bf16_t, WS_CBC); bf16_t* Z = WSP(bf16_t, WS_B1); const float* DT = WSP(float, WS_DT); float* SSQ = WSP(float, WS_SSQ);
    const float a_h = -__expf(as_global(P.in[IN_ALOG])[l * 16 + head]), Dh = as_global(P.in[IN_SSDD])[l * 16 + head];
    LAS unsigned char* bmR = C.lds; LAS unsigned char* cmR = C.lds + 9216; LAS unsigned char* xsR = C.lds + 18432; LAS unsigned char* bwR = C.lds + 30720;
    LAS float* ybuf = (LAS float*)(C.lds + 43008);
    LAS float* acum = (LAS float*)(C.lds + 59392); LAS float* dtv = acum + 64; LAS float* eac = acum + 128; LAS float* wsc = acum + 192; LAS float* misc = acum + 256; LAS float* cwl = acum + 320;
    const int t = tid >> 3, cg = tid & 7;
    const int chx = head * 64 + cg * 8, chb = 1024 + g * 64 + cg * 8, chc = 1152 + g * 64 + cg * 8;
    const float* scw = as_global(P.in[IN_SCW]) + (size_t)l * 4 * 1280; const float* scb = as_global(P.in[IN_SCB]) + (size_t)l * 1280;
    const float* scst = smp ? as_global(P.in[IN_SSDCONV]) + (size_t)(l * 8 + b) * 3 * 1280 : nullptr;
    const int qb = (wave >> 1) & 1, pb = wave & 1, r = lane & 31, hh = lane >> 5;
    f32x16 hacc[2];
#pragma unroll
    for (int nb = 0; nb < 2; ++nb)
#pragma unroll
        for (int i = 0; i < 16; ++i) hacc[nb][i] = 0.f;
    if (smp && wave < 4) {
        const float* hs = as_global(P.in[IN_SSD]) + ((size_t)((l * 8 + b) * 16 + head) * 64 + 32 * pb + r) * 64;
#pragma unroll
        for (int nb = 0; nb < 2; ++nb)
#pragma unroll
            for (int i4 = 0; i4 < 4; ++i4) { const f32x4 v = *(const f32x4*)(hs + 32 * nb + 8 * i4 + 4 * hh); hacc[nb][4 * i4] = v[0]; hacc[nb][4 * i4 + 1] = v[1]; hacc[nb][4 * i4 + 2] = v[2]; hacc[nb][4 * i4 + 3] = v[3]; }
    }
    const bf16_t* LX = WSP(bf16_t, WS_B3); bf16_t* LY = WSP(bf16_t, WS_B4);
    LAS unsigned char* LB = C.lds + 65536;
    LAS unsigned char* xcB = LB; LAS unsigned char* waT = LB + 9216; LAS unsigned char* wxT = LB + 18432;
    LAS float* xcF = (LAS float*)(LB + 27648); LAS float* aF = (LAS float*)(LB + 44032); LAS float* uF = (LAS float*)(LB + 60416); LAS float* lcwl = (LAS float*)(LB + 76800);
    const int ch0 = j * 64 + cg * 8;
    const float* lcw = as_global(P.in[IN_LCW]) + (size_t)l * 4 * DM; const float* lcb = as_global(P.in[IN_LCB]) + (size_t)l * DM;
    const float* lcst = smp ? as_global(P.in[IN_LRUCONV]) + (size_t)(l * 8 + b) * 3 * DM : nullptr;
    const int tb = qb, eb = pb, ech = j * 64 + 32 * eb + r;
    const float ba = as_global(P.in[IN_BA])[l * DM + ech], bxx = as_global(P.in[IN_BX])[l * DM + ech], sp8 = -8.0f * softplusf_(-as_global(P.in[IN_LAM])[l * DM + ech]);
    float hstate = (smp && wave == 4) ? as_global(P.in[IN_LRU])[(size_t)(l * 8 + b) * DM + j * 64 + lane] : 0.f;
    __syncthreads();
    for (int i = tid; i < 5 * 192; i += NTHREADS) { const int k = i / 192, cc = i % 192; const int ch = cc < 64 ? head * 64 + cc : (cc < 128 ? 1024 + g * 64 + (cc - 64) : 1152 + g * 64 + (cc - 128));
        cwl[i] = k < 4 ? scw[k * 1280 + ch] : scb[ch]; }
    { const u32x4* lw = (const u32x4*)(WSP(bf16_t, WS_LRUW) + (size_t)(l * 16 + j) * 8192);
      for (int i = tid; i < 1024; i += NTHREADS) { const int gate = i >> 9, e = (i >> 3) & 63, ck = i & 7; *(LAS u32x4*)((gate ? wxT : waT) + e * SROW + ck * 16) = lw[i]; } }
    for (int i = tid; i < 5 * 64; i += NTHREADS) { const int k = i >> 6, cc = i & 63; lcwl[i] = k < 4 ? lcw[k * DM + j * 64 + cc] : lcb[j * 64 + cc]; }
    u32x4 rw[4], bcv, ccv, lrw[4], zs, lyv; float dtl = 0.f;
#define RAWROW(dst, base, ld, ch, cstp, tr) { if ((tr) >= 0) dst = ((tr) < L) ? *(const u32x4*)((base) + (size_t)(tok0 + (tr)) * (ld) + (ch)) : (u32x4){0u, 0u, 0u, 0u}; \
        else if (smp) { const float* s0_ = (cstp) + (size_t)((tr) + 3) * (ld) + (ch); const f32x4 a0_ = *(const f32x4*)s0_, a1_ = *(const f32x4*)(s0_ + 4); \
            dst = (u32x4){pk2(a0_[0], a0_[1]), pk2(a0_[2], a0_[3]), pk2(a1_[0], a1_[1]), pk2(a1_[2], a1_[3])}; } else dst = (u32x4){0u, 0u, 0u, 0u}; }
#define SSD_LOAD(c_) { const int tg_ = (c_) * 64 + t; _Pragma("unroll") for (int k = 0; k < 4; ++k) { RAWROW(rw[k], XBC, 1280, chx, scst, tg_ - 3 + k) } \
        const bool v_ = tg_ < L; bcv = v_ ? *(const u32x4*)(CBC + (size_t)(tok0 + tg_) * 256 + g * 64 + cg * 8) : (u32x4){0u, 0u, 0u, 0u}; ccv = v_ ? *(const u32x4*)(CBC + (size_t)(tok0 + tg_) * 256 + 128 + g * 64 + cg * 8) : (u32x4){0u, 0u, 0u, 0u}; \
        }
#define LRU_LOAD(c_) { const int tg_ = (c_) * 64 + t; _Pragma("unroll") for (int k = 0; k < 4; ++k) { RAWROW(lrw[k], LX, DM, ch0, lcst, tg_ - 3 + k) } }
#define TAIL_LOAD(c_) { const int tg_ = (c_) * 64 + t; const bool v_ = tg_ < L; zs = v_ ? *(const u32x4*)(Z + (size_t)(tok0 + tg_) * DM + chx) : (u32x4){0u, 0u, 0u, 0u}; lyv = v_ ? *(const u32x4*)(LY + (size_t)(tok0 + tg_) * DM + ch0) : (u32x4){0u, 0u, 0u, 0u}; }
    SSD_LOAD(0) LRU_LOAD(0) TAIL_LOAD(0)
#define RAWROW_N(dst, base, ld, ch, tr) { const int trc_ = min((tr), L - 1); dst = *(const u32x4*)((base) + (size_t)(tok0 + trc_) * (ld) + (ch)); }
#define SSD_LOAD_N(c_) { const int tg_ = (c_) * 64 + t; _Pragma("unroll") for (int k = 0; k < 4; ++k) { RAWROW_N(rw[k], XBC, 1280, chx, tg_ - 3 + k) } \
        const size_t ro_ = (size_t)(tok0 + min(tg_, L - 1)) * 256 + g * 64 + cg * 8; bcv = *(const u32x4*)(CBC + ro_); ccv = *(const u32x4*)(CBC + ro_ + 128); }
#define LRU_LOAD_N(c_) { const int tg_ = (c_) * 64 + t; _Pragma("unroll") for (int k = 0; k < 4; ++k) { RAWROW_N(lrw[k], LX, DM, ch0, tg_ - 3 + k) } }
#define TAIL_LOAD_N(c_) { const int tg_ = (c_) * 64 + t; const size_t ro_ = (size_t)(tok0 + min(tg_, L - 1)) * DM; zs = *(const u32x4*)(Z + ro_ + chx); lyv = *(const u32x4*)(LY + ro_ + ch0); }
    { const float d_ = DT[(size_t)(tok0 + min(lane, L - 1)) * 16 + head]; dtl = (lane < L) ? d_ : 0.f; }
    __syncthreads();
    for (int c = 0; c < nchunk; ++c) {
        int lt_ = tid; asm volatile("" : "+v"(lt_));
        const int t = lt_ >> 3, cg = lt_ & 7, lane = lt_ & 63, r = lane & 31, hh = lane >> 5;
        const int chx = head * 64 + cg * 8, chb = 1024 + g * 64 + cg * 8, chc = 1152 + g * 64 + cg * 8, ch0 = j * 64 + cg * 8;
        const int tg = c * 64 + t; const bool valid = tg < L;
        if (wave == 0 && !(skip & 128)) {
            float cs = dtl * a_h;
            { float o = shfl_f(cs, lane - 1); if (lane >= 1) cs += o; o = shfl_f(cs, lane - 2); if (lane >= 2) cs += o; o = shfl_f(cs, lane - 4); if (lane >= 4) cs += o;
              o = shfl_f(cs, lane - 8); if (lane >= 8) cs += o; o = shfl_f(cs, lane - 16); if (lane >= 16) cs += o; o = shfl_f(cs, lane - 32); if (lane >= 32) cs += o; }
            const float tot = shfl_f(cs, 63);
            acum[lane] = cs; dtv[lane] = dtl; eac[lane] = __expf(cs); wsc[lane] = __expf(tot - cs) * dtl; if (lane == 0) misc[0] = __expf(tot);
        }
        if (!(skip & 32)) {
            float v[8]; conv8<64>(lrw, lcwl + cg * 8, v);
            *(LAS u32x4*)(xcB + t * SROW + cg * 16) = (u32x4){pk2(v[0], v[1]), pk2(v[2], v[3]), pk2(v[4], v[5]), pk2(v[6], v[7])};
            *(LAS f32x4*)(xcF + t * 64 + cg * 8) = (f32x4){v[0], v[1], v[2], v[3]}; *(LAS f32x4*)(xcF + t * 64 + cg * 8 + 4) = (f32x4){v[4], v[5], v[6], v[7]};
        }
        LRU_LOAD_N(c + 1)
        if (!(skip & 256)) __syncthreads();
        if (!(skip & 16)) {
            const float wsl = wsc[t];
            { float v[8]; conv8<192>(rw, cwl + cg * 8, v);
#pragma unroll
              for (int e = 0; e < 8; ++e) v[e] = valid ? siluf_(v[e]) : 0.f;
              if (!(skip & 1)) *(LAS u32x4*)(xsR + t * 192 + cg * 16) = (u32x4){pk2(v[0], v[1]), pk2(v[2], v[3]), pk2(v[4], v[5]), pk2(v[6], v[7])}; }
            *(LAS u32x4*)(bmR + t * SROW + cg * 16) = bcv;
            *(LAS u32x4*)(cmR + t * SROW + cg * 16) = ccv;
            if (!(skip & 1)) *(LAS u32x4*)(bwR + t * 192 + cg * 16) = (u32x4){pk2(bflo(bcv.x) * wsl, bfhi(bcv.x) * wsl), pk2(bflo(bcv.y) * wsl, bfhi(bcv.y) * wsl), pk2(bflo(bcv.z) * wsl, bfhi(bcv.z) * wsl), pk2(bflo(bcv.w) * wsl, bfhi(bcv.w) * wsl)};
        }
        asm volatile("" ::: "memory");
        SSD_LOAD_N(c + 1)
        { const int tq_ = (c + 1) * 64 + lane; const float d_ = DT[(size_t)(tok0 + min(tq_, L - 1)) * 16 + head]; dtl = d_; }
        if (wave >= 4 && !(skip & 2)) {
            f32x16 ra, ia;
#pragma unroll
            for (int i = 0; i < 16; ++i) { ra[i] = 0.f; ia[i] = 0.f; }
#pragma unroll
            for (int ks = 0; ks < 4; ++ks) { const bf16x8 A = *(const LAS bf16x8*)(xcB + (32 * tb + r) * SROW + (16 * ks + 8 * hh) * 2);
                const bf16x8 Ba = *(const LAS bf16x8*)(waT + (32 * eb + r) * SROW + (16 * ks + 8 * hh) * 2), Bx = *(const LAS bf16x8*)(wxT + (32 * eb + r) * SROW + (16 * ks + 8 * hh) * 2);
                ra = MFMA32(A, Ba, ra); ia = MFMA32(A, Bx, ia); }
#pragma unroll
            for (int i = 0; i < 16; ++i) { const int tt = 32 * tb + (i & 3) + 8 * (i >> 2) + 4 * hh, e = 32 * eb + r;
                const float rg = sigmoidf_(ra[i] + ba), ig = sigmoidf_(ia[i] + bxx), log_a = rg * sp8, av = exp_fast(log_a);
                const float u = __builtin_amdgcn_sqrtf(fmaxf(1.0f - av * av, 0.f)) * (ig * xcF[tt * 64 + e]);
                aF[tt * 64 + e] = av; uF[tt * 64 + e] = u; }
        }
        if (!(skip & 256)) __syncthreads();
        if (wave < 4 && !(skip & 4)) {
            const int tri = lane & 15, trg = (lane >> 4) & 1;
            const int troff = (tri >> 2) * 192 + (16 * trg + 4 * (tri & 3)) * 2;
#define TRFRAG(tile, row0, rowstep, col0) ({ const LAS unsigned char* a_ = (tile) + (row0) * 192 + (col0) * 2 + troff; \
                const s16x4_ lo_ = __builtin_amdgcn_ds_read_tr16_b64_v4i16((LAS s16x4_*)a_), hi_ = __builtin_amdgcn_ds_read_tr16_b64_v4i16((LAS s16x4_*)(a_ + (rowstep) * 192)); \
                (bf16x8){lo_[0], lo_[1], lo_[2], lo_[3], hi_[0], hi_[1], hi_[2], hi_[3]}; })
            f32x16 y;
#pragma unroll
            for (int i = 0; i < 16; ++i) y[i] = 0.f;
#pragma unroll
            for (int nb = 0; nb < 2; ++nb)
#pragma unroll
                for (int tt = 0; tt < 2; ++tt) { const LAS unsigned char* ap = cmR + (32 * qb + r) * SROW + (32 * nb + 16 * tt + 4 * hh) * 2;
                    const u32x2 a0 = *(const LAS u32x2*)ap, a1 = *(const LAS u32x2*)(ap + 16);
                    y = MFMA32(__builtin_bit_cast(bf16x8, (u32x4){a0.x, a0.y, a1.x, a1.y}), pack_acc(hacc[nb], tt), y); }
#pragma unroll
            for (int i = 0; i < 16; ++i) y[i] *= eac[32 * qb + (i & 3) + 8 * (i >> 2) + 4 * hh];
            const float aq = acum[32 * qb + r]; const int qg = 32 * qb + r;
            for (int sb = 0; sb <= qb; ++sb) {
                f32x16 cbt;
#pragma unroll
                for (int i = 0; i < 16; ++i) cbt[i] = 0.f;
#pragma unroll
                for (int ks = 0; ks < 4; ++ks) { const bf16x8 A = *(const LAS bf16x8*)(bmR + (32 * sb + r) * SROW + (16 * ks + 8 * hh) * 2), B = *(const LAS bf16x8*)(cmR + (32 * qb + r) * SROW + (16 * ks + 8 * hh) * 2); cbt = MFMA32(A, B, cbt); }
#pragma unroll
                for (int i = 0; i < 16; ++i) { const int sg = 32 * sb + (i & 3) + 8 * (i >> 2) + 4 * hh;
                    float wv = cbt[i] * exp_fast(fminf(aq - acum[sg], 0.f)) * dtv[sg]; wv = sg > qg ? 0.f : wv; wv = sg == qg ? wv + Dh : wv; cbt[i] = wv; }
#pragma unroll
                for (int tt = 0; tt < 2; ++tt) { const bf16x8 B = TRFRAG(xsR, 32 * sb + 16 * tt + 4 * hh, 8, 32 * pb); y = MFMA32(pack_acc(cbt, tt), B, y); }
            }
#pragma unroll
            for (int i = 0; i < 16; ++i) ybuf[(32 * qb + (i & 3) + 8 * (i >> 2) + 4 * hh) * 64 + 32 * pb + r] = y[i];
            const float dec = misc[0];
#pragma unroll
            for (int nb = 0; nb < 2; ++nb) {
#pragma unroll
                for (int i = 0; i < 16; ++i) hacc[nb][i] *= dec;
#pragma unroll
                for (int ks = 0; ks < 4; ++ks) { const bf16x8 A = TRFRAG(bwR, 16 * ks + 8 * hh, 4, 32 * nb), B = TRFRAG(xsR, 16 * ks + 8 * hh, 4, 32 * pb); hacc[nb] = MFMA32(A, B, hacc[nb]); }
            }
#undef TRFRAG
        } else if (wave == 4 && !(skip & 8)) {
            const int nsteps = (L - c * 64) < 64 ? (L - c * 64) : 64;
            for (int s0 = 0; s0 < nsteps; s0 += 8) {
                float av[8], uv[8];
#pragma unroll
                for (int q = 0; q < 8; ++q) { av[q] = aF[(s0 + q) * 64 + lane]; uv[q] = uF[(s0 + q) * 64 + lane]; }
#pragma unroll
                for (int q = 0; q < 8; ++q) { hstate = (s0 + q < nsteps) ? av[q] * hstate + uv[q] : hstate; uF[(s0 + q) * 64 + lane] = hstate; }
            }
        }
        if (!(skip & 256)) __syncthreads();
        if (!(skip & 64)) {
            const f32x4 y0 = *(const LAS f32x4*)(ybuf + t * 64 + cg * 8), y1 = *(const LAS f32x4*)(ybuf + t * 64 + cg * 8 + 4);
            const float o0 = y0[0] * bflo(zs.x), o1 = y0[1] * bfhi(zs.x), o2 = y0[2] * bflo(zs.y), o3 = y0[3] * bfhi(zs.y);
            const float o4 = y1[0] * bflo(zs.z), o5 = y1[1] * bfhi(zs.z), o6 = y1[2] * bflo(zs.w), o7 = y1[3] * bfhi(zs.w);
            float ss = (o0 * o0 + o1 * o1) + (o2 * o2 + o3 * o3) + (o4 * o4 + o5 * o5) + (o6 * o6 + o7 * o7);
            ss = row8_sum(ss);
            const f32x4 h0 = *(const LAS f32x4*)(uF + t * 64 + cg * 8), h1 = *(const LAS f32x4*)(uF + t * 64 + cg * 8 + 4);
            asm volatile("" :: "v"(o0), "v"(o7), "v"(ss), "v"(h0[0]), "v"(h1[3]));
            const bool st = valid && !dry; const size_t ro = (size_t)(tok0 + (st ? tg : 0)) * DM; unsigned char* sink = C.ws + WS_SINK + lt_ * 16;
            u32x4* zp = st ? (u32x4*)(Z + ro + chx) : (u32x4*)sink; u32x4* lp = st ? (u32x4*)(LY + ro + ch0) : (u32x4*)(sink + 8192);
            float* sp = st ? SSQ + (size_t)(tok0 + tg) * 16 + head : (float*)(sink + 16384);
            *zp = (u32x4){pk2(o0, o1), pk2(o2, o3), pk2(o4, o5), pk2(o6, o7)};
            *sp = ss;
            *lp = (u32x4){pk2(h0[0] * bflo(lyv.x), h0[1] * bfhi(lyv.x)), pk2(h0[2] * bflo(lyv.y), h0[3] * bfhi(lyv.y)), pk2(h1[0] * bflo(lyv.z), h1[1] * bfhi(lyv.z)), pk2(h1[2] * bflo(lyv.w), h1[3] * bfhi(lyv.w))};
        }
        if (skip & 512) {
#pragma unroll
            for (int k = 0; k < 4; ++k) asm volatile("" :: "v"(rw[k].x), "v"(rw[k].w), "v"(lrw[k].x), "v"(lrw[k].w));
            asm volatile("" :: "v"(bcv.x), "v"(ccv.x), "v"(zs.x), "v"(lyv.x), "v"(dtl)); }
        TAIL_LOAD_N(c + 1)
    }
#undef RAWROW
#undef SSD_LOAD
#undef LRU_LOAD
#undef TAIL_LOAD
#undef RAWROW_N
#undef SSD_LOAD_N
#undef LRU_LOAD_N
#undef TAIL_LOAD_N
    if (!dry && tid < 24) { const int rr = tid >> 3, cq = tid & 7; const size_t tokr = (size_t)(tok0 + L - 3 + rr);
        { const u32x4 q = *(const u32x4*)(LX + tokr * DM + j * 64 + cq * 8); float* co = C.out + (smp ? O_SLCONV : O_PLCONV) + ((size_t)(l * NB + b) * 3 + rr) * DM + j * 64 + cq * 8;
          *(f32x4*)co = (f32x4){bflo(q.x), bfhi(q.x), bflo(q.y), bfhi(q.y)}; *(f32x4*)(co + 4) = (f32x4){bflo(q.z), bfhi(q.z), bflo(q.w), bfhi(q.w)}; }
        { const u32x4 q = *(const u32x4*)(XBC + tokr * 1280 + head * 64 + cq * 8); float* co = C.out + (smp ? O_SSCONV : O_PSCONV) + ((size_t)(l * NB + b) * 3 + rr) * 1280 + head * 64 + cq * 8;
          *(f32x4*)co = (f32x4){bflo(q.x), bfhi(q.x), bflo(q.y), bfhi(q.y)}; *(f32x4*)(co + 4) = (f32x4){bflo(q.z), bfhi(q.z), bflo(q.w), bfhi(q.w)}; } }
    if (!dry && wave < 4 && qb == 0) {
        float* so = C.out + (smp ? O_SSSD : O_PSSD) + ((size_t)((l * NB + b) * 16 + head) * 64 + 32 * pb + r) * 64;
#pragma unroll
        for (int nb = 0; nb < 2; ++nb)
#pragma unroll
            for (int i4 = 0; i4 < 4; ++i4) *(f32x4*)(so + 32 * nb + 8 * i4 + 4 * hh) = (f32x4){hacc[nb][4 * i4], hacc[nb][4 * i4 + 1], hacc[nb][4 * i4 + 2], hacc[nb][4 * i4 + 3]};
    }
    if (wave == 4 && !dry) C.out[(smp ? O_SLRU : O_PLRU) + (size_t)(l * NB + b) * DM + j * 64 + lane] = hstate;
    __syncthreads();
}

__device__ __forceinline__ void phase_scan(const Ctx& C, int l, bool dry = false) {
    for (int it = C.bid; it < 384; it += C.G) scan_item_fused(C, l, it, dry);
}

__device__ __forceinline__ unsigned mono(float f) { const unsigned u = __float_as_uint(f); return (u & 0x80000000u) ? ~u : (u | 0x80000000u); }
__device__ __forceinline__ float unmono(unsigned k) { const unsigned u = (k & 0x80000000u) ? (k & 0x7fffffffu) : ~k; return __uint_as_float(u); }
template <int CTRL> __device__ __forceinline__ unsigned dpp_u(unsigned v) { return (unsigned)__builtin_amdgcn_update_dpp(0, (int)v, CTRL, 0xf, 0xf, true); }
__device__ __forceinline__ unsigned row_max_u(unsigned m) {
    m = max(m, dpp_u<0xB1>(m)); m = max(m, dpp_u<0x4E>(m)); m = max(m, dpp_u<0x141>(m)); m = max(m, dpp_u<0x140>(m)); return m;
}
__device__ __forceinline__ float row_max_f(float m) {
    m = fmaxf(m, __uint_as_float(dpp_u<0xB1>(__float_as_uint(m)))); m = fmaxf(m, __uint_as_float(dpp_u<0x4E>(__float_as_uint(m))));
    m = fmaxf(m, __uint_as_float(dpp_u<0x141>(__float_as_uint(m)))); m = fmaxf(m, __uint_as_float(dpp_u<0x140>(__float_as_uint(m)))); return m;
}
__device__ __forceinline__ float row_sum_f(float m) {
    m += __uint_as_float(dpp_u<0xB1>(__float_as_uint(m))); m += __uint_as_float(dpp_u<0x4E>(__float_as_uint(m)));
    m += __uint_as_float(dpp_u<0x141>(__float_as_uint(m))); m += __uint_as_float(dpp_u<0x140>(__float_as_uint(m))); return m;
}
#define CE_(a, b) { const unsigned hi_ = max(a, b), lo_ = min(a, b); a = hi_; b = lo_; }
#define KEY8(k, a, b) unsigned k##0 = (mono(a[0]) & ~127u) | (unsigned)(127 - (li * 8 + 0)), k##1 = (mono(a[1]) & ~127u) | (unsigned)(127 - (li * 8 + 1)), k##2 = (mono(a[2]) & ~127u) | (unsigned)(127 - (li * 8 + 2)), \
        k##3 = (mono(a[3]) & ~127u) | (unsigned)(127 - (li * 8 + 3)), k##4 = (mono(b[0]) & ~127u) | (unsigned)(127 - (li * 8 + 4)), k##5 = (mono(b[1]) & ~127u) | (unsigned)(127 - (li * 8 + 5)), \
        k##6 = (mono(b[2]) & ~127u) | (unsigned)(127 - (li * 8 + 6)), k##7 = (mono(b[3]) & ~127u) | (unsigned)(127 - (li * 8 + 7));
#define SORT8(k) CE_(k##0, k##1) CE_(k##2, k##3) CE_(k##4, k##5) CE_(k##6, k##7)  CE_(k##0, k##2) CE_(k##1, k##3) CE_(k##4, k##6) CE_(k##5, k##7)  CE_(k##1, k##2) CE_(k##5, k##6) \
        CE_(k##0, k##4) CE_(k##1, k##5) CE_(k##2, k##6) CE_(k##3, k##7)  CE_(k##2, k##4) CE_(k##3, k##5)  CE_(k##1, k##2) CE_(k##3, k##4) CE_(k##5, k##6)
#define POP8(k, m, c) k##0 = c ? k##1 : k##0; k##1 = c ? k##2 : k##1; k##2 = c ? k##3 : k##2; k##3 = c ? k##4 : k##3; k##4 = c ? k##5 : k##4; k##5 = c ? k##6 : k##5; k##6 = c ? k##7 : k##6; k##7 = c ? 0u : k##7;
__device__ __forceinline__ void top16_row2(const f32x4 a0, const f32x4 b0, const f32x4 a1, const f32x4 b1, int li, unsigned& r0, unsigned& r1) {
    KEY8(x, a0, b0) KEY8(y, a1, b1)
    SORT8(x) SORT8(y)
    unsigned rx = 0u, ry = 0u;
#pragma unroll
    for (int r = 0; r < 16; ++r) {
        const unsigned mx = row_max_u(x0), my = row_max_u(y0); const bool cx = (x0 == mx), cy = (y0 == my);
        POP8(x, mx, cx) POP8(y, my, cy)
        rx = (li == r) ? mx : rx; ry = (li == r) ? my : ry;
    }
    r0 = rx; r1 = ry;
}
#undef KEY8
#undef SORT8
#undef POP8
__device__ __forceinline__ void phase_topk(const Ctx& C, int l) {
    const bf16_t* SC = WSP(bf16_t, WS_SC); unsigned short* EI = WSP(unsigned short, WS_EI); float* GW = WSP(float, WS_GW);
    const int lane = C.lane, li = lane & 15, rowi = lane >> 4;
    LAS float* sv = (LAS float*)(C.lds + 4096 + C.wave * 1024);
    LAS int* si = (LAS int*)(sv + 128);
    LAS unsigned char* tab = (LAS unsigned char*)C.lds;
    if (C.tid < 64) { int c = C.tid, i = 0; for (; i < 16; ++i) { const int cnt = 16 / (i + 1); if (c < cnt) break; c -= cnt; } tab[C.tid] = (unsigned char)(C.tid < 50 ? (i | (c << 4)) : 0); }
    __syncthreads();
    int ica[4], jca[4];
#pragma unroll
    for (int q = 0; q < 4; ++q) { const int tb = tab[4 * li + q]; ica[q] = tb & 15; jca[q] = tb >> 4; }
    const int gw = C.bid * NWAVES + C.wave, NGW = C.G * NWAVES;
    u32x4 nw0, nw1;
    { const bf16_t* base = SC + (size_t)min(gw, TT * 2 - 1) * 1024;
      nw0 = *(const u32x4*)(base + lane * 8); nw1 = *(const u32x4*)(base + 512 + lane * 8); }
    const float* up = as_global(C.P->in[IN_U]) + (size_t)l * NE * DM; const float* vp = as_global(C.P->in[IN_V]) + (size_t)l * NE * DM;
#define TROW(it_) (((it_) >= NE ? vp + (size_t)((it_) - NE) * DM : up + (size_t)(it_) * DM) + lane * 4)
    int tit = gw; f32x4 tv[4];
    { const float* s0 = TROW(min(tit, 2 * NE - 1));
#pragma unroll
      for (int j = 0; j < 4; ++j) tv[j] = *(const f32x4*)(s0 + 256 * j); }
    int nit = 0;
    for (int g4 = gw; g4 < TT * 2; g4 += NGW, ++nit) {
        if (!(nit & 1) && tit < 2 * NE) { convert_row(C, tit, tv); tit += NGW;
            const float* s0 = TROW(min(tit, 2 * NE - 1));
#pragma unroll
            for (int j = 0; j < 4; ++j) tv[j] = *(const f32x4*)(s0 + 256 * j); }
        const int row = g4 >> 1, hd0 = (g4 & 1) * 4;
        const f32x4 a0 = (f32x4){bflo(nw0.x), bfhi(nw0.x), bflo(nw0.y), bfhi(nw0.y)}, b0 = (f32x4){bflo(nw0.z), bfhi(nw0.z), bflo(nw0.w), bfhi(nw0.w)};
        const f32x4 a1 = (f32x4){bflo(nw1.x), bfhi(nw1.x), bflo(nw1.y), bfhi(nw1.y)}, b1 = (f32x4){bflo(nw1.z), bfhi(nw1.z), bflo(nw1.w), bfhi(nw1.w)};
        { const bf16_t* base = SC + (size_t)min(g4 + NGW, TT * 2 - 1) * 1024;
          nw0 = *(const u32x4*)(base + lane * 8); nw1 = *(const u32x4*)(base + 512 + lane * 8); }
        unsigned r0, r1; top16_row2(a0, b0, a1, b1, li, r0, r1);
        sv[lane] = unmono(r0 & ~127u); si[lane] = 127 - (int)(r0 & 127u); sv[64 + lane] = unmono(r1 & ~127u); si[64 + lane] = 127 - (int)(r1 & 127u);
        LDS_WAIT();
        const LAS float* v1 = sv + rowi * 32; const LAS float* v2 = v1 + 16;
        unsigned k[4];
#pragma unroll
        for (int q = 0; q < 4; ++q) { const int c = 4 * li + q; const float sum = v1[ica[q]] + v2[jca[q]]; k[q] = (c < 50) ? ((mono(sum) & ~63u) | (unsigned)(63 - c)) : 0u; }
        CE_(k[0], k[1]) CE_(k[2], k[3]) CE_(k[0], k[2]) CE_(k[1], k[3]) CE_(k[1], k[2])
        unsigned res = 0u;
#pragma unroll
        for (int r = 0; r < 16; ++r) {
            const unsigned m = row_max_u(k[0]); const bool c = (k[0] == m);
            k[0] = c ? k[1] : k[0]; k[1] = c ? k[2] : k[1]; k[2] = c ? k[3] : k[2]; k[3] = c ? 0u : k[3];
            res = (li == r) ? m : res;
        }
        const int csel = 63 - (int)(res & 63u); const int tb = tab[csel];
        const int e1 = (si + rowi * 32)[tb & 15], e2 = (si + rowi * 32 + 16)[tb >> 4];
        const float svv = unmono(res & ~63u);
        const float mx = row_max_f(svv), ex = __expf(svv - mx), den = row_sum_f(ex);
        const size_t o = (size_t)row * 128 + (hd0 + rowi) * 16 + li;
        EI[o] = (unsigned short)(e1 * 128 + e2); GW[o] = ex / den;
        LDS_WAIT();
    }
    for (; tit < 2 * NE; ) { convert_row(C, tit, tv); tit += NGW;
        const float* s0 = TROW(min(tit, 2 * NE - 1));
#pragma unroll
        for (int j = 0; j < 4; ++j) tv[j] = *(const f32x4*)(s0 + 256 * j); }
#undef TROW
    __syncthreads();
}

template <int CTRL> __device__ __forceinline__ float dpp_f(float v) { return __int_as_float(__builtin_amdgcn_update_dpp(0, __float_as_int(v), CTRL, 0xf, 0xf, true)); }
__device__ __forceinline__ float swap16_f(float v, int lane) { auto r = __builtin_amdgcn_permlane16_swap(__float_as_uint(v), __float_as_uint(v), false, false); return __uint_as_float((lane & 16) ? r[0] : r[1]); }
constexpr int PEER_SLICES = 8;
#define PEER_LOAD_E(E, t_) { const u32x4* ep_ = (const u32x4*)(EI + (size_t)(t_) * 128 + r8 * 16); E[0] = ep_[0]; E[1] = ep_[1]; }
#define EID(E, i_) (((i_) & 1) ? (E[(i_) >> 3][((i_) >> 1) & 3] >> 16) : (E[(i_) >> 3][((i_) >> 1) & 3] & 0xffffu))
#define PEER_GATHER(U, E, base_, coff_) { _Pragma("unroll") for (int i_ = 0; i_ < 16; ++i_) U[i_] = *(const u32x4*)((base_) + (EID(E, i_) * 128u + (coff_))); }
#define FP8LO(d) __builtin_amdgcn_cvt_pk_f32_fp8((int)(d), false)
#define FP8HI(d) __builtin_amdgcn_cvt_pk_f32_fp8((int)(d), true)
__device__ __forceinline__ float peer_u_reduce8(const u32x4 (&U)[8], const u32x4 hq0, const u32x4 hq1, int c) {
    f32x2 h[8];
    h[0] = (f32x2){bflo(hq0.x), bfhi(hq0.x)}; h[1] = (f32x2){bflo(hq0.y), bfhi(hq0.y)}; h[2] = (f32x2){bflo(hq0.z), bfhi(hq0.z)}; h[3] = (f32x2){bflo(hq0.w), bfhi(hq0.w)};
    h[4] = (f32x2){bflo(hq1.x), bfhi(hq1.x)}; h[5] = (f32x2){bflo(hq1.y), bfhi(hq1.y)}; h[6] = (f32x2){bflo(hq1.z), bfhi(hq1.z)}; h[7] = (f32x2){bflo(hq1.w), bfhi(hq1.w)};
    float q[8];
#pragma unroll
    for (int i = 0; i < 8; ++i) {
        f32x2 s0 = FP8LO(U[i].x) * h[0], s1 = FP8HI(U[i].x) * h[1];
        s0 = __builtin_elementwise_fma(FP8LO(U[i].y), h[2], s0); s1 = __builtin_elementwise_fma(FP8HI(U[i].y), h[3], s1);
        s0 = __builtin_elementwise_fma(FP8LO(U[i].z), h[4], s0); s1 = __builtin_elementwise_fma(FP8HI(U[i].z), h[5], s1);
        s0 = __builtin_elementwise_fma(FP8LO(U[i].w), h[6], s0); s1 = __builtin_elementwise_fma(FP8HI(U[i].w), h[7], s1);
        s0 = s0 + s1; q[i] = s0.x + s0.y;
    }
    { const bool up = (c & 4) != 0;
#pragma unroll
      for (int j = 0; j < 4; ++j) { const float mine = up ? q[j + 4] : q[j], send = up ? q[j] : q[j + 4]; q[j] = mine + dpp_f<0x141>(send); } }
    { const bool up = (c & 2) != 0;
#pragma unroll
      for (int j = 0; j < 2; ++j) { const float mine = up ? q[j + 2] : q[j], send = up ? q[j] : q[j + 2]; q[j] = mine + dpp_f<0x4E>(send); } }
    { const bool up = (c & 1) != 0; const float mine = up ? q[1] : q[0], send = up ? q[0] : q[1]; q[0] = mine + dpp_f<0xB1>(send); }
    return q[0];
}
#define PEER_GATHER8(U, EW, base_, coff_) { _Pragma("unroll") for (int i_ = 0; i_ < 8; ++i_) { const unsigned w_ = EW[i_ >> 1]; U[i_] = *(const u32x4*)((base_) + (((i_ & 1) ? (w_ >> 16) : (w_ & 0xffffu)) * 128u + (coff_))); } }
__device__ __forceinline__ void phase_peer_u(const Ctx& C) {
    const int lane = C.lane, r8 = lane >> 3, c = lane & 7;
    const bf16_t* H2 = WSP(bf16_t, WS_B0); const unsigned char* U8 = C.ws + WS_U8; const unsigned short* EI = WSP(unsigned short, WS_EI); unsigned* PA = WSP(unsigned, WS_SC);
    const int s = C.bid & 7, wg = (C.bid >> 3) * NWAVES + C.wave, nwg = (C.G >> 3) * NWAVES;
    const int n = (TT - wg + nwg - 1) / nwg;
    const unsigned char* ub = U8 + (size_t)s * NE * 128; const unsigned coff = (unsigned)c * 16u; const bf16_t* hb = H2 + s * 128 + c * 16;
    unsigned* pab = PA + (size_t)s * 64 + lane;
#define TOK(i_) (min(wg + (i_) * nwg, TT - 1))
    LAS unsigned* xl = (LAS unsigned*)(C.lds + C.wave * 512);
    const unsigned* eraw = (const unsigned*)EI + lane; const unsigned* hraw = (const unsigned*)(H2 + s * 128) + lane;
#define RAW(E_, H_, t_) { E_ = eraw[(size_t)(t_) * 64]; H_ = hraw[(size_t)(t_) * (DM / 2)]; }
#define EXPAND(EX, H0, H1, E_, H_) { asm volatile("" ::: "memory"); xl[lane] = E_; xl[64 + lane] = H_; asm volatile("" ::: "memory"); \
        { const LAS u32x4* ep_ = (const LAS u32x4*)xl + r8 * 2; EX[0] = ep_[0]; EX[1] = ep_[1]; const LAS u32x4* hp_ = (const LAS u32x4*)(xl + 64) + c * 2; H0 = hp_[0]; H1 = hp_[1]; } asm volatile("" ::: "memory"); }
    u32x4 uA[8], uB[8], ec[2], en[2], hc0, hc1, hn0, hn1; unsigned eR, hR;
    __syncthreads();
    { unsigned e0, h0, e1, h1; RAW(e0, h0, TOK(0)); RAW(e1, h1, TOK(1)); RAW(eR, hR, TOK(2));
      EXPAND(ec, hc0, hc1, e0, h0);
      PEER_GATHER8(uA, ec[0], ub, coff);
      EXPAND(en, hn0, hn1, e1, h1); }
    for (int i = 0; i < n; ++i) {
        PEER_GATHER8(uB, ec[1], ub, coff);
        const float r0 = peer_u_reduce8(uA, hc0, hc1, c);
        PEER_GATHER8(uA, en[0], ub, coff);
        const float r1 = peer_u_reduce8(uB, hc0, hc1, c);
        pab[(size_t)TOK(i) * (PEER_SLICES * 64)] = pk2(r0, r1);
        ec[0] = en[0]; ec[1] = en[1]; hc0 = hn0; hc1 = hn1;
        EXPAND(en, hn0, hn1, eR, hR);
        RAW(eR, hR, TOK(i + 3));
    }
#undef RAW
#undef EXPAND
#undef TOK
}
constexpr size_t WS_ACT16 = WS_U16 + ((size_t)17 << 20);
__device__ __forceinline__ void phase_peer_act(const Ctx& C) {
    const unsigned* PA = WSP(unsigned, WS_SC); const float* GW = WSP(float, WS_GW); bf16_t* ACT = WSP(bf16_t, WS_ACT16);
    const unsigned short* EI = WSP(unsigned short, WS_EI); const float* SU = WSP(float, WS_SU); const float* SV = WSP(float, WS_SV);
    LAS float* sul = (LAS float*)C.lds; LAS float* svl = sul + NE;
    __syncthreads();
    for (int i = C.tid; i < NE / 4; i += NTHREADS) { *(LAS f32x4*)(sul + 4 * i) = *(const f32x4*)(SU + 4 * i); *(LAS f32x4*)(svl + 4 * i) = *(const f32x4*)(SV + 4 * i); }
    __syncthreads();
    const int n8 = TT * 16, stride = C.G * NTHREADS;
    for (int i8 = C.bid * NTHREADS + C.tid; i8 < n8; i8 += stride) {
        const size_t t = (size_t)(i8 >> 4); const int q = i8 & 15, r8 = q >> 1, c0 = (q & 1) * 4;
        const unsigned* pp = PA + t * (PEER_SLICES * 64) + r8 * 8 + c0;
        f32x4 alo = (f32x4){0.f, 0.f, 0.f, 0.f}, ahi = (f32x4){0.f, 0.f, 0.f, 0.f};
#pragma unroll
        for (int s = 0; s < PEER_SLICES; ++s) { const u32x4 w = *(const u32x4*)(pp + s * 64);
            alo += (f32x4){bflo(w.x), bflo(w.y), bflo(w.z), bflo(w.w)}; ahi += (f32x4){bfhi(w.x), bfhi(w.y), bfhi(w.z), bfhi(w.w)}; }
#pragma unroll
        for (int h = 0; h < 2; ++h) { const size_t o = t * 128 + r8 * 16 + h * 8 + c0; const f32x4 a = h ? ahi : alo;
            const u32x2 ew = *(const u32x2*)(EI + o); const u32x4 e = (u32x4){ew.x & 0xffffu, ew.x >> 16, ew.y & 0xffffu, ew.y >> 16}; const f32x4 g = *(const f32x4*)(GW + o);
            const f32x4 su = (f32x4){sul[e.x], sul[e.y], sul[e.z], sul[e.w]}, sv = (f32x4){svl[e.x], svl[e.y], svl[e.z], svl[e.w]};
            *(u32x2*)(ACT + o) = (u32x2){pk2(geluf_(a[0] * su[0]) * g[0] * sv[0], geluf_(a[1] * su[1]) * g[1] * sv[1]), pk2(geluf_(a[2] * su[2]) * g[2] * sv[2], geluf_(a[3] * su[3]) * g[3] * sv[3])}; }
    }
}
#define PEER_LOAD_A(A, t_) { const u32x4* ap_ = (const u32x4*)(ACT + (size_t)(t_) * 128 + r8 * 16); A[0] = ap_[0]; A[1] = ap_[1]; }
__device__ __forceinline__ void peer_v_acc8(f32x2 (&o)[8], const u32x4 (&V)[8], const u32x4 AW) {
#pragma unroll
    for (int i = 0; i < 8; ++i) { const unsigned w = AW[i >> 1]; const float a = (i & 1) ? bfhi(w) : bflo(w); const f32x2 a2 = (f32x2){a, a};
        o[0] = __builtin_elementwise_fma(FP8LO(V[i].x), a2, o[0]); o[1] = __builtin_elementwise_fma(FP8HI(V[i].x), a2, o[1]);
        o[2] = __builtin_elementwise_fma(FP8LO(V[i].y), a2, o[2]); o[3] = __builtin_elementwise_fma(FP8HI(V[i].y), a2, o[3]);
        o[4] = __builtin_elementwise_fma(FP8LO(V[i].z), a2, o[4]); o[5] = __builtin_elementwise_fma(FP8HI(V[i].z), a2, o[5]);
        o[6] = __builtin_elementwise_fma(FP8LO(V[i].w), a2, o[6]); o[7] = __builtin_elementwise_fma(FP8HI(V[i].w), a2, o[7]); }
}
__device__ __forceinline__ f32x2 peer_v_scatter(const f32x2 (&o2)[8], int lane) {
    float o[16];
#pragma unroll
    for (int j = 0; j < 8; ++j) { o[2 * j] = o2[j].x; o[2 * j + 1] = o2[j].y; }
    { const bool up = (lane & 32) != 0;
#pragma unroll
      for (int j = 0; j < 8; ++j) { const float mine = up ? o[j + 8] : o[j], send = up ? o[j] : o[j + 8]; o[j] = mine + shfx<32>(send, lane); } }
    { const bool up = (lane & 16) != 0;
#pragma unroll
      for (int j = 0; j < 4; ++j) { const float mine = up ? o[j + 4] : o[j], send = up ? o[j] : o[j + 4]; o[j] = mine + swap16_f(send, lane); } }
    { const bool up = (lane & 8) != 0;
#pragma unroll
      for (int j = 0; j < 2; ++j) { const float mine = up ? o[j + 2] : o[j], send = up ? o[j] : o[j + 2]; o[j] = mine + dpp_f<0x128>(send); } }
    return (f32x2){o[0], o[1]};
}
__device__ __forceinline__ void phase_peer_v(const Ctx& C, int l, bool dry = false) {
    const int lane = C.lane, r8 = lane >> 3, c = lane & 7;
    const unsigned char* V8 = C.ws + WS_V8; const unsigned short* EI = WSP(unsigned short, WS_EI); const bf16_t* ACT = WSP(bf16_t, WS_ACT16); const float* MOD = WSP(float, WS_MOD);
    const int s = C.bid & 7, wg = (C.bid >> 3) * NWAVES + C.wave, nwg = (C.G >> 3) * NWAVES;
    const int n = (TT - wg + nwg - 1) / nwg;
    const int jcol = ((lane >> 5) & 1) * 8 + ((lane >> 4) & 1) * 4 + ((lane >> 3) & 1) * 2;
    const int col = s * 128 + c * 16 + jcol;
    const unsigned char* vb = V8 + (size_t)s * NE * 128; const unsigned coff = (unsigned)c * 16u;
    float* xb = C.out + col;
    LAS float* g2l = (LAS float*)C.lds;
    __syncthreads();
    for (int i = C.tid; i < NBT * 128; i += NTHREADS) g2l[i] = MOD[(size_t)l * NBT * 6144 + (size_t)(i >> 7) * 6144 + 5120 + s * 128 + (i & 127)];
    __syncthreads();
    const LAS float* g2p = g2l + c * 16 + jcol;
#define TOK(i_) (min(wg + (i_) * nwg, TT - 1))
    LAS unsigned* xl = (LAS unsigned*)(C.lds + 16384 + C.wave * 512);
    const unsigned* eraw = (const unsigned*)EI + lane; const unsigned* araw = (const unsigned*)ACT + lane;
#define RAW(E_, A_, t_) { E_ = eraw[(size_t)(t_) * 64]; A_ = araw[(size_t)(t_) * 64]; }
#define EXPAND(EX, AX, E_, A_) { asm volatile("" ::: "memory"); xl[lane] = E_; xl[64 + lane] = A_; asm volatile("" ::: "memory"); \
        { const LAS u32x4* ep_ = (const LAS u32x4*)xl + r8 * 2; EX[0] = ep_[0]; EX[1] = ep_[1]; const LAS u32x4* ap_ = (const LAS u32x4*)(xl + 64) + r8 * 2; AX[0] = ap_[0]; AX[1] = ap_[1]; } asm volatile("" ::: "memory"); }
    u32x4 vA[8], vB[8], ec[2], en[2], ac[2], an[2]; unsigned eR, aR;
    { unsigned e0, a0, e1, a1; RAW(e0, a0, TOK(0)); RAW(e1, a1, TOK(1)); RAW(eR, aR, TOK(2));
      EXPAND(ec, ac, e0, a0);
      PEER_GATHER8(vA, ec[0], vb, coff);
      EXPAND(en, an, e1, a1); }
    for (int i = 0; i < n; ++i) {
        const int t = TOK(i);
        PEER_GATHER8(vB, ec[1], vb, coff);
        const f32x2 xv = *(const f32x2*)(xb + (size_t)t * DM); const f32x2 gv = *(const LAS f32x2*)(g2p + row_batch(t) * 128);
        f32x2 o[8];
#pragma unroll
        for (int j = 0; j < 8; ++j) o[j] = (f32x2){0.f, 0.f};
        peer_v_acc8(o, vA, ac[0]);
        __builtin_amdgcn_sched_barrier(0);
        PEER_GATHER8(vA, en[0], vb, coff);
        peer_v_acc8(o, vB, ac[1]);
        __builtin_amdgcn_sched_barrier(0);
        ac[0] = an[0]; ac[1] = an[1]; ec[0] = en[0]; ec[1] = en[1];
        EXPAND(en, an, eR, aR);
        RAW(eR, aR, TOK(i + 3));
        const f32x2 ov = peer_v_scatter(o, lane);
        asm volatile("" :: "v"(ov.x), "v"(ov.y));
        if (!dry) *(f32x2*)(xb + (size_t)t * DM) = xv + gv * ov;
    }
#undef RAW
#undef EXPAND
#undef TOK
}
#undef PEER_GATHER8
#undef PEER_LOAD_E
#undef EID
#undef PEER_LOAD_A
#undef PEER_GATHER
__device__ __forceinline__ void phase_final_norm(const Ctx& C) {
    const int gw = C.bid * NWAVES + C.wave, NGW = C.G * NWAVES; const float* fw = as_global(C.P->in[IN_FNW]);
    for (int row = gw; row < TT; row += NGW) {
        f32x4* xr = (f32x4*)(C.out + (size_t)row * DM) + C.lane;
        f32x4 v[4]; float s = 0.f;
#pragma unroll
        for (int j = 0; j < 4; ++j) { v[j] = xr[64 * j]; s += (v[j][0] * v[j][0] + v[j][1] * v[j][1]) + (v[j][2] * v[j][2] + v[j][3] * v[j][3]); }
        const float rstd = rsqrtf(wave_sum(s) * (1.f / DM) + EPS);
#pragma unroll
        for (int j = 0; j < 4; ++j) xr[64 * j] = v[j] * rstd * *(const f32x4*)(fw + C.lane * 4 + 256 * j);
    }
}


#define XB_TMO      128
#define XB_XCNT(j)  (256  + 64 * (j))
#define XB_XSUB(j)  (1280 + 64 * (j))
#define XB_XGEN(j)  (2304 + 64 * (j))
#define XB_TOP      3328
#define XB_TOPGEN   3392
#define XCD_BAR_WORDS 3456
#define XB_SPIN_CAP (1u << 22)
__device__ __forceinline__ unsigned xb_ld(unsigned* p)              { return __hip_atomic_load(p, __ATOMIC_RELAXED, __HIP_MEMORY_SCOPE_AGENT); }
__device__ __forceinline__ unsigned xb_add(unsigned* p, unsigned v) { return __hip_atomic_fetch_add(p, v, __ATOMIC_RELAXED, __HIP_MEMORY_SCOPE_AGENT); }
__device__ __forceinline__ unsigned xb_xcc_id() { return (unsigned)__builtin_amdgcn_s_getreg((3 << 11) | 20) & 0xFu; }
#define XB_SPIN(cond, bar) do { unsigned _sp = 0; while (cond) { __builtin_amdgcn_s_sleep(1); \
    if ((++_sp & 255u) == 0u) { if (xb_ld(&(bar)[XB_TMO])) break; if (_sp > XB_SPIN_CAP) { atomicAdd(&(bar)[XB_TMO], 1u); break; } } } } while (0)
struct XcdBarrier { unsigned* bar; unsigned x; volatile LAS unsigned* st; };
__device__ __forceinline__ XcdBarrier xcd_barrier_post(unsigned* bar, volatile LAS unsigned* st) {
    XcdBarrier b; b.bar = bar; b.x = xb_xcc_id(); b.st = st;
    if (threadIdx.x == 0) (void)xb_add(&bar[XB_XCNT(b.x)], 1u);
    return b;
}
__device__ __forceinline__ void xcd_barrier_complete(unsigned* bar, unsigned x, unsigned& nloc, unsigned& nx) {
    const unsigned G = gridDim.x * gridDim.y * gridDim.z;
    unsigned sum, cnt, mine, sp = 0u;
    for (;;) {
        sum = 0u; cnt = 0u; mine = 0u;
#pragma unroll
        for (unsigned j = 0; j < 16; ++j) { const unsigned c = xb_ld(&bar[XB_XCNT(j)]); sum += c; cnt += (c > 0u) ? 1u : 0u; mine = (j == x) ? c : mine; }
        if (sum == G) break;
        __builtin_amdgcn_s_sleep(1);
        if ((++sp & 255u) == 0u) { if (xb_ld(&bar[XB_TMO])) break; if (sp > XB_SPIN_CAP) { atomicAdd(&bar[XB_TMO], 1u); break; } }
    }
    nloc = mine > 0u ? mine : 1u; nx = cnt > 0u ? cnt : 1u;
}
__device__ __forceinline__ void xcd_barrier(const XcdBarrier& b) {
    asm volatile("s_waitcnt vmcnt(0)" ::: "memory");
    __syncthreads();
    if (threadIdx.x == 0) {
        unsigned* bar = b.bar;
        __builtin_amdgcn_s_waitcnt(0);
        unsigned nloc = b.st[0], nx = b.st[1];
        if (nloc == 0u) { xcd_barrier_complete(bar, b.x, nloc, nx); b.st[0] = nloc; b.st[1] = nx; }
        const unsigned old = xb_add(&bar[XB_XSUB(b.x)], 1u);
        const unsigned gen = old / nloc;
        if (old + 1u == (gen + 1u) * nloc) {
            __builtin_amdgcn_fence(__ATOMIC_RELEASE, "agent");
            asm volatile("s_waitcnt vmcnt(0)" ::: "memory");
            const unsigned og = xb_add(&bar[XB_TOP], 1u);
            const unsigned tg = og / nx;
            if (og + 1u == (tg + 1u) * nx) xb_add(&bar[XB_TOPGEN], 1u);
            else XB_SPIN(xb_ld(&bar[XB_TOPGEN]) == tg, bar);
            __builtin_amdgcn_fence(__ATOMIC_ACQUIRE, "agent");
            xb_add(&bar[XB_XGEN(b.x)], 1u);
            asm volatile("s_waitcnt vmcnt(0)" ::: "memory");
        } else {
            XB_SPIN(xb_ld(&bar[XB_XGEN(b.x)]) == gen, bar);
            __builtin_amdgcn_fence(__ATOMIC_ACQUIRE, "agent");
            asm volatile("s_waitcnt vmcnt(0)" ::: "memory");
        }
    }
    __syncthreads();
}

__device__ __forceinline__ Ctx relaunder(const Ctx& C) {
    Ctx D = C; int t = C.tid; asm volatile("" : "+v"(t)); D.tid = t; D.lane = t & 63;
    unsigned char* w = C.ws; float* o = C.out; asm volatile("" : "+s"(w), "+s"(o)); D.ws = as_global(w); D.out = as_global(o); return D;
}
constexpr int NPL = 13, NPH = 2 + 2 * NPL;
__device__ __forceinline__ void run_phase(const Ctx& C0, int ph, bool dry) {
    if (ph == 0) { const Ctx C = relaunder(C0); phase_prep(C); return; }
    if (ph == NPH - 1) { const Ctx C = relaunder(C0); phase_final_norm(C); return; }
    const int l = (ph - 1) / NPL, k = (ph - 1) % NPL;
    switch (k) {
    case 0: { const Ctx C = relaunder(C0); phase_norm(C, l, 0); } break;
    case 1: { const Ctx C = relaunder(C0); CParams& P = *C.P;
#ifdef STAGGER_US
              { const unsigned long long t0 = __builtin_amdgcn_s_memrealtime(); const unsigned long long d = (unsigned long long)((C.bid >> 3) & 3) * (STAGGER_US * 100);
                while (__builtin_amdgcn_s_memrealtime() - t0 < d) __builtin_amdgcn_s_sleep(4); }
#endif
              Epi1 E{WSP(bf16_t, WS_B1), WSP(bf16_t, WS_B2), WSP(bf16_t, WS_B3), WSP(bf16_t, WS_B4), WSP(float, WS_DT), as_global(P.in[IN_DTB]) + l * 16};
              gemm_run(C, WSP(bf16_t, WS_B0), WSP(bf16_t, WS_W1T) + (size_t)l * N1 * DM, nullptr, nullptr, N1, E, dry); } break;
    case 2: { const Ctx C = relaunder(C0); phase_convbc(C, l); } break;
    case 3: { const Ctx C = relaunder(C0); phase_scan(C, l, dry); } break;
    case 4: { const Ctx C = relaunder(C0); Epi2 E{WSP(bf16_t, WS_GS), WSP(bf16_t, WS_GL)};
              gemm_run(C, WSP(bf16_t, WS_B0), WSP(bf16_t, WS_WGT) + (size_t)l * NG * DM, nullptr, nullptr, NG, E, dry); } break;
    case 5: { const Ctx C = relaunder(C0); Epi3 E{WSP(bf16_t, WS_GS), WSP(bf16_t, WS_GL), WSP(float, WS_SSQ), WSP(bf16_t, WS_B0)};
              gemm_run(C, WSP(bf16_t, WS_B1), WSP(bf16_t, WS_WBS) + (size_t)l * DM * DM, WSP(bf16_t, WS_B4), WSP(bf16_t, WS_WBL) + (size_t)l * DM * DM, DM, E, dry); } break;
    case 6: { const Ctx C = relaunder(C0); CParams& P = *C.P; Epi4 E{as_global(P.in[IN_XP]), as_global(P.in[IN_XS]), C.out, WSP(float, WS_MOD) + (size_t)l * NBT * 6144, l};
              gemm_run(C, WSP(bf16_t, WS_B0), WSP(bf16_t, WS_WO) + (size_t)l * DM * DM, nullptr, nullptr, DM, E, dry); } break;
    case 7: { const Ctx C = relaunder(C0); phase_norm(C, l, 1); } break;
    case 8: { const Ctx C = relaunder(C0); Epi5 E{WSP(bf16_t, WS_SC)};
              gemm_run(C, WSP(bf16_t, WS_B0), WSP(bf16_t, WS_WC) + (size_t)l * 2048 * DM, nullptr, nullptr, 2048, E, dry); } break;
    case 9: { const Ctx C = relaunder(C0); phase_topk(C, l); } break;
    case 10: { const Ctx C = relaunder(C0); phase_peer_u(C); } break;
    case 11: { const Ctx C = relaunder(C0); phase_peer_act(C); } break;
    case 12: { const Ctx C = relaunder(C0); phase_peer_v(C, l, dry); } break;
    }
}

__global__ void __launch_bounds__(NTHREADS, 2) fwd(Params P) {
    extern __shared__ __attribute__((aligned(16))) unsigned char lds_raw[];
    const int ph_lo = P.ph_lo, ph_hi = P.ph_hi;
    volatile LAS unsigned* bst = (volatile LAS unsigned*)((LAS unsigned char*)lds_raw + LDS_BYTES - 64);
    if (threadIdx.x == 0) { bst[0] = 0u; bst[1] = 0u; }
    __syncthreads();
    (void)xcd_barrier_post((unsigned*)(P.ws + WS_CTL), bst);
#ifdef PROBE_T
    unsigned long long tm_acc = 0;
#endif
    for (int ph = ph_lo; ph < ph_hi; ++ph) {
        CParams* Pp = (CParams*)__builtin_amdgcn_kernarg_segment_ptr(); asm volatile("" : "+s"(Pp));
        Ctx C; C.P = Pp; C.lds = (LAS unsigned char*)lds_raw;
        int tid = threadIdx.x; asm volatile("" : "+v"(tid));
        unsigned char* ws = Pp->ws; float* out = Pp->out; asm volatile("" : "+s"(ws), "+s"(out));
        C.ws = ws; C.out = out;
        C.tid = tid; C.lane = tid & 63; C.wave = __builtin_amdgcn_readfirstlane(tid >> 6); C.bid = blockIdx.x; C.G = gridDim.x;
#ifdef PROBE_K
        { const bool hit = (PROBE_K == 100) ? ph == 0 : ((PROBE_K == 101) ? ph == NPH - 1 : (ph > 0 && ph < NPH - 1 && (ph - 1) % NPL == PROBE_K));
          if (hit) for (int rep = 0; rep < PROBE_N; ++rep) { run_phase(C, ph, true); __syncthreads(); } }
#endif
#ifdef PROBE_T
        const bool tm_hit = (PROBE_T == 100) ? ph == 0 : ((PROBE_T == 101) ? ph == NPH - 1 : (ph > 0 && ph < NPH - 1 && (ph - 1) % NPL == PROBE_T));
        const unsigned long long tm_t0 = __builtin_amdgcn_s_memrealtime();
#endif
        run_phase(C, ph, false);
        if (ph + 1 < ph_hi) { if (ph == 0) cg::this_grid().sync();
            else { XcdBarrier xb; xb.bar = (unsigned*)(ws + WS_CTL); xb.x = xb_xcc_id(); xb.st = (volatile LAS unsigned*)((LAS unsigned char*)lds_raw + LDS_BYTES - 64); xcd_barrier(xb); } }
#ifdef PROBE_T
        if (tm_hit) tm_acc += __builtin_amdgcn_s_memrealtime() - tm_t0;
#endif
    }
#ifdef PROBE_PREP
    if (blockIdx.x == 0 && threadIdx.x == 0) { const unsigned long long d = *(volatile LAS unsigned long long*)((LAS unsigned char*)lds_raw + LDS_BYTES - 32); const unsigned long long t0 = __builtin_amdgcn_s_memrealtime(); while (__builtin_amdgcn_s_memrealtime() - t0 < 4 * d) __builtin_amdgcn_s_sleep(8); }
#endif
#ifdef PROBE_T
    if (blockIdx.x == 0 && threadIdx.x == 0) { const unsigned long long t0 = __builtin_amdgcn_s_memrealtime(); while (__builtin_amdgcn_s_memrealtime() - t0 < 4 * tm_acc) __builtin_amdgcn_s_sleep(8); }
#endif
}

extern "C" void kernel_launch(void* const* d_in, const int* in_sizes, int n_in, void* d_out, int out_size, void* d_ws, size_t ws_size, hipStream_t stream) {
    static int grid = 0;
    if (grid == 0) {
        if (n_in != N_IN || (size_t)out_size != O_END || ws_size < WS_END) { fprintf(stderr, "kernel_launch: unexpected shapes n_in %d out %d ws %zu (need %zu)\n", n_in, out_size, ws_size, (size_t)WS_END); grid = -1; return; }
        int dev = 0, cus = 0, per_cu = 0;
        hipGetDevice(&dev); hipDeviceGetAttribute(&cus, hipDeviceAttributeMultiprocessorCount, dev);
        hipFuncSetAttribute((const void*)fwd, hipFuncAttributeMaxDynamicSharedMemorySize, LDS_BYTES);
        hipOccupancyMaxActiveBlocksPerMultiprocessor(&per_cu, (const void*)fwd, NTHREADS, LDS_BYTES);
        if (per_cu < 1) { fprintf(stderr, "kernel_launch: occupancy query says %d blocks/CU\n", per_cu); per_cu = 1; }
        grid = cus;
        fprintf(stderr, "kernel_launch: cus %d per_cu %d grid %d ws %zu\n", cus, per_cu, grid, ws_size);
    }
    if (grid < 0) return;
    Params p{};
    for (int i = 0; i < N_IN; ++i) p.in[i] = (const float*)d_in[i];
    p.out = (float*)d_out; p.ws = (unsigned char*)d_ws;
    hipMemsetAsync((char*)d_ws + WS_CTL, 0, 65536, stream);
#if MEGA
    p.ph_lo = 0; p.ph_hi = NPH;
    void* args[] = {&p};
    hipError_t e = hipLaunchCooperativeKernel((const void*)fwd, dim3(grid), dim3(NTHREADS), args, LDS_BYTES, stream);
    if (e != hipSuccess) fprintf(stderr, "cooperative launch failed: %s\n", hipGetErrorString(e));
#else
    for (int ph = 0; ph < NPH; ++ph) { p.ph_lo = ph; p.ph_hi = ph + 1; hipLaunchKernelGGL(fwd, dim3(grid), dim3(NTHREADS), LDS_BYTES, stream, p); }
#endif
}
```
